# Optimizing an MI355X kernel written in HIP

```python
import math
import jax, jax.numpy as jnp
from jax import lax
import numpy as np


D_MODEL = 1024
BATCH = 4
SEQ = 8192
DEPTH = 2

MEM_LEN = 256
SSM_WIDTH = D_MODEL // 2
SSM_GROUP = 16
SSM_GROUPS = SSM_WIDTH // SSM_GROUP
SSM_STATE = 64
DIFF_WIDTH = D_MODEL - SSM_WIDTH
DIFF_HEADS = 4
DIFF_V_DIM = DIFF_WIDTH // DIFF_HEADS
DIFF_QK_DIM = DIFF_V_DIM // 2
MIX_WIDTH = SSM_WIDTH + DIFF_WIDTH
IN_PROJ_WIDTH = SSM_WIDTH + 3 * DIFF_WIDTH
XATTN_HEADS = 4
XATTN_HEAD_DIM = D_MODEL // XATTN_HEADS
D_FF = ((8 * D_MODEL // 3 + 127) // 128) * 128
NUM_BUCKETS = 32
MAX_DISTANCE = 128
Q_BLOCK = 128
EPS = 1e-6

kernel_name = "hybrid_s5_diffattn_macaron_decoder"


def rms_norm(x, gain):
    x32 = x.astype(jnp.float32)
    y = x32 * lax.rsqrt(jnp.mean(x32 * x32, axis=-1, keepdims=True) + EPS)
    return (y * gain.astype(jnp.float32)).astype(x.dtype)


def swiglu(x, w_gate, w_up, w_down):
    return (jax.nn.silu(x @ w_gate) * (x @ w_up)) @ w_down


def rel_bucket(rel):
    n = jnp.maximum(rel, 0)
    max_exact = NUM_BUCKETS // 2
    n_f = jnp.maximum(n, 1).astype(jnp.float32)
    large = max_exact + (jnp.log(n_f / max_exact) / math.log(MAX_DISTANCE / max_exact)
                         * (NUM_BUCKETS - max_exact)).astype(jnp.int32)
    large = jnp.minimum(large, NUM_BUCKETS - 1)
    return jnp.where(n < max_exact, n, large)


def s5_scan(u, lam_re, lam_im, b_re, b_im, c_re, c_im, d, log_dt):
    f32 = jnp.float32
    u32 = u.astype(f32)
    lam = lax.complex(jnp.minimum(lam_re.astype(f32), -1e-4), lam_im.astype(f32))
    dt = jnp.exp(log_dt.astype(f32))[:, None]
    lam_bar = jnp.exp(lam * dt)
    b = lax.complex(b_re.astype(f32), b_im.astype(f32))
    b_bar = ((lam_bar - 1.0) / lam)[:, :, None] * b
    bu = jnp.einsum('gph,blgh->blgp', b_bar, u32.astype(jnp.complex64))
    a = jnp.broadcast_to(lam_bar, (1, u.shape[1]) + lam_bar.shape)

    def combine(e_i, e_j):
        a_i, b_i = e_i
        a_j, b_j = e_j
        return a_j * a_i, a_j * b_i + b_j

    _, states = lax.associative_scan(combine, (a, bu), axis=1)
    c = lax.complex(c_re.astype(f32), c_im.astype(f32))
    return jnp.real(jnp.einsum('ghp,blgp->blgh', c, states)) + d.astype(f32) * u32


def diff_attention(q, k, v, lam, rel_bias):
    f32 = jnp.float32
    B, L = q.shape[0], q.shape[1]
    nb = L // Q_BLOCK
    scale = DIFF_QK_DIM ** -0.5
    k32 = k.astype(f32)
    v32 = v.astype(f32)
    q_blocks = q.astype(f32).reshape(B, nb, Q_BLOCK, DIFF_HEADS, 2, DIFF_QK_DIM).transpose(1, 0, 2, 3, 4, 5)
    starts = jnp.arange(nb, dtype=jnp.int32) * Q_BLOCK
    k_pos = jnp.arange(L, dtype=jnp.int32)
    table = rel_bias.astype(f32)

    def block(args):
        qb, start = args
        rel = (start + jnp.arange(Q_BLOCK, dtype=jnp.int32))[:, None] - k_pos[None, :]
        bias = table[rel_bucket(rel)].transpose(2, 0, 1)
        s = jnp.einsum('bqhmd,bkhmd->bhmqk', qb, k32) * scale + bias[None, :, None]
        s = jnp.where(rel >= 0, s, -jnp.inf)
        p = jax.nn.softmax(s, axis=-1)
        a = p[:, :, 0] - lam * p[:, :, 1]
        return jnp.einsum('bhqk,bkhe->bqhe', a, v32)

    out = lax.map(block, (q_blocks, starts))
    return out.transpose(1, 0, 2, 3, 4).reshape(B, L, DIFF_HEADS, DIFF_V_DIM)


def hybrid_mixer(u, w_in, lam_re, lam_im, b_re, b_im, c_re, c_im, d, log_dt, w_glu, b_glu,
                 ssm_out_norm, lq1, lk1, lq2, lk2, subln, w_out, rel_bias, lam_init):
    f32 = jnp.float32
    B, L, _ = u.shape
    z = u @ w_in
    o0 = SSM_WIDTH
    ssm_in = z[..., :o0].reshape(B, L, SSM_GROUPS, SSM_GROUP)
    q = z[..., o0:o0 + DIFF_WIDTH].reshape(B, L, DIFF_HEADS, 2, DIFF_QK_DIM)
    k = z[..., o0 + DIFF_WIDTH:o0 + 2 * DIFF_WIDTH].reshape(B, L, DIFF_HEADS, 2, DIFF_QK_DIM)
    v = z[..., o0 + 2 * DIFF_WIDTH:].reshape(B, L, DIFF_HEADS, DIFF_V_DIM)

    y = s5_scan(ssm_in, lam_re, lam_im, b_re, b_im, c_re, c_im, d, log_dt).reshape(B, L, SSM_WIDTH)
    y = jax.nn.gelu(y).astype(u.dtype) @ w_glu + b_glu
    y_val, y_gate = jnp.split(y, 2, axis=-1)
    y_ssm = rms_norm(y_val * jax.nn.sigmoid(y_gate), ssm_out_norm)

    lam = (jnp.exp(jnp.sum(lq1.astype(f32) * lk1.astype(f32)))
           - jnp.exp(jnp.sum(lq2.astype(f32) * lk2.astype(f32))) + lam_init)
    o = diff_attention(q, k, v, lam, rel_bias)
    o = rms_norm(o, subln) * (1.0 - lam_init)
    y_attn = o.reshape(B, L, DIFF_WIDTH).astype(u.dtype)

    return jnp.concatenate([y_ssm.astype(u.dtype), y_attn], axis=-1) @ w_out


def memory_cross_attention(hq, m, wq, wkv, wo):
    f32 = jnp.float32
    B, L, _ = hq.shape
    q = (hq @ wq).reshape(B, L, XATTN_HEADS, XATTN_HEAD_DIM)
    kv = (m @ wkv).reshape(B, m.shape[1], 2, XATTN_HEADS, XATTN_HEAD_DIM)
    s = jnp.einsum('bqhd,bkhd->bhqk', q.astype(f32), kv[:, :, 0].astype(f32)) * XATTN_HEAD_DIM ** -0.5
    p = jax.nn.softmax(s, axis=-1)
    o = jnp.einsum('bhqk,bkhd->bqhd', p, kv[:, :, 1].astype(f32)).astype(hq.dtype)
    return o.reshape(B, L, D_MODEL) @ wo


def setup_inputs(seed: int = 0) -> dict:
    key = jax.random.key(seed)
    ks = jax.random.split(key, 40)
    f32 = jnp.float32

    def nrm(k, shape, scale):
        return jax.random.normal(k, shape, f32) * scale

    def gain(k, shape):
        return 1.0 + 0.01 * jax.random.normal(k, shape, f32)

    Lr, D, F, G, P, H = DEPTH, D_MODEL, D_FF, SSM_GROUPS, SSM_STATE, SSM_GROUP
    lam_im0 = jnp.broadcast_to(math.pi * jnp.arange(P, dtype=f32), (Lr, G, P))
    return {
        "x": nrm(ks[0], (BATCH, SEQ, D), 1.0),
        "mem": nrm(ks[1], (BATCH, MEM_LEN, D), 1.0),
        "rel_bias": nrm(ks[2], (NUM_BUCKETS, DIFF_HEADS), 0.5),
        "ffn1_norm": gain(ks[3], (Lr, D)),
        "ffn1_w_gate": nrm(ks[4], (Lr, D, F), D ** -0.5),
        "ffn1_w_up": nrm(ks[5], (Lr, D, F), D ** -0.5),
        "ffn1_w_down": nrm(ks[6], (Lr, F, D), F ** -0.5),
        "mix_norm": gain(ks[7], (Lr, D)),
        "w_in": nrm(ks[8], (Lr, D, IN_PROJ_WIDTH), D ** -0.5),
        "ssm_lambda_re": -0.5 + 0.01 * jax.random.normal(ks[9], (Lr, G, P), f32),
        "ssm_lambda_im": lam_im0 + 0.01 * jax.random.normal(ks[10], (Lr, G, P), f32),
        "ssm_b_re": nrm(ks[11], (Lr, G, P, H), (2.0 * H) ** -0.5),
        "ssm_b_im": nrm(ks[12], (Lr, G, P, H), (2.0 * H) ** -0.5),
        "ssm_c_re": nrm(ks[13], (Lr, G, H, P), (2.0 * P) ** -0.5),
        "ssm_c_im": nrm(ks[14], (Lr, G, H, P), (2.0 * P) ** -0.5),
        "ssm_d": nrm(ks[15], (Lr, G, H), 1.0),
        "ssm_log_dt": jax.random.uniform(ks[16], (Lr, G), f32, math.log(1e-3), math.log(1e-1)),
        "ssm_w_glu": nrm(ks[17], (Lr, SSM_WIDTH, 2 * SSM_WIDTH), SSM_WIDTH ** -0.5),
        "ssm_b_glu": nrm(ks[18], (Lr, 2 * SSM_WIDTH), 0.01),
        "ssm_out_norm": gain(ks[19], (Lr, SSM_WIDTH)),
        "diff_lambda_q1": nrm(ks[20], (Lr, DIFF_QK_DIM), 0.1),
        "diff_lambda_k1": nrm(ks[21], (Lr, DIFF_QK_DIM), 0.1),
        "diff_lambda_q2": nrm(ks[22], (Lr, DIFF_QK_DIM), 0.1),
        "diff_lambda_k2": nrm(ks[23], (Lr, DIFF_QK_DIM), 0.1),
        "diff_subln": gain(ks[24], (Lr, DIFF_V_DIM)),
        "w_out": nrm(ks[25], (Lr, MIX_WIDTH, D), MIX_WIDTH ** -0.5),
        "xattn_norm": gain(ks[26], (Lr, D)),
        "mem_norm": gain(ks[27], (Lr, D)),
        "xattn_wq": nrm(ks[28], (Lr, D, D), D ** -0.5),
        "xattn_wkv": nrm(ks[29], (Lr, D, 2 * D), D ** -0.5),
        "xattn_wo": nrm(ks[30], (Lr, D, D), D ** -0.5),
        "ffn2_norm": gain(ks[31], (Lr, D)),
        "ffn2_w_gate": nrm(ks[32], (Lr, D, F), D ** -0.5),
        "ffn2_w_up": nrm(ks[33], (Lr, D, F), D ** -0.5),
        "ffn2_w_down": nrm(ks[34], (Lr, F, D), F ** -0.5),
        "final_norm": gain(ks[35], (D,)),
    }


def reference(x, mem, rel_bias, ffn1_norm, ffn1_w_gate, ffn1_w_up, ffn1_w_down, mix_norm, w_in,
              ssm_lambda_re, ssm_lambda_im, ssm_b_re, ssm_b_im, ssm_c_re, ssm_c_im, ssm_d,
              ssm_log_dt, ssm_w_glu, ssm_b_glu, ssm_out_norm, diff_lambda_q1, diff_lambda_k1,
              diff_lambda_q2, diff_lambda_k2, diff_subln, w_out, xattn_norm, mem_norm, xattn_wq,
              xattn_wkv, xattn_wo, ffn2_norm, ffn2_w_gate, ffn2_w_up, ffn2_w_down, final_norm):
    h = x
    for l in range(DEPTH):
        lam_init = 0.8 - 0.6 * math.exp(-0.3 * l)
        h = h + 0.5 * swiglu(rms_norm(h, ffn1_norm[l]), ffn1_w_gate[l], ffn1_w_up[l], ffn1_w_down[l])
        h = h + hybrid_mixer(rms_norm(h, mix_norm[l]), w_in[l], ssm_lambda_re[l], ssm_lambda_im[l],
                             ssm_b_re[l], ssm_b_im[l], ssm_c_re[l], ssm_c_im[l], ssm_d[l],
                             ssm_log_dt[l], ssm_w_glu[l], ssm_b_glu[l], ssm_out_norm[l],
                             diff_lambda_q1[l], diff_lambda_k1[l], diff_lambda_q2[l],
                             diff_lambda_k2[l], diff_subln[l], w_out[l], rel_bias, lam_init)
        h = h + memory_cross_attention(rms_norm(h, xattn_norm[l]), rms_norm(mem, mem_norm[l]),
                                       xattn_wq[l], xattn_wkv[l], xattn_wo[l])
        h = h + 0.5 * swiglu(rms_norm(h, ffn2_norm[l]), ffn2_w_gate[l], ffn2_w_up[l], ffn2_w_down[l])
    return rms_norm(h, final_norm)
```

```cpp
#include <hip/hip_runtime.h>
#include <hip/hip_cooperative_groups.h>
#include <cstdio>
#include <cstdint>
namespace cg = cooperative_groups;

#define LAS __attribute__((address_space(3)))
typedef unsigned short bf16_t;
typedef short bf16x8 __attribute__((ext_vector_type(8)));
typedef float f32x4 __attribute__((ext_vector_type(4)));
typedef float f32x2 __attribute__((ext_vector_type(2)));
typedef unsigned u32x4 __attribute__((ext_vector_type(4)));
typedef unsigned u32x2 __attribute__((ext_vector_type(2)));
typedef __bf16 bf16x2_t __attribute__((ext_vector_type(2)));

#ifndef DEBUG_CHECK
#define DEBUG_CHECK 0
#endif

constexpr int D = 1024, BATCH = 4, SEQ = 8192, T = BATCH * SEQ, DEPTH = 2, MEM = 256, FF = 2816;
constexpr int SSMW = 512, NG = 32, NP = 64, CH = 32  , NCH = SEQ / CH  , UPW = 640  ;
constexpr float EPS = 1e-6f, LOG2E = 1.4426950408889634f;

constexpr size_t MiB = 1u << 20;
constexpr size_t WS_CTL = 0;
constexpr size_t WS_SS = 1 * MiB;
constexpr size_t WS_SSM_SS = WS_SS + 9 * (size_t)T * 4;
constexpr size_t WS_SMALL = 3 * MiB;
constexpr size_t WS_MEMN = 4 * MiB;
constexpr size_t WS_KX = 8 * MiB;
constexpr size_t WS_VXT = 12 * MiB;
constexpr size_t WS_W = 16 * MiB, W_LAYER = 76 * MiB;
constexpr size_t W_GU1 = 0, W_D1 = 11 * MiB, W_GU2 = 16 * MiB + MiB / 2, W_D2 = 27 * MiB + MiB / 2, W_IN = 33 * MiB, W_GLU = 37 * MiB, W_OUT = 38 * MiB,
                 W_Q = 40 * MiB, W_KV = 42 * MiB, W_O = 46 * MiB, W_BM = 48 * MiB, W_MT = 56 * MiB;
constexpr size_t WS_HB = WS_W + 2 * W_LAYER;
constexpr size_t WS_AR = WS_HB + 64 * MiB;
constexpr size_t AR_UP = 0, AR_Q = 40 * MiB, AR_K = 72 * MiB, AR_VT = 104 * MiB, AR_Y = 136 * MiB, AR_MIX = 168 * MiB;
constexpr size_t AR_QX = 0, AR_P = 64 * MiB, AR_OX = 128 * MiB, AR_HID = 0;
constexpr size_t WS_END = WS_AR + 234 * MiB;

constexpr int LDS_BYTES = 147456;
constexpr int LDS_RED = 131072;

struct Args { const float* in[36]; float* out; unsigned char* ws; };
typedef const __attribute__((address_space(4))) Args* KArgsP;
#define KARGS() ({ KArgsP _p = (KArgsP)__builtin_amdgcn_kernarg_segment_ptr(); asm volatile("" : "+s"(_p)); _p; })

__device__ __forceinline__ unsigned cvtpk(float lo, float hi) { f32x2 v = {lo, hi}; bf16x2_t b = __builtin_convertvector(v, bf16x2_t); return __builtin_bit_cast(unsigned, b); }
__device__ __forceinline__ float bf2f(bf16_t x) { return __uint_as_float((unsigned)x << 16); }
__device__ __forceinline__ float wave_sum(float v) {
#pragma unroll
    for (int o = 1; o < 64; o <<= 1) v += __shfl_xor(v, o);
    return v;
}
__device__ __forceinline__ float fq_sum(float v) { v += __shfl_xor(v, 16); v += __shfl_xor(v, 32); return v; }
__device__ __forceinline__ float fq_max(float v) { v = fmaxf(v, __shfl_xor(v, 16)); v = fmaxf(v, __shfl_xor(v, 32)); return v; }
__device__ __forceinline__ u32x4 pack8(f32x4 a, f32x4 b) { u32x4 w; w.x = cvtpk(a[0], a[1]); w.y = cvtpk(a[2], a[3]); w.z = cvtpk(b[0], b[1]); w.w = cvtpk(b[2], b[3]); return w; }
__device__ __forceinline__ float fast_exp2(float x) { return __builtin_amdgcn_exp2f(x); }
__device__ __forceinline__ float fast_rcp(float x) { return __builtin_amdgcn_rcpf(x); }
__device__ __forceinline__ float sigmoidf_(float x) { return fast_rcp(1.f + fast_exp2(-x * LOG2E)); }

constexpr int BM = 256, BK = 64, HALF = 128, HTB = HALF * BK * 2, NXCD = 8, WGM = 8;
__host__ __device__ __forceinline__ int lds_byte(int r, int c) { const int st = (r >> 4) * 2 + (c >> 5), rr = r & 15, cc = c & 31, ob = rr * 64 + cc * 2; return st * 1024 + (ob ^ (((ob >> 9) & 1) << 5)); }
__host__ __device__ __forceinline__ void stage_rc(int b, int& R, int& C) { const int st = b / 1024, sb = b % 1024, swz = sb ^ (((sb >> 9) & 1) << 5); R = (st >> 1) * 16 + swz / 64; C = (st & 1) * 32 + (swz % 64) / 2; }
__host__ __device__ __forceinline__ int perm32(int rho) { const int n = rho >> 4, i = rho & 15; return 8 * (i >> 2) + 4 * n + (i & 3); }

struct Unit { int pm, pn, bz; unsigned a_off, b_off; };

struct StdSched {
    int nM, nN, nwg, G, c, lda, ldb;
    __device__ void init(int M, int N, int G_, int c_, int lda_, int ldb_) { nM = M / BM; nN = N / BM; nwg = nM * nN; G = G_; c = c_; lda = lda_; ldb = ldb_; }
    __device__ bool next(int i, Unit& u) const {
        const long L = (long)i * G + c; if (L >= nwg) return false;
        int wgid = (int)L; { const int q = nwg / NXCD, r = nwg % NXCD, xcd = wgid % NXCD, off = wgid / NXCD; wgid = (xcd < r ? xcd * (q + 1) : r * (q + 1) + (xcd - r) * q) + off; }
        const int nig = WGM * nN, gid = wgid / nig, fm = gid * WGM, gsz = (nM - fm) < WGM ? (nM - fm) : WGM;
        u.pm = fm + ((wgid % nig) % gsz); u.pn = (wgid % nig) / gsz; u.bz = 0;
        u.a_off = (unsigned)(u.pm * BM) * (unsigned)lda; u.b_off = (unsigned)(u.pn * BM) * (unsigned)ldb; return true;
    }
};
struct Ssm1Sched {
    int c;
    __device__ bool next(int i, Unit& u) const {
        if (i > 0 || c >= BATCH * NG) return false;
        u.pm = 0; u.pn = 0; u.bz = c; u.a_off = (unsigned)c * NCH * UPW; u.b_off = (unsigned)(c & 31) * 256 * 512; return true;
    }
};
struct WkvSched {
    int G, c;
    __device__ bool next(int i, Unit& u) const {
        if (c < 128) return false;
        const int L = (c - 128) + i * (G - 128); if (L >= 64) return false;
        const int layer = L >> 5, rem = L & 31; u.pm = rem >> 3; u.pn = rem & 7; u.bz = layer;
        u.a_off = (unsigned)layer * 1024 * 1024 + (unsigned)u.pm * 256 * 1024; u.b_off = (unsigned)layer * (unsigned)(W_LAYER / 2) + (unsigned)u.pn * 256 * 1024; return true;
    }
};
struct Ssm2Sched {
    int G, c;
    __device__ bool next(int i, Unit& u) const {
        const int L = c + i * G; if (L >= 2 * BATCH * NG) return false;
        u.bz = L >> 1; u.pn = L & 1; u.pm = 0; u.a_off = (unsigned)u.bz * NCH * UPW; u.b_off = ((unsigned)(u.bz & 31) * 512 + (unsigned)u.pn * 256) * UPW; return true;
    }
};
struct XaSched {
    int G, c; unsigned bs_b, bs_h;
    __device__ bool next(int i, Unit& u) const {
        const int L = c + i * G; if (L >= 512) return false;
        const int bh = L >> 5; u.pm = L & 31; u.pn = 0; u.bz = bh; const int b = bh >> 2, h = bh & 3;
        u.a_off = ((unsigned)(b * SEQ + u.pm * 256)) * 1024 + h * 256; u.b_off = (unsigned)b * bs_b + (unsigned)h * bs_h; return true;
    }
};

template <class Epi, class Sched, bool ALIGN_EPI>
__device__ __forceinline__ void gemm_phase(LAS unsigned char* lds, const bf16_t* Ab, const bf16_t* Bb, int lda, int ldb, int K, const Sched& S, Epi& E) {
    int tid = threadIdx.x; asm volatile("" : "+v"(tid));
    const int wid = __builtin_amdgcn_readfirstlane(tid >> 6), lane = tid & 63, wr = wid >> 2, wc = wid & 3, fr = lane & 15, fq = lane >> 4;
    const int nt = K / BK;
    unsigned voffA[2], voffB[2]; int aoff, boff;
#define PG8_LANEOFFS(tt) do { _Pragma("unroll") for (int i = 0; i < 2; ++i) { int R, C; stage_rc((tt) * 16 + i * 8192, R, C); const int Rb = (R & ~31) + perm32(R & 31); \
        voffA[i] = (unsigned)(R * lda + C) * 2u; voffB[i] = (unsigned)(Rb * ldb + C) * 2u; } \
        aoff = lds_byte(wr * 64 + ((tt) & 15), (((tt) >> 4) & 3) * 8); boff = lds_byte(wc * 32 + ((tt) & 15), (((tt) >> 4) & 3) * 8); } while (0)
    PG8_LANEOFFS(tid);
    const unsigned kstep = (unsigned)(BK * 2);
    const unsigned hstepA = (unsigned)HALF * lda * 2, hstepB = (unsigned)HALF * ldb * 2;
    const unsigned ldsw = (unsigned)wid * 1024u;
#define PG8_SA(b, h) (((b) * 2 + (h)) * HTB)
#define PG8_SB(b, h) ((4 + (b) * 2 + (h)) * HTB)
#define PG8_STAGE(bufoff, gbase, voff) do { _Pragma("unroll") for (int _i = 0; _i < 2; ++_i) \
        __builtin_amdgcn_global_load_lds((const unsigned*)((const char*)(gbase) + (voff)[_i]), (LAS unsigned*)(lds + (bufoff) + ldsw + _i * 8192), 16, 0, 0); } while (0)
#define PG8_LDA(dst, b, h) do { _Pragma("unroll") for (int m = 0; m < 4; ++m) _Pragma("unroll") for (int k = 0; k < 2; ++k) dst[m][k] = *(const LAS bf16x8*)(lds + PG8_SA(b, h) + aoff + m * 2048 + k * 1024); } while (0)
#define PG8_LDB(dst, b, h) do { _Pragma("unroll") for (int n = 0; n < 2; ++n) _Pragma("unroll") for (int k = 0; k < 2; ++k) dst[n][k] = *(const LAS bf16x8*)(lds + PG8_SB(b, h) + boff + n * 2048 + k * 1024); } while (0)
#define PG8_MMA(ai, bj, At, Bt) do { __builtin_amdgcn_s_setprio(1); _Pragma("unroll") for (int m = 0; m < 4; ++m) _Pragma("unroll") for (int n = 0; n < 2; ++n) _Pragma("unroll") for (int k = 0; k < 2; ++k) \
        acc[ai][bj][m][n] = __builtin_amdgcn_mfma_f32_16x16x32_bf16(Bt[n][k], At[m][k], acc[ai][bj][m][n], 0, 0, 0); __builtin_amdgcn_s_setprio(0); } while (0)
#define PG8_WAIT_V(n) asm volatile("s_waitcnt vmcnt(" #n ")" ::: "memory")
#define PG8_WAIT_L(n) asm volatile("s_waitcnt lgkmcnt(" #n ")" ::: "memory")
#define PG8_BAR __builtin_amdgcn_s_barrier()
#define PG8_SCHED __builtin_amdgcn_sched_barrier(0)
    Unit cur, nxt; int ui = 0;
    if (!S.next(0, cur)) return;
    f32x4 acc[2][2][4][2];
#pragma unroll
    for (int a = 0; a < 2; ++a)
#pragma unroll
        for (int b = 0; b < 2; ++b)
#pragma unroll
            for (int m = 0; m < 4; ++m)
#pragma unroll
                for (int n = 0; n < 2; ++n) acc[a][b][m][n] = (f32x4){0.f, 0.f, 0.f, 0.f};
    bf16x8 At[4][2], B0[2][2], B1[2][2];
    const char* cA = (const char*)(Ab + cur.a_off); const char* cB = (const char*)(Bb + cur.b_off);
    PG8_STAGE(PG8_SB(0, 0), cB, voffB); PG8_STAGE(PG8_SB(0, 1), cB + hstepB, voffB); PG8_STAGE(PG8_SA(0, 0), cA, voffA); PG8_STAGE(PG8_SA(0, 1), cA + hstepA, voffA);
    if (wr == 1) PG8_BAR;
    PG8_WAIT_V(2); PG8_BAR;
    PG8_STAGE(PG8_SB(1, 0), cB + kstep, voffB); PG8_STAGE(PG8_SA(1, 0), cA + kstep, voffA); PG8_STAGE(PG8_SB(1, 1), cB + hstepB + kstep, voffB);
    PG8_WAIT_V(6); PG8_BAR;
    for (;;) {
        const bool has_next = S.next(ui + 1, nxt);
        const char* nA = has_next ? (const char*)(Ab + nxt.a_off) : cA; const char* nB = has_next ? (const char*)(Bb + nxt.b_off) : cB;
        for (int t = 0; t < nt; t += 2) {
            const bool last = (t == nt - 2);
            const char* a1 = cA + (unsigned)(t + 1) * kstep;
            const char* a2 = last ? nA : cA + (unsigned)(t + 2) * kstep; const char* b2 = last ? nB : cB + (unsigned)(t + 2) * kstep;
            const char* a3 = a2 + kstep; const char* b3 = b2 + kstep;
            PG8_LDB(B0, 0, 0); PG8_LDB(B1, 0, 1); PG8_SCHED; PG8_LDA(At, 0, 0); PG8_STAGE(PG8_SA(1, 1), a1 + hstepA, voffA);
            PG8_WAIT_V(8); PG8_WAIT_L(0); PG8_BAR; PG8_MMA(0, 0, At, B0); PG8_MMA(0, 1, At, B1); PG8_BAR; PG8_SCHED;
            PG8_LDA(At, 0, 1); PG8_STAGE(PG8_SB(0, 0), b2, voffB); PG8_STAGE(PG8_SB(0, 1), b2 + hstepB, voffB); PG8_STAGE(PG8_SA(0, 0), a2, voffA);
            PG8_WAIT_V(8); PG8_WAIT_L(0); PG8_BAR; PG8_MMA(1, 0, At, B0); PG8_MMA(1, 1, At, B1); PG8_BAR; PG8_SCHED;
            PG8_LDB(B0, 1, 0); PG8_LDB(B1, 1, 1); PG8_SCHED; PG8_LDA(At, 1, 0); PG8_STAGE(PG8_SA(0, 1), a2 + hstepA, voffA);
            PG8_WAIT_V(8); PG8_WAIT_L(0); PG8_BAR; PG8_MMA(0, 0, At, B0); PG8_MMA(0, 1, At, B1); PG8_BAR; PG8_SCHED;
            PG8_LDA(At, 1, 1); PG8_STAGE(PG8_SB(1, 0), b3, voffB); PG8_STAGE(PG8_SB(1, 1), b3 + hstepB, voffB); PG8_STAGE(PG8_SA(1, 0), a3, voffA);
            PG8_WAIT_V(8); PG8_WAIT_L(0); PG8_BAR; PG8_MMA(1, 0, At, B0); PG8_MMA(1, 1, At, B1); PG8_BAR; PG8_SCHED;
        }
        if constexpr (ALIGN_EPI) { if (wr == 0) PG8_BAR; }
        if constexpr (!Epi::AFTER_DRAIN) { int t2 = threadIdx.x; asm volatile("" : "+v"(t2)); E(acc, cur, wr, wc, t2 & 15, (t2 >> 4) & 3); }
        if (!has_next) break;
#pragma unroll
        for (int a = 0; a < 2; ++a)
#pragma unroll
            for (int b = 0; b < 2; ++b)
#pragma unroll
                for (int m = 0; m < 4; ++m)
#pragma unroll
                    for (int n = 0; n < 2; ++n) acc[a][b][m][n] = (f32x4){0.f, 0.f, 0.f, 0.f};
        cur = nxt; cA = nA; cB = nB; ++ui;
        { int t3 = threadIdx.x; asm volatile("" : "+v"(t3)); PG8_LANEOFFS(t3); }
        if constexpr (ALIGN_EPI) { if (wr == 1) PG8_BAR; }
    }
    PG8_WAIT_V(0);
    if constexpr (!ALIGN_EPI) { if (wr == 0) PG8_BAR; }
    PG8_BAR;
    if constexpr (Epi::AFTER_DRAIN) { E.fused(acc, cur, wr, wc, fr, fq, lds, wid, lane); }
#undef PG8_LANEOFFS
#undef PG8_SA
#undef PG8_SB
#undef PG8_STAGE
#undef PG8_LDA
#undef PG8_LDB
#undef PG8_MMA
#undef PG8_WAIT_V
#undef PG8_WAIT_L
#undef PG8_BAR
#undef PG8_SCHED
}

typedef f32x4 (&AccRef)[2][2][4][2];

struct EpiFfnUp {
    static constexpr bool AFTER_DRAIN = false;
    bf16_t* H; const float* ss;
    __device__ __forceinline__ void operator()(AccRef acc, const Unit& u, int wr, int wc, int fr, int fq) const {
#pragma unroll
        for (int ai = 0; ai < 2; ++ai)
#pragma unroll
            for (int m = 0; m < 4; ++m) {
                const int row = u.pm * 256 + ai * 128 + wr * 64 + m * 16 + fr;
                const float rs = rsqrtf(ss[row] * (1.f / D) + EPS);
                f32x4 o[2];
#pragma unroll
                for (int n = 0; n < 2; ++n)
#pragma unroll
                    for (int j = 0; j < 4; ++j) { const float g = acc[ai][0][m][n][j] * rs, up = acc[ai][1][m][n][j] * rs; o[n][j] = g * sigmoidf_(g) * up; }
                *(u32x4*)(H + (size_t)row * FF + u.pn * 128 + wc * 32 + 8 * fq) = pack8(o[0], o[1]);
            }
    }
};
struct EpiResid {
    static constexpr bool AFTER_DRAIN = false;
    const float* hin; float* hout; bf16_t* hb; float* ssn; float scale;
    __device__ __forceinline__ void operator()(AccRef acc, const Unit& u, int wr, int wc, int fr, int fq) const {
#pragma unroll
        for (int ai = 0; ai < 2; ++ai)
#pragma unroll
            for (int m = 0; m < 4; ++m) {
                const int row = u.pm * 256 + ai * 128 + wr * 64 + m * 16 + fr; float part = 0.f;
#pragma unroll
                for (int bj = 0; bj < 2; ++bj) {
                    const size_t idx = (size_t)row * D + u.pn * 256 + bj * 128 + wc * 32 + 8 * fq;
                    const f32x4 o0 = *(const f32x4*)(hin + idx), o1 = *(const f32x4*)(hin + idx + 4);
                    const f32x4 v0 = o0 + acc[ai][bj][m][0] * scale, v1 = o1 + acc[ai][bj][m][1] * scale;
                    *(f32x4*)(hout + idx) = v0; *(f32x4*)(hout + idx + 4) = v1;
                    *(u32x4*)(hb + idx) = pack8(v0, v1);
                    part += (v0[0] * v0[0] + v0[1] * v0[1]) + (v0[2] * v0[2] + v0[3] * v0[3]) + (v1[0] * v1[0] + v1[1] * v1[1]) + (v1[2] * v1[2] + v1[3] * v1[3]);
                }
                part = fq_sum(part);
                if (fq == 0) atomicAdd(ssn + row, part);
            }
    }
};
struct EpiWin {
    static constexpr bool AFTER_DRAIN = false;
    unsigned char* arp; const float* ss;
    __device__ __forceinline__ void operator()(AccRef acc, const Unit& u, int wr, int wc, int fr, int fq) const {
        bf16_t* up = (bf16_t*)(arp + AR_UP); bf16_t* qb = (bf16_t*)(arp + AR_Q); bf16_t* kb = (bf16_t*)(arp + AR_K); bf16_t* vt = (bf16_t*)(arp + AR_VT);
        const int sel = u.pn >> 1;
#pragma unroll
        for (int ai = 0; ai < 2; ++ai)
#pragma unroll
            for (int m = 0; m < 4; ++m) {
                const int row = u.pm * 256 + ai * 128 + wr * 64 + m * 16 + fr;
                float rs = rsqrtf(ss[row] * (1.f / D) + EPS);
                if (sel == 1) rs *= 0.125f * LOG2E;
                const int b = row >> 13, t = row & (SEQ - 1);
#pragma unroll
                for (int bj = 0; bj < 2; ++bj) {
                    const int c = (u.pn & 1) * 256 + bj * 128 + wc * 32 + 8 * fq;
                    const f32x4 v0 = acc[ai][bj][m][0] * rs, v1 = acc[ai][bj][m][1] * rs;
                    if (sel == 0) { const int g = c >> 4, hi0 = c & 15;
                        *(u32x4*)(up + ((size_t)((b * NG + g) * NCH + (t >> 5))) * UPW + (t & 31) * 16 + hi0) = pack8(v0, v1);
                    } else if (sel == 1) { *(u32x4*)(qb + (size_t)row * 512 + c) = pack8(v0, v1);
                    } else if (sel == 2) { *(u32x4*)(kb + (size_t)row * 512 + c) = pack8(v0, v1);
                    } else { const int h = c >> 7, dv = c & 127; bf16_t* p = vt + ((size_t)((b * 4 + h) * 128 + dv)) * SEQ + t;
                        const u32x4 w = pack8(v0, v1);
                        p[0] = (bf16_t)(w.x & 0xffff); p[SEQ] = (bf16_t)(w.x >> 16); p[2 * SEQ] = (bf16_t)(w.y & 0xffff); p[3 * SEQ] = (bf16_t)(w.y >> 16);
                        p[4 * SEQ] = (bf16_t)(w.z & 0xffff); p[5 * SEQ] = (bf16_t)(w.z >> 16); p[6 * SEQ] = (bf16_t)(w.w & 0xffff); p[7 * SEQ] = (bf16_t)(w.w >> 16);
                    }
                }
            }
    }
};
__device__ __forceinline__ float gelu_tanh(float x) { const float z = 0.7978845608028654f * (x + 0.044715f * x * x * x); return x * fast_rcp(1.f + fast_exp2(-2.f * LOG2E * z)); }
struct EpiSsm2 {
    static constexpr bool AFTER_DRAIN = false;
    bf16_t* yb;
    __device__ __forceinline__ void operator()(AccRef acc, const Unit& u, int wr, int wc, int fr, int fq) const {
        const int b = u.bz >> 5, g = u.bz & 31;
#pragma unroll
        for (int ai = 0; ai < 2; ++ai)
#pragma unroll
            for (int m = 0; m < 4; ++m) {
                const int ch = ai * 128 + wr * 64 + m * 16 + fr;
#pragma unroll
                for (int bj = 0; bj < 2; ++bj) {
                    const int cc = u.pn * 256 + bj * 128 + wc * 32 + 8 * fq, t = cc >> 4, ho0 = cc & 15;
                    f32x4 v0, v1;
#pragma unroll
                    for (int j = 0; j < 4; ++j) { v0[j] = gelu_tanh(acc[ai][bj][m][0][j]); v1[j] = gelu_tanh(acc[ai][bj][m][1][j]); }
                    *(u32x4*)(yb + ((size_t)(b * SEQ + ch * CH + t)) * 512 + g * 16 + ho0) = pack8(v0, v1);
                }
            }
    }
};
struct EpiGlu {
    static constexpr bool AFTER_DRAIN = false;
    bf16_t* mix; const float* bglu; float* ssq;
    __device__ __forceinline__ void operator()(AccRef acc, const Unit& u, int wr, int wc, int fr, int fq) const {
        const int c0 = u.pn * 128 + wc * 32 + 8 * fq;
        const f32x4 bv0 = *(const f32x4*)(bglu + c0), bv1 = *(const f32x4*)(bglu + c0 + 4), bg0 = *(const f32x4*)(bglu + 512 + c0), bg1 = *(const f32x4*)(bglu + 512 + c0 + 4);
#pragma unroll
        for (int ai = 0; ai < 2; ++ai)
#pragma unroll
            for (int m = 0; m < 4; ++m) {
                const int row = u.pm * 256 + ai * 128 + wr * 64 + m * 16 + fr;
                f32x4 o0, o1; float part = 0.f;
#pragma unroll
                for (int j = 0; j < 4; ++j) {
                    o0[j] = (acc[ai][0][m][0][j] + bv0[j]) * sigmoidf_(acc[ai][1][m][0][j] + bg0[j]);
                    o1[j] = (acc[ai][0][m][1][j] + bv1[j]) * sigmoidf_(acc[ai][1][m][1][j] + bg1[j]);
                    part += o0[j] * o0[j] + o1[j] * o1[j];
                }
                *(u32x4*)(mix + (size_t)row * D + c0) = pack8(o0, o1);
                part = fq_sum(part);
                if (fq == 0) atomicAdd(ssq + row, part);
            }
    }
};
struct EpiWq {
    static constexpr bool AFTER_DRAIN = false;
    bf16_t* O; const float* ss; float mul;
    __device__ __forceinline__ void operator()(AccRef acc, const Unit& u, int wr, int wc, int fr, int fq) const {
#pragma unroll
        for (int ai = 0; ai < 2; ++ai)
#pragma unroll
            for (int m = 0; m < 4; ++m) {
                const int row = u.pm * 256 + ai * 128 + wr * 64 + m * 16 + fr;
                const float rs = rsqrtf(ss[row] * (1.f / D) + EPS) * mul;
#pragma unroll
                for (int bj = 0; bj < 2; ++bj)
                    *(u32x4*)(O + (size_t)row * D + u.pn * 256 + bj * 128 + wc * 32 + 8 * fq) = pack8(acc[ai][bj][m][0] * rs, acc[ai][bj][m][1] * rs);
            }
    }
};
struct EpiWkv {
    static constexpr bool AFTER_DRAIN = false;
    bf16_t *kx, *vxt;
    __device__ __forceinline__ void operator()(AccRef acc, const Unit& u, int wr, int wc, int fr, int fq) const {
        const size_t lo = (size_t)u.bz * 1024 * 1024;
#pragma unroll
        for (int ai = 0; ai < 2; ++ai)
#pragma unroll
            for (int m = 0; m < 4; ++m) {
                const int row = u.pm * 256 + ai * 128 + wr * 64 + m * 16 + fr;
#pragma unroll
                for (int bj = 0; bj < 2; ++bj) {
                    const int col = u.pn * 256 + bj * 128 + wc * 32 + 8 * fq;
                    const u32x4 w = pack8(acc[ai][bj][m][0], acc[ai][bj][m][1]);
                    if (u.pn < 4) *(u32x4*)(kx + lo + (size_t)row * 1024 + col) = w;
                    else { const int c2 = col - 1024, h = c2 >> 8, d = c2 & 255, b = row >> 8, mm = row & 255;
                        bf16_t* p = vxt + lo + ((size_t)((b * 4 + h) * 256 + d)) * 256 + mm;
                        p[0] = (bf16_t)(w.x & 0xffff); p[256] = (bf16_t)(w.x >> 16); p[512] = (bf16_t)(w.y & 0xffff); p[768] = (bf16_t)(w.y >> 16);
                        p[1024] = (bf16_t)(w.z & 0xffff); p[1280] = (bf16_t)(w.z >> 16); p[1536] = (bf16_t)(w.w & 0xffff); p[1792] = (bf16_t)(w.w >> 16); }
                }
            }
    }
};
struct EpiSoftmax {
    static constexpr bool AFTER_DRAIN = false;
    bf16_t* P; LAS float* red;
    __device__ __forceinline__ void operator()(AccRef acc, const Unit& u, int wr, int wc, int fr, int fq) const {
        const int b = u.bz >> 2, h = u.bz & 3;
        float mx[2][4];
#pragma unroll
        for (int ai = 0; ai < 2; ++ai)
#pragma unroll
            for (int m = 0; m < 4; ++m) {
                float v = -INFINITY;
#pragma unroll
                for (int bj = 0; bj < 2; ++bj)
#pragma unroll
                    for (int n = 0; n < 2; ++n)
#pragma unroll
                        for (int j = 0; j < 4; ++j) v = fmaxf(v, acc[ai][bj][m][n][j]);
                v = fq_max(v);
                const int rl = ai * 128 + wr * 64 + m * 16 + fr;
                if (fq == 0) red[rl * 4 + wc] = v;
            }
        asm volatile("s_waitcnt lgkmcnt(0)" ::: "memory"); __builtin_amdgcn_s_barrier(); asm volatile("" ::: "memory");
#pragma unroll
        for (int ai = 0; ai < 2; ++ai)
#pragma unroll
            for (int m = 0; m < 4; ++m) {
                const int rl = ai * 128 + wr * 64 + m * 16 + fr;
                const f32x4 r4 = *(const LAS f32x4*)(red + rl * 4);
                const float M = fmaxf(fmaxf(r4[0], r4[1]), fmaxf(r4[2], r4[3]));
                float s = 0.f;
#pragma unroll
                for (int bj = 0; bj < 2; ++bj)
#pragma unroll
                    for (int n = 0; n < 2; ++n)
#pragma unroll
                        for (int j = 0; j < 4; ++j) { const float p = fast_exp2(acc[ai][bj][m][n][j] - M); acc[ai][bj][m][n][j] = p; s += p; }
                s = fq_sum(s);
                if (fq == 0) red[1024 + rl * 4 + wc] = s;
            }
        asm volatile("s_waitcnt lgkmcnt(0)" ::: "memory"); __builtin_amdgcn_s_barrier(); asm volatile("" ::: "memory");
#pragma unroll
        for (int ai = 0; ai < 2; ++ai)
#pragma unroll
            for (int m = 0; m < 4; ++m) {
                const int rl = ai * 128 + wr * 64 + m * 16 + fr;
                const f32x4 r4 = *(const LAS f32x4*)(red + 1024 + rl * 4);
                const float inv = 1.f / ((r4[0] + r4[1]) + (r4[2] + r4[3]));
                const size_t row = (size_t)b * SEQ + u.pm * 256 + rl;
#pragma unroll
                for (int bj = 0; bj < 2; ++bj)
                    *(u32x4*)(P + row * D + h * 256 + bj * 128 + wc * 32 + 8 * fq) = pack8(acc[ai][bj][m][0] * inv, acc[ai][bj][m][1] * inv);
            }
    }
};
struct EpiPV {
    static constexpr bool AFTER_DRAIN = false;
    bf16_t* O;
    __device__ __forceinline__ void operator()(AccRef acc, const Unit& u, int wr, int wc, int fr, int fq) const {
        const int b = u.bz >> 2, h = u.bz & 3;
#pragma unroll
        for (int ai = 0; ai < 2; ++ai)
#pragma unroll
            for (int m = 0; m < 4; ++m) {
                const size_t row = (size_t)b * SEQ + u.pm * 256 + ai * 128 + wr * 64 + m * 16 + fr;
#pragma unroll
                for (int bj = 0; bj < 2; ++bj)
                    *(u32x4*)(O + row * D + h * 256 + bj * 128 + wc * 32 + 8 * fq) = pack8(acc[ai][bj][m][0], acc[ai][bj][m][1]);
            }
    }
};
struct EpiSsm1 {
    static constexpr bool AFTER_DRAIN = true;
    bf16_t* up; const float *lam_re, *lam_im, *log_dt;
    __device__ __forceinline__ void operator()(AccRef, const Unit&, int, int, int, int) const {}
    __device__ __forceinline__ void fused(AccRef acc, const Unit& u, int wr, int wc, int fr, int fq, LAS unsigned char* lds, int wid, int lane) const {
        LAS float* L = (LAS float*)lds;
#pragma unroll
        for (int ai = 0; ai < 2; ++ai)
#pragma unroll
            for (int m = 0; m < 4; ++m) {
                const int rl = ai * 128 + wr * 64 + m * 16 + fr;
#pragma unroll
                for (int n = 0; n < 2; ++n) { const int col = wc * 32 + 8 * fq + 4 * n; *(LAS f32x4*)(L + rl * 128 + (col ^ ((rl & 15) << 3))) = acc[ai][0][m][n]; }
            }
        __syncthreads();
        if (wid == 0) {
            const int g = u.bz & 31, p = lane;
            const float dt = expf(log_dt[g]) * (float)CH;
            const float lr = fminf(lam_re[g * NP + p], -1e-4f), li = lam_im[g * NP + p];
            const float mag = expf(lr * dt); float sn, cs; sincosf(li * dt, &sn, &cs);
            const float ar = mag * cs, aim = mag * sn;
            float xr = 0.f, xi = 0.f;
            unsigned* dst = (unsigned*)(up + (size_t)u.bz * NCH * UPW + 512) + p;
            for (int c = 0; c < NCH; ++c) {
                dst[(size_t)c * (UPW / 2)] = cvtpk(xr, xi);
                const f32x2 l2 = *(const LAS f32x2*)(L + c * 128 + ((2 * p) ^ ((c & 15) << 3)));
                const float nr = ar * xr - aim * xi + l2[0], ni = ar * xi + aim * xr + l2[1];
                xr = nr; xi = ni;
            }
        }
        __syncthreads();
    }
};

struct GainSpec { const float* g1; const float* g2; float g2s; };
__device__ __forceinline__ float gain_of(const GainSpec& gs, int k) {
    if (!gs.g1) return 1.f;
    if (gs.g2 && k >= 512) return gs.g2[(k - 512) & 127] * gs.g2s;
    return gs.g1[k];
}
__device__ __forceinline__ void transpose_item(const float* W, int K, int N, bf16_t* WT, bool il, int nh, int hb, const GainSpec gs, LAS float* scr, int item, int lane) {
    const int nblk = N / 32, kb = item / nblk, nb = item % nblk, k0 = 64 * kb, n0 = 32 * nb;
#pragma unroll 8
    for (int i = 0; i < 32; ++i) { const int kk = 2 * i + (lane >> 5); scr[kk * 33 + (lane & 31)] = W[(size_t)(k0 + kk) * N + n0 + (lane & 31)] * gain_of(gs, k0 + kk); }
    asm volatile("s_waitcnt lgkmcnt(0)" ::: "memory");
    const int c = lane & 7;
#pragma unroll
    for (int j = 0; j < 4; ++j) { const int n = (lane >> 3) + 8 * j; const LAS float* s = scr + (8 * c) * 33 + n;
        u32x4 o; o.x = cvtpk(s[0 * 33], s[1 * 33]); o.y = cvtpk(s[2 * 33], s[3 * 33]); o.z = cvtpk(s[4 * 33], s[5 * 33]); o.w = cvtpk(s[6 * 33], s[7 * 33]);
        int row = n0 + n; if (il) { const int jj = row % nh, half = hb + row / nh; row = (jj >> 7) * 256 + half * 128 + (jj & 127); }
        *(u32x4*)(WT + (size_t)row * K + k0 + 8 * c) = o; }
    asm volatile("s_waitcnt lgkmcnt(0)" ::: "memory");
}

__device__ __forceinline__ void ssm_matrices(KArgsP a, int l, int g, LAS unsigned char* lds, bf16_t* Bm, bf16_t* Mt) {
    int tid = threadIdx.x; asm volatile("" : "+v"(tid));
    LAS f32x2* lamtab = (LAS f32x2*)lds;
    LAS f32x2* cc = (LAS f32x2*)(lds + 16896);
    LAS f32x2* bb = (LAS f32x2*)(lds + 16896 + 8192);
    LAS float* Kt = (LAS float*)(lds + 16896 + 16384);
    const float* lam_re = a->in[9] + (size_t)(l * NG + g) * NP; const float* lam_im = a->in[10] + (size_t)(l * NG + g) * NP;
    const float* b_re = a->in[11] + (size_t)(l * NG + g) * NP * 16; const float* b_im = a->in[12] + (size_t)(l * NG + g) * NP * 16;
    const float* c_re = a->in[13] + (size_t)(l * NG + g) * 16 * NP; const float* c_im = a->in[14] + (size_t)(l * NG + g) * 16 * NP;
    const float* dd = a->in[15] + (size_t)(l * NG + g) * 16;
    const float dt = expf(a->in[16][l * NG + g]);
    for (int idx = tid; idx < 33 * 64; idx += 512) { const int tau = idx >> 6, p = idx & 63;
        const float lr = fminf(lam_re[p], -1e-4f), li = lam_im[p]; const float zr = lr * dt * (float)tau, zi = li * dt * (float)tau;
        const float mag = expf(zr); float sn, cs; sincosf(zi, &sn, &cs); lamtab[idx] = (f32x2){mag * cs, mag * sn}; }
    for (int idx = tid; idx < 1024; idx += 512) {
        cc[idx] = (f32x2){c_re[idx], c_im[idx]};
        const int p = idx >> 4;
        const float lr = fminf(lam_re[p], -1e-4f), li = lam_im[p]; const float mag = expf(lr * dt); float sn, cs; sincosf(li * dt, &sn, &cs);
        const float ar = mag * cs - 1.f, ai = mag * sn, den = 1.f / (lr * lr + li * li);
        const float qr = (ar * lr + ai * li) * den, qi = (ai * lr - ar * li) * den;
        const float br = b_re[idx], bi = b_im[idx];
        bb[idx] = (f32x2){qr * br - qi * bi, qr * bi + qi * br};
    }
    __syncthreads();
    for (int idx = tid; idx < 32 * 256; idx += 512) { const int tau = idx >> 8, ho = (idx >> 4) & 15, hi = idx & 15; float s = 0.f;
        for (int p = 0; p < NP; ++p) { const f32x2 c = cc[ho * 64 + p], lm = lamtab[tau * 64 + p], b = bb[p * 16 + hi];
            const float wr_ = c[0] * lm[0] - c[1] * lm[1], wi_ = c[0] * lm[1] + c[1] * lm[0]; s += wr_ * b[0] - wi_ * b[1]; }
        if (tau == 0 && ho == hi) s += dd[ho];
        Kt[idx] = s; }
    __syncthreads();
    for (int ch = tid; ch < 512 * 80; ch += 512) { const int n = ch / 80, kc = ch % 80, t = n >> 4, ho = n & 15, k0 = kc * 8; float v[8];
        if (k0 < 512) { const int s = k0 >> 4, hi0 = k0 & 15;
#pragma unroll
            for (int j = 0; j < 8; ++j) v[j] = (s <= t) ? Kt[(t - s) * 256 + ho * 16 + hi0 + j] : 0.f;
        } else { const int p0 = (k0 - 512) >> 1;
#pragma unroll
            for (int j = 0; j < 4; ++j) { const f32x2 c = cc[ho * 64 + p0 + j], lm = lamtab[(t + 1) * 64 + p0 + j];
                v[2 * j] = c[0] * lm[0] - c[1] * lm[1]; v[2 * j + 1] = -(c[0] * lm[1] + c[1] * lm[0]); } }
        u32x4 o; o.x = cvtpk(v[0], v[1]); o.y = cvtpk(v[2], v[3]); o.z = cvtpk(v[4], v[5]); o.w = cvtpk(v[6], v[7]);
        *(u32x4*)(Mt + (size_t)n * UPW + k0) = o; }
    for (int ch = tid; ch < 256 * 64; ch += 512) { const int n = ch >> 6, k0 = (ch & 63) * 8; float v[8];
        if (n < 128) { const int p = n >> 1, ri = n & 1, s = k0 >> 4, hi0 = k0 & 15; const f32x2 lm = lamtab[(CH - 1 - s) * 64 + p];
#pragma unroll
            for (int j = 0; j < 8; ++j) { const f32x2 b = bb[p * 16 + hi0 + j]; v[j] = ri ? (lm[0] * b[1] + lm[1] * b[0]) : (lm[0] * b[0] - lm[1] * b[1]); }
        } else {
#pragma unroll
            for (int j = 0; j < 8; ++j) v[j] = 0.f; }
        u32x4 o; o.x = cvtpk(v[0], v[1]); o.y = cvtpk(v[2], v[3]); o.z = cvtpk(v[4], v[5]); o.w = cvtpk(v[6], v[7]);
        *(u32x4*)(Bm + (size_t)n * 512 + k0) = o; }
    __syncthreads();
}

__device__ __forceinline__ void prologue(KArgsP a, LAS unsigned char* lds, int G) {
    unsigned char* ws = a->ws;
    int tid = threadIdx.x; asm volatile("" : "+v"(tid));
    const int lane = tid & 63, wave = tid >> 6, bid = blockIdx.x;
    { float* z = (float*)(ws + WS_SS) + T; const size_t n = (size_t)10 * T;
      for (size_t i = (size_t)bid * 512 + tid; i < n; i += (size_t)G * 512) z[i] = 0.f; }
    for (int it = bid; it < DEPTH * NG; it += G) { const int l = it >> 5, g = it & 31;
        ssm_matrices(a, l, g, lds, (bf16_t*)(ws + WS_W + l * W_LAYER + W_BM) + (size_t)g * 256 * 512, (bf16_t*)(ws + WS_W + l * W_LAYER + W_MT) + (size_t)g * 512 * UPW); }
    if (bid == 0) {
        float* sm = (float*)(ws + WS_SMALL);
        if (tid < 128) { const int l = tid >> 6, i = tid & 63;
            const float d1 = wave_sum(a->in[20][l * 64 + i] * a->in[21][l * 64 + i]), d2 = wave_sum(a->in[22][l * 64 + i] * a->in[23][l * 64 + i]);
            if (i == 0) sm[l] = expf(d1) - expf(d2) + (0.8f - 0.6f * expf(-0.3f * (float)l)); }
        for (int idx = tid; idx < 4 * 132; idx += 512) { const int h = idx / 132, n = idx % 132; int bk;
            if (n < 16) bk = n; else { const float nf = (float)n; int lg = 16 + (int)(logf(nf / 16.f) / 2.0794415416798357f * 16.f); bk = lg < 31 ? lg : 31; }
            sm[16 + idx] = a->in[2][bk * 4 + h] * LOG2E; }
    }
    { LAS float* scr = (LAS float*)(lds + wave * 16384);
      const int gw = bid * 8 + wave, NGW = G * 8;
      for (int it = gw; it < DEPTH * 12288; it += NGW) {
          const int l = it / 12288; int r = it % 12288; unsigned char* wl = ws + WS_W + l * W_LAYER;
          const GainSpec none{nullptr, nullptr, 0.f};
          if (r < 1408) { transpose_item(a->in[4] + (size_t)l * D * FF, D, FF, (bf16_t*)(wl + W_GU1), true, FF, 0, GainSpec{a->in[3] + l * D, nullptr, 0.f}, scr, r, lane); continue; } r -= 1408;
          if (r < 1408) { transpose_item(a->in[5] + (size_t)l * D * FF, D, FF, (bf16_t*)(wl + W_GU1), true, FF, 1, GainSpec{a->in[3] + l * D, nullptr, 0.f}, scr, r, lane); continue; } r -= 1408;
          if (r < 1408) { transpose_item(a->in[6] + (size_t)l * FF * D, FF, D, (bf16_t*)(wl + W_D1), false, 1, 0, none, scr, r, lane); continue; } r -= 1408;
          if (r < 1408) { transpose_item(a->in[32] + (size_t)l * D * FF, D, FF, (bf16_t*)(wl + W_GU2), true, FF, 0, GainSpec{a->in[31] + l * D, nullptr, 0.f}, scr, r, lane); continue; } r -= 1408;
          if (r < 1408) { transpose_item(a->in[33] + (size_t)l * D * FF, D, FF, (bf16_t*)(wl + W_GU2), true, FF, 1, GainSpec{a->in[31] + l * D, nullptr, 0.f}, scr, r, lane); continue; } r -= 1408;
          if (r < 1408) { transpose_item(a->in[34] + (size_t)l * FF * D, FF, D, (bf16_t*)(wl + W_D2), false, 1, 0, none, scr, r, lane); continue; } r -= 1408;
          if (r < 1024) { transpose_item(a->in[8] + (size_t)l * D * 2048, D, 2048, (bf16_t*)(wl + W_IN), false, 1, 0, GainSpec{a->in[7] + l * D, nullptr, 0.f}, scr, r, lane); continue; } r -= 1024;
          if (r < 256) { transpose_item(a->in[17] + (size_t)l * 512 * 1024, 512, 1024, (bf16_t*)(wl + W_GLU), true, 512, 0, none, scr, r, lane); continue; } r -= 256;
          if (r < 512) { transpose_item(a->in[25] + (size_t)l * D * D, D, D, (bf16_t*)(wl + W_OUT), false, 1, 0, GainSpec{a->in[19] + l * 512, a->in[24] + l * 128, 1.f - (0.8f - 0.6f * expf(-0.3f * (float)l))}, scr, r, lane); continue; } r -= 512;
          if (r < 512) { transpose_item(a->in[28] + (size_t)l * D * D, D, D, (bf16_t*)(wl + W_Q), false, 1, 0, GainSpec{a->in[26] + l * D, nullptr, 0.f}, scr, r, lane); continue; } r -= 512;
          if (r < 1024) { transpose_item(a->in[29] + (size_t)l * D * 2048, D, 2048, (bf16_t*)(wl + W_KV), false, 1, 0, none, scr, r, lane); continue; } r -= 1024;
          transpose_item(a->in[30] + (size_t)l * D * D, D, D, (bf16_t*)(wl + W_O), false, 1, 0, none, scr, r, lane);
      }
      for (int row = gw; row < T + DEPTH * BATCH * MEM; row += NGW) {
          const bool ismem = row >= T; const int mr = row - T, l = mr >> 10, mrow = mr & 1023;
          const float* src = ismem ? a->in[1] + (size_t)mrow * D : a->in[0] + (size_t)row * D;
          f32x4 v[4]; float s = 0.f;
#pragma unroll
          for (int j = 0; j < 4; ++j) { v[j] = *((const f32x4*)src + lane + 64 * j); s += (v[j][0] * v[j][0] + v[j][1] * v[j][1]) + (v[j][2] * v[j][2] + v[j][3] * v[j][3]); }
          s = wave_sum(s);
          if (!ismem) { if (lane == 0) ((float*)(ws + WS_SS))[row] = s;
#pragma unroll
              for (int j = 0; j < 4; ++j) *((u32x2*)(ws + WS_HB + (size_t)row * D * 2) + lane + 64 * j) = (u32x2){cvtpk(v[j][0], v[j][1]), cvtpk(v[j][2], v[j][3])};
          } else { const float rs = rsqrtf(s * (1.f / D) + EPS); const float* gn = a->in[27] + l * D;
#pragma unroll
              for (int j = 0; j < 4; ++j) { const f32x4 gg = *((const f32x4*)gn + lane + 64 * j);
                  *((u32x2*)(ws + WS_MEMN + ((size_t)l * 1024 + mrow) * D * 2) + lane + 64 * j) = (u32x2){cvtpk(v[j][0] * rs * gg[0], v[j][1] * rs * gg[1]), cvtpk(v[j][2] * rs * gg[2], v[j][3] * rs * gg[3])}; }
          }
      }
    }
}

constexpr int AT_KROW = 272, AT_VROW = 144, AT_KBUF = 64 * AT_KROW, AT_VBUF = 128 * AT_VROW;
constexpr int AT_K0 = 0, AT_V0 = 2 * AT_KBUF, AT_BIAS = AT_V0 + 2 * AT_VBUF;

__device__ __forceinline__ void attn_qblock(int b, int h, int q0, float lam, LAS unsigned char* lds, const bf16_t* qbuf, const bf16_t* kbuf, const bf16_t* vT, bf16_t* mix, const float* bias_g) {
    int tid = threadIdx.x; asm volatile("" : "+v"(tid));
    const int lane = tid & 63, w = __builtin_amdgcn_readfirstlane(tid >> 6), r = lane & 15, g = lane >> 4;
    const int qw0 = q0 + w * 16, qrow = qw0 + r;
    LAS float* biasl = (LAS float*)(lds + AT_BIAS);
    if (tid < 129) biasl[tid] = bias_g[h * 132 + tid];
    bf16x8 qf[2][2];
    { const bf16_t* qp = qbuf + ((size_t)(b * SEQ + qrow)) * 512 + h * 128 + g * 8;
#pragma unroll
      for (int m = 0; m < 2; ++m)
#pragma unroll
          for (int ks = 0; ks < 2; ++ks) qf[m][ks] = *(const bf16x8*)(qp + m * 64 + ks * 32); }
    f32x4 o[2][8];
#pragma unroll
    for (int m = 0; m < 2; ++m)
#pragma unroll
        for (int db = 0; db < 8; ++db) o[m][db] = (f32x4){0.f, 0.f, 0.f, 0.f};
    float mrow[2] = {-INFINITY, -INFINITY}, lrow[2] = {0.f, 0.f};
    const int ntiles = (q0 + 128) >> 6;
    unsigned gk[2], lk[2], gv[2], lv[2];
#pragma unroll
    for (int i = 0; i < 2; ++i) { const int c = tid + i * 512;
        { const int key = c >> 4, ch = c & 15, rho = ((key >> 5) * 2 + ((key >> 2) & 1)) * 16 + ((key >> 3) & 3) * 4 + (key & 3); gk[i] = key * 512 + ch * 8; lk[i] = rho * AT_KROW + ch * 16; }
        { const int dv = c >> 3, ch = c & 7; gv[i] = dv * SEQ + ch * 8; lv[i] = dv * AT_VROW + ch * 16; } }
    const bf16_t* kbase = kbuf + ((size_t)b * SEQ) * 512 + h * 128;
    const bf16_t* vbase = vT + ((size_t)(b * 4 + h) * 128) * SEQ;
    u32x4 kreg[2], vreg[2];
#pragma unroll
    for (int i = 0; i < 2; ++i) { kreg[i] = *(const u32x4*)(kbase + gk[i]); vreg[i] = *(const u32x4*)(vbase + gv[i]); }
#pragma unroll
    for (int i = 0; i < 2; ++i) { *(LAS u32x4*)(lds + AT_K0 + lk[i]) = kreg[i]; *(LAS u32x4*)(lds + AT_V0 + lv[i]) = vreg[i]; }
    __syncthreads();
    const float cfar = biasl[128];
    for (int kt = 0; kt < ntiles; ++kt) {
        const int cur = kt & 1, k0 = kt * 64;
        const bool pf = (kt + 1 < ntiles);
        if (pf) {
#pragma unroll
            for (int i = 0; i < 2; ++i) { kreg[i] = *(const u32x4*)(kbase + (size_t)(k0 + 64) * 512 + gk[i]); vreg[i] = *(const u32x4*)(vbase + (k0 + 64) + gv[i]); } }
        if (k0 <= qw0 + 15) {
            LAS unsigned char* Kb = lds + AT_K0 + cur * AT_KBUF; LAS unsigned char* Vb = lds + AT_V0 + cur * AT_VBUF;
            f32x4 s[2][4];
#pragma unroll
            for (int m = 0; m < 2; ++m)
#pragma unroll
                for (int kb = 0; kb < 4; ++kb) { s[m][kb] = (f32x4){0.f, 0.f, 0.f, 0.f};
#pragma unroll
                    for (int ks = 0; ks < 2; ++ks) { const bf16x8 kf = *(const LAS bf16x8*)(Kb + (kb * 16 + r) * AT_KROW + (m * 64 + ks * 32 + g * 8) * 2);
                        s[m][kb] = __builtin_amdgcn_mfma_f32_16x16x32_bf16(kf, qf[m][ks], s[m][kb], 0, 0, 0); } }
            const bool far = (qw0 - (k0 + 63)) >= 128;
            if (far) {
#pragma unroll
                for (int m = 0; m < 2; ++m)
#pragma unroll
                    for (int kb = 0; kb < 4; ++kb) s[m][kb] = s[m][kb] + cfar;
            } else {
#pragma unroll
                for (int kb = 0; kb < 4; ++kb)
#pragma unroll
                    for (int j = 0; j < 4; ++j) { const int key = k0 + (kb >> 1) * 32 + g * 8 + (kb & 1) * 4 + j, dist = qrow - key;
                        const float bv = biasl[dist < 0 ? 0 : (dist > 128 ? 128 : dist)];
                        s[0][kb][j] = dist >= 0 ? s[0][kb][j] + bv : -INFINITY; s[1][kb][j] = dist >= 0 ? s[1][kb][j] + bv : -INFINITY; }
            }
            bf16x8 pfr[2][2];
#pragma unroll
            for (int m = 0; m < 2; ++m) {
                float mx = -INFINITY;
#pragma unroll
                for (int kb = 0; kb < 4; ++kb) mx = fmaxf(mx, fmaxf(fmaxf(s[m][kb][0], s[m][kb][1]), fmaxf(s[m][kb][2], s[m][kb][3])));
                mx = fq_max(mx);
                const float mnew = fmaxf(mrow[m], mx), alpha = fast_exp2(mrow[m] - mnew);
                mrow[m] = mnew; float ps = 0.f;
#pragma unroll
                for (int kb = 0; kb < 4; ++kb)
#pragma unroll
                    for (int j = 0; j < 4; ++j) { const float p = fast_exp2(s[m][kb][j] - mnew); s[m][kb][j] = p; ps += p; }
                lrow[m] = lrow[m] * alpha + ps;
#pragma unroll
                for (int db = 0; db < 8; ++db) o[m][db] = o[m][db] * alpha;
#pragma unroll
                for (int kk = 0; kk < 2; ++kk) { const u32x4 pw = pack8(s[m][2 * kk], s[m][2 * kk + 1]); pfr[m][kk] = __builtin_bit_cast(bf16x8, pw); }
            }
#pragma unroll
            for (int db = 0; db < 8; ++db)
#pragma unroll
                for (int kk = 0; kk < 2; ++kk) { const bf16x8 vf = *(const LAS bf16x8*)(Vb + (db * 16 + r) * AT_VROW + (kk * 32 + g * 8) * 2);
                    o[0][db] = __builtin_amdgcn_mfma_f32_16x16x32_bf16(vf, pfr[0][kk], o[0][db], 0, 0, 0);
                    o[1][db] = __builtin_amdgcn_mfma_f32_16x16x32_bf16(vf, pfr[1][kk], o[1][db], 0, 0, 0); }
        }
        if (pf) {
#pragma unroll
            for (int i = 0; i < 2; ++i) { *(LAS u32x4*)(lds + AT_K0 + (cur ^ 1) * AT_KBUF + lk[i]) = kreg[i]; *(LAS u32x4*)(lds + AT_V0 + (cur ^ 1) * AT_VBUF + lv[i]) = vreg[i]; } }
        __syncthreads();
    }
    const float inv0 = 1.f / fq_sum(lrow[0]), inv1 = lam / fq_sum(lrow[1]);
    float ssq = 0.f;
#pragma unroll
    for (int db = 0; db < 8; ++db)
#pragma unroll
        for (int j = 0; j < 4; ++j) { const float v = o[0][db][j] * inv0 - o[1][db][j] * inv1; o[0][db][j] = v; ssq += v * v; }
    ssq = fq_sum(ssq);
    const float rn = rsqrtf(ssq * (1.f / 128.f) + EPS);
    bf16_t* op = mix + ((size_t)(b * SEQ + qrow)) * D + 512 + h * 128 + g * 4;
#pragma unroll
    for (int db = 0; db < 8; ++db) *(u32x2*)(op + db * 16) = (u32x2){cvtpk(o[0][db][0] * rn, o[0][db][1] * rn), cvtpk(o[0][db][2] * rn, o[0][db][3] * rn)};
}

#if DEBUG_CHECK
__device__ __forceinline__ unsigned hash_u(unsigned x) { x ^= x >> 16; x *= 0x7feb352dU; x ^= x >> 15; x *= 0x846ca68bU; x ^= x >> 16; return x; }
__device__ __forceinline__ void dbg_flag(unsigned* ctl, int id, float got, float ref, float rtol, float atol) {
    const float d = fabsf(got - ref);
    if (!(d <= atol + rtol * fabsf(ref))) atomicAdd(ctl + 64 + id, 1u);
}
#endif

__global__ void __launch_bounds__(512, 2) fwd_kernel(Args a) {
    extern __shared__ __attribute__((aligned(16))) unsigned char lds_raw[];
    LAS unsigned char* lds = (LAS unsigned char*)lds_raw;
    cg::grid_group grid = cg::this_grid();
    const int G = gridDim.x;
#define PH KArgsP ka = KARGS(); int bid = blockIdx.x, G = gridDim.x, tidl = threadIdx.x; asm volatile("" : "+s"(bid), "+s"(G), "+v"(tidl)); const int lane = tidl & 63, wave = tidl >> 6; (void)lane; (void)wave; unsigned char* ws = ka->ws; float* ssb = (float*)(ws + WS_SS); float* ssm_ss = (float*)(ws + WS_SSM_SS); const float* smalls = (const float*)(ws + WS_SMALL); \
    bf16_t* hb = (bf16_t*)(ws + WS_HB); unsigned char* ar = ws + WS_AR; unsigned char* wl = ws + WS_W + l * W_LAYER; float* hbuf = ka->out; \
    (void)ssb; (void)ssm_ss; (void)smalls; (void)hb; (void)ar; (void)wl; (void)hbuf;
    prologue(KARGS(), lds, G);
    grid.sync();

    for (int l = 0; l < DEPTH; ++l) {
        { PH StdSched S; S.init(T, 2 * FF, G, bid, D, D); EpiFfnUp E{(bf16_t*)(ar + AR_HID), ssb + (size_t)(4 * l + 0) * T};
          gemm_phase<EpiFfnUp, StdSched, false>(lds, hb, (const bf16_t*)(wl + W_GU1), D, D, D, S, E); }
        grid.sync();
        { PH StdSched S; S.init(T, D, G, bid, FF, FF); EpiResid E{l == 0 ? ka->in[0] : hbuf, hbuf, hb, ssb + (size_t)(4 * l + 1) * T, 0.5f};
          gemm_phase<EpiResid, StdSched, false>(lds, (const bf16_t*)(ar + AR_HID), (const bf16_t*)(wl + W_D1), FF, FF, FF, S, E); }
        grid.sync();
        { PH StdSched S; S.init(T, 2048, G, bid, D, D); EpiWin E{ar, ssb + (size_t)(4 * l + 1) * T};
          gemm_phase<EpiWin, StdSched, false>(lds, hb, (const bf16_t*)(wl + W_IN), D, D, D, S, E); }
        grid.sync();
        if ((int)blockIdx.x < 128) { PH Ssm1Sched S{bid}; EpiSsm1 E{(bf16_t*)(ar + AR_UP), ka->in[9] + (size_t)l * NG * NP, ka->in[10] + (size_t)l * NG * NP, ka->in[16] + (size_t)l * NG};
          gemm_phase<EpiSsm1, Ssm1Sched, false>(lds, (const bf16_t*)(ar + AR_UP), (const bf16_t*)(wl + W_BM), UPW, 512, 512, S, E); }
        else if (l == 0) { PH WkvSched S{G, bid}; EpiWkv E{(bf16_t*)(ws + WS_KX), (bf16_t*)(ws + WS_VXT)};
          gemm_phase<EpiWkv, WkvSched, false>(lds, (const bf16_t*)(ws + WS_MEMN), (const bf16_t*)(ws + WS_W + W_KV), D, D, D, S, E); }
        grid.sync();
        { PH Ssm2Sched S{G, bid}; EpiSsm2 E{(bf16_t*)(ar + AR_Y)};
          gemm_phase<EpiSsm2, Ssm2Sched, false>(lds, (const bf16_t*)(ar + AR_UP), (const bf16_t*)(wl + W_MT), UPW, UPW, UPW, S, E); }
        grid.sync();
        { PH StdSched S; S.init(T, 1024, G, bid, 512, 512); EpiGlu E{(bf16_t*)(ar + AR_MIX), ka->in[18] + (size_t)l * 1024, ssm_ss + (size_t)l * T};
          gemm_phase<EpiGlu, StdSched, false>(lds, (const bf16_t*)(ar + AR_Y), (const bf16_t*)(wl + W_GLU), 512, 512, 512, S, E); }
        grid.sync();
        { PH const float lam = smalls[l];
          for (int uidx = bid; uidx < 512; uidx += G) { const int bh = uidx >> 5, j = uidx & 31, b = bh >> 2, h = bh & 3;
              attn_qblock(b, h, j * 128, lam, lds, (const bf16_t*)(ar + AR_Q), (const bf16_t*)(ar + AR_K), (const bf16_t*)(ar + AR_VT), (bf16_t*)(ar + AR_MIX), smalls + 16);
              attn_qblock(b, h, (63 - j) * 128, lam, lds, (const bf16_t*)(ar + AR_Q), (const bf16_t*)(ar + AR_K), (const bf16_t*)(ar + AR_VT), (bf16_t*)(ar + AR_MIX), smalls + 16); }
          bf16_t* mix = (bf16_t*)(ar + AR_MIX); const float* sq = ssm_ss + (size_t)l * T;
          for (int row = bid * 8 + wave; row < T; row += G * 8) { const float rs = rsqrtf(sq[row] * (1.f / 512.f) + EPS);
              u32x4* p = (u32x4*)(mix + (size_t)row * D) + lane; u32x4 v = *p;
              v.x = cvtpk(__uint_as_float(v.x << 16) * rs, __uint_as_float(v.x & 0xffff0000u) * rs); v.y = cvtpk(__uint_as_float(v.y << 16) * rs, __uint_as_float(v.y & 0xffff0000u) * rs);
              v.z = cvtpk(__uint_as_float(v.z << 16) * rs, __uint_as_float(v.z & 0xffff0000u) * rs); v.w = cvtpk(__uint_as_float(v.w << 16) * rs, __uint_as_float(v.w & 0xffff0000u) * rs);
              *p = v; } }
        grid.sync();
        { PH StdSched S; S.init(T, D, G, bid, D, D); EpiResid E{hbuf, hbuf, hb, ssb + (size_t)(4 * l + 2) * T, 1.f};
          gemm_phase<EpiResid, StdSched, false>(lds, (const bf16_t*)(ar + AR_MIX), (const bf16_t*)(wl + W_OUT), D, D, D, S, E); }
        grid.sync();
        { PH StdSched S; S.init(T, D, G, bid, D, D); EpiWq E{(bf16_t*)(ar + AR_QX), ssb + (size_t)(4 * l + 2) * T, 0.0625f * LOG2E};
          gemm_phase<EpiWq, StdSched, false>(lds, hb, (const bf16_t*)(wl + W_Q), D, D, D, S, E); }
        grid.sync();
        { PH XaSched S{G, bid, (unsigned)MEM * 1024, 256u}; EpiSoftmax E{(bf16_t*)(ar + AR_P), (LAS float*)(lds + LDS_RED)};
          gemm_phase<EpiSoftmax, XaSched, true>(lds, (const bf16_t*)(ar + AR_QX), (const bf16_t*)(ws + WS_KX) + (size_t)l * 1024 * 1024, D, D, 256, S, E); }
        grid.sync();
        { PH XaSched S{G, bid, 4u * 65536u, 65536u}; EpiPV E{(bf16_t*)(ar + AR_OX)};
          gemm_phase<EpiPV, XaSched, false>(lds, (const bf16_t*)(ar + AR_P), (const bf16_t*)(ws + WS_VXT) + (size_t)l * 1024 * 1024, D, 256, 256, S, E); }
        grid.sync();
        { PH StdSched S; S.init(T, D, G, bid, D, D); EpiResid E{hbuf, hbuf, hb, ssb + (size_t)(4 * l + 3) * T, 1.f};
          gemm_phase<EpiResid, StdSched, false>(lds, (const bf16_t*)(ar + AR_OX), (const bf16_t*)(wl + W_O), D, D, D, S, E); }
        grid.sync();
        { PH StdSched S; S.init(T, 2 * FF, G, bid, D, D); EpiFfnUp E{(bf16_t*)(ar + AR_HID), ssb + (size_t)(4 * l + 3) * T};
          gemm_phase<EpiFfnUp, StdSched, false>(lds, hb, (const bf16_t*)(wl + W_GU2), D, D, D, S, E); }
        grid.sync();
        { PH StdSched S; S.init(T, D, G, bid, FF, FF); EpiResid E{hbuf, hbuf, hb, ssb + (size_t)(4 * l + 4) * T, 0.5f};
          gemm_phase<EpiResid, StdSched, false>(lds, (const bf16_t*)(ar + AR_HID), (const bf16_t*)(wl + W_D2), FF, FF, FF, S, E); }
        grid.sync();
    }
    { const int l = 0; PH const float* sq = ssb + (size_t)8 * T; const float* gn = ka->in[35];
      for (int row = bid * 8 + wave; row < T; row += G * 8) { const float rs = rsqrtf(sq[row] * (1.f / D) + EPS);
#pragma unroll
          for (int j = 0; j < 4; ++j) { f32x4* p = (f32x4*)(hbuf + (size_t)row * D) + lane + 64 * j; const f32x4 gg = *((const f32x4*)gn + lane + 64 * j); f32x4 v = *p;
              v[0] *= rs * gg[0]; v[1] *= rs * gg[1]; v[2] *= rs * gg[2]; v[3] *= rs * gg[3]; *p = v; } } }
}

extern "C" void kernel_launch(void* const* d_in, const int* in_sizes, int n_in, void* d_out, int out_size, void* d_ws, size_t ws_size, hipStream_t stream) {
    static int grid = 0;
    if (grid == 0) {
        if (n_in != 36 || out_size != T * D || ws_size < WS_END) { fprintf(stderr, "kernel_launch: unexpected problem (n_in %d out %d ws %zu)\n", n_in, out_size, ws_size); grid = -1; return; }
        int dev = 0, cus = 0, per_cu = 0;
        if (hipGetDevice(&dev) != hipSuccess || hipDeviceGetAttribute(&cus, hipDeviceAttributeMultiprocessorCount, dev) != hipSuccess) { grid = -1; return; }
        if (hipFuncSetAttribute((const void*)fwd_kernel, hipFuncAttributeMaxDynamicSharedMemorySize, LDS_BYTES) != hipSuccess) { fprintf(stderr, "hipFuncSetAttribute failed\n"); grid = -1; return; }
        if (hipOccupancyMaxActiveBlocksPerMultiprocessor(&per_cu, (const void*)fwd_kernel, 512, LDS_BYTES) != hipSuccess || per_cu < 1) { fprintf(stderr, "occupancy query: %d\n", per_cu); }
        (void)hipGetLastError();
        grid = cus;
        if (grid != 256) fprintf(stderr, "kernel_launch: %d CUs (expected 256)\n", grid);
    }
    if (grid < 0) return;
    (void)hipMemsetAsync((char*)d_ws + WS_CTL, 0, 4096, stream);
    Args a{};
    for (int i = 0; i < 36; ++i) a.in[i] = (const float*)d_in[i];
    a.out = (float*)d_out; a.ws = (unsigned char*)d_ws;
    void* args[] = {&a};
    hipError_t e = hipLaunchCooperativeKernel((const void*)fwd_kernel, dim3(grid), dim3(512), args, LDS_BYTES, stream);
    if (e != hipSuccess) fprintf(stderr, "cooperative launch failed: %s (grid %d)\n", hipGetErrorString(e), grid);
}
```

```cpp
#include <hip/hip_runtime.h>
#include <hip/hip_cooperative_groups.h>
#include <cstdio>
#include <cstdint>
namespace cg = cooperative_groups;

#define LAS __attribute__((address_space(3)))
typedef unsigned short bf16_t;
typedef short bf16x8 __attribute__((ext_vector_type(8)));
typedef float f32x4 __attribute__((ext_vector_type(4)));
typedef float f32x2 __attribute__((ext_vector_type(2)));
typedef unsigned u32x4 __attribute__((ext_vector_type(4)));
typedef unsigned u32x2 __attribute__((ext_vector_type(2)));
typedef __bf16 bf16x2_t __attribute__((ext_vector_type(2)));

#ifndef PROBE
#define PROBE 0
#endif
#ifndef DEBUG_CHECK
#define DEBUG_CHECK 0
#endif

constexpr int D = 1024, BATCH = 4, SEQ = 8192, T = BATCH * SEQ, DEPTH = 2, MEM = 256, FF = 2816;
constexpr int SSMW = 512, NG = 32, NP = 64, CH = 32  , NCH = SEQ / CH  , UPW = 640  ;
constexpr float EPS = 1e-6f, LOG2E = 1.4426950408889634f;

constexpr size_t MiB = 1u << 20;
constexpr size_t WS_CTL = 0;
constexpr size_t WS_SS = 1 * MiB;
constexpr size_t WS_SSM_SS = WS_SS + 9 * (size_t)T * 4;
constexpr size_t WS_SMALL = 3 * MiB;
constexpr size_t WS_MEMN = 4 * MiB;
constexpr size_t WS_KX = 8 * MiB;
constexpr size_t WS_VXT = 12 * MiB;
constexpr size_t WS_W = 16 * MiB, W_LAYER = 76 * MiB;
constexpr size_t W_GU1 = 0, W_D1 = 11 * MiB, W_GU2 = 16 * MiB + MiB / 2, W_D2 = 27 * MiB + MiB / 2, W_IN = 33 * MiB, W_GLU = 37 * MiB, W_OUT = 38 * MiB,
                 W_Q = 40 * MiB, W_KV = 42 * MiB, W_O = 46 * MiB, W_BM = 48 * MiB, W_MT = 56 * MiB;
constexpr size_t WS_HB = WS_W + 2 * W_LAYER;
constexpr size_t WS_AR = WS_HB + 64 * MiB;
constexpr size_t AR_UP = 0, AR_Q = 40 * MiB, AR_K = 72 * MiB, AR_VT = 104 * MiB, AR_Y = 136 * MiB, AR_MIX = 168 * MiB;
constexpr size_t AR_QX = 0, AR_P = 64 * MiB, AR_OX = 128 * MiB, AR_HID = 0;
constexpr size_t WS_END = WS_AR + 234 * MiB;

constexpr int LDS_BYTES = 147456;
constexpr int LDS_RED = 131072; constexpr int LDS_XB = 131072 + 8192;

struct Args { const float* in[36]; float* out; unsigned char* ws; };
typedef const __attribute__((address_space(4))) Args* KArgsP;
#define KARGS() ({ KArgsP _p = (KArgsP)__builtin_amdgcn_kernarg_segment_ptr(); asm volatile("" : "+s"(_p)); _p; })

__device__ __forceinline__ unsigned cvtpk(float lo, float hi) { f32x2 v = {lo, hi}; bf16x2_t b = __builtin_convertvector(v, bf16x2_t); return __builtin_bit_cast(unsigned, b); }
__device__ __forceinline__ float bf2f(bf16_t x) { return __uint_as_float((unsigned)x << 16); }
__device__ __forceinline__ float wave_sum(float v) {
#pragma unroll
    for (int o = 1; o < 64; o <<= 1) v += __shfl_xor(v, o);
    return v;
}
__device__ __forceinline__ float fq_sum(float v) { v += __shfl_xor(v, 16); v += __shfl_xor(v, 32); return v; }
__device__ __forceinline__ float fq_max(float v) { v = fmaxf(v, __shfl_xor(v, 16)); v = fmaxf(v, __shfl_xor(v, 32)); return v; }
__device__ __forceinline__ u32x4 pack8(f32x4 a, f32x4 b) { u32x4 w; w.x = cvtpk(a[0], a[1]); w.y = cvtpk(a[2], a[3]); w.z = cvtpk(b[0], b[1]); w.w = cvtpk(b[2], b[3]); return w; }
__device__ __forceinline__ float fast_exp2(float x) { return __builtin_amdgcn_exp2f(x); }
__device__ __forceinline__ float fast_rcp(float x) { return __builtin_amdgcn_rcpf(x); }
__device__ __forceinline__ float sigmoidf_(float x) { return fast_rcp(1.f + fast_exp2(-x * LOG2E)); }


#define XB_TMO      128
#define XB_XCNT(j)  (256  + 64 * (j))
#define XB_XSUB(j)  (1280 + 64 * (j))
#define XB_XGEN(j)  (2304 + 64 * (j))
#define XB_TOP      3328
#define XB_TOPGEN   3392
#define XCD_BAR_WORDS 3456
#define XB_SPIN_CAP (1u << 22)
__device__ __forceinline__ unsigned xb_ld(unsigned* p)              { return __hip_atomic_load(p, __ATOMIC_RELAXED, __HIP_MEMORY_SCOPE_AGENT); }
__device__ __forceinline__ unsigned xb_add(unsigned* p, unsigned v) { return __hip_atomic_fetch_add(p, v, __ATOMIC_RELAXED, __HIP_MEMORY_SCOPE_AGENT); }
__device__ __forceinline__ unsigned xb_xcc_id() { return (unsigned)__builtin_amdgcn_s_getreg((3 << 11) | 20) & 0xFu; }
#define XB_SPIN(cond, bar) do { unsigned _sp = 0; while (cond) { __builtin_amdgcn_s_sleep(1); \
    if ((++_sp & 255u) == 0u) { if (xb_ld(&(bar)[XB_TMO])) break; if (_sp > XB_SPIN_CAP) { atomicAdd(&(bar)[XB_TMO], 1u); break; } } } } while (0)
struct XcdBarrier { unsigned* bar; unsigned x; volatile LAS unsigned* st; };
__device__ __forceinline__ XcdBarrier xcd_barrier_post(unsigned* bar, volatile LAS unsigned* st) {
    XcdBarrier b; b.bar = bar; b.x = xb_xcc_id(); b.st = st;
    if (threadIdx.x == 0) (void)xb_add(&bar[XB_XCNT(b.x)], 1u);
    return b;
}
__device__ __forceinline__ void xcd_barrier_complete(unsigned* bar, unsigned x, unsigned& nloc, unsigned& nx) {
    const unsigned G = gridDim.x * gridDim.y * gridDim.z;
    unsigned sum, cnt, mine, sp = 0u;
    for (;;) {
        sum = 0u; cnt = 0u; mine = 0u;
#pragma unroll
        for (unsigned j = 0; j < 16; ++j) { const unsigned c = xb_ld(&bar[XB_XCNT(j)]); sum += c; cnt += (c > 0u) ? 1u : 0u; mine = (j == x) ? c : mine; }
        if (sum == G) break;
        __builtin_amdgcn_s_sleep(1);
        if ((++sp & 255u) == 0u) { if (xb_ld(&bar[XB_TMO])) break; if (sp > XB_SPIN_CAP) { atomicAdd(&bar[XB_TMO], 1u); break; } }
    }
    nloc = mine > 0u ? mine : 1u; nx = cnt > 0u ? cnt : 1u;
}
__device__ __forceinline__ void xcd_barrier(const XcdBarrier& b) {
    asm volatile("s_waitcnt vmcnt(0)" ::: "memory");
    __syncthreads();
    if (threadIdx.x == 0) {
        unsigned* bar = b.bar;
        __builtin_amdgcn_s_waitcnt(0);
        unsigned nloc = b.st[0], nx = b.st[1];
        if (nloc == 0u) { xcd_barrier_complete(bar, b.x, nloc, nx); b.st[0] = nloc; b.st[1] = nx; }
        const unsigned old = xb_add(&bar[XB_XSUB(b.x)], 1u);
        const unsigned gen = old / nloc;
        if (old + 1u == (gen + 1u) * nloc) {
            __builtin_amdgcn_fence(__ATOMIC_RELEASE, "agent");
            asm volatile("s_waitcnt vmcnt(0)" ::: "memory");
            const unsigned og = xb_add(&bar[XB_TOP], 1u);
            const unsigned tg = og / nx;
            if (og + 1u == (tg + 1u) * nx) xb_add(&bar[XB_TOPGEN], 1u);
            else XB_SPIN(xb_ld(&bar[XB_TOPGEN]) == tg, bar);
            __builtin_amdgcn_fence(__ATOMIC_ACQUIRE, "agent");
            xb_add(&bar[XB_XGEN(b.x)], 1u);
            asm volatile("s_waitcnt vmcnt(0)" ::: "memory");
        } else {
            XB_SPIN(xb_ld(&bar[XB_XGEN(b.x)]) == gen, bar);
            __builtin_amdgcn_fence(__ATOMIC_ACQUIRE, "agent");
            asm volatile("s_waitcnt vmcnt(0)" ::: "memory");
        }
    }
    __syncthreads();
}

constexpr int BM = 256, BK = 64, HALF = 128, HTB = HALF * BK * 2, NXCD = 8, WGM = 8;
__host__ __device__ __forceinline__ int lds_byte(int r, int c) { const int st = (r >> 4) * 2 + (c >> 5), rr = r & 15, cc = c & 31, ob = rr * 64 + cc * 2; return st * 1024 + (ob ^ (((ob >> 9) & 1) << 5)); }
__host__ __device__ __forceinline__ void stage_rc(int b, int& R, int& C) { const int st = b / 1024, sb = b % 1024, swz = sb ^ (((sb >> 9) & 1) << 5); R = (st >> 1) * 16 + swz / 64; C = (st & 1) * 32 + (swz % 64) / 2; }
__host__ __device__ __forceinline__ int perm32(int rho) { const int n = rho >> 4, i = rho & 15; return 8 * (i >> 2) + 4 * n + (i & 3); }

struct Unit { int pm, pn, bz; unsigned a_off, b_off; };

struct StdSched {
    int nM, nN, nwg, G, c, lda, ldb;
    __device__ void init(int M, int N, int G_, int c_, int lda_, int ldb_) { nM = M / BM; nN = N / BM; nwg = nM * nN; G = G_; c = c_; lda = lda_; ldb = ldb_; }
    __device__ bool next(int i, Unit& u) const {
        const long L = (long)i * G + c; if (L >= nwg) return false;
        int wgid = (int)L; { const int q = nwg / NXCD, r = nwg % NXCD, xcd = wgid % NXCD, off = wgid / NXCD; wgid = (xcd < r ? xcd * (q + 1) : r * (q + 1) + (xcd - r) * q) + off; }
        const int nig = WGM * nN, gid = wgid / nig, fm = gid * WGM, gsz = (nM - fm) < WGM ? (nM - fm) : WGM;
        u.pm = fm + ((wgid % nig) % gsz); u.pn = (wgid % nig) / gsz; u.bz = 0;
        u.a_off = (unsigned)(u.pm * BM) * (unsigned)lda; u.b_off = (unsigned)(u.pn * BM) * (unsigned)ldb; return true;
    }
};
struct Ssm1Sched {
    int c;
    __device__ bool next(int i, Unit& u) const {
        if (i > 0 || c >= BATCH * NG) return false;
        u.pm = 0; u.pn = 0; u.bz = c; u.a_off = (unsigned)c * NCH * UPW; u.b_off = (unsigned)(c & 31) * 256 * 512; return true;
    }
};
struct WkvSched {
    int G, c;
    __device__ bool next(int i, Unit& u) const {
        if (c < 128) return false;
        const int L = (c - 128) + i * (G - 128); if (L >= 64) return false;
        const int layer = L >> 5, rem = L & 31; u.pm = rem >> 3; u.pn = rem & 7; u.bz = layer;
        u.a_off = (unsigned)layer * 1024 * 1024 + (unsigned)u.pm * 256 * 1024; u.b_off = (unsigned)layer * (unsigned)(W_LAYER / 2) + (unsigned)u.pn * 256 * 1024; return true;
    }
};
struct Ssm2Sched {
    int G, c;
    __device__ bool next(int i, Unit& u) const {
        const int L = c + i * G; if (L >= 2 * BATCH * NG) return false;
        u.bz = L >> 1; u.pn = L & 1; u.pm = 0; u.a_off = (unsigned)u.bz * NCH * UPW; u.b_off = ((unsigned)(u.bz & 31) * 512 + (unsigned)u.pn * 256) * UPW; return true;
    }
};
struct XaSched {
    int G, c; unsigned bs_b, bs_h;
    __device__ bool next(int i, Unit& u) const {
        const int L = c + i * G; if (L >= 512) return false;
        const int bh = L >> 5; u.pm = L & 31; u.pn = 0; u.bz = bh; const int b = bh >> 2, h = bh & 3;
        u.a_off = ((unsigned)(b * SEQ + u.pm * 256)) * 1024 + h * 256; u.b_off = (unsigned)b * bs_b + (unsigned)h * bs_h; return true;
    }
};

template <class Epi, class Sched, bool ALIGN_EPI>
__device__ __forceinline__ void gemm_phase(LAS unsigned char* lds, const bf16_t* Ab, const bf16_t* Bb, int lda, int ldb, int K, const Sched& S, Epi& E) {
    int tid = threadIdx.x; asm volatile("" : "+v"(tid));
    const int wid = __builtin_amdgcn_readfirstlane(tid >> 6), lane = tid & 63, wr = wid >> 2, wc = wid & 3, fr = lane & 15, fq = lane >> 4;
    const int nt = K / BK;
    unsigned voffA[2], voffB[2]; int aoff, boff;
#define PG8_LANEOFFS(tt) do { _Pragma("unroll") for (int i = 0; i < 2; ++i) { int R, C; stage_rc((tt) * 16 + i * 8192, R, C); const int Rb = (R & ~31) + perm32(R & 31); \
        voffA[i] = (unsigned)(R * lda + C) * 2u; voffB[i] = (unsigned)(Rb * ldb + C) * 2u; } \
        aoff = lds_byte(wr * 64 + ((tt) & 15), (((tt) >> 4) & 3) * 8); boff = lds_byte(wc * 32 + ((tt) & 15), (((tt) >> 4) & 3) * 8); } while (0)
    PG8_LANEOFFS(tid);
    const unsigned kstep = (unsigned)(BK * 2);
    const unsigned hstepA = (unsigned)HALF * lda * 2, hstepB = (unsigned)HALF * ldb * 2;
    const unsigned ldsw = (unsigned)wid * 1024u;
#define PG8_SA(b, h) (((b) * 2 + (h)) * HTB)
#define PG8_SB(b, h) ((4 + (b) * 2 + (h)) * HTB)
#define PG8_STAGE(bufoff, gbase, voff) do { _Pragma("unroll") for (int _i = 0; _i < 2; ++_i) \
        __builtin_amdgcn_global_load_lds((const unsigned*)((const char*)(gbase) + (voff)[_i]), (LAS unsigned*)(lds + (bufoff) + ldsw + _i * 8192), 16, 0, 0); } while (0)
#define PG8_LDA(dst, b, h) do { _Pragma("unroll") for (int m = 0; m < 4; ++m) _Pragma("unroll") for (int k = 0; k < 2; ++k) dst[m][k] = *(const LAS bf16x8*)(lds + PG8_SA(b, h) + aoff + m * 2048 + k * 1024); } while (0)
#define PG8_LDB(dst, b, h) do { _Pragma("unroll") for (int n = 0; n < 2; ++n) _Pragma("unroll") for (int k = 0; k < 2; ++k) dst[n][k] = *(const LAS bf16x8*)(lds + PG8_SB(b, h) + boff + n * 2048 + k * 1024); } while (0)
#define PG8_MMA(ai, bj, At, Bt) do { __builtin_amdgcn_s_setprio(1); _Pragma("unroll") for (int m = 0; m < 4; ++m) _Pragma("unroll") for (int n = 0; n < 2; ++n) _Pragma("unroll") for (int k = 0; k < 2; ++k) \
        acc[ai][bj][m][n] = __builtin_amdgcn_mfma_f32_16x16x32_bf16(Bt[n][k], At[m][k], acc[ai][bj][m][n], 0, 0, 0); __builtin_amdgcn_s_setprio(0); } while (0)
#define PG8_WAIT_V(n) asm volatile("s_waitcnt vmcnt(" #n ")" ::: "memory")
#define PG8_WAIT_L(n) asm volatile("s_waitcnt lgkmcnt(" #n ")" ::: "memory")
#define PG8_BAR __builtin_amdgcn_s_barrier()
#define PG8_SCHED __builtin_amdgcn_sched_barrier(0)
    Unit cur, nxt; int ui = 0;
    if (!S.next(0, cur)) return;
    f32x4 acc[2][2][4][2];
#pragma unroll
    for (int a = 0; a < 2; ++a)
#pragma unroll
        for (int b = 0; b < 2; ++b)
#pragma unroll
            for (int m = 0; m < 4; ++m)
#pragma unroll
                for (int n = 0; n < 2; ++n) acc[a][b][m][n] = (f32x4){0.f, 0.f, 0.f, 0.f};
    bf16x8 At[4][2], B0[2][2], B1[2][2];
    const char* cA = (const char*)(Ab + cur.a_off); const char* cB = (const char*)(Bb + cur.b_off);
    PG8_STAGE(PG8_SB(0, 0), cB, voffB); PG8_STAGE(PG8_SB(0, 1), cB + hstepB, voffB); PG8_STAGE(PG8_SA(0, 0), cA, voffA); PG8_STAGE(PG8_SA(0, 1), cA + hstepA, voffA);
    if (wr == 1) PG8_BAR;
    PG8_WAIT_V(2); PG8_BAR;
    PG8_STAGE(PG8_SB(1, 0), cB + kstep, voffB); PG8_STAGE(PG8_SA(1, 0), cA + kstep, voffA); PG8_STAGE(PG8_SB(1, 1), cB + hstepB + kstep, voffB);
    PG8_WAIT_V(6); PG8_BAR;
    for (;;) {
        const bool has_next = S.next(ui + 1, nxt);
        const char* nA = has_next ? (const char*)(Ab + nxt.a_off) : cA; const char* nB = has_next ? (const char*)(Bb + nxt.b_off) : cB;
        for (int t = 0; t < nt; t += 2) {
            const bool last = (t == nt - 2);
            const char* a1 = cA + (unsigned)(t + 1) * kstep;
            const char* a2 = last ? nA : cA + (unsigned)(t + 2) * kstep; const char* b2 = last ? nB : cB + (unsigned)(t + 2) * kstep;
            const char* a3 = a2 + kstep; const char* b3 = b2 + kstep;
            PG8_LDB(B0, 0, 0); PG8_LDB(B1, 0, 1); PG8_SCHED; PG8_LDA(At, 0, 0); PG8_STAGE(PG8_SA(1, 1), a1 + hstepA, voffA);
            PG8_WAIT_V(8); PG8_WAIT_L(0); PG8_BAR; PG8_MMA(0, 0, At, B0); PG8_MMA(0, 1, At, B1); PG8_BAR; PG8_SCHED;
            PG8_LDA(At, 0, 1); PG8_STAGE(PG8_SB(0, 0), b2, voffB); PG8_STAGE(PG8_SB(0, 1), b2 + hstepB, voffB); PG8_STAGE(PG8_SA(0, 0), a2, voffA);
            PG8_WAIT_V(8); PG8_WAIT_L(0); PG8_BAR; PG8_MMA(1, 0, At, B0); PG8_MMA(1, 1, At, B1); PG8_BAR; PG8_SCHED;
            PG8_LDB(B0, 1, 0); PG8_LDB(B1, 1, 1); PG8_SCHED; PG8_LDA(At, 1, 0); PG8_STAGE(PG8_SA(0, 1), a2 + hstepA, voffA);
            PG8_WAIT_V(8); PG8_WAIT_L(0); PG8_BAR; PG8_MMA(0, 0, At, B0); PG8_MMA(0, 1, At, B1); PG8_BAR; PG8_SCHED;
            PG8_LDA(At, 1, 1); PG8_STAGE(PG8_SB(1, 0), b3, voffB); PG8_STAGE(PG8_SB(1, 1), b3 + hstepB, voffB); PG8_STAGE(PG8_SA(1, 0), a3, voffA);
            PG8_WAIT_V(8); PG8_WAIT_L(0); PG8_BAR; PG8_MMA(1, 0, At, B0); PG8_MMA(1, 1, At, B1); PG8_BAR; PG8_SCHED;
        }
        if constexpr (ALIGN_EPI) { if (wr == 0) PG8_BAR; }
        if constexpr (!Epi::AFTER_DRAIN) { int t2 = threadIdx.x; asm volatile("" : "+v"(t2)); E(acc, cur, wr, wc, t2 & 15, (t2 >> 4) & 3); }
        if (!has_next) break;
#pragma unroll
        for (int a = 0; a < 2; ++a)
#pragma unroll
            for (int b = 0; b < 2; ++b)
#pragma unroll
                for (int m = 0; m < 4; ++m)
#pragma unroll
                    for (int n = 0; n < 2; ++n) acc[a][b][m][n] = (f32x4){0.f, 0.f, 0.f, 0.f};
        cur = nxt; cA = nA; cB = nB; ++ui;
        { int t3 = threadIdx.x; asm volatile("" : "+v"(t3)); PG8_LANEOFFS(t3); }
        if constexpr (ALIGN_EPI) { if (wr == 1) PG8_BAR; }
    }
    PG8_WAIT_V(0);
    if constexpr (!ALIGN_EPI) { if (wr == 0) PG8_BAR; }
    PG8_BAR;
    if constexpr (Epi::AFTER_DRAIN) { E.fused(acc, cur, wr, wc, fr, fq, lds, wid, lane); }
#undef PG8_LANEOFFS
#undef PG8_SA
#undef PG8_SB
#undef PG8_STAGE
#undef PG8_LDA
#undef PG8_LDB
#undef PG8_MMA
#undef PG8_WAIT_V
#undef PG8_WAIT_L
#undef PG8_BAR
#undef PG8_SCHED
}

typedef f32x4 (&AccRef)[2][2][4][2];

struct EpiFfnUp {
    static constexpr bool AFTER_DRAIN = false;
    bf16_t* H; const float* ss;
    __device__ __forceinline__ void operator()(AccRef acc, const Unit& u, int wr, int wc, int fr, int fq) const {
#pragma unroll
        for (int ai = 0; ai < 2; ++ai)
#pragma unroll
            for (int m = 0; m < 4; ++m) {
                const int row = u.pm * 256 + ai * 128 + wr * 64 + m * 16 + fr;
                const float rs = rsqrtf(ss[row] * (1.f / D) + EPS);
                f32x4 o[2];
#pragma unroll
                for (int n = 0; n < 2; ++n)
#pragma unroll
                    for (int j = 0; j < 4; ++j) { const float g = acc[ai][0][m][n][j] * rs, up = acc[ai][1][m][n][j] * rs; o[n][j] = g * sigmoidf_(g) * up; }
                *(u32x4*)(H + (size_t)row * FF + u.pn * 128 + wc * 32 + 8 * fq) = pack8(o[0], o[1]);
            }
    }
};
struct EpiResid {
    static constexpr bool AFTER_DRAIN = false;
    const float* hin; float* hout; bf16_t* hb; float* ssn; float scale;
    __device__ __forceinline__ void operator()(AccRef acc, const Unit& u, int wr, int wc, int fr, int fq) const {
#pragma unroll
        for (int ai = 0; ai < 2; ++ai)
#pragma unroll
            for (int m = 0; m < 4; ++m) {
                const int row = u.pm * 256 + ai * 128 + wr * 64 + m * 16 + fr; float part = 0.f;
#pragma unroll
                for (int bj = 0; bj < 2; ++bj) {
                    const size_t idx = (size_t)row * D + u.pn * 256 + bj * 128 + wc * 32 + 8 * fq;
                    const f32x4 o0 = *(const f32x4*)(hin + idx), o1 = *(const f32x4*)(hin + idx + 4);
                    const f32x4 v0 = o0 + acc[ai][bj][m][0] * scale, v1 = o1 + acc[ai][bj][m][1] * scale;
                    *(f32x4*)(hout + idx) = v0; *(f32x4*)(hout + idx + 4) = v1;
                    *(u32x4*)(hb + idx) = pack8(v0, v1);
                    part += (v0[0] * v0[0] + v0[1] * v0[1]) + (v0[2] * v0[2] + v0[3] * v0[3]) + (v1[0] * v1[0] + v1[1] * v1[1]) + (v1[2] * v1[2] + v1[3] * v1[3]);
                }
                part = fq_sum(part);
                if (fq == 0) atomicAdd(ssn + row, part);
            }
    }
};
struct EpiWin {
    static constexpr bool AFTER_DRAIN = false;
    unsigned char* arp; const float* ss;
    __device__ __forceinline__ void operator()(AccRef acc, const Unit& u, int wr, int wc, int fr, int fq) const {
        bf16_t* up = (bf16_t*)(arp + AR_UP); bf16_t* qb = (bf16_t*)(arp + AR_Q); bf16_t* kb = (bf16_t*)(arp + AR_K); bf16_t* vt = (bf16_t*)(arp + AR_VT);
        const int sel = u.pn >> 1;
#pragma unroll
        for (int ai = 0; ai < 2; ++ai)
#pragma unroll
            for (int m = 0; m < 4; ++m) {
                const int row = u.pm * 256 + ai * 128 + wr * 64 + m * 16 + fr;
                float rs = rsqrtf(ss[row] * (1.f / D) + EPS);
                if (sel == 1) rs *= 0.125f * LOG2E;
                const int b = row >> 13, t = row & (SEQ - 1);
#pragma unroll
                for (int bj = 0; bj < 2; ++bj) {
                    const int c = (u.pn & 1) * 256 + bj * 128 + wc * 32 + 8 * fq;
                    const f32x4 v0 = acc[ai][bj][m][0] * rs, v1 = acc[ai][bj][m][1] * rs;
                    if (sel == 0) { const int g = c >> 4, hi0 = c & 15;
                        *(u32x4*)(up + ((size_t)((b * NG + g) * NCH + (t >> 5))) * UPW + (t & 31) * 16 + hi0) = pack8(v0, v1);
                    } else if (sel == 1) { *(u32x4*)(qb + (size_t)row * 512 + c) = pack8(v0, v1);
                    } else if (sel == 2) { *(u32x4*)(kb + (size_t)row * 512 + c) = pack8(v0, v1);
                    } else { const int h = c >> 7, dv = c & 127; bf16_t* p = vt + ((size_t)((b * 4 + h) * 128 + dv)) * SEQ + t;
                        const u32x4 w = pack8(v0, v1);
                        p[0] = (bf16_t)(w.x & 0xffff); p[SEQ] = (bf16_t)(w.x >> 16); p[2 * SEQ] = (bf16_t)(w.y & 0xffff); p[3 * SEQ] = (bf16_t)(w.y >> 16);
                        p[4 * SEQ] = (bf16_t)(w.z & 0xffff); p[5 * SEQ] = (bf16_t)(w.z >> 16); p[6 * SEQ] = (bf16_t)(w.w & 0xffff); p[7 * SEQ] = (bf16_t)(w.w >> 16);
                    }
                }
            }
    }
};
__device__ __forceinline__ float gelu_tanh(float x) { const float z = 0.7978845608028654f * (x + 0.044715f * x * x * x); return x * fast_rcp(1.f + fast_exp2(-2.f * LOG2E * z)); }
struct EpiSsm2 {
    static constexpr bool AFTER_DRAIN = false;
    bf16_t* yb;
    __device__ __forceinline__ void operator()(AccRef acc, const Unit& u, int wr, int wc, int fr, int fq) const {
        const int b = u.bz >> 5, g = u.bz & 31;
#pragma unroll
        for (int ai = 0; ai < 2; ++ai)
#pragma unroll
            for (int m = 0; m < 4; ++m) {
                const int ch = ai * 128 + wr * 64 + m * 16 + fr;
#pragma unroll
                for (int bj = 0; bj < 2; ++bj) {
                    const int cc = u.pn * 256 + bj * 128 + wc * 32 + 8 * fq, t = cc >> 4, ho0 = cc & 15;
                    f32x4 v0, v1;
#pragma unroll
                    for (int j = 0; j < 4; ++j) { v0[j] = gelu_tanh(acc[ai][bj][m][0][j]); v1[j] = gelu_tanh(acc[ai][bj][m][1][j]); }
                    *(u32x4*)(yb + ((size_t)(b * SEQ + ch * CH + t)) * 512 + g * 16 + ho0) = pack8(v0, v1);
                }
            }
    }
};
struct EpiGlu {
    static constexpr bool AFTER_DRAIN = false;
    bf16_t* mix; const float* bglu; float* ssq;
    __device__ __forceinline__ void operator()(AccRef acc, const Unit& u, int wr, int wc, int fr, int fq) const {
        const int c0 = u.pn * 128 + wc * 32 + 8 * fq;
        const f32x4 bv0 = *(const f32x4*)(bglu + c0), bv1 = *(const f32x4*)(bglu + c0 + 4), bg0 = *(const f32x4*)(bglu + 512 + c0), bg1 = *(const f32x4*)(bglu + 512 + c0 + 4);
#pragma unroll
        for (int ai = 0; ai < 2; ++ai)
#pragma unroll
            for (int m = 0; m < 4; ++m) {
                const int row = u.pm * 256 + ai * 128 + wr * 64 + m * 16 + fr;
                f32x4 o0, o1; float part = 0.f;
#pragma unroll
                for (int j = 0; j < 4; ++j) {
                    o0[j] = (acc[ai][0][m][0][j] + bv0[j]) * sigmoidf_(acc[ai][1][m][0][j] + bg0[j]);
                    o1[j] = (acc[ai][0][m][1][j] + bv1[j]) * sigmoidf_(acc[ai][1][m][1][j] + bg1[j]);
                    part += o0[j] * o0[j] + o1[j] * o1[j];
                }
                *(u32x4*)(mix + (size_t)row * D + c0) = pack8(o0, o1);
                part = fq_sum(part);
                if (fq == 0) atomicAdd(ssq + row, part);
            }
    }
};
struct EpiWq {
    static constexpr bool AFTER_DRAIN = false;
    bf16_t* O; const float* ss; float mul;
    __device__ __forceinline__ void operator()(AccRef acc, const Unit& u, int wr, int wc, int fr, int fq) const {
#pragma unroll
        for (int ai = 0; ai < 2; ++ai)
#pragma unroll
            for (int m = 0; m < 4; ++m) {
                const int row = u.pm * 256 + ai * 128 + wr * 64 + m * 16 + fr;
                const float rs = rsqrtf(ss[row] * (1.f / D) + EPS) * mul;
#pragma unroll
                for (int bj = 0; bj < 2; ++bj)
                    *(u32x4*)(O + (size_t)row * D + u.pn * 256 + bj * 128 + wc * 32 + 8 * fq) = pack8(acc[ai][bj][m][0] * rs, acc[ai][bj][m][1] * rs);
            }
    }
};
struct EpiWkv {
    static constexpr bool AFTER_DRAIN = false;
    bf16_t *kx, *vxt;
    __device__ __forceinline__ void operator()(AccRef acc, const Unit& u, int wr, int wc, int fr, int fq) const {
        const size_t lo = (size_t)u.bz * 1024 * 1024;
#pragma unroll
        for (int ai = 0; ai < 2; ++ai)
#pragma unroll
            for (int m = 0; m < 4; ++m) {
                const int row = u.pm * 256 + ai * 128 + wr * 64 + m * 16 + fr;
#pragma unroll
                for (int bj = 0; bj < 2; ++bj) {
                    const int col = u.pn * 256 + bj * 128 + wc * 32 + 8 * fq;
                    const u32x4 w = pack8(acc[ai][bj][m][0], acc[ai][bj][m][1]);
                    if (u.pn < 4) *(u32x4*)(kx + lo + (size_t)row * 1024 + col) = w;
                    else { const int c2 = col - 1024, h = c2 >> 8, d = c2 & 255, b = row >> 8, mm = row & 255;
                        bf16_t* p = vxt + lo + ((size_t)((b * 4 + h) * 256 + d)) * 256 + mm;
                        p[0] = (bf16_t)(w.x & 0xffff); p[256] = (bf16_t)(w.x >> 16); p[512] = (bf16_t)(w.y & 0xffff); p[768] = (bf16_t)(w.y >> 16);
                        p[1024] = (bf16_t)(w.z & 0xffff); p[1280] = (bf16_t)(w.z >> 16); p[1536] = (bf16_t)(w.w & 0xffff); p[1792] = (bf16_t)(w.w >> 16); }
                }
            }
    }
};
struct EpiSoftmax {
    static constexpr bool AFTER_DRAIN = false;
    bf16_t* P; LAS float* red;
    __device__ __forceinline__ void operator()(AccRef acc, const Unit& u, int wr, int wc, int fr, int fq) const {
        const int b = u.bz >> 2, h = u.bz & 3;
        float mx[2][4];
#pragma unroll
        for (int ai = 0; ai < 2; ++ai)
#pragma unroll
            for (int m = 0; m < 4; ++m) {
                float v = -INFINITY;
#pragma unroll
                for (int bj = 0; bj < 2; ++bj)
#pragma unroll
                    for (int n = 0; n < 2; ++n)
#pragma unroll
                        for (int j = 0; j < 4; ++j) v = fmaxf(v, acc[ai][bj][m][n][j]);
                v = fq_max(v);
                const int rl = ai * 128 + wr * 64 + m * 16 + fr;
                if (fq == 0) red[rl * 4 + wc] = v;
            }
        asm volatile("s_waitcnt lgkmcnt(0)" ::: "memory"); __builtin_amdgcn_s_barrier(); asm volatile("" ::: "memory");
#pragma unroll
        for (int ai = 0; ai < 2; ++ai)
#pragma unroll
            for (int m = 0; m < 4; ++m) {
                const int rl = ai * 128 + wr * 64 + m * 16 + fr;
                const f32x4 r4 = *(const LAS f32x4*)(red + rl * 4);
                const float M = fmaxf(fmaxf(r4[0], r4[1]), fmaxf(r4[2], r4[3]));
                float s = 0.f;
#pragma unroll
                for (int bj = 0; bj < 2; ++bj)
#pragma unroll
                    for (int n = 0; n < 2; ++n)
#pragma unroll
                        for (int j = 0; j < 4; ++j) { const float p = fast_exp2(acc[ai][bj][m][n][j] - M); acc[ai][bj][m][n][j] = p; s += p; }
                s = fq_sum(s);
                if (fq == 0) red[1024 + rl * 4 + wc] = s;
            }
        asm volatile("s_waitcnt lgkmcnt(0)" ::: "memory"); __builtin_amdgcn_s_barrier(); asm volatile("" ::: "memory");
#pragma unroll
        for (int ai = 0; ai < 2; ++ai)
#pragma unroll
            for (int m = 0; m < 4; ++m) {
                const int rl = ai * 128 + wr * 64 + m * 16 + fr;
                const f32x4 r4 = *(const LAS f32x4*)(red + 1024 + rl * 4);
                const float inv = 1.f / ((r4[0] + r4[1]) + (r4[2] + r4[3]));
                const size_t row = (size_t)b * SEQ + u.pm * 256 + rl;
#pragma unroll
                for (int bj = 0; bj < 2; ++bj)
                    *(u32x4*)(P + row * D + h * 256 + bj * 128 + wc * 32 + 8 * fq) = pack8(acc[ai][bj][m][0] * inv, acc[ai][bj][m][1] * inv);
            }
    }
};
struct EpiPV {
    static constexpr bool AFTER_DRAIN = false;
    bf16_t* O;
    __device__ __forceinline__ void operator()(AccRef acc, const Unit& u, int wr, int wc, int fr, int fq) const {
        const int b = u.bz >> 2, h = u.bz & 3;
#pragma unroll
        for (int ai = 0; ai < 2; ++ai)
#pragma unroll
            for (int m = 0; m < 4; ++m) {
                const size_t row = (size_t)b * SEQ + u.pm * 256 + ai * 128 + wr * 64 + m * 16 + fr;
#pragma unroll
                for (int bj = 0; bj < 2; ++bj)
                    *(u32x4*)(O + row * D + h * 256 + bj * 128 + wc * 32 + 8 * fq) = pack8(acc[ai][bj][m][0], acc[ai][bj][m][1]);
            }
    }
};
struct EpiSsm1 {
    static constexpr bool AFTER_DRAIN = true;
    bf16_t* up; const float *lam_re, *lam_im, *log_dt;
    __device__ __forceinline__ void operator()(AccRef, const Unit&, int, int, int, int) const {}
    __device__ __forceinline__ void fused(AccRef acc, const Unit& u, int wr, int wc, int fr, int fq, LAS unsigned char* lds, int wid, int lane) const {
        LAS float* L = (LAS float*)lds;
#pragma unroll
        for (int ai = 0; ai < 2; ++ai)
#pragma unroll
            for (int m = 0; m < 4; ++m) {
                const int rl = ai * 128 + wr * 64 + m * 16 + fr;
#pragma unroll
                for (int n = 0; n < 2; ++n) { const int col = wc * 32 + 8 * fq + 4 * n; *(LAS f32x4*)(L + rl * 128 + (col ^ ((rl & 15) << 3))) = acc[ai][0][m][n]; }
            }
        __syncthreads();
        if (wid == 0) {
            const int g = u.bz & 31, p = lane;
            const float dt = expf(log_dt[g]) * (float)CH;
            const float lr = fminf(lam_re[g * NP + p], -1e-4f), li = lam_im[g * NP + p];
            const float mag = expf(lr * dt); float sn, cs; sincosf(li * dt, &sn, &cs);
            const float ar = mag * cs, aim = mag * sn;
            float xr = 0.f, xi = 0.f;
            unsigned* dst = (unsigned*)(up + (size_t)u.bz * NCH * UPW + 512) + p;
            for (int c = 0; c < NCH; ++c) {
                dst[(size_t)c * (UPW / 2)] = cvtpk(xr, xi);
                const f32x2 l2 = *(const LAS f32x2*)(L + c * 128 + ((2 * p) ^ ((c & 15) << 3)));
                const float nr = ar * xr - aim * xi + l2[0], ni = ar * xi + aim * xr + l2[1];
                xr = nr; xi = ni;
            }
        }
        __syncthreads();
    }
};

struct GainSpec { const float* g1; const float* g2; float g2s; };
__device__ __forceinline__ float gain_of(const GainSpec& gs, int k) {
    if (!gs.g1) return 1.f;
    if (gs.g2 && k >= 512) return gs.g2[(k - 512) & 127] * gs.g2s;
    return gs.g1[k];
}
__device__ __forceinline__ void transpose_item(const float* W, int K, int N, bf16_t* WT, bool il, int nh, int hb, const GainSpec gs, LAS float* scr, int item, int lane) {
    const int nblk = N / 32, kb = item / nblk, nb = item % nblk, k0 = 64 * kb, n0 = 32 * nb;
#pragma unroll 8
    for (int i = 0; i < 32; ++i) { const int kk = 2 * i + (lane >> 5); scr[kk * 33 + (lane & 31)] = W[(size_t)(k0 + kk) * N + n0 + (lane & 31)] * gain_of(gs, k0 + kk); }
    asm volatile("s_waitcnt lgkmcnt(0)" ::: "memory");
    const int c = lane & 7;
#pragma unroll
    for (int j = 0; j < 4; ++j) { const int n = (lane >> 3) + 8 * j; const LAS float* s = scr + (8 * c) * 33 + n;
        u32x4 o; o.x = cvtpk(s[0 * 33], s[1 * 33]); o.y = cvtpk(s[2 * 33], s[3 * 33]); o.z = cvtpk(s[4 * 33], s[5 * 33]); o.w = cvtpk(s[6 * 33], s[7 * 33]);
        int row = n0 + n; if (il) { const int jj = row % nh, half = hb + row / nh; row = (jj >> 7) * 256 + half * 128 + (jj & 127); }
        *(u32x4*)(WT + (size_t)row * K + k0 + 8 * c) = o; }
    asm volatile("s_waitcnt lgkmcnt(0)" ::: "memory");
}

__device__ __forceinline__ void ssm_matrices(KArgsP a, int l, int g, LAS unsigned char* lds, bf16_t* Bm, bf16_t* Mt) {
    int tid = threadIdx.x; asm volatile("" : "+v"(tid));
    LAS f32x2* lamtab = (LAS f32x2*)lds;
    LAS f32x2* cc = (LAS f32x2*)(lds + 16896);
    LAS f32x2* bb = (LAS f32x2*)(lds + 16896 + 8192);
    LAS float* Kt = (LAS float*)(lds + 16896 + 16384);
    const float* lam_re = a->in[9] + (size_t)(l * NG + g) * NP; const float* lam_im = a->in[10] + (size_t)(l * NG + g) * NP;
    const float* b_re = a->in[11] + (size_t)(l * NG + g) * NP * 16; const float* b_im = a->in[12] + (size_t)(l * NG + g) * NP * 16;
    const float* c_re = a->in[13] + (size_t)(l * NG + g) * 16 * NP; const float* c_im = a->in[14] + (size_t)(l * NG + g) * 16 * NP;
    const float* dd = a->in[15] + (size_t)(l * NG + g) * 16;
    const float dt = expf(a->in[16][l * NG + g]);
    for (int idx = tid; idx < 33 * 64; idx += 512) { const int tau = idx >> 6, p = idx & 63;
        const float lr = fminf(lam_re[p], -1e-4f), li = lam_im[p]; const float zr = lr * dt * (float)tau, zi = li * dt * (float)tau;
        const float mag = expf(zr); float sn, cs; sincosf(zi, &sn, &cs); lamtab[idx] = (f32x2){mag * cs, mag * sn}; }
    for (int idx = tid; idx < 1024; idx += 512) {
        cc[idx] = (f32x2){c_re[idx], c_im[idx]};
        const int p = idx >> 4;
        const float lr = fminf(lam_re[p], -1e-4f), li = lam_im[p]; const float mag = expf(lr * dt); float sn, cs; sincosf(li * dt, &sn, &cs);
        const float ar = mag * cs - 1.f, ai = mag * sn, den = 1.f / (lr * lr + li * li);
        const float qr = (ar * lr + ai * li) * den, qi = (ai * lr - ar * li) * den;
        const float br = b_re[idx], bi = b_im[idx];
        bb[idx] = (f32x2){qr * br - qi * bi, qr * bi + qi * br};
    }
    __syncthreads();
    for (int idx = tid; idx < 32 * 256; idx += 512) { const int tau = idx >> 8, ho = (idx >> 4) & 15, hi = idx & 15; float s = 0.f;
        for (int p = 0; p < NP; ++p) { const f32x2 c = cc[ho * 64 + p], lm = lamtab[tau * 64 + p], b = bb[p * 16 + hi];
            const float wr_ = c[0] * lm[0] - c[1] * lm[1], wi_ = c[0] * lm[1] + c[1] * lm[0]; s += wr_ * b[0] - wi_ * b[1]; }
        if (tau == 0 && ho == hi) s += dd[ho];
        Kt[idx] = s; }
    __syncthreads();
    for (int ch = tid; ch < 512 * 80; ch += 512) { const int n = ch / 80, kc = ch % 80, t = n >> 4, ho = n & 15, k0 = kc * 8; float v[8];
        if (k0 < 512) { const int s = k0 >> 4, hi0 = k0 & 15;
#pragma unroll
            for (int j = 0; j < 8; ++j) v[j] = (s <= t) ? Kt[(t - s) * 256 + ho * 16 + hi0 + j] : 0.f;
        } else { const int p0 = (k0 - 512) >> 1;
#pragma unroll
            for (int j = 0; j < 4; ++j) { const f32x2 c = cc[ho * 64 + p0 + j], lm = lamtab[(t + 1) * 64 + p0 + j];
                v[2 * j] = c[0] * lm[0] - c[1] * lm[1]; v[2 * j + 1] = -(c[0] * lm[1] + c[1] * lm[0]); } }
        u32x4 o; o.x = cvtpk(v[0], v[1]); o.y = cvtpk(v[2], v[3]); o.z = cvtpk(v[4], v[5]); o.w = cvtpk(v[6], v[7]);
        *(u32x4*)(Mt + (size_t)n * UPW + k0) = o; }
    for (int ch = tid; ch < 256 * 64; ch += 512) { const int n = ch >> 6, k0 = (ch & 63) * 8; float v[8];
        if (n < 128) { const int p = n >> 1, ri = n & 1, s = k0 >> 4, hi0 = k0 & 15; const f32x2 lm = lamtab[(CH - 1 - s) * 64 + p];
#pragma unroll
            for (int j = 0; j < 8; ++j) { const f32x2 b = bb[p * 16 + hi0 + j]; v[j] = ri ? (lm[0] * b[1] + lm[1] * b[0]) : (lm[0] * b[0] - lm[1] * b[1]); }
        } else {
#pragma unroll
            for (int j = 0; j < 8; ++j) v[j] = 0.f; }
        u32x4 o; o.x = cvtpk(v[0], v[1]); o.y = cvtpk(v[2], v[3]); o.z = cvtpk(v[4], v[5]); o.w = cvtpk(v[6], v[7]);
        *(u32x4*)(Bm + (size_t)n * 512 + k0) = o; }
    __syncthreads();
}

__device__ __forceinline__ void prologue(KArgsP a, LAS unsigned char* lds, int G) {
    unsigned char* ws = a->ws;
    int tid = threadIdx.x; asm volatile("" : "+v"(tid));
    const int lane = tid & 63, wave = tid >> 6, bid = blockIdx.x;
    { float* z = (float*)(ws + WS_SS) + T; const size_t n = (size_t)10 * T;
      for (size_t i = (size_t)bid * 512 + tid; i < n; i += (size_t)G * 512) z[i] = 0.f; }
    for (int it = bid; it < DEPTH * NG; it += G) { const int l = it >> 5, g = it & 31;
        ssm_matrices(a, l, g, lds, (bf16_t*)(ws + WS_W + l * W_LAYER + W_BM) + (size_t)g * 256 * 512, (bf16_t*)(ws + WS_W + l * W_LAYER + W_MT) + (size_t)g * 512 * UPW); }
    if (bid == 0) {
        float* sm = (float*)(ws + WS_SMALL);
        if (tid < 128) { const int l = tid >> 6, i = tid & 63;
            const float d1 = wave_sum(a->in[20][l * 64 + i] * a->in[21][l * 64 + i]), d2 = wave_sum(a->in[22][l * 64 + i] * a->in[23][l * 64 + i]);
            if (i == 0) sm[l] = expf(d1) - expf(d2) + (0.8f - 0.6f * expf(-0.3f * (float)l)); }
        for (int idx = tid; idx < 4 * 132; idx += 512) { const int h = idx / 132, n = idx % 132; int bk;
            if (n < 16) bk = n; else { const float nf = (float)n; int lg = 16 + (int)(logf(nf / 16.f) / 2.0794415416798357f * 16.f); bk = lg < 31 ? lg : 31; }
            sm[16 + idx] = a->in[2][bk * 4 + h] * LOG2E; }
    }
    { LAS float* scr = (LAS float*)(lds + wave * 16384);
      const int gw = bid * 8 + wave, NGW = G * 8;
      for (int it = gw; it < DEPTH * 12288; it += NGW) {
          const int l = it / 12288; int r = it % 12288; unsigned char* wl = ws + WS_W + l * W_LAYER;
          const GainSpec none{nullptr, nullptr, 0.f};
          if (r < 1408) { transpose_item(a->in[4] + (size_t)l * D * FF, D, FF, (bf16_t*)(wl + W_GU1), true, FF, 0, GainSpec{a->in[3] + l * D, nullptr, 0.f}, scr, r, lane); continue; } r -= 1408;
          if (r < 1408) { transpose_item(a->in[5] + (size_t)l * D * FF, D, FF, (bf16_t*)(wl + W_GU1), true, FF, 1, GainSpec{a->in[3] + l * D, nullptr, 0.f}, scr, r, lane); continue; } r -= 1408;
          if (r < 1408) { transpose_item(a->in[6] + (size_t)l * FF * D, FF, D, (bf16_t*)(wl + W_D1), false, 1, 0, none, scr, r, lane); continue; } r -= 1408;
          if (r < 1408) { transpose_item(a->in[32] + (size_t)l * D * FF, D, FF, (bf16_t*)(wl + W_GU2), true, FF, 0, GainSpec{a->in[31] + l * D, nullptr, 0.f}, scr, r, lane); continue; } r -= 1408;
          if (r < 1408) { transpose_item(a->in[33] + (size_t)l * D * FF, D, FF, (bf16_t*)(wl + W_GU2), true, FF, 1, GainSpec{a->in[31] + l * D, nullptr, 0.f}, scr, r, lane); continue; } r -= 1408;
          if (r < 1408) { transpose_item(a->in[34] + (size_t)l * FF * D, FF, D, (bf16_t*)(wl + W_D2), false, 1, 0, none, scr, r, lane); continue; } r -= 1408;
          if (r < 1024) { transpose_item(a->in[8] + (size_t)l * D * 2048, D, 2048, (bf16_t*)(wl + W_IN), false, 1, 0, GainSpec{a->in[7] + l * D, nullptr, 0.f}, scr, r, lane); continue; } r -= 1024;
          if (r < 256) { transpose_item(a->in[17] + (size_t)l * 512 * 1024, 512, 1024, (bf16_t*)(wl + W_GLU), true, 512, 0, none, scr, r, lane); continue; } r -= 256;
          if (r < 512) { transpose_item(a->in[25] + (size_t)l * D * D, D, D, (bf16_t*)(wl + W_OUT), false, 1, 0, GainSpec{a->in[19] + l * 512, a->in[24] + l * 128, 1.f - (0.8f - 0.6f * expf(-0.3f * (float)l))}, scr, r, lane); continue; } r -= 512;
          if (r < 512) { transpose_item(a->in[28] + (size_t)l * D * D, D, D, (bf16_t*)(wl + W_Q), false, 1, 0, GainSpec{a->in[26] + l * D, nullptr, 0.f}, scr, r, lane); continue; } r -= 512;
          if (r < 1024) { transpose_item(a->in[29] + (size_t)l * D * 2048, D, 2048, (bf16_t*)(wl + W_KV), false, 1, 0, none, scr, r, lane); continue; } r -= 1024;
          transpose_item(a->in[30] + (size_t)l * D * D, D, D, (bf16_t*)(wl + W_O), false, 1, 0, none, scr, r, lane);
      }
      for (int row = gw; row < T + DEPTH * BATCH * MEM; row += NGW) {
          const bool ismem = row >= T; const int mr = row - T, l = mr >> 10, mrow = mr & 1023;
          const float* src = ismem ? a->in[1] + (size_t)mrow * D : a->in[0] + (size_t)row * D;
          f32x4 v[4]; float s = 0.f;
#pragma unroll
          for (int j = 0; j < 4; ++j) { v[j] = *((const f32x4*)src + lane + 64 * j); s += (v[j][0] * v[j][0] + v[j][1] * v[j][1]) + (v[j][2] * v[j][2] + v[j][3] * v[j][3]); }
          s = wave_sum(s);
          if (!ismem) { if (lane == 0) ((float*)(ws + WS_SS))[row] = s;
#pragma unroll
              for (int j = 0; j < 4; ++j) *((u32x2*)(ws + WS_HB + (size_t)row * D * 2) + lane + 64 * j) = (u32x2){cvtpk(v[j][0], v[j][1]), cvtpk(v[j][2], v[j][3])};
          } else { const float rs = rsqrtf(s * (1.f / D) + EPS); const float* gn = a->in[27] + l * D;
#pragma unroll
              for (int j = 0; j < 4; ++j) { const f32x4 gg = *((const f32x4*)gn + lane + 64 * j);
                  *((u32x2*)(ws + WS_MEMN + ((size_t)l * 1024 + mrow) * D * 2) + lane + 64 * j) = (u32x2){cvtpk(v[j][0] * rs * gg[0], v[j][1] * rs * gg[1]), cvtpk(v[j][2] * rs * gg[2], v[j][3] * rs * gg[3])}; }
          }
      }
    }
}

constexpr int AT_KROW = 272, AT_VROW = 144, AT_KBUF = 64 * AT_KROW, AT_VBUF = 128 * AT_VROW;
constexpr int AT_K0 = 0, AT_V0 = 2 * AT_KBUF, AT_BIAS = AT_V0 + 2 * AT_VBUF;

__device__ __forceinline__ void attn_qblock(int b, int h, int q0, float lam, LAS unsigned char* lds, const bf16_t* qbuf, const bf16_t* kbuf, const bf16_t* vT, bf16_t* mix, const float* bias_g) {
    int tid = threadIdx.x; asm volatile("" : "+v"(tid));
    const int lane = tid & 63, w = __builtin_amdgcn_readfirstlane(tid >> 6), r = lane & 15, g = lane >> 4;
    const int qw0 = q0 + w * 16, qrow = qw0 + r;
    LAS float* biasl = (LAS float*)(lds + AT_BIAS);
    if (tid < 129) biasl[tid] = bias_g[h * 132 + tid];
    bf16x8 qf[2][2];
    { const bf16_t* qp = qbuf + ((size_t)(b * SEQ + qrow)) * 512 + h * 128 + g * 8;
#pragma unroll
      for (int m = 0; m < 2; ++m)
#pragma unroll
          for (int ks = 0; ks < 2; ++ks) qf[m][ks] = *(const bf16x8*)(qp + m * 64 + ks * 32); }
    f32x4 o[2][8];
#pragma unroll
    for (int m = 0; m < 2; ++m)
#pragma unroll
        for (int db = 0; db < 8; ++db) o[m][db] = (f32x4){0.f, 0.f, 0.f, 0.f};
    float mrow[2] = {-INFINITY, -INFINITY}, lrow[2] = {0.f, 0.f};
    const int ntiles = (q0 + 128) >> 6;
    unsigned gk[2], lk[2], gv[2], lv[2];
#pragma unroll
    for (int i = 0; i < 2; ++i) { const int c = tid + i * 512;
        { const int key = c >> 4, ch = c & 15, rho = ((key >> 5) * 2 + ((key >> 2) & 1)) * 16 + ((key >> 3) & 3) * 4 + (key & 3); gk[i] = key * 512 + ch * 8; lk[i] = rho * AT_KROW + ch * 16; }
        { const int dv = c >> 3, ch = c & 7; gv[i] = dv * SEQ + ch * 8; lv[i] = dv * AT_VROW + ch * 16; } }
    const bf16_t* kbase = kbuf + ((size_t)b * SEQ) * 512 + h * 128;
    const bf16_t* vbase = vT + ((size_t)(b * 4 + h) * 128) * SEQ;
    u32x4 kreg[2], vreg[2];
#pragma unroll
    for (int i = 0; i < 2; ++i) { kreg[i] = *(const u32x4*)(kbase + gk[i]); vreg[i] = *(const u32x4*)(vbase + gv[i]); }
#pragma unroll
    for (int i = 0; i < 2; ++i) { *(LAS u32x4*)(lds + AT_K0 + lk[i]) = kreg[i]; *(LAS u32x4*)(lds + AT_V0 + lv[i]) = vreg[i]; }
    __syncthreads();
    const float cfar = biasl[128];
    for (int kt = 0; kt < ntiles; ++kt) {
        const int cur = kt & 1, k0 = kt * 64;
        const bool pf = (kt + 1 < ntiles);
        if (pf) {
#pragma unroll
            for (int i = 0; i < 2; ++i) { kreg[i] = *(const u32x4*)(kbase + (size_t)(k0 + 64) * 512 + gk[i]); vreg[i] = *(const u32x4*)(vbase + (k0 + 64) + gv[i]); } }
        if (k0 <= qw0 + 15) {
            LAS unsigned char* Kb = lds + AT_K0 + cur * AT_KBUF; LAS unsigned char* Vb = lds + AT_V0 + cur * AT_VBUF;
            f32x4 s[2][4];
#pragma unroll
            for (int m = 0; m < 2; ++m)
#pragma unroll
                for (int kb = 0; kb < 4; ++kb) { s[m][kb] = (f32x4){0.f, 0.f, 0.f, 0.f};
#pragma unroll
                    for (int ks = 0; ks < 2; ++ks) { const bf16x8 kf = *(const LAS bf16x8*)(Kb + (kb * 16 + r) * AT_KROW + (m * 64 + ks * 32 + g * 8) * 2);
                        s[m][kb] = __builtin_amdgcn_mfma_f32_16x16x32_bf16(kf, qf[m][ks], s[m][kb], 0, 0, 0); } }
            const bool far = (qw0 - (k0 + 63)) >= 128;
            if (far) {
#pragma unroll
                for (int m = 0; m < 2; ++m)
#pragma unroll
                    for (int kb = 0; kb < 4; ++kb) s[m][kb] = s[m][kb] + cfar;
            } else {
#pragma unroll
                for (int kb = 0; kb < 4; ++kb)
#pragma unroll
                    for (int j = 0; j < 4; ++j) { const int key = k0 + (kb >> 1) * 32 + g * 8 + (kb & 1) * 4 + j, dist = qrow - key;
                        const float bv = biasl[dist < 0 ? 0 : (dist > 128 ? 128 : dist)];
                        s[0][kb][j] = dist >= 0 ? s[0][kb][j] + bv : -INFINITY; s[1][kb][j] = dist >= 0 ? s[1][kb][j] + bv : -INFINITY; }
            }
            bf16x8 pfr[2][2];
#pragma unroll
            for (int m = 0; m < 2; ++m) {
                float mx = -INFINITY;
#pragma unroll
                for (int kb = 0; kb < 4; ++kb) mx = fmaxf(mx, fmaxf(fmaxf(s[m][kb][0], s[m][kb][1]), fmaxf(s[m][kb][2], s[m][kb][3])));
                mx = fq_max(mx);
                const float mnew = fmaxf(mrow[m], mx), alpha = fast_exp2(mrow[m] - mnew);
                mrow[m] = mnew; float ps = 0.f;
#pragma unroll
                for (int kb = 0; kb < 4; ++kb)
#pragma unroll
                    for (int j = 0; j < 4; ++j) { const float p = fast_exp2(s[m][kb][j] - mnew); s[m][kb][j] = p; ps += p; }
                lrow[m] = lrow[m] * alpha + ps;
#pragma unroll
                for (int db = 0; db < 8; ++db) o[m][db] = o[m][db] * alpha;
#pragma unroll
                for (int kk = 0; kk < 2; ++kk) { const u32x4 pw = pack8(s[m][2 * kk], s[m][2 * kk + 1]); pfr[m][kk] = __builtin_bit_cast(bf16x8, pw); }
            }
#pragma unroll
            for (int db = 0; db < 8; ++db)
#pragma unroll
                for (int kk = 0; kk < 2; ++kk) { const bf16x8 vf = *(const LAS bf16x8*)(Vb + (db * 16 + r) * AT_VROW + (kk * 32 + g * 8) * 2);
                    o[0][db] = __builtin_amdgcn_mfma_f32_16x16x32_bf16(vf, pfr[0][kk], o[0][db], 0, 0, 0);
                    o[1][db] = __builtin_amdgcn_mfma_f32_16x16x32_bf16(vf, pfr[1][kk], o[1][db], 0, 0, 0); }
        }
        if (pf) {
#pragma unroll
            for (int i = 0; i < 2; ++i) { *(LAS u32x4*)(lds + AT_K0 + (cur ^ 1) * AT_KBUF + lk[i]) = kreg[i]; *(LAS u32x4*)(lds + AT_V0 + (cur ^ 1) * AT_VBUF + lv[i]) = vreg[i]; } }
        __syncthreads();
    }
    const float inv0 = 1.f / fq_sum(lrow[0]), inv1 = lam / fq_sum(lrow[1]);
    float ssq = 0.f;
#pragma unroll
    for (int db = 0; db < 8; ++db)
#pragma unroll
        for (int j = 0; j < 4; ++j) { const float v = o[0][db][j] * inv0 - o[1][db][j] * inv1; o[0][db][j] = v; ssq += v * v; }
    ssq = fq_sum(ssq);
    const float rn = rsqrtf(ssq * (1.f / 128.f) + EPS);
    bf16_t* op = mix + ((size_t)(b * SEQ + qrow)) * D + 512 + h * 128 + g * 4;
#pragma unroll
    for (int db = 0; db < 8; ++db) *(u32x2*)(op + db * 16) = (u32x2){cvtpk(o[0][db][0] * rn, o[0][db][1] * rn), cvtpk(o[0][db][2] * rn, o[0][db][3] * rn)};
}

#if DEBUG_CHECK
__device__ __forceinline__ unsigned hash_u(unsigned x) { x ^= x >> 16; x *= 0x7feb352dU; x ^= x >> 15; x *= 0x846ca68bU; x ^= x >> 16; return x; }
__device__ __forceinline__ void dbg_flag(unsigned* ctl, int id, float got, float ref, float rtol, float atol) {
    const float d = fabsf(got - ref);
    if (!(d <= atol + rtol * fabsf(ref))) atomicAdd(ctl + 64 + id, 1u);
}
#endif

__global__ void __launch_bounds__(512, 2) fwd_kernel(Args a) {
    extern __shared__ __attribute__((aligned(16))) unsigned char lds_raw[];
    LAS unsigned char* lds = (LAS unsigned char*)lds_raw;
    cg::grid_group grid = cg::this_grid();
    const int G = gridDim.x;
#define PH KArgsP ka = KARGS(); int bid = blockIdx.x, G = gridDim.x, tidl = threadIdx.x; asm volatile("" : "+s"(bid), "+s"(G), "+v"(tidl)); const int lane = tidl & 63, wave = tidl >> 6; (void)lane; (void)wave; unsigned char* ws = ka->ws; float* ssb = (float*)(ws + WS_SS); float* ssm_ss = (float*)(ws + WS_SSM_SS); const float* smalls = (const float*)(ws + WS_SMALL); \
    bf16_t* hb = (bf16_t*)(ws + WS_HB); unsigned char* ar = ws + WS_AR; unsigned char* wl = ws + WS_W + l * W_LAYER; float* hbuf = ka->out; \
    (void)ssb; (void)ssm_ss; (void)smalls; (void)hb; (void)ar; (void)wl; (void)hbuf;
    if (threadIdx.x < 2) ((LAS unsigned*)(lds + LDS_XB))[threadIdx.x] = 0u;
    __syncthreads();
    XcdBarrier xbar = xcd_barrier_post((unsigned*)(KARGS()->ws + WS_CTL) + 1024, (volatile LAS unsigned*)(lds + LDS_XB));
    prologue(KARGS(), lds, G);
    grid.sync();
#define GSYNC() xcd_barrier(xbar)

    for (int l = 0; l < DEPTH; ++l) {
        if (PROBE == 4) { for (int rep = 0; rep < 10; ++rep) GSYNC(); }
        for (int rep = 0; rep < (PROBE == 2 ? 2 : 1); ++rep)
        { PH StdSched S; S.init(T, 2 * FF, G, bid, D, D); EpiFfnUp E{(bf16_t*)(ar + AR_HID), ssb + (size_t)(4 * l + 0) * T};
          gemm_phase<EpiFfnUp, StdSched, false>(lds, hb, (const bf16_t*)(wl + W_GU1), D, D, D, S, E); }
        GSYNC();
        { PH StdSched S; S.init(T, D, G, bid, FF, FF); EpiResid E{l == 0 ? ka->in[0] : hbuf, hbuf, hb, ssb + (size_t)(4 * l + 1) * T, 0.5f};
          gemm_phase<EpiResid, StdSched, false>(lds, (const bf16_t*)(ar + AR_HID), (const bf16_t*)(wl + W_D1), FF, FF, FF, S, E); }
        GSYNC();
        for (int rep = 0; rep < (PROBE == 3 ? 2 : 1); ++rep)
        { PH StdSched S; S.init(T, 2048, G, bid, D, D); EpiWin E{ar, ssb + (size_t)(4 * l + 1) * T};
          gemm_phase<EpiWin, StdSched, false>(lds, hb, (const bf16_t*)(wl + W_IN), D, D, D, S, E); }
        GSYNC();
        for (int rep = 0; rep < (PROBE == 3 ? 2 : 1); ++rep)
        if ((int)blockIdx.x < 128) { PH Ssm1Sched S{bid}; EpiSsm1 E{(bf16_t*)(ar + AR_UP), ka->in[9] + (size_t)l * NG * NP, ka->in[10] + (size_t)l * NG * NP, ka->in[16] + (size_t)l * NG};
          gemm_phase<EpiSsm1, Ssm1Sched, false>(lds, (const bf16_t*)(ar + AR_UP), (const bf16_t*)(wl + W_BM), UPW, 512, 512, S, E); }
        else if (l == 0) { PH WkvSched S{G, bid}; EpiWkv E{(bf16_t*)(ws + WS_KX), (bf16_t*)(ws + WS_VXT)};
          gemm_phase<EpiWkv, WkvSched, false>(lds, (const bf16_t*)(ws + WS_MEMN), (const bf16_t*)(ws + WS_W + W_KV), D, D, D, S, E); }
        GSYNC();
        for (int rep = 0; rep < (PROBE == 3 ? 2 : 1); ++rep)
        { PH Ssm2Sched S{G, bid}; EpiSsm2 E{(bf16_t*)(ar + AR_Y)};
          gemm_phase<EpiSsm2, Ssm2Sched, false>(lds, (const bf16_t*)(ar + AR_UP), (const bf16_t*)(wl + W_MT), UPW, UPW, UPW, S, E); }
        GSYNC();
        { PH StdSched S; S.init(T, 1024, G, bid, 512, 512); EpiGlu E{(bf16_t*)(ar + AR_MIX), ka->in[18] + (size_t)l * 1024, ssm_ss + (size_t)l * T};
          gemm_phase<EpiGlu, StdSched, false>(lds, (const bf16_t*)(ar + AR_Y), (const bf16_t*)(wl + W_GLU), 512, 512, 512, S, E); }
        GSYNC();
        { PH const float lam = smalls[l];
          for (int rep = 0; rep < (PROBE == 1 ? 2 : 1); ++rep)
          for (int uidx = bid; uidx < 512; uidx += G) { const int bh = uidx >> 5, j = uidx & 31, b = bh >> 2, h = bh & 3;
              attn_qblock(b, h, j * 128, lam, lds, (const bf16_t*)(ar + AR_Q), (const bf16_t*)(ar + AR_K), (const bf16_t*)(ar + AR_VT), (bf16_t*)(ar + AR_MIX), smalls + 16);
              attn_qblock(b, h, (63 - j) * 128, lam, lds, (const bf16_t*)(ar + AR_Q), (const bf16_t*)(ar + AR_K), (const bf16_t*)(ar + AR_VT), (bf16_t*)(ar + AR_MIX), smalls + 16); }
          bf16_t* mix = (bf16_t*)(ar + AR_MIX); const float* sq = ssm_ss + (size_t)l * T;
          for (int row = bid * 8 + wave; row < T; row += G * 8) { const float rs = rsqrtf(sq[row] * (1.f / 512.f) + EPS);
              u32x4* p = (u32x4*)(mix + (size_t)row * D) + lane; u32x4 v = *p;
              v.x = cvtpk(__uint_as_float(v.x << 16) * rs, __uint_as_float(v.x & 0xffff0000u) * rs); v.y = cvtpk(__uint_as_float(v.y << 16) * rs, __uint_as_float(v.y & 0xffff0000u) * rs);
              v.z = cvtpk(__uint_as_float(v.z << 16) * rs, __uint_as_float(v.z & 0xffff0000u) * rs); v.w = cvtpk(__uint_as_float(v.w << 16) * rs, __uint_as_float(v.w & 0xffff0000u) * rs);
              *p = v; } }
        GSYNC();
        { PH StdSched S; S.init(T, D, G, bid, D, D); EpiResid E{hbuf, hbuf, hb, ssb + (size_t)(4 * l + 2) * T, 1.f};
          gemm_phase<EpiResid, StdSched, false>(lds, (const bf16_t*)(ar + AR_MIX), (const bf16_t*)(wl + W_OUT), D, D, D, S, E); }
        GSYNC();
        for (int rep = 0; rep < (PROBE == 3 ? 2 : 1); ++rep)
        { PH StdSched S; S.init(T, D, G, bid, D, D); EpiWq E{(bf16_t*)(ar + AR_QX), ssb + (size_t)(4 * l + 2) * T, 0.0625f * LOG2E};
          gemm_phase<EpiWq, StdSched, false>(lds, hb, (const bf16_t*)(wl + W_Q), D, D, D, S, E); }
        GSYNC();
        for (int rep = 0; rep < (PROBE == 3 ? 2 : 1); ++rep)
        { PH XaSched S{G, bid, (unsigned)MEM * 1024, 256u}; EpiSoftmax E{(bf16_t*)(ar + AR_P), (LAS float*)(lds + LDS_RED)};
          gemm_phase<EpiSoftmax, XaSched, true>(lds, (const bf16_t*)(ar + AR_QX), (const bf16_t*)(ws + WS_KX) + (size_t)l * 1024 * 1024, D, D, 256, S, E); }
        GSYNC();
        for (int rep = 0; rep < (PROBE == 3 ? 2 : 1); ++rep)
        { PH XaSched S{G, bid, 4u * 65536u, 65536u}; EpiPV E{(bf16_t*)(ar + AR_OX)};
          gemm_phase<EpiPV, XaSched, false>(lds, (const bf16_t*)(ar + AR_P), (const bf16_t*)(ws + WS_VXT) + (size_t)l * 1024 * 1024, D, 256, 256, S, E); }
        GSYNC();
        { PH StdSched S; S.init(T, D, G, bid, D, D); EpiResid E{hbuf, hbuf, hb, ssb + (size_t)(4 * l + 3) * T, 1.f};
          gemm_phase<EpiResid, StdSched, false>(lds, (const bf16_t*)(ar + AR_OX), (const bf16_t*)(wl + W_O), D, D, D, S, E); }
        GSYNC();
        for (int rep = 0; rep < (PROBE == 2 ? 2 : 1); ++rep)
        { PH StdSched S; S.init(T, 2 * FF, G, bid, D, D); EpiFfnUp E{(bf16_t*)(ar + AR_HID), ssb + (size_t)(4 * l + 3) * T};
          gemm_phase<EpiFfnUp, StdSched, false>(lds, hb, (const bf16_t*)(wl + W_GU2), D, D, D, S, E); }
        GSYNC();
        { PH StdSched S; S.init(T, D, G, bid, FF, FF); EpiResid E{hbuf, hbuf, hb, ssb + (size_t)(4 * l + 4) * T, 0.5f};
          gemm_phase<EpiResid, StdSched, false>(lds, (const bf16_t*)(ar + AR_HID), (const bf16_t*)(wl + W_D2), FF, FF, FF, S, E); }
        GSYNC();
    }
    { const int l = 0; PH const float* sq = ssb + (size_t)8 * T; const float* gn = ka->in[35];
      for (int row = bid * 8 + wave; row < T; row += G * 8) { const float rs = rsqrtf(sq[row] * (1.f / D) + EPS);
#pragma unroll
          for (int j = 0; j < 4; ++j) { f32x4* p = (f32x4*)(hbuf + (size_t)row * D) + lane + 64 * j; const f32x4 gg = *((const f32x4*)gn + lane + 64 * j); f32x4 v = *p;
              v[0] *= rs * gg[0]; v[1] *= rs * gg[1]; v[2] *= rs * gg[2]; v[3] *= rs * gg[3]; *p = v; } } }
}

extern "C" void kernel_launch(void* const* d_in, const int* in_sizes, int n_in, void* d_out, int out_size, void* d_ws, size_t ws_size, hipStream_t stream) {
    static int grid = 0;
    if (grid == 0) {
        if (n_in != 36 || out_size != T * D || ws_size < WS_END) { fprintf(stderr, "kernel_launch: unexpected problem (n_in %d out %d ws %zu)\n", n_in, out_size, ws_size); grid = -1; return; }
        int dev = 0, cus = 0, per_cu = 0;
        if (hipGetDevice(&dev) != hipSuccess || hipDeviceGetAttribute(&cus, hipDeviceAttributeMultiprocessorCount, dev) != hipSuccess) { grid = -1; return; }
        if (hipFuncSetAttribute((const void*)fwd_kernel, hipFuncAttributeMaxDynamicSharedMemorySize, LDS_BYTES) != hipSuccess) { fprintf(stderr, "hipFuncSetAttribute failed\n"); grid = -1; return; }
        if (hipOccupancyMaxActiveBlocksPerMultiprocessor(&per_cu, (const void*)fwd_kernel, 512, LDS_BYTES) != hipSuccess || per_cu < 1) { fprintf(stderr, "occupancy query: %d\n", per_cu); }
        (void)hipGetLastError();
        grid = cus;
        if (grid != 256) fprintf(stderr, "kernel_launch: %d CUs (expected 256)\n", grid);
    }
    if (grid < 0) return;
    (void)hipMemsetAsync((char*)d_ws + WS_CTL, 0, 32768, stream);
    Args a{};
    for (int i = 0; i < 36; ++i) a.in[i] = (const float*)d_in[i];
    a.out = (float*)d_out; a.ws = (unsigned char*)d_ws;
    void* args[] = {&a};
    hipError_t e = hipLaunchCooperativeKernel((const void*)fwd_kernel, dim3(grid), dim3(512), args, LDS_BYTES, stream);
    if (e != hipSuccess) fprintf(stderr, "cooperative launch failed: %s (grid %d)\n", hipGetErrorString(e), grid);
}
```

```cpp
#include <hip/hip_runtime.h>
#include <hip/hip_cooperative_groups.h>
#include <cstdio>
#include <cstdint>
namespace cg = cooperative_groups;

#define LAS __attribute__((address_space(3)))
typedef unsigned short bf16_t;
typedef short bf16x8 __attribute__((ext_vector_type(8)));
typedef float f32x4 __attribute__((ext_vector_type(4)));
typedef float f32x2 __attribute__((ext_vector_type(2)));
typedef unsigned u32x4 __attribute__((ext_vector_type(4)));
typedef unsigned u32x2 __attribute__((ext_vector_type(2)));
typedef __bf16 bf16x2_t __attribute__((ext_vector_type(2)));

#ifndef PROBE
#define PROBE 0
#endif
#ifndef DEBUG_CHECK
#define DEBUG_CHECK 0
#endif

constexpr int D = 1024, BATCH = 4, SEQ = 8192, T = BATCH * SEQ, DEPTH = 2, MEM = 256, FF = 2816;
constexpr int SSMW = 512, NG = 32, NP = 64, CH = 32  , NCH = SEQ / CH  , UPW = 640  ;
constexpr float EPS = 1e-6f, LOG2E = 1.4426950408889634f;

constexpr size_t MiB = 1u << 20;
constexpr size_t WS_CTL = 0;
constexpr size_t WS_SS = 1 * MiB;
constexpr size_t WS_SSM_SS = WS_SS + 9 * (size_t)T * 4;
constexpr size_t WS_SMALL = 3 * MiB;
constexpr size_t WS_MEMN = 4 * MiB;
constexpr size_t WS_KX = 8 * MiB;
constexpr size_t WS_VXT = 12 * MiB;
constexpr size_t WS_W = 16 * MiB, W_LAYER = 76 * MiB;
constexpr size_t W_GU1 = 0, W_D1 = 11 * MiB, W_GU2 = 16 * MiB + MiB / 2, W_D2 = 27 * MiB + MiB / 2, W_IN = 33 * MiB, W_GLU = 37 * MiB, W_OUT = 38 * MiB,
                 W_Q = 40 * MiB, W_KV = 42 * MiB, W_O = 46 * MiB, W_BM = 48 * MiB, W_MT = 56 * MiB;
constexpr size_t WS_HB = WS_W + 2 * W_LAYER;
constexpr size_t WS_AR = WS_HB + 64 * MiB;
constexpr size_t AR_UP = 0, AR_Q = 40 * MiB, AR_K = 72 * MiB, AR_VT = 104 * MiB, AR_Y = 136 * MiB, AR_MIX = 168 * MiB;
constexpr size_t AR_QX = 0, AR_P = 64 * MiB, AR_OX = 128 * MiB, AR_HID = 0;
constexpr size_t WS_END = WS_AR + 234 * MiB;

constexpr int LDS_BYTES = 147456;
constexpr int LDS_RED = 131072; constexpr int LDS_XB = 131072 + 8192;

struct Args { const float* in[36]; float* out; unsigned char* ws; };
typedef const __attribute__((address_space(4))) Args* KArgsP;
#define KARGS() ({ KArgsP _p = (KArgsP)__builtin_amdgcn_kernarg_segment_ptr(); asm volatile("" : "+s"(_p)); _p; })

__device__ __forceinline__ unsigned cvtpk(float lo, float hi) { f32x2 v = {lo, hi}; bf16x2_t b = __builtin_convertvector(v, bf16x2_t); return __builtin_bit_cast(unsigned, b); }
__device__ __forceinline__ float bf2f(bf16_t x) { return __uint_as_float((unsigned)x << 16); }
__device__ __forceinline__ float wave_sum(float v) {
#pragma unroll
    for (int o = 1; o < 64; o <<= 1) v += __shfl_xor(v, o);
    return v;
}
__device__ __forceinline__ float fq_sum(float v) { v += __shfl_xor(v, 16); v += __shfl_xor(v, 32); return v; }
__device__ __forceinline__ float max3f(float a, float b, float c) { float r; asm("v_max3_f32 %0, %1, %2, %3" : "=v"(r) : "v"(a), "v"(b), "v"(c)); return r; }
__device__ __forceinline__ float xl_max(float v) {
    u32x2 r = __builtin_amdgcn_permlane32_swap(__float_as_uint(v), __float_as_uint(v), false, false); v = fmaxf(__uint_as_float(r[0]), __uint_as_float(r[1]));
    r = __builtin_amdgcn_permlane16_swap(__float_as_uint(v), __float_as_uint(v), false, false); return fmaxf(__uint_as_float(r[0]), __uint_as_float(r[1]));
}
__device__ __forceinline__ float fq_max(float v) { v = fmaxf(v, __shfl_xor(v, 16)); v = fmaxf(v, __shfl_xor(v, 32)); return v; }
__device__ __forceinline__ u32x4 pack8(f32x4 a, f32x4 b) { u32x4 w; w.x = cvtpk(a[0], a[1]); w.y = cvtpk(a[2], a[3]); w.z = cvtpk(b[0], b[1]); w.w = cvtpk(b[2], b[3]); return w; }
__device__ __forceinline__ float fast_exp2(float x) { return __builtin_amdgcn_exp2f(x); }
__device__ __forceinline__ float fast_rcp(float x) { return __builtin_amdgcn_rcpf(x); }
__device__ __forceinline__ float sigmoidf_(float x) { return fast_rcp(1.f + fast_exp2(-x * LOG2E)); }


#define XB_TMO      128
#define XB_XCNT(j)  (256  + 64 * (j))
#define XB_XSUB(j)  (1280 + 64 * (j))
#define XB_XGEN(j)  (2304 + 64 * (j))
#define XB_TOP      3328
#define XB_TOPGEN   3392
#define XCD_BAR_WORDS 3456
#define XB_SPIN_CAP (1u << 22)
__device__ __forceinline__ unsigned xb_ld(unsigned* p)              { return __hip_atomic_load(p, __ATOMIC_RELAXED, __HIP_MEMORY_SCOPE_AGENT); }
__device__ __forceinline__ unsigned xb_add(unsigned* p, unsigned v) { return __hip_atomic_fetch_add(p, v, __ATOMIC_RELAXED, __HIP_MEMORY_SCOPE_AGENT); }
__device__ __forceinline__ unsigned xb_xcc_id() { return (unsigned)__builtin_amdgcn_s_getreg((3 << 11) | 20) & 0xFu; }
#define XB_SPIN(cond, bar) do { unsigned _sp = 0; while (cond) { __builtin_amdgcn_s_sleep(1); \
    if ((++_sp & 255u) == 0u) { if (xb_ld(&(bar)[XB_TMO])) break; if (_sp > XB_SPIN_CAP) { atomicAdd(&(bar)[XB_TMO], 1u); break; } } } } while (0)
struct XcdBarrier { unsigned* bar; unsigned x; volatile LAS unsigned* st; };
__device__ __forceinline__ XcdBarrier xcd_barrier_post(unsigned* bar, volatile LAS unsigned* st) {
    XcdBarrier b; b.bar = bar; b.x = xb_xcc_id(); b.st = st;
    if (threadIdx.x == 0) (void)xb_add(&bar[XB_XCNT(b.x)], 1u);
    return b;
}
__device__ __forceinline__ void xcd_barrier_complete(unsigned* bar, unsigned x, unsigned& nloc, unsigned& nx) {
    const unsigned G = gridDim.x * gridDim.y * gridDim.z;
    unsigned sum, cnt, mine, sp = 0u;
    for (;;) {
        sum = 0u; cnt = 0u; mine = 0u;
#pragma unroll
        for (unsigned j = 0; j < 16; ++j) { const unsigned c = xb_ld(&bar[XB_XCNT(j)]); sum += c; cnt += (c > 0u) ? 1u : 0u; mine = (j == x) ? c : mine; }
        if (sum == G) break;
        __builtin_amdgcn_s_sleep(1);
        if ((++sp & 255u) == 0u) { if (xb_ld(&bar[XB_TMO])) break; if (sp > XB_SPIN_CAP) { atomicAdd(&bar[XB_TMO], 1u); break; } }
    }
    nloc = mine > 0u ? mine : 1u; nx = cnt > 0u ? cnt : 1u;
}
__device__ __forceinline__ void xcd_barrier(const XcdBarrier& b) {
    asm volatile("s_waitcnt vmcnt(0)" ::: "memory");
    __syncthreads();
    if (threadIdx.x == 0) {
        unsigned* bar = b.bar;
        __builtin_amdgcn_s_waitcnt(0);
        unsigned nloc = b.st[0], nx = b.st[1];
        if (nloc == 0u) { xcd_barrier_complete(bar, b.x, nloc, nx); b.st[0] = nloc; b.st[1] = nx; }
        const unsigned old = xb_add(&bar[XB_XSUB(b.x)], 1u);
        const unsigned gen = old / nloc;
        if (old + 1u == (gen + 1u) * nloc) {
            __builtin_amdgcn_fence(__ATOMIC_RELEASE, "agent");
            asm volatile("s_waitcnt vmcnt(0)" ::: "memory");
            const unsigned og = xb_add(&bar[XB_TOP], 1u);
            const unsigned tg = og / nx;
            if (og + 1u == (tg + 1u) * nx) xb_add(&bar[XB_TOPGEN], 1u);
            else XB_SPIN(xb_ld(&bar[XB_TOPGEN]) == tg, bar);
            __builtin_amdgcn_fence(__ATOMIC_ACQUIRE, "agent");
            xb_add(&bar[XB_XGEN(b.x)], 1u);
            asm volatile("s_waitcnt vmcnt(0)" ::: "memory");
        } else {
            XB_SPIN(xb_ld(&bar[XB_XGEN(b.x)]) == gen, bar);
            __builtin_amdgcn_fence(__ATOMIC_ACQUIRE, "agent");
            asm volatile("s_waitcnt vmcnt(0)" ::: "memory");
        }
    }
    __syncthreads();
}

constexpr int BM = 256, BK = 64, HALF = 128, HTB = HALF * BK * 2, NXCD = 8, WGM = 8;
__host__ __device__ __forceinline__ int lds_byte(int r, int c) { const int st = (r >> 4) * 2 + (c >> 5), rr = r & 15, cc = c & 31, ob = rr * 64 + cc * 2; return st * 1024 + (ob ^ (((ob >> 9) & 1) << 5)); }
__host__ __device__ __forceinline__ void stage_rc(int b, int& R, int& C) { const int st = b / 1024, sb = b % 1024, swz = sb ^ (((sb >> 9) & 1) << 5); R = (st >> 1) * 16 + swz / 64; C = (st & 1) * 32 + (swz % 64) / 2; }
__host__ __device__ __forceinline__ int perm32(int rho) { const int n = rho >> 4, i = rho & 15; return 8 * (i >> 2) + 4 * n + (i & 3); }

struct Unit { int pm, pn, bz; unsigned a_off, b_off; };

struct StdSched {
    int nM, nN, nwg, G, c, lda, ldb;
    __device__ void init(int M, int N, int G_, int c_, int lda_, int ldb_) { nM = M / BM; nN = N / BM; nwg = nM * nN; G = G_; c = c_; lda = lda_; ldb = ldb_; }
    __device__ bool next(int i, Unit& u) const {
        const long L = (long)i * G + c; if (L >= nwg) return false;
        int wgid = (int)L; { const int q = nwg / NXCD, r = nwg % NXCD, xcd = wgid % NXCD, off = wgid / NXCD; wgid = (xcd < r ? xcd * (q + 1) : r * (q + 1) + (xcd - r) * q) + off; }
        const int nig = WGM * nN, gid = wgid / nig, fm = gid * WGM, gsz = (nM - fm) < WGM ? (nM - fm) : WGM;
        u.pm = fm + ((wgid % nig) % gsz); u.pn = (wgid % nig) / gsz; u.bz = 0;
        u.a_off = (unsigned)(u.pm * BM) * (unsigned)lda; u.b_off = (unsigned)(u.pn * BM) * (unsigned)ldb; return true;
    }
};
struct Ssm1Sched {
    int c;
    __device__ bool next(int i, Unit& u) const {
        if (i > 0 || c >= BATCH * NG) return false;
        u.pm = 0; u.pn = 0; u.bz = c; u.a_off = (unsigned)c * NCH * UPW; u.b_off = (unsigned)(c & 31) * 256 * 512; return true;
    }
};
struct WkvSched {
    int G, c;
    __device__ bool next(int i, Unit& u) const {
        if (c < 128) return false;
        const int L = (c - 128) + i * (G - 128); if (L >= 64) return false;
        const int layer = L >> 5, rem = L & 31; u.pm = rem >> 3; u.pn = rem & 7; u.bz = layer;
        u.a_off = (unsigned)layer * 1024 * 1024 + (unsigned)u.pm * 256 * 1024; u.b_off = (unsigned)layer * (unsigned)(W_LAYER / 2) + (unsigned)u.pn * 256 * 1024; return true;
    }
};
struct Ssm2Sched {
    int G, c;
    __device__ bool next(int i, Unit& u) const {
        const int L = c + i * G; if (L >= 2 * BATCH * NG) return false;
        u.bz = L >> 1; u.pn = L & 1; u.pm = 0; u.a_off = (unsigned)u.bz * NCH * UPW; u.b_off = ((unsigned)(u.bz & 31) * 512 + (unsigned)u.pn * 256) * UPW; return true;
    }
};
struct XaSched {
    int G, c; unsigned bs_b, bs_h;
    __device__ bool next(int i, Unit& u) const {
        const int L = c + i * G; if (L >= 512) return false;
        const int bh = L >> 5; u.pm = L & 31; u.pn = 0; u.bz = bh; const int b = bh >> 2, h = bh & 3;
        u.a_off = ((unsigned)(b * SEQ + u.pm * 256)) * 1024 + h * 256; u.b_off = (unsigned)b * bs_b + (unsigned)h * bs_h; return true;
    }
};

template <class Epi, class Sched, bool ALIGN_EPI>
__device__ __forceinline__ void gemm_phase(LAS unsigned char* lds, const bf16_t* Ab, const bf16_t* Bb, int lda, int ldb, int K, const Sched& S, Epi& E) {
    int tid = threadIdx.x; asm volatile("" : "+v"(tid));
    const int wid = __builtin_amdgcn_readfirstlane(tid >> 6), lane = tid & 63, wr = wid >> 2, wc = wid & 3, fr = lane & 15, fq = lane >> 4;
    const int nt = K / BK;
    unsigned voffA[2], voffB[2]; int aoff, boff;
#define PG8_LANEOFFS(tt) do { _Pragma("unroll") for (int i = 0; i < 2; ++i) { int R, C; stage_rc((tt) * 16 + i * 8192, R, C); const int Rb = (R & ~31) + perm32(R & 31); \
        voffA[i] = (unsigned)(R * lda + C) * 2u; voffB[i] = (unsigned)(Rb * ldb + C) * 2u; } \
        aoff = lds_byte(wr * 64 + ((tt) & 15), (((tt) >> 4) & 3) * 8); boff = lds_byte(wc * 32 + ((tt) & 15), (((tt) >> 4) & 3) * 8); } while (0)
    PG8_LANEOFFS(tid);
    const unsigned kstep = (unsigned)(BK * 2);
    const unsigned hstepA = (unsigned)HALF * lda * 2, hstepB = (unsigned)HALF * ldb * 2;
    const unsigned ldsw = (unsigned)wid * 1024u;
#define PG8_SA(b, h) (((b) * 2 + (h)) * HTB)
#define PG8_SB(b, h) ((4 + (b) * 2 + (h)) * HTB)
#define PG8_STAGE(bufoff, gbase, voff) do { _Pragma("unroll") for (int _i = 0; _i < 2; ++_i) \
        __builtin_amdgcn_global_load_lds((const unsigned*)((const char*)(gbase) + (voff)[_i]), (LAS unsigned*)(lds + (bufoff) + ldsw + _i * 8192), 16, 0, 0); } while (0)
#define PG8_LDA(dst, b, h) do { _Pragma("unroll") for (int m = 0; m < 4; ++m) _Pragma("unroll") for (int k = 0; k < 2; ++k) dst[m][k] = *(const LAS bf16x8*)(lds + PG8_SA(b, h) + aoff + m * 2048 + k * 1024); } while (0)
#define PG8_LDB(dst, b, h) do { _Pragma("unroll") for (int n = 0; n < 2; ++n) _Pragma("unroll") for (int k = 0; k < 2; ++k) dst[n][k] = *(const LAS bf16x8*)(lds + PG8_SB(b, h) + boff + n * 2048 + k * 1024); } while (0)
#define PG8_MMA(ai, bj, At, Bt) do { __builtin_amdgcn_s_setprio(1); _Pragma("unroll") for (int m = 0; m < 4; ++m) _Pragma("unroll") for (int n = 0; n < 2; ++n) _Pragma("unroll") for (int k = 0; k < 2; ++k) \
        acc[ai][bj][m][n] = __builtin_amdgcn_mfma_f32_16x16x32_bf16(Bt[n][k], At[m][k], acc[ai][bj][m][n], 0, 0, 0); __builtin_amdgcn_s_setprio(0); } while (0)
#define PG8_WAIT_V(n) asm volatile("s_waitcnt vmcnt(" #n ")" ::: "memory")
#define PG8_WAIT_L(n) asm volatile("s_waitcnt lgkmcnt(" #n ")" ::: "memory")
#define PG8_BAR __builtin_amdgcn_s_barrier()
#define PG8_SCHED __builtin_amdgcn_sched_barrier(0)
    Unit cur, nxt; int ui = 0;
    if (!S.next(0, cur)) return;
    f32x4 acc[2][2][4][2];
#pragma unroll
    for (int a = 0; a < 2; ++a)
#pragma unroll
        for (int b = 0; b < 2; ++b)
#pragma unroll
            for (int m = 0; m < 4; ++m)
#pragma unroll
                for (int n = 0; n < 2; ++n) acc[a][b][m][n] = (f32x4){0.f, 0.f, 0.f, 0.f};
    bf16x8 At[4][2], B0[2][2], B1[2][2];
    const char* cA = (const char*)(Ab + cur.a_off); const char* cB = (const char*)(Bb + cur.b_off);
    PG8_STAGE(PG8_SB(0, 0), cB, voffB); PG8_STAGE(PG8_SB(0, 1), cB + hstepB, voffB); PG8_STAGE(PG8_SA(0, 0), cA, voffA); PG8_STAGE(PG8_SA(0, 1), cA + hstepA, voffA);
    if (wr == 1) PG8_BAR;
    PG8_WAIT_V(2); PG8_BAR;
    PG8_STAGE(PG8_SB(1, 0), cB + kstep, voffB); PG8_STAGE(PG8_SA(1, 0), cA + kstep, voffA); PG8_STAGE(PG8_SB(1, 1), cB + hstepB + kstep, voffB);
    PG8_WAIT_V(6); PG8_BAR;
    for (;;) {
        const bool has_next = S.next(ui + 1, nxt);
        const char* nA = has_next ? (const char*)(Ab + nxt.a_off) : cA; const char* nB = has_next ? (const char*)(Bb + nxt.b_off) : cB;
        for (int t = 0; t < nt; t += 2) {
            const bool last = (t == nt - 2);
            const char* a1 = cA + (unsigned)(t + 1) * kstep;
            const char* a2 = last ? nA : cA + (unsigned)(t + 2) * kstep; const char* b2 = last ? nB : cB + (unsigned)(t + 2) * kstep;
            const char* a3 = a2 + kstep; const char* b3 = b2 + kstep;
            PG8_LDB(B0, 0, 0); PG8_LDB(B1, 0, 1); PG8_SCHED; PG8_LDA(At, 0, 0); PG8_STAGE(PG8_SA(1, 1), a1 + hstepA, voffA);
            PG8_WAIT_V(8); PG8_WAIT_L(0); PG8_BAR; PG8_MMA(0, 0, At, B0); PG8_MMA(0, 1, At, B1); PG8_BAR; PG8_SCHED;
            PG8_LDA(At, 0, 1); PG8_STAGE(PG8_SB(0, 0), b2, voffB); PG8_STAGE(PG8_SB(0, 1), b2 + hstepB, voffB); PG8_STAGE(PG8_SA(0, 0), a2, voffA);
            PG8_WAIT_V(8); PG8_WAIT_L(0); PG8_BAR; PG8_MMA(1, 0, At, B0); PG8_MMA(1, 1, At, B1); PG8_BAR; PG8_SCHED;
            PG8_LDB(B0, 1, 0); PG8_LDB(B1, 1, 1); PG8_SCHED; PG8_LDA(At, 1, 0); PG8_STAGE(PG8_SA(0, 1), a2 + hstepA, voffA);
            PG8_WAIT_V(8); PG8_WAIT_L(0); PG8_BAR; PG8_MMA(0, 0, At, B0); PG8_MMA(0, 1, At, B1); PG8_BAR; PG8_SCHED;
            PG8_LDA(At, 1, 1); PG8_STAGE(PG8_SB(1, 0), b3, voffB); PG8_STAGE(PG8_SB(1, 1), b3 + hstepB, voffB); PG8_STAGE(PG8_SA(1, 0), a3, voffA);
            PG8_WAIT_V(8); PG8_WAIT_L(0); PG8_BAR; PG8_MMA(1, 0, At, B0); PG8_MMA(1, 1, At, B1); PG8_BAR; PG8_SCHED;
        }
        if constexpr (ALIGN_EPI) { if (wr == 0) PG8_BAR; }
        if constexpr (!Epi::AFTER_DRAIN) { int t2 = threadIdx.x; asm volatile("" : "+v"(t2)); E(acc, cur, wr, wc, t2 & 15, (t2 >> 4) & 3); }
        if (!has_next) break;
#pragma unroll
        for (int a = 0; a < 2; ++a)
#pragma unroll
            for (int b = 0; b < 2; ++b)
#pragma unroll
                for (int m = 0; m < 4; ++m)
#pragma unroll
                    for (int n = 0; n < 2; ++n) acc[a][b][m][n] = (f32x4){0.f, 0.f, 0.f, 0.f};
        cur = nxt; cA = nA; cB = nB; ++ui;
        { int t3 = threadIdx.x; asm volatile("" : "+v"(t3)); PG8_LANEOFFS(t3); }
        if constexpr (ALIGN_EPI) { if (wr == 1) PG8_BAR; }
    }
    PG8_WAIT_V(0);
    if constexpr (!ALIGN_EPI) { if (wr == 0) PG8_BAR; }
    PG8_BAR;
    if constexpr (Epi::AFTER_DRAIN) { E.fused(acc, cur, wr, wc, fr, fq, lds, wid, lane); }
#undef PG8_LANEOFFS
#undef PG8_SA
#undef PG8_SB
#undef PG8_STAGE
#undef PG8_LDA
#undef PG8_LDB
#undef PG8_MMA
#undef PG8_WAIT_V
#undef PG8_WAIT_L
#undef PG8_BAR
#undef PG8_SCHED
}

typedef f32x4 (&AccRef)[2][2][4][2];

struct EpiFfnUp {
    static constexpr bool AFTER_DRAIN = false;
    bf16_t* H; const float* ss;
    __device__ __forceinline__ void operator()(AccRef acc, const Unit& u, int wr, int wc, int fr, int fq) const {
#pragma unroll
        for (int ai = 0; ai < 2; ++ai)
#pragma unroll
            for (int m = 0; m < 4; ++m) {
                const int row = u.pm * 256 + ai * 128 + wr * 64 + m * 16 + fr;
                const float rs = rsqrtf(ss[row] * (1.f / D) + EPS);
                f32x4 o[2];
#pragma unroll
                for (int n = 0; n < 2; ++n)
#pragma unroll
                    for (int j = 0; j < 4; ++j) { const float g = acc[ai][0][m][n][j] * rs, up = acc[ai][1][m][n][j] * rs; o[n][j] = g * sigmoidf_(g) * up; }
                *(u32x4*)(H + (size_t)row * FF + u.pn * 128 + wc * 32 + 8 * fq) = pack8(o[0], o[1]);
            }
    }
};
struct EpiResid {
    static constexpr bool AFTER_DRAIN = false;
    const float* hin; float* hout; bf16_t* hb; float* ssn; float scale;
    __device__ __forceinline__ void operator()(AccRef acc, const Unit& u, int wr, int wc, int fr, int fq) const {
#pragma unroll
        for (int ai = 0; ai < 2; ++ai)
#pragma unroll
            for (int m = 0; m < 4; ++m) {
                const int row = u.pm * 256 + ai * 128 + wr * 64 + m * 16 + fr; float part = 0.f;
#pragma unroll
                for (int bj = 0; bj < 2; ++bj) {
                    const size_t idx = (size_t)row * D + u.pn * 256 + bj * 128 + wc * 32 + 8 * fq;
                    const f32x4 o0 = *(const f32x4*)(hin + idx), o1 = *(const f32x4*)(hin + idx + 4);
                    const f32x4 v0 = o0 + acc[ai][bj][m][0] * scale, v1 = o1 + acc[ai][bj][m][1] * scale;
                    *(f32x4*)(hout + idx) = v0; *(f32x4*)(hout + idx + 4) = v1;
                    *(u32x4*)(hb + idx) = pack8(v0, v1);
                    part += (v0[0] * v0[0] + v0[1] * v0[1]) + (v0[2] * v0[2] + v0[3] * v0[3]) + (v1[0] * v1[0] + v1[1] * v1[1]) + (v1[2] * v1[2] + v1[3] * v1[3]);
                }
                part = fq_sum(part);
                if (fq == 0) atomicAdd(ssn + row, part);
            }
    }
};
struct EpiWin {
    static constexpr bool AFTER_DRAIN = false;
    unsigned char* arp; const float* ss;
    __device__ __forceinline__ void operator()(AccRef acc, const Unit& u, int wr, int wc, int fr, int fq) const {
        bf16_t* up = (bf16_t*)(arp + AR_UP); bf16_t* qb = (bf16_t*)(arp + AR_Q); bf16_t* kb = (bf16_t*)(arp + AR_K); bf16_t* vt = (bf16_t*)(arp + AR_VT);
        const int sel = u.pn >> 1;
#pragma unroll
        for (int ai = 0; ai < 2; ++ai)
#pragma unroll
            for (int m = 0; m < 4; ++m) {
                const int row = u.pm * 256 + ai * 128 + wr * 64 + m * 16 + fr;
                float rs = rsqrtf(ss[row] * (1.f / D) + EPS);
                if (sel == 1) rs *= 0.125f * LOG2E;
                const int b = row >> 13, t = row & (SEQ - 1);
#pragma unroll
                for (int bj = 0; bj < 2; ++bj) {
                    const int c = (u.pn & 1) * 256 + bj * 128 + wc * 32 + 8 * fq;
                    const f32x4 v0 = acc[ai][bj][m][0] * rs, v1 = acc[ai][bj][m][1] * rs;
                    if (sel == 0) { const int g = c >> 4, hi0 = c & 15;
                        *(u32x4*)(up + ((size_t)((b * NG + g) * NCH + (t >> 5))) * UPW + (t & 31) * 16 + hi0) = pack8(v0, v1);
                    } else if (sel == 1) { *(u32x4*)(qb + (size_t)row * 512 + c) = pack8(v0, v1);
                    } else if (sel == 2) { *(u32x4*)(kb + (size_t)row * 512 + c) = pack8(v0, v1);
                    } else { const int h = c >> 7, dv = c & 127; bf16_t* p = vt + ((size_t)((b * 4 + h) * 128 + dv)) * SEQ + t;
                        const u32x4 w = pack8(v0, v1);
                        p[0] = (bf16_t)(w.x & 0xffff); p[SEQ] = (bf16_t)(w.x >> 16); p[2 * SEQ] = (bf16_t)(w.y & 0xffff); p[3 * SEQ] = (bf16_t)(w.y >> 16);
                        p[4 * SEQ] = (bf16_t)(w.z & 0xffff); p[5 * SEQ] = (bf16_t)(w.z >> 16); p[6 * SEQ] = (bf16_t)(w.w & 0xffff); p[7 * SEQ] = (bf16_t)(w.w >> 16);
                    }
                }
            }
    }
};
__device__ __forceinline__ float gelu_tanh(float x) { const float z = 0.7978845608028654f * (x + 0.044715f * x * x * x); return x * fast_rcp(1.f + fast_exp2(-2.f * LOG2E * z)); }
struct EpiSsm2 {
    static constexpr bool AFTER_DRAIN = false;
    bf16_t* yb;
    __device__ __forceinline__ void operator()(AccRef acc, const Unit& u, int wr, int wc, int fr, int fq) const {
        const int b = u.bz >> 5, g = u.bz & 31;
#pragma unroll
        for (int ai = 0; ai < 2; ++ai)
#pragma unroll
            for (int m = 0; m < 4; ++m) {
                const int ch = ai * 128 + wr * 64 + m * 16 + fr;
#pragma unroll
                for (int bj = 0; bj < 2; ++bj) {
                    const int cc = u.pn * 256 + bj * 128 + wc * 32 + 8 * fq, t = cc >> 4, ho0 = cc & 15;
                    f32x4 v0, v1;
#pragma unroll
                    for (int j = 0; j < 4; ++j) { v0[j] = gelu_tanh(acc[ai][bj][m][0][j]); v1[j] = gelu_tanh(acc[ai][bj][m][1][j]); }
                    *(u32x4*)(yb + ((size_t)(b * SEQ + ch * CH + t)) * 512 + g * 16 + ho0) = pack8(v0, v1);
                }
            }
    }
};
struct EpiGlu {
    static constexpr bool AFTER_DRAIN = false;
    bf16_t* mix; const float* bglu; float* ssq;
    __device__ __forceinline__ void operator()(AccRef acc, const Unit& u, int wr, int wc, int fr, int fq) const {
        const int c0 = u.pn * 128 + wc * 32 + 8 * fq;
        const f32x4 bv0 = *(const f32x4*)(bglu + c0), bv1 = *(const f32x4*)(bglu + c0 + 4), bg0 = *(const f32x4*)(bglu + 512 + c0), bg1 = *(const f32x4*)(bglu + 512 + c0 + 4);
#pragma unroll
        for (int ai = 0; ai < 2; ++ai)
#pragma unroll
            for (int m = 0; m < 4; ++m) {
                const int row = u.pm * 256 + ai * 128 + wr * 64 + m * 16 + fr;
                f32x4 o0, o1; float part = 0.f;
#pragma unroll
                for (int j = 0; j < 4; ++j) {
                    o0[j] = (acc[ai][0][m][0][j] + bv0[j]) * sigmoidf_(acc[ai][1][m][0][j] + bg0[j]);
                    o1[j] = (acc[ai][0][m][1][j] + bv1[j]) * sigmoidf_(acc[ai][1][m][1][j] + bg1[j]);
                    part += o0[j] * o0[j] + o1[j] * o1[j];
                }
                *(u32x4*)(mix + (size_t)row * D + c0) = pack8(o0, o1);
                part = fq_sum(part);
                if (fq == 0) atomicAdd(ssq + row, part);
            }
    }
};
struct EpiWq {
    static constexpr bool AFTER_DRAIN = false;
    bf16_t* O; const float* ss; float mul;
    __device__ __forceinline__ void operator()(AccRef acc, const Unit& u, int wr, int wc, int fr, int fq) const {
#pragma unroll
        for (int ai = 0; ai < 2; ++ai)
#pragma unroll
            for (int m = 0; m < 4; ++m) {
                const int row = u.pm * 256 + ai * 128 + wr * 64 + m * 16 + fr;
                const float rs = rsqrtf(ss[row] * (1.f / D) + EPS) * mul;
#pragma unroll
                for (int bj = 0; bj < 2; ++bj)
                    *(u32x4*)(O + (size_t)row * D + u.pn * 256 + bj * 128 + wc * 32 + 8 * fq) = pack8(acc[ai][bj][m][0] * rs, acc[ai][bj][m][1] * rs);
            }
    }
};
struct EpiWkv {
    static constexpr bool AFTER_DRAIN = false;
    bf16_t *kx, *vxt;
    __device__ __forceinline__ void operator()(AccRef acc, const Unit& u, int wr, int wc, int fr, int fq) const {
        const size_t lo = (size_t)u.bz * 1024 * 1024;
#pragma unroll
        for (int ai = 0; ai < 2; ++ai)
#pragma unroll
            for (int m = 0; m < 4; ++m) {
                const int row = u.pm * 256 + ai * 128 + wr * 64 + m * 16 + fr;
#pragma unroll
                for (int bj = 0; bj < 2; ++bj) {
                    const int col = u.pn * 256 + bj * 128 + wc * 32 + 8 * fq;
                    const u32x4 w = pack8(acc[ai][bj][m][0], acc[ai][bj][m][1]);
                    if (u.pn < 4) *(u32x4*)(kx + lo + (size_t)row * 1024 + col) = w;
                    else { const int c2 = col - 1024, h = c2 >> 8, d = c2 & 255, b = row >> 8, mm = row & 255;
                        bf16_t* p = vxt + lo + ((size_t)((b * 4 + h) * 256 + d)) * 256 + mm;
                        p[0] = (bf16_t)(w.x & 0xffff); p[256] = (bf16_t)(w.x >> 16); p[512] = (bf16_t)(w.y & 0xffff); p[768] = (bf16_t)(w.y >> 16);
                        p[1024] = (bf16_t)(w.z & 0xffff); p[1280] = (bf16_t)(w.z >> 16); p[1536] = (bf16_t)(w.w & 0xffff); p[1792] = (bf16_t)(w.w >> 16); }
                }
            }
    }
};
struct EpiSoftmax {
    static constexpr bool AFTER_DRAIN = false;
    bf16_t* P; LAS float* red;
    __device__ __forceinline__ void operator()(AccRef acc, const Unit& u, int wr, int wc, int fr, int fq) const {
        const int b = u.bz >> 2, h = u.bz & 3;
        float mx[2][4];
#pragma unroll
        for (int ai = 0; ai < 2; ++ai)
#pragma unroll
            for (int m = 0; m < 4; ++m) {
                float v = -INFINITY;
#pragma unroll
                for (int bj = 0; bj < 2; ++bj)
#pragma unroll
                    for (int n = 0; n < 2; ++n)
#pragma unroll
                        for (int j = 0; j < 4; ++j) v = fmaxf(v, acc[ai][bj][m][n][j]);
                v = fq_max(v);
                const int rl = ai * 128 + wr * 64 + m * 16 + fr;
                if (fq == 0) red[rl * 4 + wc] = v;
            }
        asm volatile("s_waitcnt lgkmcnt(0)" ::: "memory"); __builtin_amdgcn_s_barrier(); asm volatile("" ::: "memory");
#pragma unroll
        for (int ai = 0; ai < 2; ++ai)
#pragma unroll
            for (int m = 0; m < 4; ++m) {
                const int rl = ai * 128 + wr * 64 + m * 16 + fr;
                const f32x4 r4 = *(const LAS f32x4*)(red + rl * 4);
                const float M = fmaxf(fmaxf(r4[0], r4[1]), fmaxf(r4[2], r4[3]));
                float s = 0.f;
#pragma unroll
                for (int bj = 0; bj < 2; ++bj)
#pragma unroll
                    for (int n = 0; n < 2; ++n)
#pragma unroll
                        for (int j = 0; j < 4; ++j) { const float p = fast_exp2(acc[ai][bj][m][n][j] - M); acc[ai][bj][m][n][j] = p; s += p; }
                s = fq_sum(s);
                if (fq == 0) red[1024 + rl * 4 + wc] = s;
            }
        asm volatile("s_waitcnt lgkmcnt(0)" ::: "memory"); __builtin_amdgcn_s_barrier(); asm volatile("" ::: "memory");
#pragma unroll
        for (int ai = 0; ai < 2; ++ai)
#pragma unroll
            for (int m = 0; m < 4; ++m) {
                const int rl = ai * 128 + wr * 64 + m * 16 + fr;
                const f32x4 r4 = *(const LAS f32x4*)(red + 1024 + rl * 4);
                const float inv = 1.f / ((r4[0] + r4[1]) + (r4[2] + r4[3]));
                const size_t row = (size_t)b * SEQ + u.pm * 256 + rl;
#pragma unroll
                for (int bj = 0; bj < 2; ++bj)
                    *(u32x4*)(P + row * D + h * 256 + bj * 128 + wc * 32 + 8 * fq) = pack8(acc[ai][bj][m][0] * inv, acc[ai][bj][m][1] * inv);
            }
    }
};
struct EpiPV {
    static constexpr bool AFTER_DRAIN = false;
    bf16_t* O;
    __device__ __forceinline__ void operator()(AccRef acc, const Unit& u, int wr, int wc, int fr, int fq) const {
        const int b = u.bz >> 2, h = u.bz & 3;
#pragma unroll
        for (int ai = 0; ai < 2; ++ai)
#pragma unroll
            for (int m = 0; m < 4; ++m) {
                const size_t row = (size_t)b * SEQ + u.pm * 256 + ai * 128 + wr * 64 + m * 16 + fr;
#pragma unroll
                for (int bj = 0; bj < 2; ++bj)
                    *(u32x4*)(O + row * D + h * 256 + bj * 128 + wc * 32 + 8 * fq) = pack8(acc[ai][bj][m][0], acc[ai][bj][m][1]);
            }
    }
};
struct EpiSsm1 {
    static constexpr bool AFTER_DRAIN = true;
    bf16_t* up; const float *lam_re, *lam_im, *log_dt;
    __device__ __forceinline__ void operator()(AccRef, const Unit&, int, int, int, int) const {}
    __device__ __forceinline__ void fused(AccRef acc, const Unit& u, int wr, int wc, int fr, int fq, LAS unsigned char* lds, int wid, int lane) const {
        LAS float* L = (LAS float*)lds;
#pragma unroll
        for (int ai = 0; ai < 2; ++ai)
#pragma unroll
            for (int m = 0; m < 4; ++m) {
                const int rl = ai * 128 + wr * 64 + m * 16 + fr;
#pragma unroll
                for (int n = 0; n < 2; ++n) { const int col = wc * 32 + 8 * fq + 4 * n; *(LAS f32x4*)(L + rl * 128 + (col ^ ((rl & 15) << 3))) = acc[ai][0][m][n]; }
            }
        __syncthreads();
        if (wid == 0) {
            const int g = u.bz & 31, p = lane;
            const float dt = expf(log_dt[g]) * (float)CH;
            const float lr = fminf(lam_re[g * NP + p], -1e-4f), li = lam_im[g * NP + p];
            const float mag = expf(lr * dt); float sn, cs; sincosf(li * dt, &sn, &cs);
            const float ar = mag * cs, aim = mag * sn;
            float xr = 0.f, xi = 0.f;
            unsigned* dst = (unsigned*)(up + (size_t)u.bz * NCH * UPW + 512) + p;
            for (int c = 0; c < NCH; ++c) {
                dst[(size_t)c * (UPW / 2)] = cvtpk(xr, xi);
                const f32x2 l2 = *(const LAS f32x2*)(L + c * 128 + ((2 * p) ^ ((c & 15) << 3)));
                const float nr = ar * xr - aim * xi + l2[0], ni = ar * xi + aim * xr + l2[1];
                xr = nr; xi = ni;
            }
        }
        __syncthreads();
    }
};

struct GainSpec { const float* g1; const float* g2; float g2s; };
__device__ __forceinline__ float gain_of(const GainSpec& gs, int k) {
    if (!gs.g1) return 1.f;
    if (gs.g2 && k >= 512) return gs.g2[(k - 512) & 127] * gs.g2s;
    return gs.g1[k];
}
__device__ __forceinline__ void transpose_item(const float* W, int K, int N, bf16_t* WT, bool il, int nh, int hb, const GainSpec gs, LAS float* scr, int item, int lane) {
    const int nblk = N / 32, kb = item / nblk, nb = item % nblk, k0 = 64 * kb, n0 = 32 * nb;
#pragma unroll 8
    for (int i = 0; i < 32; ++i) { const int kk = 2 * i + (lane >> 5); scr[kk * 33 + (lane & 31)] = W[(size_t)(k0 + kk) * N + n0 + (lane & 31)] * gain_of(gs, k0 + kk); }
    asm volatile("s_waitcnt lgkmcnt(0)" ::: "memory");
    const int c = lane & 7;
#pragma unroll
    for (int j = 0; j < 4; ++j) { const int n = (lane >> 3) + 8 * j; const LAS float* s = scr + (8 * c) * 33 + n;
        u32x4 o; o.x = cvtpk(s[0 * 33], s[1 * 33]); o.y = cvtpk(s[2 * 33], s[3 * 33]); o.z = cvtpk(s[4 * 33], s[5 * 33]); o.w = cvtpk(s[6 * 33], s[7 * 33]);
        int row = n0 + n; if (il) { const int jj = row % nh, half = hb + row / nh; row = (jj >> 7) * 256 + half * 128 + (jj & 127); }
        *(u32x4*)(WT + (size_t)row * K + k0 + 8 * c) = o; }
    asm volatile("s_waitcnt lgkmcnt(0)" ::: "memory");
}

__device__ __forceinline__ void ssm_matrices(KArgsP a, int l, int g, LAS unsigned char* lds, bf16_t* Bm, bf16_t* Mt) {
    int tid = threadIdx.x; asm volatile("" : "+v"(tid));
    LAS f32x2* lamtab = (LAS f32x2*)lds;
    LAS f32x2* cc = (LAS f32x2*)(lds + 16896);
    LAS f32x2* bb = (LAS f32x2*)(lds + 16896 + 8192);
    LAS float* Kt = (LAS float*)(lds + 16896 + 16384);
    const float* lam_re = a->in[9] + (size_t)(l * NG + g) * NP; const float* lam_im = a->in[10] + (size_t)(l * NG + g) * NP;
    const float* b_re = a->in[11] + (size_t)(l * NG + g) * NP * 16; const float* b_im = a->in[12] + (size_t)(l * NG + g) * NP * 16;
    const float* c_re = a->in[13] + (size_t)(l * NG + g) * 16 * NP; const float* c_im = a->in[14] + (size_t)(l * NG + g) * 16 * NP;
    const float* dd = a->in[15] + (size_t)(l * NG + g) * 16;
    const float dt = expf(a->in[16][l * NG + g]);
    for (int idx = tid; idx < 33 * 64; idx += 512) { const int tau = idx >> 6, p = idx & 63;
        const float lr = fminf(lam_re[p], -1e-4f), li = lam_im[p]; const float zr = lr * dt * (float)tau, zi = li * dt * (float)tau;
        const float mag = expf(zr); float sn, cs; sincosf(zi, &sn, &cs); lamtab[idx] = (f32x2){mag * cs, mag * sn}; }
    for (int idx = tid; idx < 1024; idx += 512) {
        cc[idx] = (f32x2){c_re[idx], c_im[idx]};
        const int p = idx >> 4;
        const float lr = fminf(lam_re[p], -1e-4f), li = lam_im[p]; const float mag = expf(lr * dt); float sn, cs; sincosf(li * dt, &sn, &cs);
        const float ar = mag * cs - 1.f, ai = mag * sn, den = 1.f / (lr * lr + li * li);
        const float qr = (ar * lr + ai * li) * den, qi = (ai * lr - ar * li) * den;
        const float br = b_re[idx], bi = b_im[idx];
        bb[idx] = (f32x2){qr * br - qi * bi, qr * bi + qi * br};
    }
    __syncthreads();
    for (int idx = tid; idx < 32 * 256; idx += 512) { const int tau = idx >> 8, ho = (idx >> 4) & 15, hi = idx & 15; float s = 0.f;
        for (int p = 0; p < NP; ++p) { const f32x2 c = cc[ho * 64 + p], lm = lamtab[tau * 64 + p], b = bb[p * 16 + hi];
            const float wr_ = c[0] * lm[0] - c[1] * lm[1], wi_ = c[0] * lm[1] + c[1] * lm[0]; s += wr_ * b[0] - wi_ * b[1]; }
        if (tau == 0 && ho == hi) s += dd[ho];
        Kt[idx] = s; }
    __syncthreads();
    for (int ch = tid; ch < 512 * 80; ch += 512) { const int n = ch / 80, kc = ch % 80, t = n >> 4, ho = n & 15, k0 = kc * 8; float v[8];
        if (k0 < 512) { const int s = k0 >> 4, hi0 = k0 & 15;
#pragma unroll
            for (int j = 0; j < 8; ++j) v[j] = (s <= t) ? Kt[(t - s) * 256 + ho * 16 + hi0 + j] : 0.f;
        } else { const int p0 = (k0 - 512) >> 1;
#pragma unroll
            for (int j = 0; j < 4; ++j) { const f32x2 c = cc[ho * 64 + p0 + j], lm = lamtab[(t + 1) * 64 + p0 + j];
                v[2 * j] = c[0] * lm[0] - c[1] * lm[1]; v[2 * j + 1] = -(c[0] * lm[1] + c[1] * lm[0]); } }
        u32x4 o; o.x = cvtpk(v[0], v[1]); o.y = cvtpk(v[2], v[3]); o.z = cvtpk(v[4], v[5]); o.w = cvtpk(v[6], v[7]);
        *(u32x4*)(Mt + (size_t)n * UPW + k0) = o; }
    for (int ch = tid; ch < 256 * 64; ch += 512) { const int n = ch >> 6, k0 = (ch & 63) * 8; float v[8];
        if (n < 128) { const int p = n >> 1, ri = n & 1, s = k0 >> 4, hi0 = k0 & 15; const f32x2 lm = lamtab[(CH - 1 - s) * 64 + p];
#pragma unroll
            for (int j = 0; j < 8; ++j) { const f32x2 b = bb[p * 16 + hi0 + j]; v[j] = ri ? (lm[0] * b[1] + lm[1] * b[0]) : (lm[0] * b[0] - lm[1] * b[1]); }
        } else {
#pragma unroll
            for (int j = 0; j < 8; ++j) v[j] = 0.f; }
        u32x4 o; o.x = cvtpk(v[0], v[1]); o.y = cvtpk(v[2], v[3]); o.z = cvtpk(v[4], v[5]); o.w = cvtpk(v[6], v[7]);
        *(u32x4*)(Bm + (size_t)n * 512 + k0) = o; }
    __syncthreads();
}

__device__ __forceinline__ void prologue(KArgsP a, LAS unsigned char* lds, int G) {
    unsigned char* ws = a->ws;
    int tid = threadIdx.x; asm volatile("" : "+v"(tid));
    const int lane = tid & 63, wave = tid >> 6, bid = blockIdx.x;
    { float* z = (float*)(ws + WS_SS) + T; const size_t n = (size_t)10 * T;
      for (size_t i = (size_t)bid * 512 + tid; i < n; i += (size_t)G * 512) z[i] = 0.f; }
    for (int it = bid; it < DEPTH * NG; it += G) { const int l = it >> 5, g = it & 31;
        ssm_matrices(a, l, g, lds, (bf16_t*)(ws + WS_W + l * W_LAYER + W_BM) + (size_t)g * 256 * 512, (bf16_t*)(ws + WS_W + l * W_LAYER + W_MT) + (size_t)g * 512 * UPW); }
    if (bid == 0) {
        float* sm = (float*)(ws + WS_SMALL);
        if (tid < 128) { const int l = tid >> 6, i = tid & 63;
            const float d1 = wave_sum(a->in[20][l * 64 + i] * a->in[21][l * 64 + i]), d2 = wave_sum(a->in[22][l * 64 + i] * a->in[23][l * 64 + i]);
            if (i == 0) sm[l] = expf(d1) - expf(d2) + (0.8f - 0.6f * expf(-0.3f * (float)l)); }
        for (int idx = tid; idx < 4 * 132; idx += 512) { const int h = idx / 132, n = idx % 132; int bk;
            if (n < 16) bk = n; else { const float nf = (float)n; int lg = 16 + (int)(logf(nf / 16.f) / 2.0794415416798357f * 16.f); bk = lg < 31 ? lg : 31; }
            sm[16 + idx] = a->in[2][bk * 4 + h] * LOG2E; }
    }
    { LAS float* scr = (LAS float*)(lds + wave * 16384);
      const int gw = bid * 8 + wave, NGW = G * 8;
      for (int it = gw; it < DEPTH * 12288; it += NGW) {
          const int l = it / 12288; int r = it % 12288; unsigned char* wl = ws + WS_W + l * W_LAYER;
          const GainSpec none{nullptr, nullptr, 0.f};
          if (r < 1408) { transpose_item(a->in[4] + (size_t)l * D * FF, D, FF, (bf16_t*)(wl + W_GU1), true, FF, 0, GainSpec{a->in[3] + l * D, nullptr, 0.f}, scr, r, lane); continue; } r -= 1408;
          if (r < 1408) { transpose_item(a->in[5] + (size_t)l * D * FF, D, FF, (bf16_t*)(wl + W_GU1), true, FF, 1, GainSpec{a->in[3] + l * D, nullptr, 0.f}, scr, r, lane); continue; } r -= 1408;
          if (r < 1408) { transpose_item(a->in[6] + (size_t)l * FF * D, FF, D, (bf16_t*)(wl + W_D1), false, 1, 0, none, scr, r, lane); continue; } r -= 1408;
          if (r < 1408) { transpose_item(a->in[32] + (size_t)l * D * FF, D, FF, (bf16_t*)(wl + W_GU2), true, FF, 0, GainSpec{a->in[31] + l * D, nullptr, 0.f}, scr, r, lane); continue; } r -= 1408;
          if (r < 1408) { transpose_item(a->in[33] + (size_t)l * D * FF, D, FF, (bf16_t*)(wl + W_GU2), true, FF, 1, GainSpec{a->in[31] + l * D, nullptr, 0.f}, scr, r, lane); continue; } r -= 1408;
          if (r < 1408) { transpose_item(a->in[34] + (size_t)l * FF * D, FF, D, (bf16_t*)(wl + W_D2), false, 1, 0, none, scr, r, lane); continue; } r -= 1408;
          if (r < 1024) { transpose_item(a->in[8] + (size_t)l * D * 2048, D, 2048, (bf16_t*)(wl + W_IN), false, 1, 0, GainSpec{a->in[7] + l * D, nullptr, 0.f}, scr, r, lane); continue; } r -= 1024;
          if (r < 256) { transpose_item(a->in[17] + (size_t)l * 512 * 1024, 512, 1024, (bf16_t*)(wl + W_GLU), true, 512, 0, none, scr, r, lane); continue; } r -= 256;
          if (r < 512) { transpose_item(a->in[25] + (size_t)l * D * D, D, D, (bf16_t*)(wl + W_OUT), false, 1, 0, GainSpec{a->in[19] + l * 512, a->in[24] + l * 128, 1.f - (0.8f - 0.6f * expf(-0.3f * (float)l))}, scr, r, lane); continue; } r -= 512;
          if (r < 512) { transpose_item(a->in[28] + (size_t)l * D * D, D, D, (bf16_t*)(wl + W_Q), false, 1, 0, GainSpec{a->in[26] + l * D, nullptr, 0.f}, scr, r, lane); continue; } r -= 512;
          if (r < 1024) { transpose_item(a->in[29] + (size_t)l * D * 2048, D, 2048, (bf16_t*)(wl + W_KV), false, 1, 0, none, scr, r, lane); continue; } r -= 1024;
          transpose_item(a->in[30] + (size_t)l * D * D, D, D, (bf16_t*)(wl + W_O), false, 1, 0, none, scr, r, lane);
      }
      for (int row = gw; row < T + DEPTH * BATCH * MEM; row += NGW) {
          const bool ismem = row >= T; const int mr = row - T, l = mr >> 10, mrow = mr & 1023;
          const float* src = ismem ? a->in[1] + (size_t)mrow * D : a->in[0] + (size_t)row * D;
          f32x4 v[4]; float s = 0.f;
#pragma unroll
          for (int j = 0; j < 4; ++j) { v[j] = *((const f32x4*)src + lane + 64 * j); s += (v[j][0] * v[j][0] + v[j][1] * v[j][1]) + (v[j][2] * v[j][2] + v[j][3] * v[j][3]); }
          s = wave_sum(s);
          if (!ismem) { if (lane == 0) ((float*)(ws + WS_SS))[row] = s;
#pragma unroll
              for (int j = 0; j < 4; ++j) *((u32x2*)(ws + WS_HB + (size_t)row * D * 2) + lane + 64 * j) = (u32x2){cvtpk(v[j][0], v[j][1]), cvtpk(v[j][2], v[j][3])};
          } else { const float rs = rsqrtf(s * (1.f / D) + EPS); const float* gn = a->in[27] + l * D;
#pragma unroll
              for (int j = 0; j < 4; ++j) { const f32x4 gg = *((const f32x4*)gn + lane + 64 * j);
                  *((u32x2*)(ws + WS_MEMN + ((size_t)l * 1024 + mrow) * D * 2) + lane + 64 * j) = (u32x2){cvtpk(v[j][0] * rs * gg[0], v[j][1] * rs * gg[1]), cvtpk(v[j][2] * rs * gg[2], v[j][3] * rs * gg[3])}; }
          }
      }
    }
}

constexpr int AT_KROW = 256, AT_VROW = 128, AT_KBUF = 64 * AT_KROW, AT_VBUF = 128 * AT_VROW;
constexpr int AT_K0 = 0, AT_V0 = 2 * AT_KBUF, AT_BIAS = AT_V0 + 2 * AT_VBUF;

__device__ __forceinline__ void attn_qblock(int b, int h, int q0, float lam, LAS unsigned char* lds, const bf16_t* qbuf, const bf16_t* kbuf, const bf16_t* vT, bf16_t* mix, const float* bias_g) {
    int tid = threadIdx.x; asm volatile("" : "+v"(tid));
    const int lane = tid & 63, w = __builtin_amdgcn_readfirstlane(tid >> 6), r = lane & 15, g = lane >> 4;
    const int qw0 = q0 + w * 16, qrow = qw0 + r;
    LAS float* biasl = (LAS float*)(lds + AT_BIAS);
    if (tid < 129) biasl[tid] = bias_g[h * 132 + tid];
    bf16x8 qf[2][2];
    { const bf16_t* qp = qbuf + ((size_t)(b * SEQ + qrow)) * 512 + h * 128 + g * 8;
#pragma unroll
      for (int m = 0; m < 2; ++m)
#pragma unroll
          for (int ks = 0; ks < 2; ++ks) qf[m][ks] = *(const bf16x8*)(qp + m * 64 + ks * 32); }
    f32x4 o[2][8];
#pragma unroll
    for (int m = 0; m < 2; ++m)
#pragma unroll
        for (int db = 0; db < 8; ++db) o[m][db] = (f32x4){0.f, 0.f, 0.f, 0.f};
    float mrow[2] = {-INFINITY, -INFINITY}, lrow[2] = {0.f, 0.f};
    const int ntiles = (q0 + 128) >> 6;
    unsigned gk[2], lk[2], gv[2], lv[2];
#pragma unroll
    for (int i = 0; i < 2; ++i) { const int c = tid + i * 512;
        { const int key = c >> 4, ch = c & 15, rho = ((key >> 5) * 2 + ((key >> 2) & 1)) * 16 + ((key >> 3) & 3) * 4 + (key & 3); gk[i] = key * 512 + ch * 8; lk[i] = rho * AT_KROW + ((ch ^ (rho & 15)) * 16); }
        { const int dv = c >> 3, ch = c & 7; gv[i] = dv * SEQ + ch * 8; lv[i] = dv * AT_VROW + ((ch ^ ((dv >> 1) & 7)) * 16); } }
    const bf16_t* kbase = kbuf + ((size_t)b * SEQ) * 512 + h * 128;
    const bf16_t* vbase = vT + ((size_t)(b * 4 + h) * 128) * SEQ;
    u32x4 kreg[2], vreg[2];
#pragma unroll
    for (int i = 0; i < 2; ++i) { kreg[i] = *(const u32x4*)(kbase + gk[i]); vreg[i] = *(const u32x4*)(vbase + gv[i]); }
#pragma unroll
    for (int i = 0; i < 2; ++i) { *(LAS u32x4*)(lds + AT_K0 + lk[i]) = kreg[i]; *(LAS u32x4*)(lds + AT_V0 + lv[i]) = vreg[i]; }
    __syncthreads();
    const float cfar = biasl[128];
    for (int kt = 0; kt < ntiles; ++kt) {
        const int cur = kt & 1, k0 = kt * 64;
        const bool pf = (kt + 1 < ntiles);
        if (pf) {
#pragma unroll
            for (int i = 0; i < 2; ++i) { kreg[i] = *(const u32x4*)(kbase + (size_t)(k0 + 64) * 512 + gk[i]); vreg[i] = *(const u32x4*)(vbase + (k0 + 64) + gv[i]); } }
        if (k0 <= qw0 + 15) {
            LAS unsigned char* Kb = lds + AT_K0 + cur * AT_KBUF; LAS unsigned char* Vb = lds + AT_V0 + cur * AT_VBUF;
            f32x4 s[2][4];
            bf16x8 kfa[8], kfb[8];
#pragma unroll
            for (int kb = 0; kb < 4; ++kb)
#pragma unroll
                for (int ks = 0; ks < 2; ++ks) kfa[kb * 2 + ks] = *(const LAS bf16x8*)(Kb + (kb * 16 + r) * AT_KROW + (((ks * 4 + g) ^ r) * 16));
            __builtin_amdgcn_sched_barrier(0);
#pragma unroll
            for (int kb = 0; kb < 4; ++kb)
#pragma unroll
                for (int ks = 0; ks < 2; ++ks) kfb[kb * 2 + ks] = *(const LAS bf16x8*)(Kb + (kb * 16 + r) * AT_KROW + (((8 + ks * 4 + g) ^ r) * 16));
            __builtin_amdgcn_sched_barrier(0);
            __builtin_amdgcn_s_setprio(1);
#pragma unroll
            for (int kb = 0; kb < 4; ++kb) { s[0][kb] = __builtin_amdgcn_mfma_f32_16x16x32_bf16(kfa[kb * 2], qf[0][0], (f32x4){0.f, 0.f, 0.f, 0.f}, 0, 0, 0);
                s[0][kb] = __builtin_amdgcn_mfma_f32_16x16x32_bf16(kfa[kb * 2 + 1], qf[0][1], s[0][kb], 0, 0, 0); }
            __builtin_amdgcn_sched_barrier(0);
            bf16x8 vfa[8];
#pragma unroll
            for (int db = 0; db < 4; ++db)
#pragma unroll
                for (int kk = 0; kk < 2; ++kk) vfa[db * 2 + kk] = *(const LAS bf16x8*)(Vb + (db * 16 + r) * AT_VROW + (((kk * 4 + g) ^ (r >> 1)) * 16));
            __builtin_amdgcn_sched_barrier(0);
#pragma unroll
            for (int kb = 0; kb < 4; ++kb) { s[1][kb] = __builtin_amdgcn_mfma_f32_16x16x32_bf16(kfb[kb * 2], qf[1][0], (f32x4){0.f, 0.f, 0.f, 0.f}, 0, 0, 0);
                s[1][kb] = __builtin_amdgcn_mfma_f32_16x16x32_bf16(kfb[kb * 2 + 1], qf[1][1], s[1][kb], 0, 0, 0); }
            __builtin_amdgcn_s_setprio(0);
            __builtin_amdgcn_sched_barrier(0);
            const bool far = (qw0 - (k0 + 63)) >= 128;
            float cf = cfar;
            if (!far) { cf = 0.f;
                float badd[4][4];
#pragma unroll
                for (int kb = 0; kb < 4; ++kb)
#pragma unroll
                    for (int j = 0; j < 4; ++j) { const int key = k0 + (kb >> 1) * 32 + g * 8 + (kb & 1) * 4 + j, dist = qrow - key;
                        const int idx = dist < 0 ? 0 : (dist > 128 ? 128 : dist);
                        badd[kb][j] = biasl[idx]; }
#pragma unroll
                for (int kb = 0; kb < 4; ++kb)
#pragma unroll
                    for (int j = 0; j < 4; ++j) { const int key = k0 + (kb >> 1) * 32 + g * 8 + (kb & 1) * 4 + j;
                        const float ad = (qrow >= key) ? badd[kb][j] : -INFINITY;
                        s[0][kb][j] += ad; s[1][kb][j] += ad; }
            }
            bf16x8 pfr[2][2];
#pragma unroll
            for (int m = 0; m < 2; ++m) {
                float mx = max3f(s[m][0][0], s[m][0][1], s[m][0][2]);
                mx = max3f(mx, s[m][0][3], s[m][1][0]); mx = max3f(mx, s[m][1][1], s[m][1][2]); mx = max3f(mx, s[m][1][3], s[m][2][0]);
                mx = max3f(mx, s[m][2][1], s[m][2][2]); mx = max3f(mx, s[m][2][3], s[m][3][0]); mx = max3f(mx, s[m][3][1], s[m][3][2]); mx = fmaxf(mx, s[m][3][3]);
                mx = xl_max(mx) + cf;
                if (__any((mx - mrow[m]) > 6.0f)) {
                    const float mnew = fmaxf(mrow[m], mx), alpha = fast_exp2(mrow[m] - mnew);
                    mrow[m] = mnew; lrow[m] *= alpha;
#pragma unroll
                    for (int db = 0; db < 8; ++db) o[m][db] = o[m][db] * alpha;
                }
                const float mc = mrow[m] - cf;
                f32x2 ps2 = {0.f, 0.f};
#pragma unroll
                for (int kb = 0; kb < 4; ++kb) {
                    f32x2 a = {s[m][kb][0], s[m][kb][1]}, c = {s[m][kb][2], s[m][kb][3]};
                    a = a - mc; c = c - mc;
                    a[0] = fast_exp2(a[0]); a[1] = fast_exp2(a[1]); c[0] = fast_exp2(c[0]); c[1] = fast_exp2(c[1]);
                    ps2 = ps2 + a; ps2 = ps2 + c;
                    s[m][kb][0] = a[0]; s[m][kb][1] = a[1]; s[m][kb][2] = c[0]; s[m][kb][3] = c[1];
                }
                lrow[m] += ps2[0] + ps2[1];
#pragma unroll
                for (int kk = 0; kk < 2; ++kk) { const u32x4 pw = pack8(s[m][2 * kk], s[m][2 * kk + 1]); pfr[m][kk] = __builtin_bit_cast(bf16x8, pw); }
            }
            __builtin_amdgcn_sched_barrier(0);
            bf16x8 vfb[8];
#pragma unroll
            for (int db = 0; db < 4; ++db)
#pragma unroll
                for (int kk = 0; kk < 2; ++kk) vfb[db * 2 + kk] = *(const LAS bf16x8*)(Vb + ((db + 4) * 16 + r) * AT_VROW + (((kk * 4 + g) ^ (r >> 1)) * 16));
            __builtin_amdgcn_sched_barrier(0);
            __builtin_amdgcn_s_setprio(1);
#pragma unroll
            for (int db = 0; db < 4; ++db)
#pragma unroll
                for (int kk = 0; kk < 2; ++kk) {
                    o[0][db] = __builtin_amdgcn_mfma_f32_16x16x32_bf16(vfa[db * 2 + kk], pfr[0][kk], o[0][db], 0, 0, 0);
                    o[1][db] = __builtin_amdgcn_mfma_f32_16x16x32_bf16(vfa[db * 2 + kk], pfr[1][kk], o[1][db], 0, 0, 0); }
            __builtin_amdgcn_sched_barrier(0);
#pragma unroll
            for (int db = 0; db < 4; ++db)
#pragma unroll
                for (int kk = 0; kk < 2; ++kk) {
                    o[0][db + 4] = __builtin_amdgcn_mfma_f32_16x16x32_bf16(vfb[db * 2 + kk], pfr[0][kk], o[0][db + 4], 0, 0, 0);
                    o[1][db + 4] = __builtin_amdgcn_mfma_f32_16x16x32_bf16(vfb[db * 2 + kk], pfr[1][kk], o[1][db + 4], 0, 0, 0); }
            __builtin_amdgcn_s_setprio(0);
        }
        if (pf) {
#pragma unroll
            for (int i = 0; i < 2; ++i) { *(LAS u32x4*)(lds + AT_K0 + (cur ^ 1) * AT_KBUF + lk[i]) = kreg[i]; *(LAS u32x4*)(lds + AT_V0 + (cur ^ 1) * AT_VBUF + lv[i]) = vreg[i]; } }
        __syncthreads();
    }
    const float inv0 = 1.f / fq_sum(lrow[0]), inv1 = lam / fq_sum(lrow[1]);
    float ssq = 0.f;
#pragma unroll
    for (int db = 0; db < 8; ++db)
#pragma unroll
        for (int j = 0; j < 4; ++j) { const float v = o[0][db][j] * inv0 - o[1][db][j] * inv1; o[0][db][j] = v; ssq += v * v; }
    ssq = fq_sum(ssq);
    const float rn = rsqrtf(ssq * (1.f / 128.f) + EPS);
    bf16_t* op = mix + ((size_t)(b * SEQ + qrow)) * D + 512 + h * 128 + g * 4;
#pragma unroll
    for (int db = 0; db < 8; ++db) *(u32x2*)(op + db * 16) = (u32x2){cvtpk(o[0][db][0] * rn, o[0][db][1] * rn), cvtpk(o[0][db][2] * rn, o[0][db][3] * rn)};
}

#if DEBUG_CHECK
__device__ __forceinline__ unsigned hash_u(unsigned x) { x ^= x >> 16; x *= 0x7feb352dU; x ^= x >> 15; x *= 0x846ca68bU; x ^= x >> 16; return x; }
__device__ __forceinline__ void dbg_flag(unsigned* ctl, int id, float got, float ref, float rtol, float atol) {
    const float d = fabsf(got - ref);
    if (!(d <= atol + rtol * fabsf(ref))) atomicAdd(ctl + 64 + id, 1u);
}
#endif

__global__ void __launch_bounds__(512, 2) fwd_kernel(Args a) {
    extern __shared__ __attribute__((aligned(16))) unsigned char lds_raw[];
    LAS unsigned char* lds = (LAS unsigned char*)lds_raw;
    cg::grid_group grid = cg::this_grid();
    const int G = gridDim.x;
#define PH KArgsP ka = KARGS(); int bid = blockIdx.x, G = gridDim.x, tidl = threadIdx.x; asm volatile("" : "+s"(bid), "+s"(G), "+v"(tidl)); const int lane = tidl & 63, wave = tidl >> 6; (void)lane; (void)wave; unsigned char* ws = ka->ws; float* ssb = (float*)(ws + WS_SS); float* ssm_ss = (float*)(ws + WS_SSM_SS); const float* smalls = (const float*)(ws + WS_SMALL); \
    bf16_t* hb = (bf16_t*)(ws + WS_HB); unsigned char* ar = ws + WS_AR; unsigned char* wl = ws + WS_W + l * W_LAYER; float* hbuf = ka->out; \
    (void)ssb; (void)ssm_ss; (void)smalls; (void)hb; (void)ar; (void)wl; (void)hbuf;
    if (threadIdx.x < 2) ((LAS unsigned*)(lds + LDS_XB))[threadIdx.x] = 0u;
    __syncthreads();
    XcdBarrier xbar = xcd_barrier_post((unsigned*)(KARGS()->ws + WS_CTL) + 1024, (volatile LAS unsigned*)(lds + LDS_XB));
    prologue(KARGS(), lds, G);
    grid.sync();
#define GSYNC() xcd_barrier(xbar)

    for (int l = 0; l < DEPTH; ++l) {
        if (PROBE == 4) { for (int rep = 0; rep < 10; ++rep) GSYNC(); }
        for (int rep = 0; rep < (PROBE == 2 ? 2 : 1); ++rep)
        { PH StdSched S; S.init(T, 2 * FF, G, bid, D, D); EpiFfnUp E{(bf16_t*)(ar + AR_HID), ssb + (size_t)(4 * l + 0) * T};
          gemm_phase<EpiFfnUp, StdSched, false>(lds, hb, (const bf16_t*)(wl + W_GU1), D, D, D, S, E); }
        GSYNC();
        { PH StdSched S; S.init(T, D, G, bid, FF, FF); EpiResid E{l == 0 ? ka->in[0] : hbuf, hbuf, hb, ssb + (size_t)(4 * l + 1) * T, 0.5f};
          gemm_phase<EpiResid, StdSched, false>(lds, (const bf16_t*)(ar + AR_HID), (const bf16_t*)(wl + W_D1), FF, FF, FF, S, E); }
        GSYNC();
        for (int rep = 0; rep < (PROBE == 3 ? 2 : 1); ++rep)
        { PH StdSched S; S.init(T, 2048, G, bid, D, D); EpiWin E{ar, ssb + (size_t)(4 * l + 1) * T};
          gemm_phase<EpiWin, StdSched, false>(lds, hb, (const bf16_t*)(wl + W_IN), D, D, D, S, E); }
        GSYNC();
        for (int rep = 0; rep < (PROBE == 3 ? 2 : 1); ++rep)
        if ((int)blockIdx.x < 128) { PH Ssm1Sched S{bid}; EpiSsm1 E{(bf16_t*)(ar + AR_UP), ka->in[9] + (size_t)l * NG * NP, ka->in[10] + (size_t)l * NG * NP, ka->in[16] + (size_t)l * NG};
          gemm_phase<EpiSsm1, Ssm1Sched, false>(lds, (const bf16_t*)(ar + AR_UP), (const bf16_t*)(wl + W_BM), UPW, 512, 512, S, E); }
        else if (l == 0) { PH WkvSched S{G, bid}; EpiWkv E{(bf16_t*)(ws + WS_KX), (bf16_t*)(ws + WS_VXT)};
          gemm_phase<EpiWkv, WkvSched, false>(lds, (const bf16_t*)(ws + WS_MEMN), (const bf16_t*)(ws + WS_W + W_KV), D, D, D, S, E); }
        GSYNC();
        for (int rep = 0; rep < (PROBE == 3 ? 2 : 1); ++rep)
        { PH Ssm2Sched S{G, bid}; EpiSsm2 E{(bf16_t*)(ar + AR_Y)};
          gemm_phase<EpiSsm2, Ssm2Sched, false>(lds, (const bf16_t*)(ar + AR_UP), (const bf16_t*)(wl + W_MT), UPW, UPW, UPW, S, E); }
        GSYNC();
        { PH StdSched S; S.init(T, 1024, G, bid, 512, 512); EpiGlu E{(bf16_t*)(ar + AR_MIX), ka->in[18] + (size_t)l * 1024, ssm_ss + (size_t)l * T};
          gemm_phase<EpiGlu, StdSched, false>(lds, (const bf16_t*)(ar + AR_Y), (const bf16_t*)(wl + W_GLU), 512, 512, 512, S, E); }
        GSYNC();
        { PH const float lam = smalls[l];
          for (int rep = 0; rep < (PROBE == 1 ? 2 : 1); ++rep)
          for (int uidx = bid; uidx < 512; uidx += G) { const int bh = uidx >> 5, j = uidx & 31, b = bh >> 2, h = bh & 3;
              attn_qblock(b, h, j * 128, lam, lds, (const bf16_t*)(ar + AR_Q), (const bf16_t*)(ar + AR_K), (const bf16_t*)(ar + AR_VT), (bf16_t*)(ar + AR_MIX), smalls + 16);
              attn_qblock(b, h, (63 - j) * 128, lam, lds, (const bf16_t*)(ar + AR_Q), (const bf16_t*)(ar + AR_K), (const bf16_t*)(ar + AR_VT), (bf16_t*)(ar + AR_MIX), smalls + 16); }
          bf16_t* mix = (bf16_t*)(ar + AR_MIX); const float* sq = ssm_ss + (size_t)l * T;
          for (int row = bid * 8 + wave; row < T; row += G * 8) { const float rs = rsqrtf(sq[row] * (1.f / 512.f) + EPS);
              u32x4* p = (u32x4*)(mix + (size_t)row * D) + lane; u32x4 v = *p;
              v.x = cvtpk(__uint_as_float(v.x << 16) * rs, __uint_as_float(v.x & 0xffff0000u) * rs); v.y = cvtpk(__uint_as_float(v.y << 16) * rs, __uint_as_float(v.y & 0xffff0000u) * rs);
              v.z = cvtpk(__uint_as_float(v.z << 16) * rs, __uint_as_float(v.z & 0xffff0000u) * rs); v.w = cvtpk(__uint_as_float(v.w << 16) * rs, __uint_as_float(v.w & 0xffff0000u) * rs);
              *p = v; } }
        GSYNC();
        { PH StdSched S; S.init(T, D, G, bid, D, D); EpiResid E{hbuf, hbuf, hb, ssb + (size_t)(4 * l + 2) * T, 1.f};
          gemm_phase<EpiResid, StdSched, false>(lds, (const bf16_t*)(ar + AR_MIX), (const bf16_t*)(wl + W_OUT), D, D, D, S, E); }
        GSYNC();
        for (int rep = 0; rep < (PROBE == 3 ? 2 : 1); ++rep)
        { PH StdSched S; S.init(T, D, G, bid, D, D); EpiWq E{(bf16_t*)(ar + AR_QX), ssb + (size_t)(4 * l + 2) * T, 0.0625f * LOG2E};
          gemm_phase<EpiWq, StdSched, false>(lds, hb, (const bf16_t*)(wl + W_Q), D, D, D, S, E); }
        GSYNC();
        for (int rep = 0; rep < (PROBE == 3 ? 2 : 1); ++rep)
        { PH XaSched S{G, bid, (unsigned)MEM * 1024, 256u}; EpiSoftmax E{(bf16_t*)(ar + AR_P), (LAS float*)(lds + LDS_RED)};
          gemm_phase<EpiSoftmax, XaSched, true>(lds, (const bf16_t*)(ar + AR_QX), (const bf16_t*)(ws + WS_KX) + (size_t)l * 1024 * 1024, D, D, 256, S, E); }
        GSYNC();
        for (int rep = 0; rep < (PROBE == 3 ? 2 : 1); ++rep)
        { PH XaSched S{G, bid, 4u * 65536u, 65536u}; EpiPV E{(bf16_t*)(ar + AR_OX)};
          gemm_phase<EpiPV, XaSched, false>(lds, (const bf16_t*)(ar + AR_P), (const bf16_t*)(ws + WS_VXT) + (size_t)l * 1024 * 1024, D, 256, 256, S, E); }
        GSYNC();
        { PH StdSched S; S.init(T, D, G, bid, D, D); EpiResid E{hbuf, hbuf, hb, ssb + (size_t)(4 * l + 3) * T, 1.f};
          gemm_phase<EpiResid, StdSched, false>(lds, (const bf16_t*)(ar + AR_OX), (const bf16_t*)(wl + W_O), D, D, D, S, E); }
        GSYNC();
        for (int rep = 0; rep < (PROBE == 2 ? 2 : 1); ++rep)
        { PH StdSched S; S.init(T, 2 * FF, G, bid, D, D); EpiFfnUp E{(bf16_t*)(ar + AR_HID), ssb + (size_t)(4 * l + 3) * T};
          gemm_phase<EpiFfnUp, StdSched, false>(lds, hb, (const bf16_t*)(wl + W_GU2), D, D, D, S, E); }
        GSYNC();
        { PH StdSched S; S.init(T, D, G, bid, FF, FF); EpiResid E{hbuf, hbuf, hb, ssb + (size_t)(4 * l + 4) * T, 0.5f};
          gemm_phase<EpiResid, StdSched, false>(lds, (const bf16_t*)(ar + AR_HID), (const bf16_t*)(wl + W_D2), FF, FF, FF, S, E); }
        GSYNC();
    }
    { const int l = 0; PH const float* sq = ssb + (size_t)8 * T; const float* gn = ka->in[35];
      for (int row = bid * 8 + wave; row < T; row += G * 8) { const float rs = rsqrtf(sq[row] * (1.f / D) + EPS);
#pragma unroll
          for (int j = 0; j < 4; ++j) { f32x4* p = (f32x4*)(hbuf + (size_t)row * D) + lane + 64 * j; const f32x4 gg = *((const f32x4*)gn + lane + 64 * j); f32x4 v = *p;
              v[0] *= rs * gg[0]; v[1] *= rs * gg[1]; v[2] *= rs * gg[2]; v[3] *= rs * gg[3]; *p = v; } } }
}

extern "C" void kernel_launch(void* const* d_in, const int* in_sizes, int n_in, void* d_out, int out_size, void* d_ws, size_t ws_size, hipStream_t stream) {
    static int grid = 0;
    if (grid == 0) {
        if (n_in != 36 || out_size != T * D || ws_size < WS_END) { fprintf(stderr, "kernel_launch: unexpected problem (n_in %d out %d ws %zu)\n", n_in, out_size, ws_size); grid = -1; return; }
        int dev = 0, cus = 0, per_cu = 0;
        if (hipGetDevice(&dev) != hipSuccess || hipDeviceGetAttribute(&cus, hipDeviceAttributeMultiprocessorCount, dev) != hipSuccess) { grid = -1; return; }
        if (hipFuncSetAttribute((const void*)fwd_kernel, hipFuncAttributeMaxDynamicSharedMemorySize, LDS_BYTES) != hipSuccess) { fprintf(stderr, "hipFuncSetAttribute failed\n"); grid = -1; return; }
        if (hipOccupancyMaxActiveBlocksPerMultiprocessor(&per_cu, (const void*)fwd_kernel, 512, LDS_BYTES) != hipSuccess || per_cu < 1) { fprintf(stderr, "occupancy query: %d\n", per_cu); }
        (void)hipGetLastError();
        grid = cus;
        if (grid != 256) fprintf(stderr, "kernel_launch: %d CUs (expected 256)\n", grid);
    }
    if (grid < 0) return;
    (void)hipMemsetAsync((char*)d_ws + WS_CTL, 0, 32768, stream);
    Args a{};
    for (int i = 0; i < 36; ++i) a.in[i] = (const float*)d_in[i];
    a.out = (float*)d_out; a.ws = (unsigned char*)d_ws;
    void* args[] = {&a};
    hipError_t e = hipLaunchCooperativeKernel((const void*)fwd_kernel, dim3(grid), dim3(512), args, LDS_BYTES, stream);
    if (e != hipSuccess) fprintf(stderr, "cooperative launch failed: %s (grid %d)\n", hipGetErrorString(e), grid);
}
```

```cpp
#include <hip/hip_runtime.h>
#include <hip/hip_cooperative_groups.h>
#include <cstdio>
#include <cstdint>
namespace cg = cooperative_groups;

#define LAS __attribute__((address_space(3)))
typedef unsigned short bf16_t;
typedef short bf16x8 __attribute__((ext_vector_type(8)));
typedef float f32x4 __attribute__((ext_vector_type(4)));
typedef float f32x2 __attribute__((ext_vector_type(2)));
typedef unsigned u32x4 __attribute__((ext_vector_type(4)));
typedef unsigned u32x2 __attribute__((ext_vector_type(2)));
typedef __bf16 bf16x2_t __attribute__((ext_vector_type(2)));

#ifndef PROBE
#define PROBE 0
#endif
#ifndef DEBUG_CHECK
#define DEBUG_CHECK 0
#endif

constexpr int D = 1024, BATCH = 4, SEQ = 8192, T = BATCH * SEQ, DEPTH = 2, MEM = 256, FF = 2816;
constexpr int SSMW = 512, NG = 32, NP = 64, CH = 32  , NCH = SEQ / CH  , UPW = 640  ;
constexpr float EPS = 1e-6f, LOG2E = 1.4426950408889634f;

constexpr size_t MiB = 1u << 20;
constexpr size_t WS_CTL = 0;
constexpr size_t WS_SS = 466 * MiB;
constexpr size_t WS_SSM_SS = WS_SS + 9 * (size_t)T * 64;
constexpr size_t WS_SMALL = 3 * MiB;
constexpr size_t WS_MEMN = 4 * MiB;
constexpr size_t WS_KX = 8 * MiB;
constexpr size_t WS_VXT = 12 * MiB;
constexpr size_t WS_W = 16 * MiB, W_LAYER = 76 * MiB;
constexpr size_t W_GU1 = 0, W_D1 = 11 * MiB, W_GU2 = 16 * MiB + MiB / 2, W_D2 = 27 * MiB + MiB / 2, W_IN = 33 * MiB, W_GLU = 37 * MiB, W_OUT = 38 * MiB,
                 W_Q = 40 * MiB, W_KV = 42 * MiB, W_O = 46 * MiB, W_BM = 48 * MiB, W_MT = 56 * MiB;
constexpr size_t WS_HB = WS_W + 2 * W_LAYER;
constexpr size_t WS_AR = WS_HB + 64 * MiB;
constexpr size_t AR_UP = 0, AR_Q = 40 * MiB, AR_K = 72 * MiB, AR_VT = 104 * MiB, AR_Y = 136 * MiB, AR_MIX = 168 * MiB;
constexpr size_t AR_QX = 0, AR_P = 64 * MiB, AR_OX = 128 * MiB, AR_HID = 0;
constexpr size_t WS_END = WS_SSM_SS + 2 * (size_t)T * 64;

constexpr int LDS_BYTES = 147456;
constexpr int LDS_RED = 131072; constexpr int LDS_XB = 131072 + 8192;

struct Args { const float* in[36]; float* out; unsigned char* ws; };
typedef const __attribute__((address_space(4))) Args* KArgsP;
#define KARGS() ({ KArgsP _p = (KArgsP)__builtin_amdgcn_kernarg_segment_ptr(); asm volatile("" : "+s"(_p)); _p; })

__device__ __forceinline__ unsigned cvtpk(float lo, float hi) { f32x2 v = {lo, hi}; bf16x2_t b = __builtin_convertvector(v, bf16x2_t); return __builtin_bit_cast(unsigned, b); }
__device__ __forceinline__ float bf2f(bf16_t x) { return __uint_as_float((unsigned)x << 16); }
__device__ __forceinline__ float wave_sum(float v) {
#pragma unroll
    for (int o = 1; o < 64; o <<= 1) v += __shfl_xor(v, o);
    return v;
}
__device__ __forceinline__ float fq_sum(float v) { v += __shfl_xor(v, 16); v += __shfl_xor(v, 32); return v; }
__device__ __forceinline__ float max3f(float a, float b, float c) { float r; asm("v_max3_f32 %0, %1, %2, %3" : "=v"(r) : "v"(a), "v"(b), "v"(c)); return r; }
__device__ __forceinline__ float xl_max(float v) {
    u32x2 r = __builtin_amdgcn_permlane32_swap(__float_as_uint(v), __float_as_uint(v), false, false); v = fmaxf(__uint_as_float(r[0]), __uint_as_float(r[1]));
    r = __builtin_amdgcn_permlane16_swap(__float_as_uint(v), __float_as_uint(v), false, false); return fmaxf(__uint_as_float(r[0]), __uint_as_float(r[1]));
}
__device__ __forceinline__ float fq_max(float v) { v = fmaxf(v, __shfl_xor(v, 16)); v = fmaxf(v, __shfl_xor(v, 32)); return v; }
__device__ __forceinline__ u32x4 pack8(f32x4 a, f32x4 b) { u32x4 w; w.x = cvtpk(a[0], a[1]); w.y = cvtpk(a[2], a[3]); w.z = cvtpk(b[0], b[1]); w.w = cvtpk(b[2], b[3]); return w; }
__device__ __forceinline__ float fast_exp2(float x) { return __builtin_amdgcn_exp2f(x); }
__device__ __forceinline__ float fast_rcp(float x) { return __builtin_amdgcn_rcpf(x); }
__device__ __forceinline__ float sigmoidf_(float x) { return fast_rcp(1.f + fast_exp2(-x * LOG2E)); }


__device__ __forceinline__ float ss_sum16(const float* ss16, int row) {
    const f32x4* p = (const f32x4*)(ss16 + (size_t)row * 16); const f32x4 a = p[0], b = p[1], c = p[2], d = p[3];
    return (((a[0] + a[1]) + (a[2] + a[3])) + ((b[0] + b[1]) + (b[2] + b[3]))) + (((c[0] + c[1]) + (c[2] + c[3])) + ((d[0] + d[1]) + (d[2] + d[3])));
}
#define XB_TMO      128
#define XB_XCNT(j)  (256  + 64 * (j))
#define XB_XSUB(j)  (1280 + 64 * (j))
#define XB_XGEN(j)  (2304 + 64 * (j))
#define XB_TOP      3328
#define XB_TOPGEN   3392
#define XCD_BAR_WORDS 3456
#define XB_SPIN_CAP (1u << 22)
__device__ __forceinline__ unsigned xb_ld(unsigned* p)              { return __hip_atomic_load(p, __ATOMIC_RELAXED, __HIP_MEMORY_SCOPE_AGENT); }
__device__ __forceinline__ unsigned xb_add(unsigned* p, unsigned v) { return __hip_atomic_fetch_add(p, v, __ATOMIC_RELAXED, __HIP_MEMORY_SCOPE_AGENT); }
__device__ __forceinline__ unsigned xb_xcc_id() { return (unsigned)__builtin_amdgcn_s_getreg((3 << 11) | 20) & 0xFu; }
#define XB_SPIN(cond, bar) do { unsigned _sp = 0; while (cond) { __builtin_amdgcn_s_sleep(1); \
    if ((++_sp & 255u) == 0u) { if (xb_ld(&(bar)[XB_TMO])) break; if (_sp > XB_SPIN_CAP) { atomicAdd(&(bar)[XB_TMO], 1u); break; } } } } while (0)
struct XcdBarrier { unsigned* bar; unsigned x; volatile LAS unsigned* st; };
__device__ __forceinline__ XcdBarrier xcd_barrier_post(unsigned* bar, volatile LAS unsigned* st) {
    XcdBarrier b; b.bar = bar; b.x = xb_xcc_id(); b.st = st;
    if (threadIdx.x == 0) (void)xb_add(&bar[XB_XCNT(b.x)], 1u);
    return b;
}
__device__ __forceinline__ void xcd_barrier_complete(unsigned* bar, unsigned x, unsigned& nloc, unsigned& nx) {
    const unsigned G = gridDim.x * gridDim.y * gridDim.z;
    unsigned sum, cnt, mine, sp = 0u;
    for (;;) {
        sum = 0u; cnt = 0u; mine = 0u;
#pragma unroll
        for (unsigned j = 0; j < 16; ++j) { const unsigned c = xb_ld(&bar[XB_XCNT(j)]); sum += c; cnt += (c > 0u) ? 1u : 0u; mine = (j == x) ? c : mine; }
        if (sum == G) break;
        __builtin_amdgcn_s_sleep(1);
        if ((++sp & 255u) == 0u) { if (xb_ld(&bar[XB_TMO])) break; if (sp > XB_SPIN_CAP) { atomicAdd(&bar[XB_TMO], 1u); break; } }
    }
    nloc = mine > 0u ? mine : 1u; nx = cnt > 0u ? cnt : 1u;
}
__device__ __forceinline__ void xcd_barrier(const XcdBarrier& b) {
    asm volatile("s_waitcnt vmcnt(0)" ::: "memory");
    __syncthreads();
    if (threadIdx.x == 0) {
        unsigned* bar = b.bar;
        __builtin_amdgcn_s_waitcnt(0);
        unsigned nloc = b.st[0], nx = b.st[1];
        if (nloc == 0u) { xcd_barrier_complete(bar, b.x, nloc, nx); b.st[0] = nloc; b.st[1] = nx; }
        const unsigned old = xb_add(&bar[XB_XSUB(b.x)], 1u);
        const unsigned gen = old / nloc;
        if (old + 1u == (gen + 1u) * nloc) {
            __builtin_amdgcn_fence(__ATOMIC_RELEASE, "agent");
            asm volatile("s_waitcnt vmcnt(0)" ::: "memory");
            const unsigned og = xb_add(&bar[XB_TOP], 1u);
            const unsigned tg = og / nx;
            if (og + 1u == (tg + 1u) * nx) xb_add(&bar[XB_TOPGEN], 1u);
            else XB_SPIN(xb_ld(&bar[XB_TOPGEN]) == tg, bar);
            __builtin_amdgcn_fence(__ATOMIC_ACQUIRE, "agent");
            xb_add(&bar[XB_XGEN(b.x)], 1u);
            asm volatile("s_waitcnt vmcnt(0)" ::: "memory");
        } else {
            XB_SPIN(xb_ld(&bar[XB_XGEN(b.x)]) == gen, bar);
            __builtin_amdgcn_fence(__ATOMIC_ACQUIRE, "agent");
            asm volatile("s_waitcnt vmcnt(0)" ::: "memory");
        }
    }
    __syncthreads();
}

constexpr int BM = 256, BK = 64, HALF = 128, HTB = HALF * BK * 2, NXCD = 8, WGM = 8;
__host__ __device__ __forceinline__ int lds_byte(int r, int c) { const int st = (r >> 4) * 2 + (c >> 5), rr = r & 15, cc = c & 31, ob = rr * 64 + cc * 2; return st * 1024 + (ob ^ (((ob >> 9) & 1) << 5)); }
__host__ __device__ __forceinline__ void stage_rc(int b, int& R, int& C) { const int st = b / 1024, sb = b % 1024, swz = sb ^ (((sb >> 9) & 1) << 5); R = (st >> 1) * 16 + swz / 64; C = (st & 1) * 32 + (swz % 64) / 2; }
__host__ __device__ __forceinline__ int perm32(int rho) { const int n = rho >> 4, i = rho & 15; return 8 * (i >> 2) + 4 * n + (i & 3); }

struct Unit { int pm, pn, bz; unsigned a_off, b_off; };

struct StdSched {
    int nM, nN, nwg, G, c, lda, ldb;
    __device__ void init(int M, int N, int G_, int c_, int lda_, int ldb_) { nM = M / BM; nN = N / BM; nwg = nM * nN; G = G_; c = c_; lda = lda_; ldb = ldb_; }
    __device__ bool next(int i, Unit& u) const {
        const long L = (long)i * G + c; if (L >= nwg) return false;
        int wgid = (int)L; { const int q = nwg / NXCD, r = nwg % NXCD, xcd = wgid % NXCD, off = wgid / NXCD; wgid = (xcd < r ? xcd * (q + 1) : r * (q + 1) + (xcd - r) * q) + off; }
        const int nig = WGM * nN, gid = wgid / nig, fm = gid * WGM, gsz = (nM - fm) < WGM ? (nM - fm) : WGM;
        u.pm = fm + ((wgid % nig) % gsz); u.pn = (wgid % nig) / gsz; u.bz = 0;
        u.a_off = (unsigned)(u.pm * BM) * (unsigned)lda; u.b_off = (unsigned)(u.pn * BM) * (unsigned)ldb; return true;
    }
};
struct Ssm1Sched {
    int c;
    __device__ bool next(int i, Unit& u) const {
        if (i > 0 || c >= BATCH * NG) return false;
        u.pm = 0; u.pn = 0; u.bz = c; u.a_off = (unsigned)c * NCH * UPW; u.b_off = (unsigned)(c & 31) * 256 * 512; return true;
    }
};
struct WkvSched {
    int G, c;
    __device__ bool next(int i, Unit& u) const {
        if (c < 128) return false;
        const int L = (c - 128) + i * (G - 128); if (L >= 64) return false;
        const int layer = L >> 5, rem = L & 31; u.pm = rem >> 3; u.pn = rem & 7; u.bz = layer;
        u.a_off = (unsigned)layer * 1024 * 1024 + (unsigned)u.pm * 256 * 1024; u.b_off = (unsigned)layer * (unsigned)(W_LAYER / 2) + (unsigned)u.pn * 256 * 1024; return true;
    }
};
struct Ssm2Sched {
    int G, c;
    __device__ bool next(int i, Unit& u) const {
        const int L = c + i * G; if (L >= 2 * BATCH * NG) return false;
        u.bz = L >> 1; u.pn = L & 1; u.pm = 0; u.a_off = (unsigned)u.bz * NCH * UPW; u.b_off = ((unsigned)(u.bz & 31) * 512 + (unsigned)u.pn * 256) * UPW; return true;
    }
};
struct XaSched {
    int G, c; unsigned bs_b, bs_h;
    __device__ bool next(int i, Unit& u) const {
        const int L = c + i * G; if (L >= 512) return false;
        const int bh = L >> 5; u.pm = L & 31; u.pn = 0; u.bz = bh; const int b = bh >> 2, h = bh & 3;
        u.a_off = ((unsigned)(b * SEQ + u.pm * 256)) * 1024 + h * 256; u.b_off = (unsigned)b * bs_b + (unsigned)h * bs_h; return true;
    }
};

template <class Epi, class Sched, bool ALIGN_EPI>
__device__ __forceinline__ void gemm_phase(LAS unsigned char* lds, const bf16_t* Ab, const bf16_t* Bb, int lda, int ldb, int K, const Sched& S, Epi& E) {
    int tid = threadIdx.x; asm volatile("" : "+v"(tid));
    const int wid = __builtin_amdgcn_readfirstlane(tid >> 6), lane = tid & 63, wr = wid >> 2, wc = wid & 3, fr = lane & 15, fq = lane >> 4;
    const int nt = K / BK;
    unsigned voffA[2], voffB[2]; int aoff, boff;
#define PG8_LANEOFFS(tt) do { _Pragma("unroll") for (int i = 0; i < 2; ++i) { int R, C; stage_rc((tt) * 16 + i * 8192, R, C); const int Rb = (R & ~31) + perm32(R & 31); \
        voffA[i] = (unsigned)(R * lda + C) * 2u; voffB[i] = (unsigned)(Rb * ldb + C) * 2u; } \
        aoff = lds_byte(wr * 64 + ((tt) & 15), (((tt) >> 4) & 3) * 8); boff = lds_byte(wc * 32 + ((tt) & 15), (((tt) >> 4) & 3) * 8); } while (0)
    PG8_LANEOFFS(tid);
    const unsigned kstep = (unsigned)(BK * 2);
    const unsigned hstepA = (unsigned)HALF * lda * 2, hstepB = (unsigned)HALF * ldb * 2;
    const unsigned ldsw = (unsigned)wid * 1024u;
#define PG8_SA(b, h) (((b) * 2 + (h)) * HTB)
#define PG8_SB(b, h) ((4 + (b) * 2 + (h)) * HTB)
#define PG8_STAGE(bufoff, gbase, voff) do { _Pragma("unroll") for (int _i = 0; _i < 2; ++_i) \
        __builtin_amdgcn_global_load_lds((const unsigned*)((const char*)(gbase) + (voff)[_i]), (LAS unsigned*)(lds + (bufoff) + ldsw + _i * 8192), 16, 0, 0); } while (0)
#define PG8_LDA(dst, b, h) do { _Pragma("unroll") for (int m = 0; m < 4; ++m) _Pragma("unroll") for (int k = 0; k < 2; ++k) dst[m][k] = *(const LAS bf16x8*)(lds + PG8_SA(b, h) + aoff + m * 2048 + k * 1024); } while (0)
#define PG8_LDB(dst, b, h) do { _Pragma("unroll") for (int n = 0; n < 2; ++n) _Pragma("unroll") for (int k = 0; k < 2; ++k) dst[n][k] = *(const LAS bf16x8*)(lds + PG8_SB(b, h) + boff + n * 2048 + k * 1024); } while (0)
#define PG8_MMA(ai, bj, At, Bt) do { __builtin_amdgcn_s_setprio(1); _Pragma("unroll") for (int m = 0; m < 4; ++m) _Pragma("unroll") for (int n = 0; n < 2; ++n) _Pragma("unroll") for (int k = 0; k < 2; ++k) \
        acc[ai][bj][m][n] = __builtin_amdgcn_mfma_f32_16x16x32_bf16(Bt[n][k], At[m][k], acc[ai][bj][m][n], 0, 0, 0); __builtin_amdgcn_s_setprio(0); } while (0)
#define PG8_WAIT_V(n) asm volatile("s_waitcnt vmcnt(" #n ")" ::: "memory")
#define PG8_WAIT_L(n) asm volatile("s_waitcnt lgkmcnt(" #n ")" ::: "memory")
#define PG8_BAR __builtin_amdgcn_s_barrier()
#define PG8_SCHED __builtin_amdgcn_sched_barrier(0)
    Unit cur, nxt; int ui = 0;
    if (!S.next(0, cur)) return;
    f32x4 acc[2][2][4][2];
#pragma unroll
    for (int a = 0; a < 2; ++a)
#pragma unroll
        for (int b = 0; b < 2; ++b)
#pragma unroll
            for (int m = 0; m < 4; ++m)
#pragma unroll
                for (int n = 0; n < 2; ++n) acc[a][b][m][n] = (f32x4){0.f, 0.f, 0.f, 0.f};
    bf16x8 At[4][2], B0[2][2], B1[2][2];
    const char* cA = (const char*)(Ab + cur.a_off); const char* cB = (const char*)(Bb + cur.b_off);
    PG8_STAGE(PG8_SB(0, 0), cB, voffB); PG8_STAGE(PG8_SB(0, 1), cB + hstepB, voffB); PG8_STAGE(PG8_SA(0, 0), cA, voffA); PG8_STAGE(PG8_SA(0, 1), cA + hstepA, voffA);
    if (wr == 1) PG8_BAR;
    PG8_WAIT_V(2); PG8_BAR;
    PG8_STAGE(PG8_SB(1, 0), cB + kstep, voffB); PG8_STAGE(PG8_SA(1, 0), cA + kstep, voffA); PG8_STAGE(PG8_SB(1, 1), cB + hstepB + kstep, voffB);
    PG8_WAIT_V(6); PG8_BAR;
    for (;;) {
        const bool has_next = S.next(ui + 1, nxt);
        const char* nA = has_next ? (const char*)(Ab + nxt.a_off) : cA; const char* nB = has_next ? (const char*)(Bb + nxt.b_off) : cB;
        for (int t = 0; t < nt; t += 2) {
            const bool last = (t == nt - 2);
            const char* a1 = cA + (unsigned)(t + 1) * kstep;
            const char* a2 = last ? nA : cA + (unsigned)(t + 2) * kstep; const char* b2 = last ? nB : cB + (unsigned)(t + 2) * kstep;
            const char* a3 = a2 + kstep; const char* b3 = b2 + kstep;
            PG8_LDB(B0, 0, 0); PG8_LDB(B1, 0, 1); PG8_SCHED; PG8_LDA(At, 0, 0); PG8_STAGE(PG8_SA(1, 1), a1 + hstepA, voffA);
            PG8_WAIT_V(8); PG8_WAIT_L(0); PG8_BAR; PG8_MMA(0, 0, At, B0); PG8_MMA(0, 1, At, B1); PG8_BAR; PG8_SCHED;
            PG8_LDA(At, 0, 1); PG8_STAGE(PG8_SB(0, 0), b2, voffB); PG8_STAGE(PG8_SB(0, 1), b2 + hstepB, voffB); PG8_STAGE(PG8_SA(0, 0), a2, voffA);
            PG8_WAIT_V(8); PG8_WAIT_L(0); PG8_BAR; PG8_MMA(1, 0, At, B0); PG8_MMA(1, 1, At, B1); PG8_BAR; PG8_SCHED;
            PG8_LDB(B0, 1, 0); PG8_LDB(B1, 1, 1); PG8_SCHED; PG8_LDA(At, 1, 0); PG8_STAGE(PG8_SA(0, 1), a2 + hstepA, voffA);
            PG8_WAIT_V(8); PG8_WAIT_L(0); PG8_BAR; PG8_MMA(0, 0, At, B0); PG8_MMA(0, 1, At, B1); PG8_BAR; PG8_SCHED;
            PG8_LDA(At, 1, 1); PG8_STAGE(PG8_SB(1, 0), b3, voffB); PG8_STAGE(PG8_SB(1, 1), b3 + hstepB, voffB); PG8_STAGE(PG8_SA(1, 0), a3, voffA);
            PG8_WAIT_V(8); PG8_WAIT_L(0); PG8_BAR; PG8_MMA(1, 0, At, B0); PG8_MMA(1, 1, At, B1); PG8_BAR; PG8_SCHED;
        }
        if constexpr (ALIGN_EPI) { if (wr == 0) PG8_BAR; }
        if constexpr (!Epi::AFTER_DRAIN) { int t2 = threadIdx.x; asm volatile("" : "+v"(t2)); E(acc, cur, wr, wc, t2 & 15, (t2 >> 4) & 3); }
        if (!has_next) break;
#pragma unroll
        for (int a = 0; a < 2; ++a)
#pragma unroll
            for (int b = 0; b < 2; ++b)
#pragma unroll
                for (int m = 0; m < 4; ++m)
#pragma unroll
                    for (int n = 0; n < 2; ++n) acc[a][b][m][n] = (f32x4){0.f, 0.f, 0.f, 0.f};
        cur = nxt; cA = nA; cB = nB; ++ui;
        { int t3 = threadIdx.x; asm volatile("" : "+v"(t3)); PG8_LANEOFFS(t3); }
        if constexpr (ALIGN_EPI) { if (wr == 1) PG8_BAR; }
    }
    PG8_WAIT_V(0);
    if constexpr (!ALIGN_EPI) { if (wr == 0) PG8_BAR; }
    PG8_BAR;
    if constexpr (Epi::AFTER_DRAIN) { E.fused(acc, cur, wr, wc, fr, fq, lds, wid, lane); }
#undef PG8_LANEOFFS
#undef PG8_SA
#undef PG8_SB
#undef PG8_STAGE
#undef PG8_LDA
#undef PG8_LDB
#undef PG8_MMA
#undef PG8_WAIT_V
#undef PG8_WAIT_L
#undef PG8_BAR
#undef PG8_SCHED
}

typedef f32x4 (&AccRef)[2][2][4][2];

struct EpiFfnUp {
    static constexpr bool AFTER_DRAIN = false;
    bf16_t* H; const float* ss;
    __device__ __forceinline__ void operator()(AccRef acc, const Unit& u, int wr, int wc, int fr, int fq) const {
#pragma unroll
        for (int ai = 0; ai < 2; ++ai)
#pragma unroll
            for (int m = 0; m < 4; ++m) {
                const int row = u.pm * 256 + ai * 128 + wr * 64 + m * 16 + fr;
                const float rs = rsqrtf(ss_sum16(ss, row) * (1.f / D) + EPS);
                f32x4 o[2];
#pragma unroll
                for (int n = 0; n < 2; ++n)
#pragma unroll
                    for (int j = 0; j < 4; ++j) { const float g = acc[ai][0][m][n][j] * rs, up = acc[ai][1][m][n][j] * rs; o[n][j] = g * sigmoidf_(g) * up; }
                *(u32x4*)(H + (size_t)row * FF + u.pn * 128 + wc * 32 + 8 * fq) = pack8(o[0], o[1]);
            }
    }
};
struct EpiResid {
    static constexpr bool AFTER_DRAIN = false;
    bf16_t* hb; float* ssn; float scale;
    __device__ __forceinline__ void operator()(AccRef acc, const Unit& u, int wr, int wc, int fr, int fq) const {
#pragma unroll
        for (int ai = 0; ai < 2; ++ai)
#pragma unroll
            for (int m = 0; m < 4; ++m) {
                const int row = u.pm * 256 + ai * 128 + wr * 64 + m * 16 + fr; float part = 0.f;
#pragma unroll
                for (int bj = 0; bj < 2; ++bj) {
                    const size_t idx = (size_t)row * D + u.pn * 256 + bj * 128 + wc * 32 + 8 * fq;
                    const u32x4 ow = *(const u32x4*)(hb + idx);
                    f32x4 v0, v1;
                    v0[0] = __uint_as_float(ow.x << 16); v0[1] = __uint_as_float(ow.x & 0xffff0000u); v0[2] = __uint_as_float(ow.y << 16); v0[3] = __uint_as_float(ow.y & 0xffff0000u);
                    v1[0] = __uint_as_float(ow.z << 16); v1[1] = __uint_as_float(ow.z & 0xffff0000u); v1[2] = __uint_as_float(ow.w << 16); v1[3] = __uint_as_float(ow.w & 0xffff0000u);
                    v0 = v0 + acc[ai][bj][m][0] * scale; v1 = v1 + acc[ai][bj][m][1] * scale;
                    *(u32x4*)(hb + idx) = pack8(v0, v1);
                    part += (v0[0] * v0[0] + v0[1] * v0[1]) + (v0[2] * v0[2] + v0[3] * v0[3]) + (v1[0] * v1[0] + v1[1] * v1[1]) + (v1[2] * v1[2] + v1[3] * v1[3]);
                }
                part = fq_sum(part);
                if (fq == 0) ssn[(size_t)row * 16 + u.pn * 4 + wc] = part;
            }
    }
};
struct EpiWin {
    static constexpr bool AFTER_DRAIN = false;
    unsigned char* arp; const float* ss;
    __device__ __forceinline__ void operator()(AccRef acc, const Unit& u, int wr, int wc, int fr, int fq) const {
        bf16_t* up = (bf16_t*)(arp + AR_UP); bf16_t* qb = (bf16_t*)(arp + AR_Q); bf16_t* kb = (bf16_t*)(arp + AR_K); bf16_t* vt = (bf16_t*)(arp + AR_VT);
        const int sel = u.pn >> 1;
#pragma unroll
        for (int ai = 0; ai < 2; ++ai)
#pragma unroll
            for (int m = 0; m < 4; ++m) {
                const int row = u.pm * 256 + ai * 128 + wr * 64 + m * 16 + fr;
                float rs = rsqrtf(ss_sum16(ss, row) * (1.f / D) + EPS);
                if (sel == 1) rs *= 0.125f * LOG2E;
                const int b = row >> 13, t = row & (SEQ - 1);
#pragma unroll
                for (int bj = 0; bj < 2; ++bj) {
                    const int c = (u.pn & 1) * 256 + bj * 128 + wc * 32 + 8 * fq;
                    const f32x4 v0 = acc[ai][bj][m][0] * rs, v1 = acc[ai][bj][m][1] * rs;
                    if (sel == 0) { const int g = c >> 4, hi0 = c & 15;
                        *(u32x4*)(up + ((size_t)((b * NG + g) * NCH + (t >> 5))) * UPW + (t & 31) * 16 + hi0) = pack8(v0, v1);
                    } else if (sel == 1) { *(u32x4*)(qb + (size_t)row * 512 + c) = pack8(v0, v1);
                    } else if (sel == 2) { *(u32x4*)(kb + (size_t)row * 512 + c) = pack8(v0, v1);
                    } else { const int h = c >> 7, dv = c & 127; bf16_t* p = vt + ((size_t)((b * 4 + h) * 128 + dv)) * SEQ + t;
                        const u32x4 w = pack8(v0, v1);
                        p[0] = (bf16_t)(w.x & 0xffff); p[SEQ] = (bf16_t)(w.x >> 16); p[2 * SEQ] = (bf16_t)(w.y & 0xffff); p[3 * SEQ] = (bf16_t)(w.y >> 16);
                        p[4 * SEQ] = (bf16_t)(w.z & 0xffff); p[5 * SEQ] = (bf16_t)(w.z >> 16); p[6 * SEQ] = (bf16_t)(w.w & 0xffff); p[7 * SEQ] = (bf16_t)(w.w >> 16);
                    }
                }
            }
    }
};
__device__ __forceinline__ float gelu_tanh(float x) { const float z = 0.7978845608028654f * (x + 0.044715f * x * x * x); return x * fast_rcp(1.f + fast_exp2(-2.f * LOG2E * z)); }
struct EpiSsm2 {
    static constexpr bool AFTER_DRAIN = false;
    bf16_t* yb;
    __device__ __forceinline__ void operator()(AccRef acc, const Unit& u, int wr, int wc, int fr, int fq) const {
        const int b = u.bz >> 5, g = u.bz & 31;
#pragma unroll
        for (int ai = 0; ai < 2; ++ai)
#pragma unroll
            for (int m = 0; m < 4; ++m) {
                const int ch = ai * 128 + wr * 64 + m * 16 + fr;
#pragma unroll
                for (int bj = 0; bj < 2; ++bj) {
                    const int cc = u.pn * 256 + bj * 128 + wc * 32 + 8 * fq, t = cc >> 4, ho0 = cc & 15;
                    f32x4 v0, v1;
#pragma unroll
                    for (int j = 0; j < 4; ++j) { v0[j] = gelu_tanh(acc[ai][bj][m][0][j]); v1[j] = gelu_tanh(acc[ai][bj][m][1][j]); }
                    *(u32x4*)(yb + ((size_t)(b * SEQ + ch * CH + t)) * 512 + g * 16 + ho0) = pack8(v0, v1);
                }
            }
    }
};
struct EpiGlu {
    static constexpr bool AFTER_DRAIN = false;
    bf16_t* mix; const float* bglu; float* ssq;
    __device__ __forceinline__ void operator()(AccRef acc, const Unit& u, int wr, int wc, int fr, int fq) const {
        const int c0 = u.pn * 128 + wc * 32 + 8 * fq;
        const f32x4 bv0 = *(const f32x4*)(bglu + c0), bv1 = *(const f32x4*)(bglu + c0 + 4), bg0 = *(const f32x4*)(bglu + 512 + c0), bg1 = *(const f32x4*)(bglu + 512 + c0 + 4);
#pragma unroll
        for (int ai = 0; ai < 2; ++ai)
#pragma unroll
            for (int m = 0; m < 4; ++m) {
                const int row = u.pm * 256 + ai * 128 + wr * 64 + m * 16 + fr;
                f32x4 o0, o1; float part = 0.f;
#pragma unroll
                for (int j = 0; j < 4; ++j) {
                    o0[j] = (acc[ai][0][m][0][j] + bv0[j]) * sigmoidf_(acc[ai][1][m][0][j] + bg0[j]);
                    o1[j] = (acc[ai][0][m][1][j] + bv1[j]) * sigmoidf_(acc[ai][1][m][1][j] + bg1[j]);
                    part += o0[j] * o0[j] + o1[j] * o1[j];
                }
                *(u32x4*)(mix + (size_t)row * D + c0) = pack8(o0, o1);
                part = fq_sum(part);
                if (fq == 0) ssq[(size_t)row * 16 + u.pn * 4 + wc] = part;
            }
    }
};
struct EpiWq {
    static constexpr bool AFTER_DRAIN = false;
    bf16_t* O; const float* ss; float mul;
    __device__ __forceinline__ void operator()(AccRef acc, const Unit& u, int wr, int wc, int fr, int fq) const {
#pragma unroll
        for (int ai = 0; ai < 2; ++ai)
#pragma unroll
            for (int m = 0; m < 4; ++m) {
                const int row = u.pm * 256 + ai * 128 + wr * 64 + m * 16 + fr;
                const float rs = rsqrtf(ss_sum16(ss, row) * (1.f / D) + EPS) * mul;
#pragma unroll
                for (int bj = 0; bj < 2; ++bj)
                    *(u32x4*)(O + (size_t)row * D + u.pn * 256 + bj * 128 + wc * 32 + 8 * fq) = pack8(acc[ai][bj][m][0] * rs, acc[ai][bj][m][1] * rs);
            }
    }
};
struct EpiWkv {
    static constexpr bool AFTER_DRAIN = false;
    bf16_t *kx, *vxt;
    __device__ __forceinline__ void operator()(AccRef acc, const Unit& u, int wr, int wc, int fr, int fq) const {
        const size_t lo = (size_t)u.bz * 1024 * 1024;
#pragma unroll
        for (int ai = 0; ai < 2; ++ai)
#pragma unroll
            for (int m = 0; m < 4; ++m) {
                const int row = u.pm * 256 + ai * 128 + wr * 64 + m * 16 + fr;
#pragma unroll
                for (int bj = 0; bj < 2; ++bj) {
                    const int col = u.pn * 256 + bj * 128 + wc * 32 + 8 * fq;
                    const u32x4 w = pack8(acc[ai][bj][m][0], acc[ai][bj][m][1]);
                    if (u.pn < 4) *(u32x4*)(kx + lo + (size_t)row * 1024 + col) = w;
                    else { const int c2 = col - 1024, h = c2 >> 8, d = c2 & 255, b = row >> 8, mm = row & 255;
                        bf16_t* p = vxt + lo + ((size_t)((b * 4 + h) * 256 + d)) * 256 + mm;
                        p[0] = (bf16_t)(w.x & 0xffff); p[256] = (bf16_t)(w.x >> 16); p[512] = (bf16_t)(w.y & 0xffff); p[768] = (bf16_t)(w.y >> 16);
                        p[1024] = (bf16_t)(w.z & 0xffff); p[1280] = (bf16_t)(w.z >> 16); p[1536] = (bf16_t)(w.w & 0xffff); p[1792] = (bf16_t)(w.w >> 16); }
                }
            }
    }
};
struct EpiSoftmax {
    static constexpr bool AFTER_DRAIN = false;
    bf16_t* P; LAS float* red;
    __device__ __forceinline__ void operator()(AccRef acc, const Unit& u, int wr, int wc, int fr, int fq) const {
        const int b = u.bz >> 2, h = u.bz & 3;
        float mx[2][4];
#pragma unroll
        for (int ai = 0; ai < 2; ++ai)
#pragma unroll
            for (int m = 0; m < 4; ++m) {
                float v = -INFINITY;
#pragma unroll
                for (int bj = 0; bj < 2; ++bj)
#pragma unroll
                    for (int n = 0; n < 2; ++n)
#pragma unroll
                        for (int j = 0; j < 4; ++j) v = fmaxf(v, acc[ai][bj][m][n][j]);
                v = fq_max(v);
                const int rl = ai * 128 + wr * 64 + m * 16 + fr;
                if (fq == 0) red[rl * 4 + wc] = v;
            }
        asm volatile("s_waitcnt lgkmcnt(0)" ::: "memory"); __builtin_amdgcn_s_barrier(); asm volatile("" ::: "memory");
#pragma unroll
        for (int ai = 0; ai < 2; ++ai)
#pragma unroll
            for (int m = 0; m < 4; ++m) {
                const int rl = ai * 128 + wr * 64 + m * 16 + fr;
                const f32x4 r4 = *(const LAS f32x4*)(red + rl * 4);
                const float M = fmaxf(fmaxf(r4[0], r4[1]), fmaxf(r4[2], r4[3]));
                float s = 0.f;
#pragma unroll
                for (int bj = 0; bj < 2; ++bj)
#pragma unroll
                    for (int n = 0; n < 2; ++n)
#pragma unroll
                        for (int j = 0; j < 4; ++j) { const float p = fast_exp2(acc[ai][bj][m][n][j] - M); acc[ai][bj][m][n][j] = p; s += p; }
                s = fq_sum(s);
                if (fq == 0) red[1024 + rl * 4 + wc] = s;
            }
        asm volatile("s_waitcnt lgkmcnt(0)" ::: "memory"); __builtin_amdgcn_s_barrier(); asm volatile("" ::: "memory");
#pragma unroll
        for (int ai = 0; ai < 2; ++ai)
#pragma unroll
            for (int m = 0; m < 4; ++m) {
                const int rl = ai * 128 + wr * 64 + m * 16 + fr;
                const f32x4 r4 = *(const LAS f32x4*)(red + 1024 + rl * 4);
                const float inv = 1.f / ((r4[0] + r4[1]) + (r4[2] + r4[3]));
                const size_t row = (size_t)b * SEQ + u.pm * 256 + rl;
#pragma unroll
                for (int bj = 0; bj < 2; ++bj)
                    *(u32x4*)(P + row * D + h * 256 + bj * 128 + wc * 32 + 8 * fq) = pack8(acc[ai][bj][m][0] * inv, acc[ai][bj][m][1] * inv);
            }
    }
};
struct EpiNull {
    static constexpr bool AFTER_DRAIN = false;
    float* sink;
    __device__ __forceinline__ void operator()(AccRef acc, const Unit& u, int wr, int wc, int fr, int fq) const {
        float t = 0.f;
#pragma unroll
        for (int ai = 0; ai < 2; ++ai)
#pragma unroll
            for (int bj = 0; bj < 2; ++bj)
#pragma unroll
                for (int m = 0; m < 4; ++m)
#pragma unroll
                    for (int n = 0; n < 2; ++n) t += acc[ai][bj][m][n][0] + acc[ai][bj][m][n][1] + acc[ai][bj][m][n][2] + acc[ai][bj][m][n][3];
        if (t == 12345.678f) sink[u.pm] = t;
    }
};
struct EpiPV {
    static constexpr bool AFTER_DRAIN = false;
    bf16_t* O;
    __device__ __forceinline__ void operator()(AccRef acc, const Unit& u, int wr, int wc, int fr, int fq) const {
        const int b = u.bz >> 2, h = u.bz & 3;
#pragma unroll
        for (int ai = 0; ai < 2; ++ai)
#pragma unroll
            for (int m = 0; m < 4; ++m) {
                const size_t row = (size_t)b * SEQ + u.pm * 256 + ai * 128 + wr * 64 + m * 16 + fr;
#pragma unroll
                for (int bj = 0; bj < 2; ++bj)
                    *(u32x4*)(O + row * D + h * 256 + bj * 128 + wc * 32 + 8 * fq) = pack8(acc[ai][bj][m][0], acc[ai][bj][m][1]);
            }
    }
};
struct EpiSsm1 {
    static constexpr bool AFTER_DRAIN = true;
    bf16_t* up; const float *lam_re, *lam_im, *log_dt;
    __device__ __forceinline__ void operator()(AccRef, const Unit&, int, int, int, int) const {}
    __device__ __forceinline__ void fused(AccRef acc, const Unit& u, int wr, int wc, int fr, int fq, LAS unsigned char* lds, int wid, int lane) const {
        LAS float* L = (LAS float*)lds;
#pragma unroll
        for (int ai = 0; ai < 2; ++ai)
#pragma unroll
            for (int m = 0; m < 4; ++m) {
                const int rl = ai * 128 + wr * 64 + m * 16 + fr;
#pragma unroll
                for (int n = 0; n < 2; ++n) { const int col = wc * 32 + 8 * fq + 4 * n; *(LAS f32x4*)(L + rl * 128 + (col ^ ((rl & 15) << 3))) = acc[ai][0][m][n]; }
            }
        __syncthreads();
        if (wid == 0) {
            const int g = u.bz & 31, p = lane;
            const float dt = expf(log_dt[g]) * (float)CH;
            const float lr = fminf(lam_re[g * NP + p], -1e-4f), li = lam_im[g * NP + p];
            const float mag = expf(lr * dt); float sn, cs; sincosf(li * dt, &sn, &cs);
            const float ar = mag * cs, aim = mag * sn;
            float xr = 0.f, xi = 0.f;
            unsigned* dst = (unsigned*)(up + (size_t)u.bz * NCH * UPW + 512) + p;
            for (int c = 0; c < NCH; ++c) {
                dst[(size_t)c * (UPW / 2)] = cvtpk(xr, xi);
                const f32x2 l2 = *(const LAS f32x2*)(L + c * 128 + ((2 * p) ^ ((c & 15) << 3)));
                const float nr = ar * xr - aim * xi + l2[0], ni = ar * xi + aim * xr + l2[1];
                xr = nr; xi = ni;
            }
        }
        __syncthreads();
    }
};

struct GainSpec { const float* g1; const float* g2; float g2s; };
__device__ __forceinline__ float gain_of(const GainSpec& gs, int k) {
    if (!gs.g1) return 1.f;
    if (gs.g2 && k >= 512) return gs.g2[(k - 512) & 127] * gs.g2s;
    return gs.g1[k];
}
__device__ __forceinline__ void transpose_item(const float* W, int K, int N, bf16_t* WT, bool il, int nh, int hb, const GainSpec gs, LAS float* scr, int item, int lane) {
    const int nblk = N / 32, kb = item / nblk, nb = item % nblk, k0 = 64 * kb, n0 = 32 * nb;
#pragma unroll 8
    for (int i = 0; i < 32; ++i) { const int kk = 2 * i + (lane >> 5); scr[kk * 33 + (lane & 31)] = W[(size_t)(k0 + kk) * N + n0 + (lane & 31)] * gain_of(gs, k0 + kk); }
    asm volatile("s_waitcnt lgkmcnt(0)" ::: "memory");
    const int c = lane & 7;
#pragma unroll
    for (int j = 0; j < 4; ++j) { const int n = (lane >> 3) + 8 * j; const LAS float* s = scr + (8 * c) * 33 + n;
        u32x4 o; o.x = cvtpk(s[0 * 33], s[1 * 33]); o.y = cvtpk(s[2 * 33], s[3 * 33]); o.z = cvtpk(s[4 * 33], s[5 * 33]); o.w = cvtpk(s[6 * 33], s[7 * 33]);
        int row = n0 + n; if (il) { const int jj = row % nh, half = hb + row / nh; row = (jj >> 7) * 256 + half * 128 + (jj & 127); }
        *(u32x4*)(WT + (size_t)row * K + k0 + 8 * c) = o; }
    asm volatile("s_waitcnt lgkmcnt(0)" ::: "memory");
}

__device__ __forceinline__ void ssm_matrices(KArgsP a, int l, int g, LAS unsigned char* lds, bf16_t* Bm, bf16_t* Mt) {
    int tid = threadIdx.x; asm volatile("" : "+v"(tid));
    LAS f32x2* lamtab = (LAS f32x2*)lds;
    LAS f32x2* cc = (LAS f32x2*)(lds + 16896);
    LAS f32x2* bb = (LAS f32x2*)(lds + 16896 + 8192);
    LAS float* Kt = (LAS float*)(lds + 16896 + 16384);
    const float* lam_re = a->in[9] + (size_t)(l * NG + g) * NP; const float* lam_im = a->in[10] + (size_t)(l * NG + g) * NP;
    const float* b_re = a->in[11] + (size_t)(l * NG + g) * NP * 16; const float* b_im = a->in[12] + (size_t)(l * NG + g) * NP * 16;
    const float* c_re = a->in[13] + (size_t)(l * NG + g) * 16 * NP; const float* c_im = a->in[14] + (size_t)(l * NG + g) * 16 * NP;
    const float* dd = a->in[15] + (size_t)(l * NG + g) * 16;
    const float dt = expf(a->in[16][l * NG + g]);
    for (int idx = tid; idx < 33 * 64; idx += 512) { const int tau = idx >> 6, p = idx & 63;
        const float lr = fminf(lam_re[p], -1e-4f), li = lam_im[p]; const float zr = lr * dt * (float)tau, zi = li * dt * (float)tau;
        const float mag = expf(zr); float sn, cs; sincosf(zi, &sn, &cs); lamtab[idx] = (f32x2){mag * cs, mag * sn}; }
    for (int idx = tid; idx < 1024; idx += 512) {
        cc[idx] = (f32x2){c_re[idx], c_im[idx]};
        const int p = idx >> 4;
        const float lr = fminf(lam_re[p], -1e-4f), li = lam_im[p]; const float mag = expf(lr * dt); float sn, cs; sincosf(li * dt, &sn, &cs);
        const float ar = mag * cs - 1.f, ai = mag * sn, den = 1.f / (lr * lr + li * li);
        const float qr = (ar * lr + ai * li) * den, qi = (ai * lr - ar * li) * den;
        const float br = b_re[idx], bi = b_im[idx];
        bb[idx] = (f32x2){qr * br - qi * bi, qr * bi + qi * br};
    }
    __syncthreads();
    for (int idx = tid; idx < 32 * 256; idx += 512) { const int tau = idx >> 8, ho = (idx >> 4) & 15, hi = idx & 15; float s = 0.f;
        for (int p = 0; p < NP; ++p) { const f32x2 c = cc[ho * 64 + p], lm = lamtab[tau * 64 + p], b = bb[p * 16 + hi];
            const float wr_ = c[0] * lm[0] - c[1] * lm[1], wi_ = c[0] * lm[1] + c[1] * lm[0]; s += wr_ * b[0] - wi_ * b[1]; }
        if (tau == 0 && ho == hi) s += dd[ho];
        Kt[idx] = s; }
    __syncthreads();
    for (int ch = tid; ch < 512 * 80; ch += 512) { const int n = ch / 80, kc = ch % 80, t = n >> 4, ho = n & 15, k0 = kc * 8; float v[8];
        if (k0 < 512) { const int s = k0 >> 4, hi0 = k0 & 15;
#pragma unroll
            for (int j = 0; j < 8; ++j) v[j] = (s <= t) ? Kt[(t - s) * 256 + ho * 16 + hi0 + j] : 0.f;
        } else { const int p0 = (k0 - 512) >> 1;
#pragma unroll
            for (int j = 0; j < 4; ++j) { const f32x2 c = cc[ho * 64 + p0 + j], lm = lamtab[(t + 1) * 64 + p0 + j];
                v[2 * j] = c[0] * lm[0] - c[1] * lm[1]; v[2 * j + 1] = -(c[0] * lm[1] + c[1] * lm[0]); } }
        u32x4 o; o.x = cvtpk(v[0], v[1]); o.y = cvtpk(v[2], v[3]); o.z = cvtpk(v[4], v[5]); o.w = cvtpk(v[6], v[7]);
        *(u32x4*)(Mt + (size_t)n * UPW + k0) = o; }
    for (int ch = tid; ch < 256 * 64; ch += 512) { const int n = ch >> 6, k0 = (ch & 63) * 8; float v[8];
        if (n < 128) { const int p = n >> 1, ri = n & 1, s = k0 >> 4, hi0 = k0 & 15; const f32x2 lm = lamtab[(CH - 1 - s) * 64 + p];
#pragma unroll
            for (int j = 0; j < 8; ++j) { const f32x2 b = bb[p * 16 + hi0 + j]; v[j] = ri ? (lm[0] * b[1] + lm[1] * b[0]) : (lm[0] * b[0] - lm[1] * b[1]); }
        } else {
#pragma unroll
            for (int j = 0; j < 8; ++j) v[j] = 0.f; }
        u32x4 o; o.x = cvtpk(v[0], v[1]); o.y = cvtpk(v[2], v[3]); o.z = cvtpk(v[4], v[5]); o.w = cvtpk(v[6], v[7]);
        *(u32x4*)(Bm + (size_t)n * 512 + k0) = o; }
    __syncthreads();
}

__device__ __forceinline__ void prologue(KArgsP a, LAS unsigned char* lds, int G) {
    unsigned char* ws = a->ws;
    int tid = threadIdx.x; asm volatile("" : "+v"(tid));
    const int lane = tid & 63, wave = tid >> 6, bid = blockIdx.x;
    for (int it = bid; it < DEPTH * NG; it += G) { const int l = it >> 5, g = it & 31;
        ssm_matrices(a, l, g, lds, (bf16_t*)(ws + WS_W + l * W_LAYER + W_BM) + (size_t)g * 256 * 512, (bf16_t*)(ws + WS_W + l * W_LAYER + W_MT) + (size_t)g * 512 * UPW); }
    if (bid == 0) {
        float* sm = (float*)(ws + WS_SMALL);
        if (tid < 128) { const int l = tid >> 6, i = tid & 63;
            const float d1 = wave_sum(a->in[20][l * 64 + i] * a->in[21][l * 64 + i]), d2 = wave_sum(a->in[22][l * 64 + i] * a->in[23][l * 64 + i]);
            if (i == 0) sm[l] = expf(d1) - expf(d2) + (0.8f - 0.6f * expf(-0.3f * (float)l)); }
        for (int idx = tid; idx < 4 * 132; idx += 512) { const int h = idx / 132, n = idx % 132; int bk;
            if (n < 16) bk = n; else { const float nf = (float)n; int lg = 16 + (int)(logf(nf / 16.f) / 2.0794415416798357f * 16.f); bk = lg < 31 ? lg : 31; }
            sm[16 + idx] = a->in[2][bk * 4 + h] * LOG2E; }
    }
    { LAS float* scr = (LAS float*)(lds + wave * 16384);
      const int gw = bid * 8 + wave, NGW = G * 8;
      for (int it = gw; it < DEPTH * 12288; it += NGW) {
          const int l = it / 12288; int r = it % 12288; unsigned char* wl = ws + WS_W + l * W_LAYER;
          const GainSpec none{nullptr, nullptr, 0.f};
          if (r < 1408) { transpose_item(a->in[4] + (size_t)l * D * FF, D, FF, (bf16_t*)(wl + W_GU1), true, FF, 0, GainSpec{a->in[3] + l * D, nullptr, 0.f}, scr, r, lane); continue; } r -= 1408;
          if (r < 1408) { transpose_item(a->in[5] + (size_t)l * D * FF, D, FF, (bf16_t*)(wl + W_GU1), true, FF, 1, GainSpec{a->in[3] + l * D, nullptr, 0.f}, scr, r, lane); continue; } r -= 1408;
          if (r < 1408) { transpose_item(a->in[6] + (size_t)l * FF * D, FF, D, (bf16_t*)(wl + W_D1), false, 1, 0, none, scr, r, lane); continue; } r -= 1408;
          if (r < 1408) { transpose_item(a->in[32] + (size_t)l * D * FF, D, FF, (bf16_t*)(wl + W_GU2), true, FF, 0, GainSpec{a->in[31] + l * D, nullptr, 0.f}, scr, r, lane); continue; } r -= 1408;
          if (r < 1408) { transpose_item(a->in[33] + (size_t)l * D * FF, D, FF, (bf16_t*)(wl + W_GU2), true, FF, 1, GainSpec{a->in[31] + l * D, nullptr, 0.f}, scr, r, lane); continue; } r -= 1408;
          if (r < 1408) { transpose_item(a->in[34] + (size_t)l * FF * D, FF, D, (bf16_t*)(wl + W_D2), false, 1, 0, none, scr, r, lane); continue; } r -= 1408;
          if (r < 1024) { transpose_item(a->in[8] + (size_t)l * D * 2048, D, 2048, (bf16_t*)(wl + W_IN), false, 1, 0, GainSpec{a->in[7] + l * D, nullptr, 0.f}, scr, r, lane); continue; } r -= 1024;
          if (r < 256) { transpose_item(a->in[17] + (size_t)l * 512 * 1024, 512, 1024, (bf16_t*)(wl + W_GLU), true, 512, 0, none, scr, r, lane); continue; } r -= 256;
          if (r < 512) { transpose_item(a->in[25] + (size_t)l * D * D, D, D, (bf16_t*)(wl + W_OUT), false, 1, 0, GainSpec{a->in[19] + l * 512, a->in[24] + l * 128, 1.f - (0.8f - 0.6f * expf(-0.3f * (float)l))}, scr, r, lane); continue; } r -= 512;
          if (r < 512) { transpose_item(a->in[28] + (size_t)l * D * D, D, D, (bf16_t*)(wl + W_Q), false, 1, 0, GainSpec{a->in[26] + l * D, nullptr, 0.f}, scr, r, lane); continue; } r -= 512;
          if (r < 1024) { transpose_item(a->in[29] + (size_t)l * D * 2048, D, 2048, (bf16_t*)(wl + W_KV), false, 1, 0, none, scr, r, lane); continue; } r -= 1024;
          transpose_item(a->in[30] + (size_t)l * D * D, D, D, (bf16_t*)(wl + W_O), false, 1, 0, none, scr, r, lane);
      }
      for (int row = gw; row < T + DEPTH * BATCH * MEM; row += NGW) {
          const bool ismem = row >= T; const int mr = row - T, l = mr >> 10, mrow = mr & 1023;
          const float* src = ismem ? a->in[1] + (size_t)mrow * D : a->in[0] + (size_t)row * D;
          f32x4 v[4]; float s = 0.f;
#pragma unroll
          for (int j = 0; j < 4; ++j) { v[j] = *((const f32x4*)src + lane + 64 * j); s += (v[j][0] * v[j][0] + v[j][1] * v[j][1]) + (v[j][2] * v[j][2] + v[j][3] * v[j][3]); }
          s = wave_sum(s);
          if (!ismem) { if (lane < 16) ((float*)(ws + WS_SS))[(size_t)row * 16 + lane] = lane == 0 ? s : 0.f;
#pragma unroll
              for (int j = 0; j < 4; ++j) *((u32x2*)(ws + WS_HB + (size_t)row * D * 2) + lane + 64 * j) = (u32x2){cvtpk(v[j][0], v[j][1]), cvtpk(v[j][2], v[j][3])};
          } else { const float rs = rsqrtf(s * (1.f / D) + EPS); const float* gn = a->in[27] + l * D;
#pragma unroll
              for (int j = 0; j < 4; ++j) { const f32x4 gg = *((const f32x4*)gn + lane + 64 * j);
                  *((u32x2*)(ws + WS_MEMN + ((size_t)l * 1024 + mrow) * D * 2) + lane + 64 * j) = (u32x2){cvtpk(v[j][0] * rs * gg[0], v[j][1] * rs * gg[1]), cvtpk(v[j][2] * rs * gg[2], v[j][3] * rs * gg[3])}; }
          }
      }
    }
}

constexpr int AT_KROW = 256, AT_VROW = 128, AT_KBUF = 64 * AT_KROW, AT_VBUF = 128 * AT_VROW;
constexpr int AT_K0 = 0, AT_V0 = 2 * AT_KBUF, AT_BIAS = AT_V0 + 2 * AT_VBUF;

__device__ __forceinline__ void attn_qblock(int b, int h, int q0, float lam, LAS unsigned char* lds, const bf16_t* qbuf, const bf16_t* kbuf, const bf16_t* vT, bf16_t* mix, const float* bias_g) {
    int tid = threadIdx.x; asm volatile("" : "+v"(tid));
    const int lane = tid & 63, w = __builtin_amdgcn_readfirstlane(tid >> 6), r = lane & 15, g = lane >> 4;
    const int qw0 = q0 + w * 16, qrow = qw0 + r;
    LAS float* biasl = (LAS float*)(lds + AT_BIAS);
    if (tid < 129) biasl[tid] = bias_g[h * 132 + tid];
    bf16x8 qf[2][2];
    { const bf16_t* qp = qbuf + ((size_t)(b * SEQ + qrow)) * 512 + h * 128 + g * 8;
#pragma unroll
      for (int m = 0; m < 2; ++m)
#pragma unroll
          for (int ks = 0; ks < 2; ++ks) qf[m][ks] = *(const bf16x8*)(qp + m * 64 + ks * 32); }
    f32x4 o[2][8];
#pragma unroll
    for (int m = 0; m < 2; ++m)
#pragma unroll
        for (int db = 0; db < 8; ++db) o[m][db] = (f32x4){0.f, 0.f, 0.f, 0.f};
    float mrow[2] = {-INFINITY, -INFINITY}, lrow[2] = {0.f, 0.f};
    const int ntiles = (q0 + 128) >> 6;
    unsigned gk[2], lk[2], gv[2], lv[2];
#pragma unroll
    for (int i = 0; i < 2; ++i) { const int c = tid + i * 512;
        { const int key = c >> 4, ch = c & 15, rho = ((key >> 5) * 2 + ((key >> 2) & 1)) * 16 + ((key >> 3) & 3) * 4 + (key & 3); gk[i] = key * 512 + ch * 8; lk[i] = rho * AT_KROW + ((ch ^ (rho & 15)) * 16); }
        { const int dv = c >> 3, ch = c & 7; gv[i] = dv * SEQ + ch * 8; lv[i] = dv * AT_VROW + ((ch ^ ((dv >> 1) & 7)) * 16); } }
    const bf16_t* kbase = kbuf + ((size_t)b * SEQ) * 512 + h * 128;
    const bf16_t* vbase = vT + ((size_t)(b * 4 + h) * 128) * SEQ;
    u32x4 kreg[2], vreg[2];
#pragma unroll
    for (int i = 0; i < 2; ++i) { kreg[i] = *(const u32x4*)(kbase + gk[i]); vreg[i] = *(const u32x4*)(vbase + gv[i]); }
#pragma unroll
    for (int i = 0; i < 2; ++i) { *(LAS u32x4*)(lds + AT_K0 + lk[i]) = kreg[i]; *(LAS u32x4*)(lds + AT_V0 + lv[i]) = vreg[i]; }
    __syncthreads();
    const float cfar = biasl[128];
    for (int kt = 0; kt < ntiles; ++kt) {
        const int cur = kt & 1, k0 = kt * 64;
        const bool pf = (kt + 1 < ntiles);
        if (pf) {
#pragma unroll
            for (int i = 0; i < 2; ++i) { kreg[i] = *(const u32x4*)(kbase + (size_t)(k0 + 64) * 512 + gk[i]); vreg[i] = *(const u32x4*)(vbase + (k0 + 64) + gv[i]); } }
        if (k0 <= qw0 + 15) {
            LAS unsigned char* Kb = lds + AT_K0 + cur * AT_KBUF; LAS unsigned char* Vb = lds + AT_V0 + cur * AT_VBUF;
            f32x4 s[2][4];
            bf16x8 kfa[8], kfb[8];
#pragma unroll
            for (int kb = 0; kb < 4; ++kb)
#pragma unroll
                for (int ks = 0; ks < 2; ++ks) kfa[kb * 2 + ks] = *(const LAS bf16x8*)(Kb + (kb * 16 + r) * AT_KROW + (((ks * 4 + g) ^ r) * 16));
            __builtin_amdgcn_sched_barrier(0);
#pragma unroll
            for (int kb = 0; kb < 4; ++kb)
#pragma unroll
                for (int ks = 0; ks < 2; ++ks) kfb[kb * 2 + ks] = *(const LAS bf16x8*)(Kb + (kb * 16 + r) * AT_KROW + (((8 + ks * 4 + g) ^ r) * 16));
            __builtin_amdgcn_sched_barrier(0);
            __builtin_amdgcn_s_setprio(1);
#pragma unroll
            for (int kb = 0; kb < 4; ++kb) { s[0][kb] = __builtin_amdgcn_mfma_f32_16x16x32_bf16(kfa[kb * 2], qf[0][0], (f32x4){0.f, 0.f, 0.f, 0.f}, 0, 0, 0);
                s[0][kb] = __builtin_amdgcn_mfma_f32_16x16x32_bf16(kfa[kb * 2 + 1], qf[0][1], s[0][kb], 0, 0, 0); }
            __builtin_amdgcn_sched_barrier(0);
            bf16x8 vfa[8];
#pragma unroll
            for (int db = 0; db < 4; ++db)
#pragma unroll
                for (int kk = 0; kk < 2; ++kk) vfa[db * 2 + kk] = *(const LAS bf16x8*)(Vb + (db * 16 + r) * AT_VROW + (((kk * 4 + g) ^ (r >> 1)) * 16));
            __builtin_amdgcn_sched_barrier(0);
#pragma unroll
            for (int kb = 0; kb < 4; ++kb) { s[1][kb] = __builtin_amdgcn_mfma_f32_16x16x32_bf16(kfb[kb * 2], qf[1][0], (f32x4){0.f, 0.f, 0.f, 0.f}, 0, 0, 0);
                s[1][kb] = __builtin_amdgcn_mfma_f32_16x16x32_bf16(kfb[kb * 2 + 1], qf[1][1], s[1][kb], 0, 0, 0); }
            __builtin_amdgcn_s_setprio(0);
            __builtin_amdgcn_sched_barrier(0);
            const bool far = (qw0 - (k0 + 63)) >= 128;
            float cf = cfar;
            if (!far) { cf = 0.f;
                float badd[4][4];
#pragma unroll
                for (int kb = 0; kb < 4; ++kb)
#pragma unroll
                    for (int j = 0; j < 4; ++j) { const int key = k0 + (kb >> 1) * 32 + g * 8 + (kb & 1) * 4 + j, dist = qrow - key;
                        const int idx = dist < 0 ? 0 : (dist > 128 ? 128 : dist);
                        badd[kb][j] = biasl[idx]; }
#pragma unroll
                for (int kb = 0; kb < 4; ++kb)
#pragma unroll
                    for (int j = 0; j < 4; ++j) { const int key = k0 + (kb >> 1) * 32 + g * 8 + (kb & 1) * 4 + j;
                        const float ad = (qrow >= key) ? badd[kb][j] : -INFINITY;
                        s[0][kb][j] += ad; s[1][kb][j] += ad; }
            }
            bf16x8 pfr[2][2];
#pragma unroll
            for (int m = 0; m < 2; ++m) {
                float mx = max3f(s[m][0][0], s[m][0][1], s[m][0][2]);
                mx = max3f(mx, s[m][0][3], s[m][1][0]); mx = max3f(mx, s[m][1][1], s[m][1][2]); mx = max3f(mx, s[m][1][3], s[m][2][0]);
                mx = max3f(mx, s[m][2][1], s[m][2][2]); mx = max3f(mx, s[m][2][3], s[m][3][0]); mx = max3f(mx, s[m][3][1], s[m][3][2]); mx = fmaxf(mx, s[m][3][3]);
                mx = xl_max(mx) + cf;
                if (__any((mx - mrow[m]) > 6.0f)) {
                    const float mnew = fmaxf(mrow[m], mx), alpha = fast_exp2(mrow[m] - mnew);
                    mrow[m] = mnew; lrow[m] *= alpha;
#pragma unroll
                    for (int db = 0; db < 8; ++db) o[m][db] = o[m][db] * alpha;
                }
                const float mc = mrow[m] - cf;
                f32x2 ps2 = {0.f, 0.f};
#pragma unroll
                for (int kb = 0; kb < 4; ++kb) {
                    f32x2 a = {s[m][kb][0], s[m][kb][1]}, c = {s[m][kb][2], s[m][kb][3]};
                    a = a - mc; c = c - mc;
                    a[0] = fast_exp2(a[0]); a[1] = fast_exp2(a[1]); c[0] = fast_exp2(c[0]); c[1] = fast_exp2(c[1]);
                    ps2 = ps2 + a; ps2 = ps2 + c;
                    s[m][kb][0] = a[0]; s[m][kb][1] = a[1]; s[m][kb][2] = c[0]; s[m][kb][3] = c[1];
                }
                lrow[m] += ps2[0] + ps2[1];
#pragma unroll
                for (int kk = 0; kk < 2; ++kk) { const u32x4 pw = pack8(s[m][2 * kk], s[m][2 * kk + 1]); pfr[m][kk] = __builtin_bit_cast(bf16x8, pw); }
            }
            __builtin_amdgcn_sched_barrier(0);
            bf16x8 vfb[8];
#pragma unroll
            for (int db = 0; db < 4; ++db)
#pragma unroll
                for (int kk = 0; kk < 2; ++kk) vfb[db * 2 + kk] = *(const LAS bf16x8*)(Vb + ((db + 4) * 16 + r) * AT_VROW + (((kk * 4 + g) ^ (r >> 1)) * 16));
            __builtin_amdgcn_sched_barrier(0);
            __builtin_amdgcn_s_setprio(1);
#pragma unroll
            for (int db = 0; db < 4; ++db)
#pragma unroll
                for (int kk = 0; kk < 2; ++kk) {
                    o[0][db] = __builtin_amdgcn_mfma_f32_16x16x32_bf16(vfa[db * 2 + kk], pfr[0][kk], o[0][db], 0, 0, 0);
                    o[1][db] = __builtin_amdgcn_mfma_f32_16x16x32_bf16(vfa[db * 2 + kk], pfr[1][kk], o[1][db], 0, 0, 0); }
            __builtin_amdgcn_sched_barrier(0);
#pragma unroll
            for (int db = 0; db < 4; ++db)
#pragma unroll
                for (int kk = 0; kk < 2; ++kk) {
                    o[0][db + 4] = __builtin_amdgcn_mfma_f32_16x16x32_bf16(vfb[db * 2 + kk], pfr[0][kk], o[0][db + 4], 0, 0, 0);
                    o[1][db + 4] = __builtin_amdgcn_mfma_f32_16x16x32_bf16(vfb[db * 2 + kk], pfr[1][kk], o[1][db + 4], 0, 0, 0); }
            __builtin_amdgcn_s_setprio(0);
        }
        if (pf) {
#pragma unroll
            for (int i = 0; i < 2; ++i) { *(LAS u32x4*)(lds + AT_K0 + (cur ^ 1) * AT_KBUF + lk[i]) = kreg[i]; *(LAS u32x4*)(lds + AT_V0 + (cur ^ 1) * AT_VBUF + lv[i]) = vreg[i]; } }
        __syncthreads();
    }
    const float inv0 = 1.f / fq_sum(lrow[0]), inv1 = lam / fq_sum(lrow[1]);
    float ssq = 0.f;
#pragma unroll
    for (int db = 0; db < 8; ++db)
#pragma unroll
        for (int j = 0; j < 4; ++j) { const float v = o[0][db][j] * inv0 - o[1][db][j] * inv1; o[0][db][j] = v; ssq += v * v; }
    ssq = fq_sum(ssq);
    const float rn = rsqrtf(ssq * (1.f / 128.f) + EPS);
    bf16_t* op = mix + ((size_t)(b * SEQ + qrow)) * D + 512 + h * 128 + g * 4;
#pragma unroll
    for (int db = 0; db < 8; ++db) *(u32x2*)(op + db * 16) = (u32x2){cvtpk(o[0][db][0] * rn, o[0][db][1] * rn), cvtpk(o[0][db][2] * rn, o[0][db][3] * rn)};
}

#if DEBUG_CHECK
__device__ __forceinline__ unsigned hash_u(unsigned x) { x ^= x >> 16; x *= 0x7feb352dU; x ^= x >> 15; x *= 0x846ca68bU; x ^= x >> 16; return x; }
__device__ __forceinline__ void dbg_flag(unsigned* ctl, int id, float got, float ref, float rtol, float atol) {
    const float d = fabsf(got - ref);
    if (!(d <= atol + rtol * fabsf(ref))) atomicAdd(ctl + 64 + id, 1u);
}
#endif

__global__ void __launch_bounds__(512, 2) fwd_kernel(Args a) {
    extern __shared__ __attribute__((aligned(16))) unsigned char lds_raw[];
    LAS unsigned char* lds = (LAS unsigned char*)lds_raw;
    cg::grid_group grid = cg::this_grid();
    const int G = gridDim.x;
#define PH KArgsP ka = KARGS(); int bid = blockIdx.x, G = gridDim.x, tidl = threadIdx.x; asm volatile("" : "+s"(bid), "+s"(G), "+v"(tidl)); const int lane = tidl & 63, wave = tidl >> 6; (void)lane; (void)wave; unsigned char* ws = ka->ws; float* ssb = (float*)(ws + WS_SS); float* ssm_ss = (float*)(ws + WS_SSM_SS); const float* smalls = (const float*)(ws + WS_SMALL); \
    bf16_t* hb = (bf16_t*)(ws + WS_HB); unsigned char* ar = ws + WS_AR; unsigned char* wl = ws + WS_W + l * W_LAYER; float* hbuf = ka->out; \
    (void)ssb; (void)ssm_ss; (void)smalls; (void)hb; (void)ar; (void)wl; (void)hbuf;
    if (threadIdx.x < 2) ((LAS unsigned*)(lds + LDS_XB))[threadIdx.x] = 0u;
    __syncthreads();
    XcdBarrier xbar = xcd_barrier_post((unsigned*)(KARGS()->ws + WS_CTL) + 1024, (volatile LAS unsigned*)(lds + LDS_XB));
    for (int rep = 0; rep < (PROBE == 5 ? 2 : 1); ++rep) prologue(KARGS(), lds, G);
    grid.sync();
#define GSYNC() xcd_barrier(xbar)

    for (int l = 0; l < DEPTH; ++l) {
        if (PROBE == 4) { for (int rep = 0; rep < 10; ++rep) GSYNC(); }
        for (int rep = 0; rep < (PROBE == 2 ? 2 : 1); ++rep)
        { PH StdSched S; S.init(T, 2 * FF, G, bid, D, D); EpiFfnUp E{(bf16_t*)(ar + AR_HID), ssb + (size_t)(4 * l + 0) * T * 16};
          gemm_phase<EpiFfnUp, StdSched, true>(lds, hb, (const bf16_t*)(wl + W_GU1), D, D, D, S, E); }
        GSYNC();
        if (PROBE == 6) { PH StdSched S; S.init(T, D, G, bid, FF, FF); EpiNull E{(float*)(ws + WS_CTL + 20000)};
          gemm_phase<EpiNull, StdSched, false>(lds, (const bf16_t*)(ar + AR_HID), (const bf16_t*)(wl + W_D1), FF, FF, FF, S, E); }
        for (int rep = (PROBE == 7 ? 0 : 1); rep < 2; ++rep)
        { PH StdSched S; S.init(T, D, G, bid, FF, FF); EpiResid E{hb, ssb + (size_t)(4 * l + 1) * T * 16, (PROBE == 7 && rep == 0) ? 0.f : 0.5f};
          gemm_phase<EpiResid, StdSched, true>(lds, (const bf16_t*)(ar + AR_HID), (const bf16_t*)(wl + W_D1), FF, FF, FF, S, E); }
        GSYNC();
        for (int rep = 0; rep < (PROBE == 3 ? 2 : 1); ++rep)
        { PH StdSched S; S.init(T, 2048, G, bid, D, D); EpiWin E{ar, ssb + (size_t)(4 * l + 1) * T * 16};
          gemm_phase<EpiWin, StdSched, true>(lds, hb, (const bf16_t*)(wl + W_IN), D, D, D, S, E); }
        GSYNC();
        for (int rep = 0; rep < (PROBE == 3 ? 2 : 1); ++rep)
        if ((int)blockIdx.x < 128) { PH Ssm1Sched S{bid}; EpiSsm1 E{(bf16_t*)(ar + AR_UP), ka->in[9] + (size_t)l * NG * NP, ka->in[10] + (size_t)l * NG * NP, ka->in[16] + (size_t)l * NG};
          gemm_phase<EpiSsm1, Ssm1Sched, false>(lds, (const bf16_t*)(ar + AR_UP), (const bf16_t*)(wl + W_BM), UPW, 512, 512, S, E); }
        else if (l == 0) { PH WkvSched S{G, bid}; EpiWkv E{(bf16_t*)(ws + WS_KX), (bf16_t*)(ws + WS_VXT)};
          gemm_phase<EpiWkv, WkvSched, false>(lds, (const bf16_t*)(ws + WS_MEMN), (const bf16_t*)(ws + WS_W + W_KV), D, D, D, S, E); }
        GSYNC();
        for (int rep = 0; rep < (PROBE == 3 ? 2 : 1); ++rep)
        { PH Ssm2Sched S{G, bid}; EpiSsm2 E{(bf16_t*)(ar + AR_Y)};
          gemm_phase<EpiSsm2, Ssm2Sched, false>(lds, (const bf16_t*)(ar + AR_UP), (const bf16_t*)(wl + W_MT), UPW, UPW, UPW, S, E); }
        GSYNC();
        for (int rep = 0; rep < (PROBE == 8 ? 2 : 1); ++rep)
        { PH StdSched S; S.init(T, 1024, G, bid, 512, 512); EpiGlu E{(bf16_t*)(ar + AR_MIX), ka->in[18] + (size_t)l * 1024, ssm_ss + (size_t)l * T * 16};
          gemm_phase<EpiGlu, StdSched, true>(lds, (const bf16_t*)(ar + AR_Y), (const bf16_t*)(wl + W_GLU), 512, 512, 512, S, E); }
        GSYNC();
        { PH const float lam = smalls[l];
          for (int rep = 0; rep < (PROBE == 1 ? 2 : 1); ++rep)
          for (int uidx = bid; uidx < 512; uidx += G) { const int bh = uidx >> 5, j = uidx & 31, b = bh >> 2, h = bh & 3;
              attn_qblock(b, h, j * 128, lam, lds, (const bf16_t*)(ar + AR_Q), (const bf16_t*)(ar + AR_K), (const bf16_t*)(ar + AR_VT), (bf16_t*)(ar + AR_MIX), smalls + 16);
              attn_qblock(b, h, (63 - j) * 128, lam, lds, (const bf16_t*)(ar + AR_Q), (const bf16_t*)(ar + AR_K), (const bf16_t*)(ar + AR_VT), (bf16_t*)(ar + AR_MIX), smalls + 16); }
          bf16_t* mix = (bf16_t*)(ar + AR_MIX); const float* sq = ssm_ss + (size_t)l * T * 16;
          for (int row = bid * 8 + wave; row < T; row += G * 8) { const float rs = rsqrtf(ss_sum16(sq, row) * (1.f / 512.f) + EPS);
              u32x4* p = (u32x4*)(mix + (size_t)row * D) + lane; u32x4 v = *p;
              v.x = cvtpk(__uint_as_float(v.x << 16) * rs, __uint_as_float(v.x & 0xffff0000u) * rs); v.y = cvtpk(__uint_as_float(v.y << 16) * rs, __uint_as_float(v.y & 0xffff0000u) * rs);
              v.z = cvtpk(__uint_as_float(v.z << 16) * rs, __uint_as_float(v.z & 0xffff0000u) * rs); v.w = cvtpk(__uint_as_float(v.w << 16) * rs, __uint_as_float(v.w & 0xffff0000u) * rs);
              *p = v; } }
        GSYNC();
        for (int rep = (PROBE == 7 ? 0 : 1); rep < 2; ++rep)
        { PH StdSched S; S.init(T, D, G, bid, D, D); EpiResid E{hb, ssb + (size_t)(4 * l + 2) * T * 16, (PROBE == 7 && rep == 0) ? 0.f : 1.f};
          gemm_phase<EpiResid, StdSched, true>(lds, (const bf16_t*)(ar + AR_MIX), (const bf16_t*)(wl + W_OUT), D, D, D, S, E); }
        GSYNC();
        for (int rep = 0; rep < (PROBE == 3 ? 2 : 1); ++rep)
        { PH StdSched S; S.init(T, D, G, bid, D, D); EpiWq E{(bf16_t*)(ar + AR_QX), ssb + (size_t)(4 * l + 2) * T * 16, 0.0625f * LOG2E};
          gemm_phase<EpiWq, StdSched, true>(lds, hb, (const bf16_t*)(wl + W_Q), D, D, D, S, E); }
        GSYNC();
        for (int rep = 0; rep < (PROBE == 3 ? 2 : 1); ++rep)
        { PH XaSched S{G, bid, (unsigned)MEM * 1024, 256u}; EpiSoftmax E{(bf16_t*)(ar + AR_P), (LAS float*)(lds + LDS_RED)};
          gemm_phase<EpiSoftmax, XaSched, true>(lds, (const bf16_t*)(ar + AR_QX), (const bf16_t*)(ws + WS_KX) + (size_t)l * 1024 * 1024, D, D, 256, S, E); }
        GSYNC();
        for (int rep = 0; rep < (PROBE == 3 ? 2 : 1); ++rep)
        { PH XaSched S{G, bid, 4u * 65536u, 65536u}; EpiPV E{(bf16_t*)(ar + AR_OX)};
          gemm_phase<EpiPV, XaSched, false>(lds, (const bf16_t*)(ar + AR_P), (const bf16_t*)(ws + WS_VXT) + (size_t)l * 1024 * 1024, D, 256, 256, S, E); }
        GSYNC();
        for (int rep = (PROBE == 7 ? 0 : 1); rep < 2; ++rep)
        { PH StdSched S; S.init(T, D, G, bid, D, D); EpiResid E{hb, ssb + (size_t)(4 * l + 3) * T * 16, (PROBE == 7 && rep == 0) ? 0.f : 1.f};
          gemm_phase<EpiResid, StdSched, true>(lds, (const bf16_t*)(ar + AR_OX), (const bf16_t*)(wl + W_O), D, D, D, S, E); }
        GSYNC();
        for (int rep = 0; rep < (PROBE == 2 ? 2 : 1); ++rep)
        { PH StdSched S; S.init(T, 2 * FF, G, bid, D, D); EpiFfnUp E{(bf16_t*)(ar + AR_HID), ssb + (size_t)(4 * l + 3) * T * 16};
          gemm_phase<EpiFfnUp, StdSched, true>(lds, hb, (const bf16_t*)(wl + W_GU2), D, D, D, S, E); }
        GSYNC();
        if (PROBE == 6) { PH StdSched S; S.init(T, D, G, bid, FF, FF); EpiNull E{(float*)(ws + WS_CTL + 20000)};
          gemm_phase<EpiNull, StdSched, false>(lds, (const bf16_t*)(ar + AR_HID), (const bf16_t*)(wl + W_D2), FF, FF, FF, S, E); }
        for (int rep = (PROBE == 7 ? 0 : 1); rep < 2; ++rep)
        { PH StdSched S; S.init(T, D, G, bid, FF, FF); EpiResid E{hb, ssb + (size_t)(4 * l + 4) * T * 16, (PROBE == 7 && rep == 0) ? 0.f : 0.5f};
          gemm_phase<EpiResid, StdSched, true>(lds, (const bf16_t*)(ar + AR_HID), (const bf16_t*)(wl + W_D2), FF, FF, FF, S, E); }
        GSYNC();
    }
    { const int l = 0; PH const float* sq = ssb + (size_t)8 * T * 16; const float* gn = ka->in[35];
      for (int row = bid * 8 + wave; row < T; row += G * 8) { const float rs = rsqrtf(ss_sum16(sq, row) * (1.f / D) + EPS);
#pragma unroll
          for (int j = 0; j < 2; ++j) { const u32x4 w = *((const u32x4*)(hb + (size_t)row * D) + lane + 64 * j);
              const f32x4 g0 = *((const f32x4*)gn + 2 * (lane + 64 * j)), g1 = *((const f32x4*)gn + 2 * (lane + 64 * j) + 1);
              f32x4 v0, v1;
              v0[0] = __uint_as_float(w.x << 16) * rs * g0[0]; v0[1] = __uint_as_float(w.x & 0xffff0000u) * rs * g0[1]; v0[2] = __uint_as_float(w.y << 16) * rs * g0[2]; v0[3] = __uint_as_float(w.y & 0xffff0000u) * rs * g0[3];
              v1[0] = __uint_as_float(w.z << 16) * rs * g1[0]; v1[1] = __uint_as_float(w.z & 0xffff0000u) * rs * g1[1]; v1[2] = __uint_as_float(w.w << 16) * rs * g1[2]; v1[3] = __uint_as_float(w.w & 0xffff0000u) * rs * g1[3];
              f32x4* op = (f32x4*)(hbuf + (size_t)row * D) + 2 * (lane + 64 * j); op[0] = v0; op[1] = v1; } } }
}

extern "C" void kernel_launch(void* const* d_in, const int* in_sizes, int n_in, void* d_out, int out_size, void* d_ws, size_t ws_size, hipStream_t stream) {
    static int grid = 0;
    if (grid == 0) {
        if (n_in != 36 || out_size != T * D || ws_size < WS_END) { fprintf(stderr, "kernel_launch: unexpected problem (n_in %d out %d ws %zu)\n", n_in, out_size, ws_size); grid = -1; return; }
        int dev = 0, cus = 0, per_cu = 0;
        if (hipGetDevice(&dev) != hipSuccess || hipDeviceGetAttribute(&cus, hipDeviceAttributeMultiprocessorCount, dev) != hipSuccess) { grid = -1; return; }
        if (hipFuncSetAttribute((const void*)fwd_kernel, hipFuncAttributeMaxDynamicSharedMemorySize, LDS_BYTES) != hipSuccess) { fprintf(stderr, "hipFuncSetAttribute failed\n"); grid = -1; return; }
        if (hipOccupancyMaxActiveBlocksPerMultiprocessor(&per_cu, (const void*)fwd_kernel, 512, LDS_BYTES) != hipSuccess || per_cu < 1) { fprintf(stderr, "occupancy query: %d\n", per_cu); }
        (void)hipGetLastError();
        grid = cus;
        if (grid != 256) fprintf(stderr, "kernel_launch: %d CUs (expected 256)\n", grid);
    }
    if (grid < 0) return;
    (void)hipMemsetAsync((char*)d_ws + WS_CTL, 0, 32768, stream);
    Args a{};
    for (int i = 0; i < 36; ++i) a.in[i] = (const float*)d_in[i];
    a.out = (float*)d_out; a.ws = (unsigned char*)d_ws;
    void* args[] = {&a};
    hipError_t e = hipLaunchCooperativeKernel((const void*)fwd_kernel, dim3(grid), dim3(512), args, LDS_BYTES, stream);
    if (e != hipSuccess) fprintf(stderr, "cooperative launch failed: %s (grid %d)\n", hipGetErrorString(e), grid);
}
```

```cpp
#include <hip/hip_runtime.h>
#include <hip/hip_cooperative_groups.h>
#include <cstdio>
#include <cstdint>
namespace cg = cooperative_groups;

#define LAS __attribute__((address_space(3)))
typedef unsigned short bf16_t;
typedef short bf16x8 __attribute__((ext_vector_type(8)));
typedef float f32x4 __attribute__((ext_vector_type(4)));
typedef float f32x2 __attribute__((ext_vector_type(2)));
typedef unsigned u32x4 __attribute__((ext_vector_type(4)));
typedef unsigned u32x2 __attribute__((ext_vector_type(2)));
typedef __bf16 bf16x2_t __attribute__((ext_vector_type(2)));

#ifndef PROBE
#define PROBE 0
#endif
#ifndef DEBUG_CHECK
#define DEBUG_CHECK 0
#endif

constexpr int D = 1024, BATCH = 4, SEQ = 8192, T = BATCH * SEQ, DEPTH = 2, MEM = 256, FF = 2816;
constexpr int SSMW = 512, NG = 32, NP = 64, CH = 32  , NCH = SEQ / CH  , UPW = 640  ;
constexpr float EPS = 1e-6f, LOG2E = 1.4426950408889634f;

constexpr size_t MiB = 1u << 20;
constexpr size_t WS_CTL = 0;
constexpr size_t WS_SS = 466 * MiB;
constexpr size_t WS_SSM_SS = WS_SS + 9 * (size_t)T * 64;
constexpr size_t WS_SMALL = 3 * MiB;
constexpr size_t WS_MEMN = 4 * MiB;
constexpr size_t WS_KX = 8 * MiB;
constexpr size_t WS_VXT = 12 * MiB;
constexpr size_t WS_W = 16 * MiB, W_LAYER = 76 * MiB;
constexpr size_t W_GU1 = 0, W_D1 = 11 * MiB, W_GU2 = 16 * MiB + MiB / 2, W_D2 = 27 * MiB + MiB / 2, W_IN = 33 * MiB, W_GLU = 37 * MiB, W_OUT = 38 * MiB,
                 W_Q = 40 * MiB, W_KV = 42 * MiB, W_O = 46 * MiB, W_BM = 48 * MiB, W_MT = 56 * MiB;
constexpr size_t WS_HB = WS_W + 2 * W_LAYER;
constexpr size_t WS_AR = WS_HB + 64 * MiB;
constexpr size_t AR_UP = 0, AR_Q = 40 * MiB, AR_K = 72 * MiB, AR_VT = 104 * MiB, AR_Y = 136 * MiB, AR_MIX = 168 * MiB;
constexpr size_t AR_QX = 0, AR_P = 64 * MiB, AR_OX = 128 * MiB, AR_HID = 0;
constexpr size_t WS_END = WS_SSM_SS + 2 * (size_t)T * 64;

constexpr int LDS_BYTES = 147456;
constexpr int LDS_RED = 131072; constexpr int LDS_XB = 131072 + 8192;

struct Args { const float* in[36]; float* out; unsigned char* ws; };
typedef const __attribute__((address_space(4))) Args* KArgsP;
#define KARGS() ({ KArgsP _p = (KArgsP)__builtin_amdgcn_kernarg_segment_ptr(); asm volatile("" : "+s"(_p)); _p; })

__device__ __forceinline__ unsigned cvtpk(float lo, float hi) { f32x2 v = {lo, hi}; bf16x2_t b = __builtin_convertvector(v, bf16x2_t); return __builtin_bit_cast(unsigned, b); }
__device__ __forceinline__ float bf2f(bf16_t x) { return __uint_as_float((unsigned)x << 16); }
__device__ __forceinline__ float wave_sum(float v) {
#pragma unroll
    for (int o = 1; o < 64; o <<= 1) v += __shfl_xor(v, o);
    return v;
}
__device__ __forceinline__ float fq_sum(float v) { v += __shfl_xor(v, 16); v += __shfl_xor(v, 32); return v; }
__device__ __forceinline__ float max3f(float a, float b, float c) { float r; asm("v_max3_f32 %0, %1, %2, %3" : "=v"(r) : "v"(a), "v"(b), "v"(c)); return r; }
__device__ __forceinline__ float max2f(float a, float b) { float r; asm("v_max_f32_e32 %0, %1, %2" : "=v"(r) : "v"(a), "v"(b)); return r; }
__device__ __forceinline__ float xl_max(float v) {
    u32x2 r = __builtin_amdgcn_permlane32_swap(__float_as_uint(v), __float_as_uint(v), false, false); v = max2f(__uint_as_float(r[0]), __uint_as_float(r[1]));
    r = __builtin_amdgcn_permlane16_swap(__float_as_uint(v), __float_as_uint(v), false, false); return max2f(__uint_as_float(r[0]), __uint_as_float(r[1]));
}
__device__ __forceinline__ float fq_max(float v) { v = fmaxf(v, __shfl_xor(v, 16)); v = fmaxf(v, __shfl_xor(v, 32)); return v; }
__device__ __forceinline__ u32x4 pack8(f32x4 a, f32x4 b) { u32x4 w; w.x = cvtpk(a[0], a[1]); w.y = cvtpk(a[2], a[3]); w.z = cvtpk(b[0], b[1]); w.w = cvtpk(b[2], b[3]); return w; }
__device__ __forceinline__ float fast_exp2(float x) { return __builtin_amdgcn_exp2f(x); }
__device__ __forceinline__ float fast_rcp(float x) { return __builtin_amdgcn_rcpf(x); }
__device__ __forceinline__ float sigmoidf_(float x) { return fast_rcp(1.f + fast_exp2(-x * LOG2E)); }


__device__ __forceinline__ float ss_sum16(const float* ss16, int row) {
    const f32x4* p = (const f32x4*)(ss16 + (size_t)row * 16); const f32x4 a = p[0], b = p[1], c = p[2], d = p[3];
    return (((a[0] + a[1]) + (a[2] + a[3])) + ((b[0] + b[1]) + (b[2] + b[3]))) + (((c[0] + c[1]) + (c[2] + c[3])) + ((d[0] + d[1]) + (d[2] + d[3])));
}
#define XB_TMO      128
#define XB_XCNT(j)  (256  + 64 * (j))
#define XB_XSUB(j)  (1280 + 64 * (j))
#define XB_XGEN(j)  (2304 + 64 * (j))
#define XB_TOP      3328
#define XB_TOPGEN   3392
#define XCD_BAR_WORDS 3456
#define XB_SPIN_CAP (1u << 22)
__device__ __forceinline__ unsigned xb_ld(unsigned* p)              { return __hip_atomic_load(p, __ATOMIC_RELAXED, __HIP_MEMORY_SCOPE_AGENT); }
__device__ __forceinline__ unsigned xb_add(unsigned* p, unsigned v) { return __hip_atomic_fetch_add(p, v, __ATOMIC_RELAXED, __HIP_MEMORY_SCOPE_AGENT); }
__device__ __forceinline__ unsigned xb_xcc_id() { return (unsigned)__builtin_amdgcn_s_getreg((3 << 11) | 20) & 0xFu; }
#define XB_SPIN(cond, bar) do { unsigned _sp = 0; while (cond) { __builtin_amdgcn_s_sleep(1); \
    if ((++_sp & 255u) == 0u) { if (xb_ld(&(bar)[XB_TMO])) break; if (_sp > XB_SPIN_CAP) { atomicAdd(&(bar)[XB_TMO], 1u); break; } } } } while (0)
struct XcdBarrier { unsigned* bar; unsigned x; volatile LAS unsigned* st; };
__device__ __forceinline__ XcdBarrier xcd_barrier_post(unsigned* bar, volatile LAS unsigned* st) {
    XcdBarrier b; b.bar = bar; b.x = xb_xcc_id(); b.st = st;
    if (threadIdx.x == 0) (void)xb_add(&bar[XB_XCNT(b.x)], 1u);
    return b;
}
__device__ __forceinline__ void xcd_barrier_complete(unsigned* bar, unsigned x, unsigned& nloc, unsigned& nx) {
    const unsigned G = gridDim.x * gridDim.y * gridDim.z;
    unsigned sum, cnt, mine, sp = 0u;
    for (;;) {
        sum = 0u; cnt = 0u; mine = 0u;
#pragma unroll
        for (unsigned j = 0; j < 16; ++j) { const unsigned c = xb_ld(&bar[XB_XCNT(j)]); sum += c; cnt += (c > 0u) ? 1u : 0u; mine = (j == x) ? c : mine; }
        if (sum == G) break;
        __builtin_amdgcn_s_sleep(1);
        if ((++sp & 255u) == 0u) { if (xb_ld(&bar[XB_TMO])) break; if (sp > XB_SPIN_CAP) { atomicAdd(&bar[XB_TMO], 1u); break; } }
    }
    nloc = mine > 0u ? mine : 1u; nx = cnt > 0u ? cnt : 1u;
}
__device__ __forceinline__ void xcd_barrier(const XcdBarrier& b) {
    asm volatile("s_waitcnt vmcnt(0)" ::: "memory");
    __syncthreads();
    if (threadIdx.x == 0) {
        unsigned* bar = b.bar;
        __builtin_amdgcn_s_waitcnt(0);
        unsigned nloc = b.st[0], nx = b.st[1];
        if (nloc == 0u) { xcd_barrier_complete(bar, b.x, nloc, nx); b.st[0] = nloc; b.st[1] = nx; }
        const unsigned old = xb_add(&bar[XB_XSUB(b.x)], 1u);
        const unsigned gen = old / nloc;
        if (old + 1u == (gen + 1u) * nloc) {
            __builtin_amdgcn_fence(__ATOMIC_RELEASE, "agent");
            asm volatile("s_waitcnt vmcnt(0)" ::: "memory");
            const unsigned og = xb_add(&bar[XB_TOP], 1u);
            const unsigned tg = og / nx;
            if (og + 1u == (tg + 1u) * nx) xb_add(&bar[XB_TOPGEN], 1u);
            else XB_SPIN(xb_ld(&bar[XB_TOPGEN]) == tg, bar);
            __builtin_amdgcn_fence(__ATOMIC_ACQUIRE, "agent");
            xb_add(&bar[XB_XGEN(b.x)], 1u);
            asm volatile("s_waitcnt vmcnt(0)" ::: "memory");
        } else {
            XB_SPIN(xb_ld(&bar[XB_XGEN(b.x)]) == gen, bar);
            __builtin_amdgcn_fence(__ATOMIC_ACQUIRE, "agent");
            asm volatile("s_waitcnt vmcnt(0)" ::: "memory");
        }
    }
    __syncthreads();
}

constexpr int BM = 256, BK = 64, HALF = 128, HTB = HALF * BK * 2, NXCD = 8, WGM = 8;
__host__ __device__ __forceinline__ int lds_byte(int r, int c) { const int st = (r >> 4) * 2 + (c >> 5), rr = r & 15, cc = c & 31, ob = rr * 64 + cc * 2; return st * 1024 + (ob ^ (((ob >> 9) & 1) << 5)); }
__host__ __device__ __forceinline__ void stage_rc(int b, int& R, int& C) { const int st = b / 1024, sb = b % 1024, swz = sb ^ (((sb >> 9) & 1) << 5); R = (st >> 1) * 16 + swz / 64; C = (st & 1) * 32 + (swz % 64) / 2; }
__host__ __device__ __forceinline__ int perm32(int rho) { const int n = rho >> 4, i = rho & 15; return 8 * (i >> 2) + 4 * n + (i & 3); }

struct Unit { int pm, pn, bz; unsigned a_off, b_off; };

struct StdSched {
    int nM, nN, nwg, G, c, lda, ldb;
    __device__ void init(int M, int N, int G_, int c_, int lda_, int ldb_) { nM = M / BM; nN = N / BM; nwg = nM * nN; G = G_; c = c_; lda = lda_; ldb = ldb_; }
    __device__ bool next(int i, Unit& u) const {
        const long L = (long)i * G + c; if (L >= nwg) return false;
        int wgid = (int)L; { const int q = nwg / NXCD, r = nwg % NXCD, xcd = wgid % NXCD, off = wgid / NXCD; wgid = (xcd < r ? xcd * (q + 1) : r * (q + 1) + (xcd - r) * q) + off; }
        const int nig = WGM * nN, gid = wgid / nig, fm = gid * WGM, gsz = (nM - fm) < WGM ? (nM - fm) : WGM;
        u.pm = fm + ((wgid % nig) % gsz); u.pn = (wgid % nig) / gsz; u.bz = 0;
        u.a_off = (unsigned)(u.pm * BM) * (unsigned)lda; u.b_off = (unsigned)(u.pn * BM) * (unsigned)ldb; return true;
    }
};
struct Ssm1Sched {
    int c;
    __device__ bool next(int i, Unit& u) const {
        if (i > 0 || c >= BATCH * NG) return false;
        u.pm = 0; u.pn = 0; u.bz = c; u.a_off = (unsigned)c * NCH * UPW; u.b_off = (unsigned)(c & 31) * 256 * 512; return true;
    }
};
struct WkvSched {
    int G, c;
    __device__ bool next(int i, Unit& u) const {
        if (c < 128) return false;
        const int L = (c - 128) + i * (G - 128); if (L >= 64) return false;
        const int layer = L >> 5, rem = L & 31; u.pm = rem >> 3; u.pn = rem & 7; u.bz = layer;
        u.a_off = (unsigned)layer * 1024 * 1024 + (unsigned)u.pm * 256 * 1024; u.b_off = (unsigned)layer * (unsigned)(W_LAYER / 2) + (unsigned)u.pn * 256 * 1024; return true;
    }
};
struct Ssm2Sched {
    int G, c;
    __device__ bool next(int i, Unit& u) const {
        const int L = c + i * G; if (L >= 2 * BATCH * NG) return false;
        u.bz = L >> 1; u.pn = L & 1; u.pm = 0; u.a_off = (unsigned)u.bz * NCH * UPW; u.b_off = ((unsigned)(u.bz & 31) * 512 + (unsigned)u.pn * 256) * UPW; return true;
    }
};
struct XaSched {
    int G, c; unsigned bs_b, bs_h;
    __device__ bool next(int i, Unit& u) const {
        const int L = c + i * G; if (L >= 512) return false;
        const int bh = L >> 5; u.pm = L & 31; u.pn = 0; u.bz = bh; const int b = bh >> 2, h = bh & 3;
        u.a_off = ((unsigned)(b * SEQ + u.pm * 256)) * 1024 + h * 256; u.b_off = (unsigned)b * bs_b + (unsigned)h * bs_h; return true;
    }
};

template <class Epi, class Sched, bool ALIGN_EPI>
__device__ __forceinline__ void gemm_phase(LAS unsigned char* lds, const bf16_t* Ab, const bf16_t* Bb, int lda, int ldb, int K, const Sched& S, Epi& E) {
    int tid = threadIdx.x; asm volatile("" : "+v"(tid));
    const int wid = __builtin_amdgcn_readfirstlane(tid >> 6), lane = tid & 63, wr = wid >> 2, wc = wid & 3, fr = lane & 15, fq = lane >> 4;
    const int nt = K / BK;
    unsigned voffA[2], voffB[2]; int aoff, boff;
#define PG8_LANEOFFS(tt) do { _Pragma("unroll") for (int i = 0; i < 2; ++i) { int R, C; stage_rc((tt) * 16 + i * 8192, R, C); const int Rb = (R & ~31) + perm32(R & 31); \
        voffA[i] = (unsigned)(R * lda + C) * 2u; voffB[i] = (unsigned)(Rb * ldb + C) * 2u; } \
        aoff = lds_byte(wr * 64 + ((tt) & 15), (((tt) >> 4) & 3) * 8); boff = lds_byte(wc * 32 + ((tt) & 15), (((tt) >> 4) & 3) * 8); } while (0)
    PG8_LANEOFFS(tid);
    const unsigned kstep = (unsigned)(BK * 2);
    const unsigned hstepA = (unsigned)HALF * lda * 2, hstepB = (unsigned)HALF * ldb * 2;
    const unsigned ldsw = (unsigned)wid * 1024u;
#define PG8_SA(b, h) (((b) * 2 + (h)) * HTB)
#define PG8_SB(b, h) ((4 + (b) * 2 + (h)) * HTB)
#define PG8_STAGE(bufoff, gbase, voff) do { _Pragma("unroll") for (int _i = 0; _i < 2; ++_i) \
        __builtin_amdgcn_global_load_lds((const unsigned*)((const char*)(gbase) + (voff)[_i]), (LAS unsigned*)(lds + (bufoff) + ldsw + _i * 8192), 16, 0, 0); } while (0)
#define PG8_LDA(dst, b, h) do { _Pragma("unroll") for (int m = 0; m < 4; ++m) _Pragma("unroll") for (int k = 0; k < 2; ++k) dst[m][k] = *(const LAS bf16x8*)(lds + PG8_SA(b, h) + aoff + m * 2048 + k * 1024); } while (0)
#define PG8_LDB(dst, b, h) do { _Pragma("unroll") for (int n = 0; n < 2; ++n) _Pragma("unroll") for (int k = 0; k < 2; ++k) dst[n][k] = *(const LAS bf16x8*)(lds + PG8_SB(b, h) + boff + n * 2048 + k * 1024); } while (0)
#define PG8_MMA(ai, bj, At, Bt) do { __builtin_amdgcn_s_setprio(1); _Pragma("unroll") for (int m = 0; m < 4; ++m) _Pragma("unroll") for (int n = 0; n < 2; ++n) _Pragma("unroll") for (int k = 0; k < 2; ++k) \
        acc[ai][bj][m][n] = __builtin_amdgcn_mfma_f32_16x16x32_bf16(Bt[n][k], At[m][k], acc[ai][bj][m][n], 0, 0, 0); __builtin_amdgcn_s_setprio(0); } while (0)
#define PG8_WAIT_V(n) asm volatile("s_waitcnt vmcnt(" #n ")" ::: "memory")
#define PG8_WAIT_L(n) asm volatile("s_waitcnt lgkmcnt(" #n ")" ::: "memory")
#define PG8_BAR __builtin_amdgcn_s_barrier()
#define PG8_SCHED __builtin_amdgcn_sched_barrier(0)
    Unit cur, nxt; int ui = 0;
    if (!S.next(0, cur)) return;
    f32x4 acc[2][2][4][2];
#pragma unroll
    for (int a = 0; a < 2; ++a)
#pragma unroll
        for (int b = 0; b < 2; ++b)
#pragma unroll
            for (int m = 0; m < 4; ++m)
#pragma unroll
                for (int n = 0; n < 2; ++n) acc[a][b][m][n] = (f32x4){0.f, 0.f, 0.f, 0.f};
    bf16x8 At[4][2], B0[2][2], B1[2][2];
    const char* cA = (const char*)(Ab + cur.a_off); const char* cB = (const char*)(Bb + cur.b_off);
    PG8_STAGE(PG8_SB(0, 0), cB, voffB); PG8_STAGE(PG8_SB(0, 1), cB + hstepB, voffB); PG8_STAGE(PG8_SA(0, 0), cA, voffA); PG8_STAGE(PG8_SA(0, 1), cA + hstepA, voffA);
    if (wr == 1) PG8_BAR;
    PG8_WAIT_V(2); PG8_BAR;
    PG8_STAGE(PG8_SB(1, 0), cB + kstep, voffB); PG8_STAGE(PG8_SA(1, 0), cA + kstep, voffA); PG8_STAGE(PG8_SB(1, 1), cB + hstepB + kstep, voffB);
    PG8_WAIT_V(6); PG8_BAR;
    for (;;) {
        const bool has_next = S.next(ui + 1, nxt);
        const char* nA = has_next ? (const char*)(Ab + nxt.a_off) : cA; const char* nB = has_next ? (const char*)(Bb + nxt.b_off) : cB;
        for (int t = 0; t < nt; t += 2) {
            const bool last = (t == nt - 2);
            const char* a1 = cA + (unsigned)(t + 1) * kstep;
            const char* a2 = last ? nA : cA + (unsigned)(t + 2) * kstep; const char* b2 = last ? nB : cB + (unsigned)(t + 2) * kstep;
            const char* a3 = a2 + kstep; const char* b3 = b2 + kstep;
            PG8_LDB(B0, 0, 0); PG8_LDB(B1, 0, 1); PG8_SCHED; PG8_LDA(At, 0, 0); PG8_STAGE(PG8_SA(1, 1), a1 + hstepA, voffA);
            PG8_WAIT_V(8); PG8_WAIT_L(0); PG8_BAR; PG8_MMA(0, 0, At, B0); PG8_MMA(0, 1, At, B1); PG8_BAR; PG8_SCHED;
            PG8_LDA(At, 0, 1); PG8_STAGE(PG8_SB(0, 0), b2, voffB); PG8_STAGE(PG8_SB(0, 1), b2 + hstepB, voffB); PG8_STAGE(PG8_SA(0, 0), a2, voffA);
            PG8_WAIT_V(8); PG8_WAIT_L(0); PG8_BAR; PG8_MMA(1, 0, At, B0); PG8_MMA(1, 1, At, B1); PG8_BAR; PG8_SCHED;
            PG8_LDB(B0, 1, 0); PG8_LDB(B1, 1, 1); PG8_SCHED; PG8_LDA(At, 1, 0); PG8_STAGE(PG8_SA(0, 1), a2 + hstepA, voffA);
            PG8_WAIT_V(8); PG8_WAIT_L(0); PG8_BAR; PG8_MMA(0, 0, At, B0); PG8_MMA(0, 1, At, B1); PG8_BAR; PG8_SCHED;
            PG8_LDA(At, 1, 1); PG8_STAGE(PG8_SB(1, 0), b3, voffB); PG8_STAGE(PG8_SB(1, 1), b3 + hstepB, voffB); PG8_STAGE(PG8_SA(1, 0), a3, voffA);
            PG8_WAIT_V(8); PG8_WAIT_L(0); PG8_BAR; PG8_MMA(1, 0, At, B0); PG8_MMA(1, 1, At, B1); PG8_BAR; PG8_SCHED;
        }
        if constexpr (ALIGN_EPI) { if (wr == 0) PG8_BAR; }
        if constexpr (!Epi::AFTER_DRAIN) { int t2 = threadIdx.x; asm volatile("" : "+v"(t2)); E(acc, cur, wr, wc, t2 & 15, (t2 >> 4) & 3); }
        if (!has_next) break;
#pragma unroll
        for (int a = 0; a < 2; ++a)
#pragma unroll
            for (int b = 0; b < 2; ++b)
#pragma unroll
                for (int m = 0; m < 4; ++m)
#pragma unroll
                    for (int n = 0; n < 2; ++n) acc[a][b][m][n] = (f32x4){0.f, 0.f, 0.f, 0.f};
        cur = nxt; cA = nA; cB = nB; ++ui;
        { int t3 = threadIdx.x; asm volatile("" : "+v"(t3)); PG8_LANEOFFS(t3); }
        if constexpr (ALIGN_EPI) { if (wr == 1) PG8_BAR; }
    }
    PG8_WAIT_V(0);
    if constexpr (!ALIGN_EPI) { if (wr == 0) PG8_BAR; }
    PG8_BAR;
    if constexpr (Epi::AFTER_DRAIN) { E.fused(acc, cur, wr, wc, fr, fq, lds, wid, lane); }
#undef PG8_LANEOFFS
#undef PG8_SA
#undef PG8_SB
#undef PG8_STAGE
#undef PG8_LDA
#undef PG8_LDB
#undef PG8_MMA
#undef PG8_WAIT_V
#undef PG8_WAIT_L
#undef PG8_BAR
#undef PG8_SCHED
}

typedef f32x4 (&AccRef)[2][2][4][2];

struct EpiFfnUp {
    static constexpr bool AFTER_DRAIN = false;
    bf16_t* H; const float* ss;
    __device__ __forceinline__ void operator()(AccRef acc, const Unit& u, int wr, int wc, int fr, int fq) const {
#pragma unroll
        for (int ai = 0; ai < 2; ++ai)
#pragma unroll
            for (int m = 0; m < 4; ++m) {
                const int row = u.pm * 256 + ai * 128 + wr * 64 + m * 16 + fr;
                const float rs = rsqrtf(ss_sum16(ss, row) * (1.f / D) + EPS);
                f32x4 o[2];
#pragma unroll
                for (int n = 0; n < 2; ++n)
#pragma unroll
                    for (int j = 0; j < 4; ++j) { const float g = acc[ai][0][m][n][j] * rs, up = acc[ai][1][m][n][j] * rs; o[n][j] = g * sigmoidf_(g) * up; }
                *(u32x4*)(H + (size_t)row * FF + u.pn * 128 + wc * 32 + 8 * fq) = pack8(o[0], o[1]);
            }
    }
};
struct EpiResid {
    static constexpr bool AFTER_DRAIN = false;
    bf16_t* hb; float* ssn; float scale;
    __device__ __forceinline__ void operator()(AccRef acc, const Unit& u, int wr, int wc, int fr, int fq) const {
#pragma unroll
        for (int ai = 0; ai < 2; ++ai)
#pragma unroll
            for (int m = 0; m < 4; ++m) {
                const int row = u.pm * 256 + ai * 128 + wr * 64 + m * 16 + fr; float part = 0.f;
#pragma unroll
                for (int bj = 0; bj < 2; ++bj) {
                    const size_t idx = (size_t)row * D + u.pn * 256 + bj * 128 + wc * 32 + 8 * fq;
                    const u32x4 ow = *(const u32x4*)(hb + idx);
                    f32x4 v0, v1;
                    v0[0] = __uint_as_float(ow.x << 16); v0[1] = __uint_as_float(ow.x & 0xffff0000u); v0[2] = __uint_as_float(ow.y << 16); v0[3] = __uint_as_float(ow.y & 0xffff0000u);
                    v1[0] = __uint_as_float(ow.z << 16); v1[1] = __uint_as_float(ow.z & 0xffff0000u); v1[2] = __uint_as_float(ow.w << 16); v1[3] = __uint_as_float(ow.w & 0xffff0000u);
                    v0 = v0 + acc[ai][bj][m][0] * scale; v1 = v1 + acc[ai][bj][m][1] * scale;
                    *(u32x4*)(hb + idx) = pack8(v0, v1);
                    part += (v0[0] * v0[0] + v0[1] * v0[1]) + (v0[2] * v0[2] + v0[3] * v0[3]) + (v1[0] * v1[0] + v1[1] * v1[1]) + (v1[2] * v1[2] + v1[3] * v1[3]);
                }
                part = fq_sum(part);
                if (fq == 0) ssn[(size_t)row * 16 + u.pn * 4 + wc] = part;
            }
    }
};
struct EpiWin {
    static constexpr bool AFTER_DRAIN = false;
    unsigned char* arp; const float* ss;
    __device__ __forceinline__ void operator()(AccRef acc, const Unit& u, int wr, int wc, int fr, int fq) const {
        bf16_t* up = (bf16_t*)(arp + AR_UP); bf16_t* qb = (bf16_t*)(arp + AR_Q); bf16_t* kb = (bf16_t*)(arp + AR_K); bf16_t* vt = (bf16_t*)(arp + AR_VT);
        const int sel = u.pn >> 1;
#pragma unroll
        for (int ai = 0; ai < 2; ++ai)
#pragma unroll
            for (int m = 0; m < 4; ++m) {
                const int row = u.pm * 256 + ai * 128 + wr * 64 + m * 16 + fr;
                float rs = rsqrtf(ss_sum16(ss, row) * (1.f / D) + EPS);
                if (sel == 1) rs *= 0.125f * LOG2E;
                const int b = row >> 13, t = row & (SEQ - 1);
#pragma unroll
                for (int bj = 0; bj < 2; ++bj) {
                    const int c = (u.pn & 1) * 256 + bj * 128 + wc * 32 + 8 * fq;
                    const f32x4 v0 = acc[ai][bj][m][0] * rs, v1 = acc[ai][bj][m][1] * rs;
                    if (sel == 0) { const int g = c >> 4, hi0 = c & 15;
                        *(u32x4*)(up + ((size_t)((b * NG + g) * NCH + (t >> 5))) * UPW + (t & 31) * 16 + hi0) = pack8(v0, v1);
                    } else if (sel == 1) { *(u32x4*)(qb + (size_t)row * 512 + c) = pack8(v0, v1);
                    } else if (sel == 2) { *(u32x4*)(kb + (size_t)row * 512 + c) = pack8(v0, v1);
                    } else { const int h = c >> 7, dv = c & 127; bf16_t* p = vt + ((size_t)((b * 4 + h) * 128 + dv)) * SEQ + t;
                        const u32x4 w = pack8(v0, v1);
                        p[0] = (bf16_t)(w.x & 0xffff); p[SEQ] = (bf16_t)(w.x >> 16); p[2 * SEQ] = (bf16_t)(w.y & 0xffff); p[3 * SEQ] = (bf16_t)(w.y >> 16);
                        p[4 * SEQ] = (bf16_t)(w.z & 0xffff); p[5 * SEQ] = (bf16_t)(w.z >> 16); p[6 * SEQ] = (bf16_t)(w.w & 0xffff); p[7 * SEQ] = (bf16_t)(w.w >> 16);
                    }
                }
            }
    }
};
__device__ __forceinline__ float gelu_tanh(float x) { const float z = 0.7978845608028654f * (x + 0.044715f * x * x * x); return x * fast_rcp(1.f + fast_exp2(-2.f * LOG2E * z)); }
struct EpiSsm2 {
    static constexpr bool AFTER_DRAIN = false;
    bf16_t* yb;
    __device__ __forceinline__ void operator()(AccRef acc, const Unit& u, int wr, int wc, int fr, int fq) const {
        const int b = u.bz >> 5, g = u.bz & 31;
#pragma unroll
        for (int ai = 0; ai < 2; ++ai)
#pragma unroll
            for (int m = 0; m < 4; ++m) {
                const int ch = ai * 128 + wr * 64 + m * 16 + fr;
#pragma unroll
                for (int bj = 0; bj < 2; ++bj) {
                    const int cc = u.pn * 256 + bj * 128 + wc * 32 + 8 * fq, t = cc >> 4, ho0 = cc & 15;
                    f32x4 v0, v1;
#pragma unroll
                    for (int j = 0; j < 4; ++j) { v0[j] = gelu_tanh(acc[ai][bj][m][0][j]); v1[j] = gelu_tanh(acc[ai][bj][m][1][j]); }
                    *(u32x4*)(yb + ((size_t)(b * SEQ + ch * CH + t)) * 512 + g * 16 + ho0) = pack8(v0, v1);
                }
            }
    }
};
struct EpiGlu {
    static constexpr bool AFTER_DRAIN = false;
    bf16_t* mix; const float* bglu; float* ssq;
    __device__ __forceinline__ void operator()(AccRef acc, const Unit& u, int wr, int wc, int fr, int fq) const {
        const int c0 = u.pn * 128 + wc * 32 + 8 * fq;
        const f32x4 bv0 = *(const f32x4*)(bglu + c0), bv1 = *(const f32x4*)(bglu + c0 + 4), bg0 = *(const f32x4*)(bglu + 512 + c0), bg1 = *(const f32x4*)(bglu + 512 + c0 + 4);
#pragma unroll
        for (int ai = 0; ai < 2; ++ai)
#pragma unroll
            for (int m = 0; m < 4; ++m) {
                const int row = u.pm * 256 + ai * 128 + wr * 64 + m * 16 + fr;
                f32x4 o0, o1; float part = 0.f;
#pragma unroll
                for (int j = 0; j < 4; ++j) {
                    o0[j] = (acc[ai][0][m][0][j] + bv0[j]) * sigmoidf_(acc[ai][1][m][0][j] + bg0[j]);
                    o1[j] = (acc[ai][0][m][1][j] + bv1[j]) * sigmoidf_(acc[ai][1][m][1][j] + bg1[j]);
                    part += o0[j] * o0[j] + o1[j] * o1[j];
                }
                *(u32x4*)(mix + (size_t)row * D + c0) = pack8(o0, o1);
                part = fq_sum(part);
                if (fq == 0) ssq[(size_t)row * 16 + u.pn * 4 + wc] = part;
            }
    }
};
struct EpiWq {
    static constexpr bool AFTER_DRAIN = false;
    bf16_t* O; const float* ss; float mul;
    __device__ __forceinline__ void operator()(AccRef acc, const Unit& u, int wr, int wc, int fr, int fq) const {
#pragma unroll
        for (int ai = 0; ai < 2; ++ai)
#pragma unroll
            for (int m = 0; m < 4; ++m) {
                const int row = u.pm * 256 + ai * 128 + wr * 64 + m * 16 + fr;
                const float rs = rsqrtf(ss_sum16(ss, row) * (1.f / D) + EPS) * mul;
#pragma unroll
                for (int bj = 0; bj < 2; ++bj)
                    *(u32x4*)(O + (size_t)row * D + u.pn * 256 + bj * 128 + wc * 32 + 8 * fq) = pack8(acc[ai][bj][m][0] * rs, acc[ai][bj][m][1] * rs);
            }
    }
};
struct EpiWkv {
    static constexpr bool AFTER_DRAIN = false;
    bf16_t *kx, *vxt;
    __device__ __forceinline__ void operator()(AccRef acc, const Unit& u, int wr, int wc, int fr, int fq) const {
        const size_t lo = (size_t)u.bz * 1024 * 1024;
#pragma unroll
        for (int ai = 0; ai < 2; ++ai)
#pragma unroll
            for (int m = 0; m < 4; ++m) {
                const int row = u.pm * 256 + ai * 128 + wr * 64 + m * 16 + fr;
#pragma unroll
                for (int bj = 0; bj < 2; ++bj) {
                    const int col = u.pn * 256 + bj * 128 + wc * 32 + 8 * fq;
                    const u32x4 w = pack8(acc[ai][bj][m][0], acc[ai][bj][m][1]);
                    if (u.pn < 4) *(u32x4*)(kx + lo + (size_t)row * 1024 + col) = w;
                    else { const int c2 = col - 1024, h = c2 >> 8, d = c2 & 255, b = row >> 8, mm = row & 255;
                        bf16_t* p = vxt + lo + ((size_t)((b * 4 + h) * 256 + d)) * 256 + mm;
                        p[0] = (bf16_t)(w.x & 0xffff); p[256] = (bf16_t)(w.x >> 16); p[512] = (bf16_t)(w.y & 0xffff); p[768] = (bf16_t)(w.y >> 16);
                        p[1024] = (bf16_t)(w.z & 0xffff); p[1280] = (bf16_t)(w.z >> 16); p[1536] = (bf16_t)(w.w & 0xffff); p[1792] = (bf16_t)(w.w >> 16); }
                }
            }
    }
};
struct EpiSoftmax {
    static constexpr bool AFTER_DRAIN = false;
    bf16_t* P; LAS float* red;
    __device__ __forceinline__ void operator()(AccRef acc, const Unit& u, int wr, int wc, int fr, int fq) const {
        const int b = u.bz >> 2, h = u.bz & 3;
        float mx[2][4];
#pragma unroll
        for (int ai = 0; ai < 2; ++ai)
#pragma unroll
            for (int m = 0; m < 4; ++m) {
                float v = -INFINITY;
#pragma unroll
                for (int bj = 0; bj < 2; ++bj)
#pragma unroll
                    for (int n = 0; n < 2; ++n)
#pragma unroll
                        for (int j = 0; j < 4; ++j) v = fmaxf(v, acc[ai][bj][m][n][j]);
                v = fq_max(v);
                const int rl = ai * 128 + wr * 64 + m * 16 + fr;
                if (fq == 0) red[rl * 4 + wc] = v;
            }
        asm volatile("s_waitcnt lgkmcnt(0)" ::: "memory"); __builtin_amdgcn_s_barrier(); asm volatile("" ::: "memory");
#pragma unroll
        for (int ai = 0; ai < 2; ++ai)
#pragma unroll
            for (int m = 0; m < 4; ++m) {
                const int rl = ai * 128 + wr * 64 + m * 16 + fr;
                const f32x4 r4 = *(const LAS f32x4*)(red + rl * 4);
                const float M = fmaxf(fmaxf(r4[0], r4[1]), fmaxf(r4[2], r4[3]));
                float s = 0.f;
#pragma unroll
                for (int bj = 0; bj < 2; ++bj)
#pragma unroll
                    for (int n = 0; n < 2; ++n)
#pragma unroll
                        for (int j = 0; j < 4; ++j) { const float p = fast_exp2(acc[ai][bj][m][n][j] - M); acc[ai][bj][m][n][j] = p; s += p; }
                s = fq_sum(s);
                if (fq == 0) red[1024 + rl * 4 + wc] = s;
            }
        asm volatile("s_waitcnt lgkmcnt(0)" ::: "memory"); __builtin_amdgcn_s_barrier(); asm volatile("" ::: "memory");
#pragma unroll
        for (int ai = 0; ai < 2; ++ai)
#pragma unroll
            for (int m = 0; m < 4; ++m) {
                const int rl = ai * 128 + wr * 64 + m * 16 + fr;
                const f32x4 r4 = *(const LAS f32x4*)(red + 1024 + rl * 4);
                const float inv = 1.f / ((r4[0] + r4[1]) + (r4[2] + r4[3]));
                const size_t row = (size_t)b * SEQ + u.pm * 256 + rl;
#pragma unroll
                for (int bj = 0; bj < 2; ++bj)
                    *(u32x4*)(P + row * D + h * 256 + bj * 128 + wc * 32 + 8 * fq) = pack8(acc[ai][bj][m][0] * inv, acc[ai][bj][m][1] * inv);
            }
    }
};
struct EpiNull {
    static constexpr bool AFTER_DRAIN = false;
    float* sink;
    __device__ __forceinline__ void operator()(AccRef acc, const Unit& u, int wr, int wc, int fr, int fq) const {
        float t = 0.f;
#pragma unroll
        for (int ai = 0; ai < 2; ++ai)
#pragma unroll
            for (int bj = 0; bj < 2; ++bj)
#pragma unroll
                for (int m = 0; m < 4; ++m)
#pragma unroll
                    for (int n = 0; n < 2; ++n) t += acc[ai][bj][m][n][0] + acc[ai][bj][m][n][1] + acc[ai][bj][m][n][2] + acc[ai][bj][m][n][3];
        if (t == 12345.678f) sink[u.pm] = t;
    }
};
struct EpiPV {
    static constexpr bool AFTER_DRAIN = false;
    bf16_t* O;
    __device__ __forceinline__ void operator()(AccRef acc, const Unit& u, int wr, int wc, int fr, int fq) const {
        const int b = u.bz >> 2, h = u.bz & 3;
#pragma unroll
        for (int ai = 0; ai < 2; ++ai)
#pragma unroll
            for (int m = 0; m < 4; ++m) {
                const size_t row = (size_t)b * SEQ + u.pm * 256 + ai * 128 + wr * 64 + m * 16 + fr;
#pragma unroll
                for (int bj = 0; bj < 2; ++bj)
                    *(u32x4*)(O + row * D + h * 256 + bj * 128 + wc * 32 + 8 * fq) = pack8(acc[ai][bj][m][0], acc[ai][bj][m][1]);
            }
    }
};
struct EpiSsm1 {
    static constexpr bool AFTER_DRAIN = true;
    bf16_t* up; const float *lam_re, *lam_im, *log_dt;
    __device__ __forceinline__ void operator()(AccRef, const Unit&, int, int, int, int) const {}
    __device__ __forceinline__ void fused(AccRef acc, const Unit& u, int wr, int wc, int fr, int fq, LAS unsigned char* lds, int wid, int lane) const {
        LAS float* L = (LAS float*)lds;
#pragma unroll
        for (int ai = 0; ai < 2; ++ai)
#pragma unroll
            for (int m = 0; m < 4; ++m) {
                const int rl = ai * 128 + wr * 64 + m * 16 + fr;
#pragma unroll
                for (int n = 0; n < 2; ++n) { const int col = wc * 32 + 8 * fq + 4 * n; *(LAS f32x4*)(L + rl * 128 + (col ^ ((rl & 15) << 3))) = acc[ai][0][m][n]; }
            }
        __syncthreads();
        if (wid == 0) {
            const int g = u.bz & 31, p = lane;
            const float dt = expf(log_dt[g]) * (float)CH;
            const float lr = fminf(lam_re[g * NP + p], -1e-4f), li = lam_im[g * NP + p];
            const float mag = expf(lr * dt); float sn, cs; sincosf(li * dt, &sn, &cs);
            const float ar = mag * cs, aim = mag * sn;
            float xr = 0.f, xi = 0.f;
            unsigned* dst = (unsigned*)(up + (size_t)u.bz * NCH * UPW + 512) + p;
            for (int c = 0; c < NCH; ++c) {
                dst[(size_t)c * (UPW / 2)] = cvtpk(xr, xi);
                const f32x2 l2 = *(const LAS f32x2*)(L + c * 128 + ((2 * p) ^ ((c & 15) << 3)));
                const float nr = ar * xr - aim * xi + l2[0], ni = ar * xi + aim * xr + l2[1];
                xr = nr; xi = ni;
            }
        }
        __syncthreads();
    }
};

struct GainSpec { const float* g1; const float* g2; float g2s; };
__device__ __forceinline__ float gain_of(const GainSpec& gs, int k) {
    if (!gs.g1) return 1.f;
    if (gs.g2 && k >= 512) return gs.g2[(k - 512) & 127] * gs.g2s;
    return gs.g1[k];
}
__device__ __forceinline__ void transpose_item(const float* W, int K, int N, bf16_t* WT, bool il, int nh, int hb, const GainSpec gs, LAS float* scr, int item, int lane) {
    const int nblk = N / 32, kb = item / nblk, nb = item % nblk, k0 = 64 * kb, n0 = 32 * nb;
    float tv[32];
#pragma unroll
    for (int i = 0; i < 32; ++i) { const int kk = 2 * i + (lane >> 5); tv[i] = W[(size_t)(k0 + kk) * N + n0 + (lane & 31)]; }
#pragma unroll
    for (int i = 0; i < 32; ++i) { const int kk = 2 * i + (lane >> 5); scr[kk * 33 + (lane & 31)] = tv[i] * gain_of(gs, k0 + kk); }
    asm volatile("s_waitcnt lgkmcnt(0)" ::: "memory");
    const int c = lane & 7;
#pragma unroll
    for (int j = 0; j < 4; ++j) { const int n = (lane >> 3) + 8 * j; const LAS float* s = scr + (8 * c) * 33 + n;
        u32x4 o; o.x = cvtpk(s[0 * 33], s[1 * 33]); o.y = cvtpk(s[2 * 33], s[3 * 33]); o.z = cvtpk(s[4 * 33], s[5 * 33]); o.w = cvtpk(s[6 * 33], s[7 * 33]);
        int row = n0 + n; if (il) { const int jj = row % nh, half = hb + row / nh; row = (jj >> 7) * 256 + half * 128 + (jj & 127); }
        *(u32x4*)(WT + (size_t)row * K + k0 + 8 * c) = o; }
    asm volatile("s_waitcnt lgkmcnt(0)" ::: "memory");
}

__device__ __forceinline__ void ssm_matrices(KArgsP a, int l, int g, LAS unsigned char* lds, bf16_t* Bm, bf16_t* Mt) {
    int tid = threadIdx.x; asm volatile("" : "+v"(tid));
    LAS f32x2* lamtab = (LAS f32x2*)lds;
    LAS f32x2* cc = (LAS f32x2*)(lds + 16896);
    LAS f32x2* bb = (LAS f32x2*)(lds + 16896 + 8192);
    LAS float* Kt = (LAS float*)(lds + 16896 + 16384);
    const float* lam_re = a->in[9] + (size_t)(l * NG + g) * NP; const float* lam_im = a->in[10] + (size_t)(l * NG + g) * NP;
    const float* b_re = a->in[11] + (size_t)(l * NG + g) * NP * 16; const float* b_im = a->in[12] + (size_t)(l * NG + g) * NP * 16;
    const float* c_re = a->in[13] + (size_t)(l * NG + g) * 16 * NP; const float* c_im = a->in[14] + (size_t)(l * NG + g) * 16 * NP;
    const float* dd = a->in[15] + (size_t)(l * NG + g) * 16;
    const float dt = expf(a->in[16][l * NG + g]);
    for (int idx = tid; idx < 33 * 64; idx += 512) { const int tau = idx >> 6, p = idx & 63;
        const float lr = fminf(lam_re[p], -1e-4f), li = lam_im[p]; const float zr = lr * dt * (float)tau, zi = li * dt * (float)tau;
        const float mag = expf(zr); float sn, cs; sincosf(zi, &sn, &cs); lamtab[idx] = (f32x2){mag * cs, mag * sn}; }
    for (int idx = tid; idx < 1024; idx += 512) {
        cc[idx] = (f32x2){c_re[idx], c_im[idx]};
        const int p = idx >> 4;
        const float lr = fminf(lam_re[p], -1e-4f), li = lam_im[p]; const float mag = expf(lr * dt); float sn, cs; sincosf(li * dt, &sn, &cs);
        const float ar = mag * cs - 1.f, ai = mag * sn, den = 1.f / (lr * lr + li * li);
        const float qr = (ar * lr + ai * li) * den, qi = (ai * lr - ar * li) * den;
        const float br = b_re[idx], bi = b_im[idx];
        bb[idx] = (f32x2){qr * br - qi * bi, qr * bi + qi * br};
    }
    __syncthreads();
    for (int idx = tid; idx < 32 * 256; idx += 512) { const int tau = idx >> 8, ho = (idx >> 4) & 15, hi = idx & 15; float s = 0.f;
        for (int p = 0; p < NP; ++p) { const f32x2 c = cc[ho * 64 + p], lm = lamtab[tau * 64 + p], b = bb[p * 16 + hi];
            const float wr_ = c[0] * lm[0] - c[1] * lm[1], wi_ = c[0] * lm[1] + c[1] * lm[0]; s += wr_ * b[0] - wi_ * b[1]; }
        if (tau == 0 && ho == hi) s += dd[ho];
        Kt[idx] = s; }
    __syncthreads();
    for (int ch = tid; ch < 512 * 80; ch += 512) { const int n = ch / 80, kc = ch % 80, t = n >> 4, ho = n & 15, k0 = kc * 8; float v[8];
        if (k0 < 512) { const int s = k0 >> 4, hi0 = k0 & 15;
#pragma unroll
            for (int j = 0; j < 8; ++j) v[j] = (s <= t) ? Kt[(t - s) * 256 + ho * 16 + hi0 + j] : 0.f;
        } else { const int p0 = (k0 - 512) >> 1;
#pragma unroll
            for (int j = 0; j < 4; ++j) { const f32x2 c = cc[ho * 64 + p0 + j], lm = lamtab[(t + 1) * 64 + p0 + j];
                v[2 * j] = c[0] * lm[0] - c[1] * lm[1]; v[2 * j + 1] = -(c[0] * lm[1] + c[1] * lm[0]); } }
        u32x4 o; o.x = cvtpk(v[0], v[1]); o.y = cvtpk(v[2], v[3]); o.z = cvtpk(v[4], v[5]); o.w = cvtpk(v[6], v[7]);
        *(u32x4*)(Mt + (size_t)n * UPW + k0) = o; }
    for (int ch = tid; ch < 256 * 64; ch += 512) { const int n = ch >> 6, k0 = (ch & 63) * 8; float v[8];
        if (n < 128) { const int p = n >> 1, ri = n & 1, s = k0 >> 4, hi0 = k0 & 15; const f32x2 lm = lamtab[(CH - 1 - s) * 64 + p];
#pragma unroll
            for (int j = 0; j < 8; ++j) { const f32x2 b = bb[p * 16 + hi0 + j]; v[j] = ri ? (lm[0] * b[1] + lm[1] * b[0]) : (lm[0] * b[0] - lm[1] * b[1]); }
        } else {
#pragma unroll
            for (int j = 0; j < 8; ++j) v[j] = 0.f; }
        u32x4 o; o.x = cvtpk(v[0], v[1]); o.y = cvtpk(v[2], v[3]); o.z = cvtpk(v[4], v[5]); o.w = cvtpk(v[6], v[7]);
        *(u32x4*)(Bm + (size_t)n * 512 + k0) = o; }
    __syncthreads();
}

__device__ __forceinline__ void prologue(KArgsP a, LAS unsigned char* lds, int G) {
    unsigned char* ws = a->ws;
    int tid = threadIdx.x; asm volatile("" : "+v"(tid));
    const int lane = tid & 63, wave = tid >> 6, bid = blockIdx.x;
    for (int it = bid; it < DEPTH * NG; it += G) { const int l = it >> 5, g = it & 31;
        ssm_matrices(a, l, g, lds, (bf16_t*)(ws + WS_W + l * W_LAYER + W_BM) + (size_t)g * 256 * 512, (bf16_t*)(ws + WS_W + l * W_LAYER + W_MT) + (size_t)g * 512 * UPW); }
    if (bid == 0) {
        float* sm = (float*)(ws + WS_SMALL);
        if (tid < 128) { const int l = tid >> 6, i = tid & 63;
            const float d1 = wave_sum(a->in[20][l * 64 + i] * a->in[21][l * 64 + i]), d2 = wave_sum(a->in[22][l * 64 + i] * a->in[23][l * 64 + i]);
            if (i == 0) sm[l] = expf(d1) - expf(d2) + (0.8f - 0.6f * expf(-0.3f * (float)l)); }
        for (int idx = tid; idx < 4 * 132; idx += 512) { const int h = idx / 132, n = idx % 132; int bk;
            if (n < 16) bk = n; else { const float nf = (float)n; int lg = 16 + (int)(logf(nf / 16.f) / 2.0794415416798357f * 16.f); bk = lg < 31 ? lg : 31; }
            sm[16 + idx] = a->in[2][bk * 4 + h] * LOG2E; }
    }
    { LAS float* scr = (LAS float*)(lds + wave * 16384);
      const int gw = bid * 8 + wave, NGW = G * 8;
      const int nssm = (G > DEPTH * NG) ? DEPTH * NG : 0;
      for (int it = (bid - nssm) * 8 + wave; bid >= nssm && it < DEPTH * 12288; it += (G - nssm) * 8) {
          const int l = it / 12288; int r = it % 12288; unsigned char* wl = ws + WS_W + l * W_LAYER;
          const GainSpec none{nullptr, nullptr, 0.f};
          if (r < 1408) { transpose_item(a->in[4] + (size_t)l * D * FF, D, FF, (bf16_t*)(wl + W_GU1), true, FF, 0, GainSpec{a->in[3] + l * D, nullptr, 0.f}, scr, r, lane); continue; } r -= 1408;
          if (r < 1408) { transpose_item(a->in[5] + (size_t)l * D * FF, D, FF, (bf16_t*)(wl + W_GU1), true, FF, 1, GainSpec{a->in[3] + l * D, nullptr, 0.f}, scr, r, lane); continue; } r -= 1408;
          if (r < 1408) { transpose_item(a->in[6] + (size_t)l * FF * D, FF, D, (bf16_t*)(wl + W_D1), false, 1, 0, none, scr, r, lane); continue; } r -= 1408;
          if (r < 1408) { transpose_item(a->in[32] + (size_t)l * D * FF, D, FF, (bf16_t*)(wl + W_GU2), true, FF, 0, GainSpec{a->in[31] + l * D, nullptr, 0.f}, scr, r, lane); continue; } r -= 1408;
          if (r < 1408) { transpose_item(a->in[33] + (size_t)l * D * FF, D, FF, (bf16_t*)(wl + W_GU2), true, FF, 1, GainSpec{a->in[31] + l * D, nullptr, 0.f}, scr, r, lane); continue; } r -= 1408;
          if (r < 1408) { transpose_item(a->in[34] + (size_t)l * FF * D, FF, D, (bf16_t*)(wl + W_D2), false, 1, 0, none, scr, r, lane); continue; } r -= 1408;
          if (r < 1024) { transpose_item(a->in[8] + (size_t)l * D * 2048, D, 2048, (bf16_t*)(wl + W_IN), false, 1, 0, GainSpec{a->in[7] + l * D, nullptr, 0.f}, scr, r, lane); continue; } r -= 1024;
          if (r < 256) { transpose_item(a->in[17] + (size_t)l * 512 * 1024, 512, 1024, (bf16_t*)(wl + W_GLU), true, 512, 0, none, scr, r, lane); continue; } r -= 256;
          if (r < 512) { transpose_item(a->in[25] + (size_t)l * D * D, D, D, (bf16_t*)(wl + W_OUT), false, 1, 0, GainSpec{a->in[19] + l * 512, a->in[24] + l * 128, 1.f - (0.8f - 0.6f * expf(-0.3f * (float)l))}, scr, r, lane); continue; } r -= 512;
          if (r < 512) { transpose_item(a->in[28] + (size_t)l * D * D, D, D, (bf16_t*)(wl + W_Q), false, 1, 0, GainSpec{a->in[26] + l * D, nullptr, 0.f}, scr, r, lane); continue; } r -= 512;
          if (r < 1024) { transpose_item(a->in[29] + (size_t)l * D * 2048, D, 2048, (bf16_t*)(wl + W_KV), false, 1, 0, none, scr, r, lane); continue; } r -= 1024;
          transpose_item(a->in[30] + (size_t)l * D * D, D, D, (bf16_t*)(wl + W_O), false, 1, 0, none, scr, r, lane);
      }
      for (int row = gw; row < T + DEPTH * BATCH * MEM; row += NGW) {
          const bool ismem = row >= T; const int mr = row - T, l = mr >> 10, mrow = mr & 1023;
          const float* src = ismem ? a->in[1] + (size_t)mrow * D : a->in[0] + (size_t)row * D;
          f32x4 v[4]; float s = 0.f;
#pragma unroll
          for (int j = 0; j < 4; ++j) { v[j] = *((const f32x4*)src + lane + 64 * j); s += (v[j][0] * v[j][0] + v[j][1] * v[j][1]) + (v[j][2] * v[j][2] + v[j][3] * v[j][3]); }
          s = wave_sum(s);
          if (!ismem) { if (lane < 16) ((float*)(ws + WS_SS))[(size_t)row * 16 + lane] = lane == 0 ? s : 0.f;
#pragma unroll
              for (int j = 0; j < 4; ++j) *((u32x2*)(ws + WS_HB + (size_t)row * D * 2) + lane + 64 * j) = (u32x2){cvtpk(v[j][0], v[j][1]), cvtpk(v[j][2], v[j][3])};
          } else { const float rs = rsqrtf(s * (1.f / D) + EPS); const float* gn = a->in[27] + l * D;
#pragma unroll
              for (int j = 0; j < 4; ++j) { const f32x4 gg = *((const f32x4*)gn + lane + 64 * j);
                  *((u32x2*)(ws + WS_MEMN + ((size_t)l * 1024 + mrow) * D * 2) + lane + 64 * j) = (u32x2){cvtpk(v[j][0] * rs * gg[0], v[j][1] * rs * gg[1]), cvtpk(v[j][2] * rs * gg[2], v[j][3] * rs * gg[3])}; }
          }
      }
    }
}

constexpr int AT_KROW = 256, AT_VROW = 128, AT_KBUF = 64 * AT_KROW, AT_VBUF = 128 * AT_VROW;
constexpr int AT_NBUF = 3, AT_K0 = 0, AT_V0 = AT_NBUF * AT_KBUF, AT_BIAS = AT_V0 + AT_NBUF * AT_VBUF;

__device__ __forceinline__ void at_pv(LAS unsigned char* Vb, int r, int g, const bf16x8 (&pfr)[2][2], f32x4 (&o)[2][8], f32x4 (&ol)[2]) {
    bf16x8 vfa[8], vfb[8];
#pragma unroll
    for (int db = 0; db < 4; ++db)
#pragma unroll
        for (int kk = 0; kk < 2; ++kk) vfa[db * 2 + kk] = *(const LAS bf16x8*)(Vb + (db * 16 + r) * AT_VROW + (((kk * 4 + g) ^ (r >> 1)) * 16));
    __builtin_amdgcn_sched_barrier(0);
#pragma unroll
    for (int db = 0; db < 4; ++db)
#pragma unroll
        for (int kk = 0; kk < 2; ++kk) vfb[db * 2 + kk] = *(const LAS bf16x8*)(Vb + ((db + 4) * 16 + r) * AT_VROW + (((kk * 4 + g) ^ (r >> 1)) * 16));
    __builtin_amdgcn_sched_barrier(0);
    __builtin_amdgcn_s_setprio(1);
#pragma unroll
    for (int kk = 0; kk < 2; ++kk) {
#pragma unroll
        for (int db = 0; db < 4; ++db) {
            o[0][db] = __builtin_amdgcn_mfma_f32_16x16x32_bf16(vfa[db * 2 + kk], pfr[0][kk], o[0][db], 0, 0, 0);
            o[1][db] = __builtin_amdgcn_mfma_f32_16x16x32_bf16(vfa[db * 2 + kk], pfr[1][kk], o[1][db], 0, 0, 0); }
        __builtin_amdgcn_sched_barrier(0); }
#pragma unroll
    for (int kk = 0; kk < 2; ++kk) {
#pragma unroll
        for (int db = 0; db < 4; ++db) {
            o[0][db + 4] = __builtin_amdgcn_mfma_f32_16x16x32_bf16(vfb[db * 2 + kk], pfr[0][kk], o[0][db + 4], 0, 0, 0);
            o[1][db + 4] = __builtin_amdgcn_mfma_f32_16x16x32_bf16(vfb[db * 2 + kk], pfr[1][kk], o[1][db + 4], 0, 0, 0); }
        __builtin_amdgcn_sched_barrier(0); }
    { const short one = (short)0x3F80; const bf16x8 ones = {one, one, one, one, one, one, one, one};
#pragma unroll
      for (int kk = 0; kk < 2; ++kk) { ol[0] = __builtin_amdgcn_mfma_f32_16x16x32_bf16(ones, pfr[0][kk], ol[0], 0, 0, 0); ol[1] = __builtin_amdgcn_mfma_f32_16x16x32_bf16(ones, pfr[1][kk], ol[1], 0, 0, 0); } }
    __builtin_amdgcn_s_setprio(0);
    __builtin_amdgcn_sched_barrier(0);
}

__device__ __forceinline__ void at_qk_sm(LAS unsigned char* Kb, const LAS float* biasl, int r, int g, int k0, int qw0, int qrow, float cfar,
                                         const bf16x8 (&qf)[2][2], float (&mrow)[2], f32x4 (&ol)[2], f32x4 (&o)[2][8], bf16x8 (&pfr)[2][2], bool first) {
    f32x4 s[2][4];
    const bool far = (qw0 - (k0 + 63)) >= 128;
    const float cf = far ? cfar : 0.f;
    const float ci0 = first ? cf : cf - mrow[0], ci1 = first ? cf : cf - mrow[1];
    bf16x8 kfa[8], kfb[8];
#pragma unroll
    for (int kb = 0; kb < 4; ++kb)
#pragma unroll
        for (int ks = 0; ks < 2; ++ks) kfa[kb * 2 + ks] = *(const LAS bf16x8*)(Kb + (kb * 16 + r) * AT_KROW + (((ks * 4 + g) ^ r) * 16));
    __builtin_amdgcn_sched_barrier(0);
#pragma unroll
    for (int kb = 0; kb < 4; ++kb)
#pragma unroll
        for (int ks = 0; ks < 2; ++ks) kfb[kb * 2 + ks] = *(const LAS bf16x8*)(Kb + (kb * 16 + r) * AT_KROW + (((8 + ks * 4 + g) ^ r) * 16));
    __builtin_amdgcn_sched_barrier(0);
    __builtin_amdgcn_s_setprio(1);
#pragma unroll
    for (int kb = 0; kb < 4; ++kb) s[0][kb] = __builtin_amdgcn_mfma_f32_16x16x32_bf16(kfa[kb * 2], qf[0][0], (f32x4){ci0, ci0, ci0, ci0}, 0, 0, 0);
    __builtin_amdgcn_sched_barrier(0);
#pragma unroll
    for (int kb = 0; kb < 4; ++kb) s[0][kb] = __builtin_amdgcn_mfma_f32_16x16x32_bf16(kfa[kb * 2 + 1], qf[0][1], s[0][kb], 0, 0, 0);
    __builtin_amdgcn_sched_barrier(0);
#pragma unroll
    for (int kb = 0; kb < 4; ++kb) s[1][kb] = __builtin_amdgcn_mfma_f32_16x16x32_bf16(kfb[kb * 2], qf[1][0], (f32x4){ci1, ci1, ci1, ci1}, 0, 0, 0);
    __builtin_amdgcn_sched_barrier(0);
#pragma unroll
    for (int kb = 0; kb < 4; ++kb) s[1][kb] = __builtin_amdgcn_mfma_f32_16x16x32_bf16(kfb[kb * 2 + 1], qf[1][1], s[1][kb], 0, 0, 0);
    __builtin_amdgcn_s_setprio(0);
    __builtin_amdgcn_sched_barrier(0);
    if (!far) {
        float badd[4][4];
#pragma unroll
        for (int kb = 0; kb < 4; ++kb)
#pragma unroll
            for (int j = 0; j < 4; ++j) { const int key = k0 + (kb >> 1) * 32 + g * 8 + (kb & 1) * 4 + j, dist = qrow - key;
                const int idx = dist < 0 ? 0 : (dist > 128 ? 128 : dist);
                badd[kb][j] = biasl[idx]; }
#pragma unroll
        for (int kb = 0; kb < 4; ++kb)
#pragma unroll
            for (int j = 0; j < 4; ++j) { const int key = k0 + (kb >> 1) * 32 + g * 8 + (kb & 1) * 4 + j;
                const float ad = (qrow >= key) ? badd[kb][j] : -INFINITY;
                s[0][kb][j] += ad; s[1][kb][j] += ad; }
    }
#pragma unroll
    for (int m = 0; m < 2; ++m) {
        float mx = max3f(s[m][0][0], s[m][0][1], s[m][0][2]);
        mx = max3f(mx, s[m][0][3], s[m][1][0]); mx = max3f(mx, s[m][1][1], s[m][1][2]); mx = max3f(mx, s[m][1][3], s[m][2][0]);
        mx = max3f(mx, s[m][2][1], s[m][2][2]); mx = max3f(mx, s[m][2][3], s[m][3][0]); mx = max3f(mx, s[m][3][1], s[m][3][2]); mx = max2f(mx, s[m][3][3]);
        mx = xl_max(mx);
        if (first || __any(mx > 6.0f)) {
            const float delta = first ? mx : fmaxf(mx, 0.f), alpha = first ? 0.f : fast_exp2(-delta);
            mrow[m] = first ? delta : mrow[m] + delta;
            ol[m] = ol[m] * alpha;
#pragma unroll
            for (int db = 0; db < 8; ++db) o[m][db] = o[m][db] * alpha;
#pragma unroll
            for (int kb = 0; kb < 4; ++kb) s[m][kb] = s[m][kb] - delta;
        }
#pragma unroll
        for (int kb = 0; kb < 4; ++kb)
#pragma unroll
            for (int j = 0; j < 4; ++j) s[m][kb][j] = fast_exp2(s[m][kb][j]);
#pragma unroll
        for (int kk = 0; kk < 2; ++kk) { const u32x4 pw = pack8(s[m][2 * kk], s[m][2 * kk + 1]); pfr[m][kk] = __builtin_bit_cast(bf16x8, pw); }
    }
}

__device__ __forceinline__ void attn_qblock(int b, int h, int q0, float lam, LAS unsigned char* lds, const bf16_t* qbuf, const bf16_t* kbuf, const bf16_t* vT, bf16_t* mix, const float* bias_g) {
    int tid = threadIdx.x; asm volatile("" : "+v"(tid));
    const int lane = tid & 63, w = __builtin_amdgcn_readfirstlane(tid >> 6), r = lane & 15, g = lane >> 4;
    const bool grpB = w >= 4;
    const int qw0 = q0 + w * 16, qrow = qw0 + r;
    LAS float* biasl = (LAS float*)(lds + AT_BIAS);
    __syncthreads();
    if (tid < 129) biasl[tid] = bias_g[h * 132 + tid];
    bf16x8 qf[2][2];
    { const bf16_t* qp = qbuf + ((size_t)(b * SEQ + qrow)) * 512 + h * 128 + g * 8;
#pragma unroll
      for (int m = 0; m < 2; ++m)
#pragma unroll
          for (int ks = 0; ks < 2; ++ks) qf[m][ks] = *(const bf16x8*)(qp + m * 64 + ks * 32); }
    f32x4 o[2][8];
#pragma unroll
    for (int m = 0; m < 2; ++m)
#pragma unroll
        for (int db = 0; db < 8; ++db) o[m][db] = (f32x4){0.f, 0.f, 0.f, 0.f};
    float mrow[2] = {0.f, 0.f};
    f32x4 ol[2] = {(f32x4){0.f, 0.f, 0.f, 0.f}, (f32x4){0.f, 0.f, 0.f, 0.f}};
    bf16x8 pfr[2][2];
#pragma unroll
    for (int m = 0; m < 2; ++m)
#pragma unroll
        for (int kk = 0; kk < 2; ++kk) pfr[m][kk] = (bf16x8){0, 0, 0, 0, 0, 0, 0, 0};
    const int ntiles = (q0 + 128) >> 6;
    unsigned gk[2], lk[2], gv[2], lv[2];
#pragma unroll
    for (int i = 0; i < 2; ++i) { const int c = tid + i * 512;
        { const int key = c >> 4, ch = c & 15, rho = ((key >> 5) * 2 + ((key >> 2) & 1)) * 16 + ((key >> 3) & 3) * 4 + (key & 3); gk[i] = key * 512 + ch * 8; lk[i] = rho * AT_KROW + ((ch ^ (rho & 15)) * 16); }
        { const int dv = c >> 3, ch = c & 7; gv[i] = dv * SEQ + ch * 8; lv[i] = dv * AT_VROW + ((ch ^ ((dv >> 1) & 7)) * 16); } }
    const bf16_t* kbase = kbuf + ((size_t)b * SEQ) * 512 + h * 128;
    const bf16_t* vbase = vT + ((size_t)(b * 4 + h) * 128) * SEQ;
    u32x4 kreg[2], vreg[2];
#pragma unroll
    for (int i = 0; i < 2; ++i) { kreg[i] = *(const u32x4*)(kbase + gk[i]); vreg[i] = *(const u32x4*)(vbase + gv[i]); }
#pragma unroll
    for (int i = 0; i < 2; ++i) { *(LAS u32x4*)(lds + AT_K0 + lk[i]) = kreg[i]; *(LAS u32x4*)(lds + AT_V0 + lv[i]) = vreg[i]; }
    __syncthreads();
    const float cfar = biasl[128];
    int cur = 0; bool pend = false;
    for (int kt = 0; kt < ntiles; ++kt) {
        const int k0 = kt * 64, nxt = (cur == AT_NBUF - 1) ? 0 : cur + 1, prv = (cur == 0) ? AT_NBUF - 1 : cur - 1;
        const bool pf = (kt + 1 < ntiles);
        if (pf) {
#pragma unroll
            for (int i = 0; i < 2; ++i) { kreg[i] = *(const u32x4*)(kbase + (size_t)(k0 + 64) * 512 + gk[i]); vreg[i] = *(const u32x4*)(vbase + (k0 + 64) + gv[i]); } }
        const bool active = (k0 <= qw0 + 15);
        if (grpB && pend) at_pv(lds + AT_V0 + prv * AT_VBUF, r, g, pfr, o, ol);
        if (active) at_qk_sm(lds + AT_K0 + cur * AT_KBUF, biasl, r, g, k0, qw0, qrow, cfar, qf, mrow, ol, o, pfr, kt == 0);
        if (!grpB && active) at_pv(lds + AT_V0 + cur * AT_VBUF, r, g, pfr, o, ol);
        pend = active;
        if (pf) {
#pragma unroll
            for (int i = 0; i < 2; ++i) { *(LAS u32x4*)(lds + AT_K0 + nxt * AT_KBUF + lk[i]) = kreg[i]; *(LAS u32x4*)(lds + AT_V0 + nxt * AT_VBUF + lv[i]) = vreg[i]; } }
        __syncthreads();
        cur = nxt;
    }
    if (grpB && pend) { const int prv = (cur == 0) ? AT_NBUF - 1 : cur - 1; at_pv(lds + AT_V0 + prv * AT_VBUF, r, g, pfr, o, ol); }
    const float inv0 = 1.f / ol[0][0], inv1 = lam / ol[1][0];
    float ssq = 0.f;
#pragma unroll
    for (int db = 0; db < 8; ++db)
#pragma unroll
        for (int j = 0; j < 4; ++j) { const float v = o[0][db][j] * inv0 - o[1][db][j] * inv1; o[0][db][j] = v; ssq += v * v; }
    ssq = fq_sum(ssq);
    const float rn = rsqrtf(ssq * (1.f / 128.f) + EPS);
    bf16_t* op = mix + ((size_t)(b * SEQ + qrow)) * D + 512 + h * 128 + g * 4;
#pragma unroll
    for (int db = 0; db < 8; ++db) *(u32x2*)(op + db * 16) = (u32x2){cvtpk(o[0][db][0] * rn, o[0][db][1] * rn), cvtpk(o[0][db][2] * rn, o[0][db][3] * rn)};
}

#if DEBUG_CHECK
__device__ __forceinline__ unsigned hash_u(unsigned x) { x ^= x >> 16; x *= 0x7feb352dU; x ^= x >> 15; x *= 0x846ca68bU; x ^= x >> 16; return x; }
__device__ __forceinline__ void dbg_flag(unsigned* ctl, int id, float got, float ref, float rtol, float atol) {
    const float d = fabsf(got - ref);
    if (!(d <= atol + rtol * fabsf(ref))) atomicAdd(ctl + 64 + id, 1u);
}
#endif

__global__ void __launch_bounds__(512, 2) fwd_kernel(Args a) {
    extern __shared__ __attribute__((aligned(16))) unsigned char lds_raw[];
    LAS unsigned char* lds = (LAS unsigned char*)lds_raw;
    cg::grid_group grid = cg::this_grid();
    const int G = gridDim.x;
#define PH KArgsP ka = KARGS(); int bid = blockIdx.x, G = gridDim.x, tidl = threadIdx.x; asm volatile("" : "+s"(bid), "+s"(G), "+v"(tidl)); const int lane = tidl & 63, wave = tidl >> 6; (void)lane; (void)wave; unsigned char* ws = ka->ws; float* ssb = (float*)(ws + WS_SS); float* ssm_ss = (float*)(ws + WS_SSM_SS); const float* smalls = (const float*)(ws + WS_SMALL); \
    bf16_t* hb = (bf16_t*)(ws + WS_HB); unsigned char* ar = ws + WS_AR; unsigned char* wl = ws + WS_W + l * W_LAYER; float* hbuf = ka->out; \
    (void)ssb; (void)ssm_ss; (void)smalls; (void)hb; (void)ar; (void)wl; (void)hbuf;
    if (threadIdx.x < 2) ((LAS unsigned*)(lds + LDS_XB))[threadIdx.x] = 0u;
    __syncthreads();
    XcdBarrier xbar = xcd_barrier_post((unsigned*)(KARGS()->ws + WS_CTL) + 1024, (volatile LAS unsigned*)(lds + LDS_XB));
    for (int rep = 0; rep < (PROBE == 5 ? 2 : 1); ++rep) prologue(KARGS(), lds, G);
    grid.sync();
#define GSYNC() xcd_barrier(xbar)

    for (int l = 0; l < DEPTH; ++l) {
        if (PROBE == 4) { for (int rep = 0; rep < 10; ++rep) GSYNC(); }
        for (int rep = 0; rep < (PROBE == 2 ? 2 : 1); ++rep)
        { PH StdSched S; S.init(T, 2 * FF, G, bid, D, D); EpiFfnUp E{(bf16_t*)(ar + AR_HID), ssb + (size_t)(4 * l + 0) * T * 16};
          gemm_phase<EpiFfnUp, StdSched, true>(lds, hb, (const bf16_t*)(wl + W_GU1), D, D, D, S, E); }
        GSYNC();
        if (PROBE == 6) { PH StdSched S; S.init(T, D, G, bid, FF, FF); EpiNull E{(float*)(ws + WS_CTL + 20000)};
          gemm_phase<EpiNull, StdSched, false>(lds, (const bf16_t*)(ar + AR_HID), (const bf16_t*)(wl + W_D1), FF, FF, FF, S, E); }
        for (int rep = (PROBE == 7 ? 0 : 1); rep < 2; ++rep)
        { PH StdSched S; S.init(T, D, G, bid, FF, FF); EpiResid E{hb, ssb + (size_t)(4 * l + 1) * T * 16, (PROBE == 7 && rep == 0) ? 0.f : 0.5f};
          gemm_phase<EpiResid, StdSched, true>(lds, (const bf16_t*)(ar + AR_HID), (const bf16_t*)(wl + W_D1), FF, FF, FF, S, E); }
        GSYNC();
        for (int rep = 0; rep < (PROBE == 3 ? 2 : 1); ++rep)
        { PH StdSched S; S.init(T, 2048, G, bid, D, D); EpiWin E{ar, ssb + (size_t)(4 * l + 1) * T * 16};
          gemm_phase<EpiWin, StdSched, true>(lds, hb, (const bf16_t*)(wl + W_IN), D, D, D, S, E); }
        GSYNC();
        for (int rep = 0; rep < (PROBE == 3 ? 2 : 1); ++rep)
        if ((int)blockIdx.x < 128) { PH Ssm1Sched S{bid}; EpiSsm1 E{(bf16_t*)(ar + AR_UP), ka->in[9] + (size_t)l * NG * NP, ka->in[10] + (size_t)l * NG * NP, ka->in[16] + (size_t)l * NG};
          gemm_phase<EpiSsm1, Ssm1Sched, false>(lds, (const bf16_t*)(ar + AR_UP), (const bf16_t*)(wl + W_BM), UPW, 512, 512, S, E); }
        else if (l == 0) { PH WkvSched S{G, bid}; EpiWkv E{(bf16_t*)(ws + WS_KX), (bf16_t*)(ws + WS_VXT)};
          gemm_phase<EpiWkv, WkvSched, false>(lds, (const bf16_t*)(ws + WS_MEMN), (const bf16_t*)(ws + WS_W + W_KV), D, D, D, S, E); }
        GSYNC();
        for (int rep = 0; rep < (PROBE == 3 ? 2 : 1); ++rep)
        { PH Ssm2Sched S{G, bid}; EpiSsm2 E{(bf16_t*)(ar + AR_Y)};
          gemm_phase<EpiSsm2, Ssm2Sched, false>(lds, (const bf16_t*)(ar + AR_UP), (const bf16_t*)(wl + W_MT), UPW, UPW, UPW, S, E); }
        GSYNC();
        for (int rep = 0; rep < (PROBE == 8 ? 2 : 1); ++rep)
        { PH StdSched S; S.init(T, 1024, G, bid, 512, 512); EpiGlu E{(bf16_t*)(ar + AR_MIX), ka->in[18] + (size_t)l * 1024, ssm_ss + (size_t)l * T * 16};
          gemm_phase<EpiGlu, StdSched, true>(lds, (const bf16_t*)(ar + AR_Y), (const bf16_t*)(wl + W_GLU), 512, 512, 512, S, E); }
        GSYNC();
        { PH const float lam = smalls[l];
          for (int rep = 0; rep < (PROBE == 1 ? 2 : 1); ++rep)
          for (int uidx = bid; uidx < 512; uidx += G) {
              int bh = uidx >> 5, j = uidx & 31;
              if (G == 256) { bh = (bid & 7) + 8 * (uidx >> 8); j = bid >> 3; }
              const int b = bh >> 2, h = bh & 3;
              attn_qblock(b, h, j * 128, lam, lds, (const bf16_t*)(ar + AR_Q), (const bf16_t*)(ar + AR_K), (const bf16_t*)(ar + AR_VT), (bf16_t*)(ar + AR_MIX), smalls + 16);
              attn_qblock(b, h, (63 - j) * 128, lam, lds, (const bf16_t*)(ar + AR_Q), (const bf16_t*)(ar + AR_K), (const bf16_t*)(ar + AR_VT), (bf16_t*)(ar + AR_MIX), smalls + 16); }
          bf16_t* mix = (bf16_t*)(ar + AR_MIX); const float* sq = ssm_ss + (size_t)l * T * 16;
          for (int row = bid * 8 + wave; row < T; row += G * 8) { const float rs = rsqrtf(ss_sum16(sq, row) * (1.f / 512.f) + EPS);
              u32x4* p = (u32x4*)(mix + (size_t)row * D) + lane; u32x4 v = *p;
              v.x = cvtpk(__uint_as_float(v.x << 16) * rs, __uint_as_float(v.x & 0xffff0000u) * rs); v.y = cvtpk(__uint_as_float(v.y << 16) * rs, __uint_as_float(v.y & 0xffff0000u) * rs);
              v.z = cvtpk(__uint_as_float(v.z << 16) * rs, __uint_as_float(v.z & 0xffff0000u) * rs); v.w = cvtpk(__uint_as_float(v.w << 16) * rs, __uint_as_float(v.w & 0xffff0000u) * rs);
              *p = v; } }
        GSYNC();
        for (int rep = (PROBE == 7 ? 0 : 1); rep < 2; ++rep)
        { PH StdSched S; S.init(T, D, G, bid, D, D); EpiResid E{hb, ssb + (size_t)(4 * l + 2) * T * 16, (PROBE == 7 && rep == 0) ? 0.f : 1.f};
          gemm_phase<EpiResid, StdSched, true>(lds, (const bf16_t*)(ar + AR_MIX), (const bf16_t*)(wl + W_OUT), D, D, D, S, E); }
        GSYNC();
        for (int rep = 0; rep < (PROBE == 3 ? 2 : 1); ++rep)
        { PH StdSched S; S.init(T, D, G, bid, D, D); EpiWq E{(bf16_t*)(ar + AR_QX), ssb + (size_t)(4 * l + 2) * T * 16, 0.0625f * LOG2E};
          gemm_phase<EpiWq, StdSched, true>(lds, hb, (const bf16_t*)(wl + W_Q), D, D, D, S, E); }
        GSYNC();
        for (int rep = 0; rep < (PROBE == 3 ? 2 : 1); ++rep)
        { PH XaSched S{G, bid, (unsigned)MEM * 1024, 256u}; EpiSoftmax E{(bf16_t*)(ar + AR_P), (LAS float*)(lds + LDS_RED)};
          gemm_phase<EpiSoftmax, XaSched, true>(lds, (const bf16_t*)(ar + AR_QX), (const bf16_t*)(ws + WS_KX) + (size_t)l * 1024 * 1024, D, D, 256, S, E); }
        GSYNC();
        for (int rep = 0; rep < (PROBE == 3 ? 2 : 1); ++rep)
        { PH XaSched S{G, bid, 4u * 65536u, 65536u}; EpiPV E{(bf16_t*)(ar + AR_OX)};
          gemm_phase<EpiPV, XaSched, false>(lds, (const bf16_t*)(ar + AR_P), (const bf16_t*)(ws + WS_VXT) + (size_t)l * 1024 * 1024, D, 256, 256, S, E); }
        GSYNC();
        for (int rep = (PROBE == 7 ? 0 : 1); rep < 2; ++rep)
        { PH StdSched S; S.init(T, D, G, bid, D, D); EpiResid E{hb, ssb + (size_t)(4 * l + 3) * T * 16, (PROBE == 7 && rep == 0) ? 0.f : 1.f};
          gemm_phase<EpiResid, StdSched, true>(lds, (const bf16_t*)(ar + AR_OX), (const bf16_t*)(wl + W_O), D, D, D, S, E); }
        GSYNC();
        for (int rep = 0; rep < (PROBE == 2 ? 2 : 1); ++rep)
        { PH StdSched S; S.init(T, 2 * FF, G, bid, D, D); EpiFfnUp E{(bf16_t*)(ar + AR_HID), ssb + (size_t)(4 * l + 3) * T * 16};
          gemm_phase<EpiFfnUp, StdSched, true>(lds, hb, (const bf16_t*)(wl + W_GU2), D, D, D, S, E); }
        GSYNC();
        if (PROBE == 6) { PH StdSched S; S.init(T, D, G, bid, FF, FF); EpiNull E{(float*)(ws + WS_CTL + 20000)};
          gemm_phase<EpiNull, StdSched, false>(lds, (const bf16_t*)(ar + AR_HID), (const bf16_t*)(wl + W_D2), FF, FF, FF, S, E); }
        for (int rep = (PROBE == 7 ? 0 : 1); rep < 2; ++rep)
        { PH StdSched S; S.init(T, D, G, bid, FF, FF); EpiResid E{hb, ssb + (size_t)(4 * l + 4) * T * 16, (PROBE == 7 && rep == 0) ? 0.f : 0.5f};
          gemm_phase<EpiResid, StdSched, true>(lds, (const bf16_t*)(ar + AR_HID), (const bf16_t*)(wl + W_D2), FF, FF, FF, S, E); }
        GSYNC();
    }
    { const int l = 0; PH const float* sq = ssb + (size_t)8 * T * 16; const float* gn = ka->in[35];
      for (int row = bid * 8 + wave; row < T; row += G * 8) { const float rs = rsqrtf(ss_sum16(sq, row) * (1.f / D) + EPS);
#pragma unroll
          for (int j = 0; j < 2; ++j) { const u32x4 w = *((const u32x4*)(hb + (size_t)row * D) + lane + 64 * j);
              const f32x4 g0 = *((const f32x4*)gn + 2 * (lane + 64 * j)), g1 = *((const f32x4*)gn + 2 * (lane + 64 * j) + 1);
              f32x4 v0, v1;
              v0[0] = __uint_as_float(w.x << 16) * rs * g0[0]; v0[1] = __uint_as_float(w.x & 0xffff0000u) * rs * g0[1]; v0[2] = __uint_as_float(w.y << 16) * rs * g0[2]; v0[3] = __uint_as_float(w.y & 0xffff0000u) * rs * g0[3];
              v1[0] = __uint_as_float(w.z << 16) * rs * g1[0]; v1[1] = __uint_as_float(w.z & 0xffff0000u) * rs * g1[1]; v1[2] = __uint_as_float(w.w << 16) * rs * g1[2]; v1[3] = __uint_as_float(w.w & 0xffff0000u) * rs * g1[3];
              f32x4* op = (f32x4*)(hbuf + (size_t)row * D) + 2 * (lane + 64 * j); op[0] = v0; op[1] = v1; } } }
}

extern "C" void kernel_launch(void* const* d_in, const int* in_sizes, int n_in, void* d_out, int out_size, void* d_ws, size_t ws_size, hipStream_t stream) {
    static int grid = 0;
    if (grid == 0) {
        if (n_in != 36 || out_size != T * D || ws_size < WS_END) { fprintf(stderr, "kernel_launch: unexpected problem (n_in %d out %d ws %zu)\n", n_in, out_size, ws_size); grid = -1; return; }
        int dev = 0, cus = 0, per_cu = 0;
        if (hipGetDevice(&dev) != hipSuccess || hipDeviceGetAttribute(&cus, hipDeviceAttributeMultiprocessorCount, dev) != hipSuccess) { grid = -1; return; }
        if (hipFuncSetAttribute((const void*)fwd_kernel, hipFuncAttributeMaxDynamicSharedMemorySize, LDS_BYTES) != hipSuccess) { fprintf(stderr, "hipFuncSetAttribute failed\n"); grid = -1; return; }
        if (hipOccupancyMaxActiveBlocksPerMultiprocessor(&per_cu, (const void*)fwd_kernel, 512, LDS_BYTES) != hipSuccess || per_cu < 1) { fprintf(stderr, "occupancy query: %d\n", per_cu); }
        (void)hipGetLastError();
        grid = cus;
        if (grid != 256) fprintf(stderr, "kernel_launch: %d CUs (expected 256)\n", grid);
    }
    if (grid < 0) return;
    (void)hipMemsetAsync((char*)d_ws + WS_CTL, 0, 32768, stream);
    Args a{};
    for (int i = 0; i < 36; ++i) a.in[i] = (const float*)d_in[i];
    a.out = (float*)d_out; a.ws = (unsigned char*)d_ws;
    void* args[] = {&a};
    hipError_t e = hipLaunchCooperativeKernel((const void*)fwd_kernel, dim3(grid), dim3(512), args, LDS_BYTES, stream);
    if (e != hipSuccess) fprintf(stderr, "cooperative launch failed: %s (grid %d)\n", hipGetErrorString(e), grid);
}
```

```cpp
#include <hip/hip_runtime.h>
#include <hip/hip_cooperative_groups.h>
#include <cstdio>
#include <cstdint>
namespace cg = cooperative_groups;

#define LAS __attribute__((address_space(3)))
typedef unsigned short bf16_t;
typedef short bf16x8 __attribute__((ext_vector_type(8)));
typedef float f32x4 __attribute__((ext_vector_type(4)));
typedef float f32x2 __attribute__((ext_vector_type(2)));
typedef unsigned u32x4 __attribute__((ext_vector_type(4)));
typedef unsigned u32x2 __attribute__((ext_vector_type(2)));
typedef __bf16 bf16x2_t __attribute__((ext_vector_type(2)));

#ifndef PROBE
#define PROBE 0
#endif
#ifndef ATT_VAR
#define ATT_VAR 0
#endif
#ifndef DEBUG_CHECK
#define DEBUG_CHECK 0
#endif

constexpr int D = 1024, BATCH = 4, SEQ = 8192, T = BATCH * SEQ, DEPTH = 2, MEM = 256, FF = 2816;
constexpr int SSMW = 512, NG = 32, NP = 64, CH = 32  , NCH = SEQ / CH  , UPW = 640  ;
constexpr float EPS = 1e-6f, LOG2E = 1.4426950408889634f;

constexpr size_t MiB = 1u << 20;
constexpr size_t WS_CTL = 0;
constexpr size_t WS_SS = 466 * MiB;
constexpr size_t WS_SSM_SS = WS_SS + 9 * (size_t)T * 64;
constexpr size_t WS_SMALL = 3 * MiB;
constexpr size_t WS_MEMN = 4 * MiB;
constexpr size_t WS_KX = 8 * MiB;
constexpr size_t WS_VXT = 12 * MiB;
constexpr size_t WS_W = 16 * MiB, W_LAYER = 76 * MiB;
constexpr size_t W_GU1 = 0, W_D1 = 11 * MiB, W_GU2 = 16 * MiB + MiB / 2, W_D2 = 27 * MiB + MiB / 2, W_IN = 33 * MiB, W_GLU = 37 * MiB, W_OUT = 38 * MiB,
                 W_Q = 40 * MiB, W_KV = 42 * MiB, W_O = 46 * MiB, W_BM = 48 * MiB, W_MT = 56 * MiB;
constexpr size_t WS_HB = WS_W + 2 * W_LAYER;
constexpr size_t WS_AR = WS_HB + 64 * MiB;
constexpr size_t AR_UP = 0, AR_Q = 40 * MiB, AR_K = 72 * MiB, AR_VT = 104 * MiB, AR_Y = 136 * MiB, AR_MIX = 168 * MiB;
constexpr size_t AR_QX = 0, AR_P = 64 * MiB, AR_OX = 128 * MiB, AR_HID = 0;
constexpr size_t WS_END = WS_SSM_SS + 2 * (size_t)T * 64;

constexpr int LDS_BYTES = 155648;
constexpr int LDS_RED = 131072; constexpr int LDS_XB = 131072 + 8192;
constexpr int LDS_RS = 131072 + 8192 + 256, RS_MAX_UNITS = 12;

struct Args { const float* in[36]; float* out; unsigned char* ws; };
typedef const __attribute__((address_space(4))) Args* KArgsP;
#define KARGS() ({ KArgsP _p = (KArgsP)__builtin_amdgcn_kernarg_segment_ptr(); asm volatile("" : "+s"(_p)); _p; })

__device__ __forceinline__ unsigned cvtpk(float lo, float hi) { f32x2 v = {lo, hi}; bf16x2_t b = __builtin_convertvector(v, bf16x2_t); return __builtin_bit_cast(unsigned, b); }
__device__ __forceinline__ float bf2f(bf16_t x) { return __uint_as_float((unsigned)x << 16); }
__device__ __forceinline__ float wave_sum(float v) {
#pragma unroll
    for (int o = 1; o < 64; o <<= 1) v += __shfl_xor(v, o);
    return v;
}
__device__ __forceinline__ float fq_sum(float v) { v += __shfl_xor(v, 16); v += __shfl_xor(v, 32); return v; }
__device__ __forceinline__ float max3f(float a, float b, float c) { float r; asm("v_max3_f32 %0, %1, %2, %3" : "=v"(r) : "v"(a), "v"(b), "v"(c)); return r; }
__device__ __forceinline__ float max2f(float a, float b) { float r; asm("v_max_f32_e32 %0, %1, %2" : "=v"(r) : "v"(a), "v"(b)); return r; }
__device__ __forceinline__ float xl_max(float v) {
    u32x2 r = __builtin_amdgcn_permlane32_swap(__float_as_uint(v), __float_as_uint(v), false, false); v = max2f(__uint_as_float(r[0]), __uint_as_float(r[1]));
    r = __builtin_amdgcn_permlane16_swap(__float_as_uint(v), __float_as_uint(v), false, false); return max2f(__uint_as_float(r[0]), __uint_as_float(r[1]));
}
__device__ __forceinline__ float fq_max(float v) { v = fmaxf(v, __shfl_xor(v, 16)); v = fmaxf(v, __shfl_xor(v, 32)); return v; }
__device__ __forceinline__ u32x4 pack8(f32x4 a, f32x4 b) { u32x4 w; w.x = cvtpk(a[0], a[1]); w.y = cvtpk(a[2], a[3]); w.z = cvtpk(b[0], b[1]); w.w = cvtpk(b[2], b[3]); return w; }
__device__ __forceinline__ float fast_exp2(float x) { return __builtin_amdgcn_exp2f(x); }
__device__ __forceinline__ float fast_rcp(float x) { return __builtin_amdgcn_rcpf(x); }
__device__ __forceinline__ float sigmoidf_(float x) { return fast_rcp(1.f + fast_exp2(-x * LOG2E)); }


__device__ __forceinline__ float ss_sum16(const float* ss16, int row) {
    const f32x4* p = (const f32x4*)(ss16 + (size_t)row * 16); const f32x4 a = p[0], b = p[1], c = p[2], d = p[3];
    return (((a[0] + a[1]) + (a[2] + a[3])) + ((b[0] + b[1]) + (b[2] + b[3]))) + (((c[0] + c[1]) + (c[2] + c[3])) + ((d[0] + d[1]) + (d[2] + d[3])));
}
#define XB_TMO      128
#define XB_XCNT(j)  (256  + 64 * (j))
#define XB_XSUB(j)  (1280 + 64 * (j))
#define XB_XGEN(j)  (2304 + 64 * (j))
#define XB_TOP      3328
#define XB_TOPGEN   3392
#define XCD_BAR_WORDS 3456
#define XB_SPIN_CAP (1u << 22)
__device__ __forceinline__ unsigned xb_ld(unsigned* p)              { return __hip_atomic_load(p, __ATOMIC_RELAXED, __HIP_MEMORY_SCOPE_AGENT); }
__device__ __forceinline__ unsigned xb_add(unsigned* p, unsigned v) { return __hip_atomic_fetch_add(p, v, __ATOMIC_RELAXED, __HIP_MEMORY_SCOPE_AGENT); }
__device__ __forceinline__ unsigned xb_xcc_id() { return (unsigned)__builtin_amdgcn_s_getreg((3 << 11) | 20) & 0xFu; }
#define XB_SPIN(cond, bar) do { unsigned _sp = 0; while (cond) { __builtin_amdgcn_s_sleep(1); \
    if ((++_sp & 255u) == 0u) { if (xb_ld(&(bar)[XB_TMO])) break; if (_sp > XB_SPIN_CAP) { atomicAdd(&(bar)[XB_TMO], 1u); break; } } } } while (0)
struct XcdBarrier { unsigned* bar; unsigned x; volatile LAS unsigned* st; };
__device__ __forceinline__ XcdBarrier xcd_barrier_post(unsigned* bar, volatile LAS unsigned* st) {
    XcdBarrier b; b.bar = bar; b.x = xb_xcc_id(); b.st = st;
    if (threadIdx.x == 0) (void)xb_add(&bar[XB_XCNT(b.x)], 1u);
    return b;
}
__device__ __forceinline__ void xcd_barrier_complete(unsigned* bar, unsigned x, unsigned& nloc, unsigned& nx) {
    const unsigned G = gridDim.x * gridDim.y * gridDim.z;
    unsigned sum, cnt, mine, sp = 0u;
    for (;;) {
        sum = 0u; cnt = 0u; mine = 0u;
#pragma unroll
        for (unsigned j = 0; j < 16; ++j) { const unsigned c = xb_ld(&bar[XB_XCNT(j)]); sum += c; cnt += (c > 0u) ? 1u : 0u; mine = (j == x) ? c : mine; }
        if (sum == G) break;
        __builtin_amdgcn_s_sleep(1);
        if ((++sp & 255u) == 0u) { if (xb_ld(&bar[XB_TMO])) break; if (sp > XB_SPIN_CAP) { atomicAdd(&bar[XB_TMO], 1u); break; } }
    }
    nloc = mine > 0u ? mine : 1u; nx = cnt > 0u ? cnt : 1u;
}
__device__ __forceinline__ void xcd_barrier(const XcdBarrier& b) {
    asm volatile("s_waitcnt vmcnt(0)" ::: "memory");
    __syncthreads();
    if (threadIdx.x == 0) {
        unsigned* bar = b.bar;
        __builtin_amdgcn_s_waitcnt(0);
        unsigned nloc = b.st[0], nx = b.st[1];
        if (nloc == 0u) { xcd_barrier_complete(bar, b.x, nloc, nx); b.st[0] = nloc; b.st[1] = nx; }
        const unsigned old = xb_add(&bar[XB_XSUB(b.x)], 1u);
        const unsigned gen = old / nloc;
        if (old + 1u == (gen + 1u) * nloc) {
            __builtin_amdgcn_fence(__ATOMIC_RELEASE, "agent");
            asm volatile("s_waitcnt vmcnt(0)" ::: "memory");
            const unsigned og = xb_add(&bar[XB_TOP], 1u);
            const unsigned tg = og / nx;
            if (og + 1u == (tg + 1u) * nx) xb_add(&bar[XB_TOPGEN], 1u);
            else XB_SPIN(xb_ld(&bar[XB_TOPGEN]) == tg, bar);
            __builtin_amdgcn_fence(__ATOMIC_ACQUIRE, "agent");
            xb_add(&bar[XB_XGEN(b.x)], 1u);
            asm volatile("s_waitcnt vmcnt(0)" ::: "memory");
        } else {
            XB_SPIN(xb_ld(&bar[XB_XGEN(b.x)]) == gen, bar);
            __builtin_amdgcn_fence(__ATOMIC_ACQUIRE, "agent");
            asm volatile("s_waitcnt vmcnt(0)" ::: "memory");
        }
    }
    __syncthreads();
}

constexpr int BM = 256, BK = 64, HALF = 128, HTB = HALF * BK * 2, NXCD = 8, WGM = 8;
__host__ __device__ __forceinline__ int lds_byte(int r, int c) { const int st = (r >> 4) * 2 + (c >> 5), rr = r & 15, cc = c & 31, ob = rr * 64 + cc * 2; return st * 1024 + (ob ^ (((ob >> 9) & 1) << 5)); }
__host__ __device__ __forceinline__ void stage_rc(int b, int& R, int& C) { const int st = b / 1024, sb = b % 1024, swz = sb ^ (((sb >> 9) & 1) << 5); R = (st >> 1) * 16 + swz / 64; C = (st & 1) * 32 + (swz % 64) / 2; }
__host__ __device__ __forceinline__ int perm32(int rho) { const int n = rho >> 4, i = rho & 15; return 8 * (i >> 2) + 4 * n + (i & 3); }

struct Unit { int pm, pn, bz, ui; unsigned a_off, b_off; };

struct StdSched {
    int nM, nN, nwg, G, c, lda, ldb;
    __device__ void init(int M, int N, int G_, int c_, int lda_, int ldb_) { nM = M / BM; nN = N / BM; nwg = nM * nN; G = G_; c = c_; lda = lda_; ldb = ldb_; }
    __device__ bool next(int i, Unit& u) const {
        const long L = (long)i * G + c; if (L >= nwg) return false;
        int wgid = (int)L; { const int q = nwg / NXCD, r = nwg % NXCD, xcd = wgid % NXCD, off = wgid / NXCD; wgid = (xcd < r ? xcd * (q + 1) : r * (q + 1) + (xcd - r) * q) + off; }
        const int nig = WGM * nN, gid = wgid / nig, fm = gid * WGM, gsz = (nM - fm) < WGM ? (nM - fm) : WGM;
        u.pm = fm + ((wgid % nig) % gsz); u.pn = (wgid % nig) / gsz; u.bz = 0;
        u.a_off = (unsigned)(u.pm * BM) * (unsigned)lda; u.b_off = (unsigned)(u.pn * BM) * (unsigned)ldb; return true;
    }
};
struct Ssm1Sched {
    int c;
    __device__ bool next(int i, Unit& u) const {
        if (i > 0 || c >= BATCH * NG) return false;
        u.pm = 0; u.pn = 0; u.bz = c; u.a_off = (unsigned)c * NCH * UPW; u.b_off = (unsigned)(c & 31) * 256 * 512; return true;
    }
};
struct WkvSched {
    int G, c;
    __device__ bool next(int i, Unit& u) const {
        if (c < 128) return false;
        const int L = (c - 128) + i * (G - 128); if (L >= 64) return false;
        const int layer = L >> 5, rem = L & 31; u.pm = rem >> 3; u.pn = rem & 7; u.bz = layer;
        u.a_off = (unsigned)layer * 1024 * 1024 + (unsigned)u.pm * 256 * 1024; u.b_off = (unsigned)layer * (unsigned)(W_LAYER / 2) + (unsigned)u.pn * 256 * 1024; return true;
    }
};
struct Ssm2Sched {
    int G, c;
    __device__ bool next(int i, Unit& u) const {
        const int L = c + i * G; if (L >= 2 * BATCH * NG) return false;
        u.bz = L >> 1; u.pn = L & 1; u.pm = 0; u.a_off = (unsigned)u.bz * NCH * UPW; u.b_off = ((unsigned)(u.bz & 31) * 512 + (unsigned)u.pn * 256) * UPW; return true;
    }
};
struct XaSched {
    int G, c; unsigned bs_b, bs_h;
    __device__ bool next(int i, Unit& u) const {
        const int L = c + i * G; if (L >= 512) return false;
        const int bh = L >> 5; u.pm = L & 31; u.pn = 0; u.bz = bh; const int b = bh >> 2, h = bh & 3;
        u.a_off = ((unsigned)(b * SEQ + u.pm * 256)) * 1024 + h * 256; u.b_off = (unsigned)b * bs_b + (unsigned)h * bs_h; return true;
    }
};

template <class Epi, class Sched, bool ALIGN_EPI>
__device__ __forceinline__ void gemm_phase(LAS unsigned char* lds, const bf16_t* Ab, const bf16_t* Bb, int lda, int ldb, int K, const Sched& S, Epi& E) {
    int tid = threadIdx.x; asm volatile("" : "+v"(tid));
    const int wid = __builtin_amdgcn_readfirstlane(tid >> 6), lane = tid & 63, wr = wid >> 2, wc = wid & 3, fr = lane & 15, fq = lane >> 4;
    const int nt = K / BK;
    unsigned voffA[2], voffB[2]; int aoff, boff;
#define PG8_LANEOFFS(tt) do { _Pragma("unroll") for (int i = 0; i < 2; ++i) { int R, C; stage_rc((tt) * 16 + i * 8192, R, C); const int Rb = (R & ~31) + perm32(R & 31); \
        voffA[i] = (unsigned)(R * lda + C) * 2u; voffB[i] = (unsigned)(Rb * ldb + C) * 2u; } \
        aoff = lds_byte(wr * 64 + ((tt) & 15), (((tt) >> 4) & 3) * 8); boff = lds_byte(wc * 32 + ((tt) & 15), (((tt) >> 4) & 3) * 8); } while (0)
    PG8_LANEOFFS(tid);
    const unsigned kstep = (unsigned)(BK * 2);
    const unsigned hstepA = (unsigned)HALF * lda * 2, hstepB = (unsigned)HALF * ldb * 2;
    const unsigned ldsw = (unsigned)wid * 1024u;
#define PG8_SA(b, h) (((b) * 2 + (h)) * HTB)
#define PG8_SB(b, h) ((4 + (b) * 2 + (h)) * HTB)
#define PG8_STAGE(bufoff, gbase, voff) do { _Pragma("unroll") for (int _i = 0; _i < 2; ++_i) \
        __builtin_amdgcn_global_load_lds((const unsigned*)((const char*)(gbase) + (voff)[_i]), (LAS unsigned*)(lds + (bufoff) + ldsw + _i * 8192), 16, 0, 0); } while (0)
#define PG8_LDA(dst, b, h) do { _Pragma("unroll") for (int m = 0; m < 4; ++m) _Pragma("unroll") for (int k = 0; k < 2; ++k) dst[m][k] = *(const LAS bf16x8*)(lds + PG8_SA(b, h) + aoff + m * 2048 + k * 1024); } while (0)
#define PG8_LDB(dst, b, h) do { _Pragma("unroll") for (int n = 0; n < 2; ++n) _Pragma("unroll") for (int k = 0; k < 2; ++k) dst[n][k] = *(const LAS bf16x8*)(lds + PG8_SB(b, h) + boff + n * 2048 + k * 1024); } while (0)
#define PG8_MMA(ai, bj, At, Bt) do { __builtin_amdgcn_s_setprio(1); _Pragma("unroll") for (int m = 0; m < 4; ++m) _Pragma("unroll") for (int n = 0; n < 2; ++n) _Pragma("unroll") for (int k = 0; k < 2; ++k) \
        acc[ai][bj][m][n] = __builtin_amdgcn_mfma_f32_16x16x32_bf16(Bt[n][k], At[m][k], acc[ai][bj][m][n], 0, 0, 0); __builtin_amdgcn_s_setprio(0); } while (0)
#define PG8_WAIT_V(n) asm volatile("s_waitcnt vmcnt(" #n ")" ::: "memory")
#define PG8_WAIT_L(n) asm volatile("s_waitcnt lgkmcnt(" #n ")" ::: "memory")
#define PG8_BAR __builtin_amdgcn_s_barrier()
#define PG8_SCHED __builtin_amdgcn_sched_barrier(0)
    Unit cur, nxt; int ui = 0;
    if (!S.next(0, cur)) return;
    cur.ui = 0;
    if constexpr (Epi::HAS_RS) {
        LAS float* rst = (LAS float*)(lds + LDS_RS);
        for (int i = (tid >> 8); i < RS_MAX_UNITS; i += 2) { Unit uu; if (!S.next(i, uu)) break; const int row = uu.pm * 256 + (tid & 255); rst[i * 256 + (tid & 255)] = rsqrtf(ss_sum16(E.ss, row) * (1.f / D) + EPS); }
        __syncthreads();
    }
    f32x4 acc[2][2][4][2];
#pragma unroll
    for (int a = 0; a < 2; ++a)
#pragma unroll
        for (int b = 0; b < 2; ++b)
#pragma unroll
            for (int m = 0; m < 4; ++m)
#pragma unroll
                for (int n = 0; n < 2; ++n) acc[a][b][m][n] = (f32x4){0.f, 0.f, 0.f, 0.f};
    bf16x8 At[4][2], B0[2][2], B1[2][2];
    const char* cA = (const char*)(Ab + cur.a_off); const char* cB = (const char*)(Bb + cur.b_off);
    PG8_STAGE(PG8_SB(0, 0), cB, voffB); PG8_STAGE(PG8_SB(0, 1), cB + hstepB, voffB); PG8_STAGE(PG8_SA(0, 0), cA, voffA); PG8_STAGE(PG8_SA(0, 1), cA + hstepA, voffA);
    if (wr == 1) PG8_BAR;
    PG8_WAIT_V(2); PG8_BAR;
    PG8_STAGE(PG8_SB(1, 0), cB + kstep, voffB); PG8_STAGE(PG8_SA(1, 0), cA + kstep, voffA); PG8_STAGE(PG8_SB(1, 1), cB + hstepB + kstep, voffB);
    PG8_WAIT_V(6); PG8_BAR;
    for (;;) {
        const bool has_next = S.next(ui + 1, nxt); nxt.ui = ui + 1;
        const char* nA = has_next ? (const char*)(Ab + nxt.a_off) : cA; const char* nB = has_next ? (const char*)(Bb + nxt.b_off) : cB;
        for (int t = 0; t < nt; t += 2) {
            const bool last = (t == nt - 2);
            const char* a1 = cA + (unsigned)(t + 1) * kstep;
            const char* a2 = last ? nA : cA + (unsigned)(t + 2) * kstep; const char* b2 = last ? nB : cB + (unsigned)(t + 2) * kstep;
            const char* a3 = a2 + kstep; const char* b3 = b2 + kstep;
            PG8_LDB(B0, 0, 0); PG8_LDB(B1, 0, 1); PG8_SCHED; PG8_LDA(At, 0, 0); PG8_STAGE(PG8_SA(1, 1), a1 + hstepA, voffA);
            PG8_WAIT_V(8); PG8_WAIT_L(0); PG8_BAR; PG8_MMA(0, 0, At, B0); PG8_MMA(0, 1, At, B1); PG8_BAR; PG8_SCHED;
            PG8_LDA(At, 0, 1); PG8_STAGE(PG8_SB(0, 0), b2, voffB); PG8_STAGE(PG8_SB(0, 1), b2 + hstepB, voffB); PG8_STAGE(PG8_SA(0, 0), a2, voffA);
            PG8_WAIT_V(8); PG8_WAIT_L(0); PG8_BAR; PG8_MMA(1, 0, At, B0); PG8_MMA(1, 1, At, B1); PG8_BAR; PG8_SCHED;
            PG8_LDB(B0, 1, 0); PG8_LDB(B1, 1, 1); PG8_SCHED; PG8_LDA(At, 1, 0); PG8_STAGE(PG8_SA(0, 1), a2 + hstepA, voffA);
            PG8_WAIT_V(8); PG8_WAIT_L(0); PG8_BAR; PG8_MMA(0, 0, At, B0); PG8_MMA(0, 1, At, B1); PG8_BAR; PG8_SCHED;
            PG8_LDA(At, 1, 1); PG8_STAGE(PG8_SB(1, 0), b3, voffB); PG8_STAGE(PG8_SB(1, 1), b3 + hstepB, voffB); PG8_STAGE(PG8_SA(1, 0), a3, voffA);
            PG8_WAIT_V(8); PG8_WAIT_L(0); PG8_BAR; PG8_MMA(1, 0, At, B0); PG8_MMA(1, 1, At, B1); PG8_BAR; PG8_SCHED;
        }
        if constexpr (ALIGN_EPI) { if (wr == 0) PG8_BAR; }
        if constexpr (!Epi::AFTER_DRAIN) { int t2 = threadIdx.x; asm volatile("" : "+v"(t2)); E(acc, cur, wr, wc, t2 & 15, (t2 >> 4) & 3); }
        if (!has_next) break;
#pragma unroll
        for (int a = 0; a < 2; ++a)
#pragma unroll
            for (int b = 0; b < 2; ++b)
#pragma unroll
                for (int m = 0; m < 4; ++m)
#pragma unroll
                    for (int n = 0; n < 2; ++n) acc[a][b][m][n] = (f32x4){0.f, 0.f, 0.f, 0.f};
        cur = nxt; cA = nA; cB = nB; ++ui;
        { int t3 = threadIdx.x; asm volatile("" : "+v"(t3)); PG8_LANEOFFS(t3); }
        if constexpr (ALIGN_EPI) { if (wr == 1) PG8_BAR; }
    }
    PG8_WAIT_V(0);
    if constexpr (!ALIGN_EPI) { if (wr == 0) PG8_BAR; }
    PG8_BAR;
    if constexpr (Epi::AFTER_DRAIN) { E.fused(acc, cur, wr, wc, fr, fq, lds, wid, lane); }
#undef PG8_LANEOFFS
#undef PG8_SA
#undef PG8_SB
#undef PG8_STAGE
#undef PG8_LDA
#undef PG8_LDB
#undef PG8_MMA
#undef PG8_WAIT_V
#undef PG8_WAIT_L
#undef PG8_BAR
#undef PG8_SCHED
}

typedef f32x4 (&AccRef)[2][2][4][2];

struct EpiFfnUp {
    static constexpr bool AFTER_DRAIN = false, HAS_RS = true;
    bf16_t* H; const float* ss; const LAS float* rst;
    __device__ __forceinline__ void operator()(AccRef acc, const Unit& u, int wr, int wc, int fr, int fq) const {
#pragma unroll
        for (int ai = 0; ai < 2; ++ai)
#pragma unroll
            for (int m = 0; m < 4; ++m) {
                const int row = u.pm * 256 + ai * 128 + wr * 64 + m * 16 + fr;
                const float rs = rst[u.ui * 256 + ai * 128 + wr * 64 + m * 16 + fr];
                f32x4 o[2];
#pragma unroll
                for (int n = 0; n < 2; ++n)
#pragma unroll
                    for (int j = 0; j < 4; ++j) { const float g = acc[ai][0][m][n][j] * rs, up = acc[ai][1][m][n][j] * rs; o[n][j] = g * sigmoidf_(g) * up; }
                *(u32x4*)(H + (size_t)row * FF + u.pn * 128 + wc * 32 + 8 * fq) = pack8(o[0], o[1]);
            }
    }
};
struct EpiResid {
    static constexpr bool AFTER_DRAIN = false, HAS_RS = false;
    bf16_t* hb; float* ssn; float scale;
    __device__ __forceinline__ void operator()(AccRef acc, const Unit& u, int wr, int wc, int fr, int fq) const {
#pragma unroll
        for (int ai = 0; ai < 2; ++ai) {
            u32x4 ow[4][2];
#pragma unroll
            for (int m = 0; m < 4; ++m)
#pragma unroll
                for (int bj = 0; bj < 2; ++bj)
                    ow[m][bj] = *(const u32x4*)(hb + (size_t)(u.pm * 256 + ai * 128 + wr * 64 + m * 16 + fr) * D + u.pn * 256 + bj * 128 + wc * 32 + 8 * fq);
            __builtin_amdgcn_sched_barrier(0);
#pragma unroll
            for (int m = 0; m < 4; ++m) {
                const int row = u.pm * 256 + ai * 128 + wr * 64 + m * 16 + fr; float part = 0.f;
#pragma unroll
                for (int bj = 0; bj < 2; ++bj) {
                    const size_t idx = (size_t)row * D + u.pn * 256 + bj * 128 + wc * 32 + 8 * fq;
                    const u32x4 o4 = ow[m][bj];
                    f32x4 v0, v1;
                    v0[0] = __uint_as_float(o4.x << 16); v0[1] = __uint_as_float(o4.x & 0xffff0000u); v0[2] = __uint_as_float(o4.y << 16); v0[3] = __uint_as_float(o4.y & 0xffff0000u);
                    v1[0] = __uint_as_float(o4.z << 16); v1[1] = __uint_as_float(o4.z & 0xffff0000u); v1[2] = __uint_as_float(o4.w << 16); v1[3] = __uint_as_float(o4.w & 0xffff0000u);
                    v0 = v0 + acc[ai][bj][m][0] * scale; v1 = v1 + acc[ai][bj][m][1] * scale;
                    *(u32x4*)(hb + idx) = pack8(v0, v1);
                    part += (v0[0] * v0[0] + v0[1] * v0[1]) + (v0[2] * v0[2] + v0[3] * v0[3]) + (v1[0] * v1[0] + v1[1] * v1[1]) + (v1[2] * v1[2] + v1[3] * v1[3]);
                }
                part = fq_sum(part);
                if (fq == 0) ssn[(size_t)row * 16 + u.pn * 4 + wc] = part;
            }
            __builtin_amdgcn_sched_barrier(0);
        }
    }
};
struct EpiWin {
    static constexpr bool AFTER_DRAIN = false, HAS_RS = true;
    unsigned char* arp; const float* ss; const LAS float* rst;
    __device__ __forceinline__ void operator()(AccRef acc, const Unit& u, int wr, int wc, int fr, int fq) const {
        bf16_t* up = (bf16_t*)(arp + AR_UP); bf16_t* qb = (bf16_t*)(arp + AR_Q); bf16_t* kb = (bf16_t*)(arp + AR_K); bf16_t* vt = (bf16_t*)(arp + AR_VT);
        const int sel = u.pn >> 1;
#pragma unroll
        for (int ai = 0; ai < 2; ++ai)
#pragma unroll
            for (int m = 0; m < 4; ++m) {
                const int row = u.pm * 256 + ai * 128 + wr * 64 + m * 16 + fr;
                float rs = rst[u.ui * 256 + ai * 128 + wr * 64 + m * 16 + fr];
                if (sel == 1) rs *= 0.125f * LOG2E;
                const int b = row >> 13, t = row & (SEQ - 1);
#pragma unroll
                for (int bj = 0; bj < 2; ++bj) {
                    const int c = (u.pn & 1) * 256 + bj * 128 + wc * 32 + 8 * fq;
                    const f32x4 v0 = acc[ai][bj][m][0] * rs, v1 = acc[ai][bj][m][1] * rs;
                    if (sel == 0) { const int g = c >> 4, hi0 = c & 15;
                        *(u32x4*)(up + ((size_t)((b * NG + g) * NCH + (t >> 5))) * UPW + (t & 31) * 16 + hi0) = pack8(v0, v1);
                    } else if (sel == 1) { *(u32x4*)(qb + (size_t)row * 512 + c) = pack8(v0, v1);
                    } else if (sel == 2) { *(u32x4*)(kb + (size_t)row * 512 + c) = pack8(v0, v1);
                    } else { const int h = c >> 7, dv = c & 127; bf16_t* p = vt + ((size_t)((b * 4 + h) * 128 + dv)) * SEQ + t;
                        const u32x4 w = pack8(v0, v1);
                        p[0] = (bf16_t)(w.x & 0xffff); p[SEQ] = (bf16_t)(w.x >> 16); p[2 * SEQ] = (bf16_t)(w.y & 0xffff); p[3 * SEQ] = (bf16_t)(w.y >> 16);
                        p[4 * SEQ] = (bf16_t)(w.z & 0xffff); p[5 * SEQ] = (bf16_t)(w.z >> 16); p[6 * SEQ] = (bf16_t)(w.w & 0xffff); p[7 * SEQ] = (bf16_t)(w.w >> 16);
                    }
                }
            }
    }
};
__device__ __forceinline__ float gelu_tanh(float x) { const float z = 0.7978845608028654f * (x + 0.044715f * x * x * x); return x * fast_rcp(1.f + fast_exp2(-2.f * LOG2E * z)); }
struct EpiSsm2 {
    static constexpr bool AFTER_DRAIN = false, HAS_RS = false;
    bf16_t* yb;
    __device__ __forceinline__ void operator()(AccRef acc, const Unit& u, int wr, int wc, int fr, int fq) const {
        const int b = u.bz >> 5, g = u.bz & 31;
#pragma unroll
        for (int ai = 0; ai < 2; ++ai)
#pragma unroll
            for (int m = 0; m < 4; ++m) {
                const int ch = ai * 128 + wr * 64 + m * 16 + fr;
#pragma unroll
                for (int bj = 0; bj < 2; ++bj) {
                    const int cc = u.pn * 256 + bj * 128 + wc * 32 + 8 * fq, t = cc >> 4, ho0 = cc & 15;
                    f32x4 v0, v1;
#pragma unroll
                    for (int j = 0; j < 4; ++j) { v0[j] = gelu_tanh(acc[ai][bj][m][0][j]); v1[j] = gelu_tanh(acc[ai][bj][m][1][j]); }
                    *(u32x4*)(yb + ((size_t)(b * SEQ + ch * CH + t)) * 512 + g * 16 + ho0) = pack8(v0, v1);
                }
            }
    }
};
struct EpiGlu {
    static constexpr bool AFTER_DRAIN = false, HAS_RS = false;
    bf16_t* mix; const float* bglu; float* ssq;
    __device__ __forceinline__ void operator()(AccRef acc, const Unit& u, int wr, int wc, int fr, int fq) const {
        const int c0 = u.pn * 128 + wc * 32 + 8 * fq;
        const f32x4 bv0 = *(const f32x4*)(bglu + c0), bv1 = *(const f32x4*)(bglu + c0 + 4), bg0 = *(const f32x4*)(bglu + 512 + c0), bg1 = *(const f32x4*)(bglu + 512 + c0 + 4);
#pragma unroll
        for (int ai = 0; ai < 2; ++ai)
#pragma unroll
            for (int m = 0; m < 4; ++m) {
                const int row = u.pm * 256 + ai * 128 + wr * 64 + m * 16 + fr;
                f32x4 o0, o1; float part = 0.f;
#pragma unroll
                for (int j = 0; j < 4; ++j) {
                    o0[j] = (acc[ai][0][m][0][j] + bv0[j]) * sigmoidf_(acc[ai][1][m][0][j] + bg0[j]);
                    o1[j] = (acc[ai][0][m][1][j] + bv1[j]) * sigmoidf_(acc[ai][1][m][1][j] + bg1[j]);
                    part += o0[j] * o0[j] + o1[j] * o1[j];
                }
                *(u32x4*)(mix + (size_t)row * D + c0) = pack8(o0, o1);
                part = fq_sum(part);
                if (fq == 0) ssq[(size_t)row * 16 + u.pn * 4 + wc] = part;
            }
    }
};
struct EpiWq {
    static constexpr bool AFTER_DRAIN = false, HAS_RS = true;
    bf16_t* O; const float* ss; float mul; const LAS float* rst;
    __device__ __forceinline__ void operator()(AccRef acc, const Unit& u, int wr, int wc, int fr, int fq) const {
#pragma unroll
        for (int ai = 0; ai < 2; ++ai)
#pragma unroll
            for (int m = 0; m < 4; ++m) {
                const int row = u.pm * 256 + ai * 128 + wr * 64 + m * 16 + fr;
                const float rs = rst[u.ui * 256 + ai * 128 + wr * 64 + m * 16 + fr] * mul;
#pragma unroll
                for (int bj = 0; bj < 2; ++bj)
                    *(u32x4*)(O + (size_t)row * D + u.pn * 256 + bj * 128 + wc * 32 + 8 * fq) = pack8(acc[ai][bj][m][0] * rs, acc[ai][bj][m][1] * rs);
            }
    }
};
struct EpiWkv {
    static constexpr bool AFTER_DRAIN = false, HAS_RS = false;
    bf16_t *kx, *vxt;
    __device__ __forceinline__ void operator()(AccRef acc, const Unit& u, int wr, int wc, int fr, int fq) const {
        const size_t lo = (size_t)u.bz * 1024 * 1024;
#pragma unroll
        for (int ai = 0; ai < 2; ++ai)
#pragma unroll
            for (int m = 0; m < 4; ++m) {
                const int row = u.pm * 256 + ai * 128 + wr * 64 + m * 16 + fr;
#pragma unroll
                for (int bj = 0; bj < 2; ++bj) {
                    const int col = u.pn * 256 + bj * 128 + wc * 32 + 8 * fq;
                    const u32x4 w = pack8(acc[ai][bj][m][0], acc[ai][bj][m][1]);
                    if (u.pn < 4) *(u32x4*)(kx + lo + (size_t)row * 1024 + col) = w;
                    else { const int c2 = col - 1024, h = c2 >> 8, d = c2 & 255, b = row >> 8, mm = row & 255;
                        bf16_t* p = vxt + lo + ((size_t)((b * 4 + h) * 256 + d)) * 256 + mm;
                        p[0] = (bf16_t)(w.x & 0xffff); p[256] = (bf16_t)(w.x >> 16); p[512] = (bf16_t)(w.y & 0xffff); p[768] = (bf16_t)(w.y >> 16);
                        p[1024] = (bf16_t)(w.z & 0xffff); p[1280] = (bf16_t)(w.z >> 16); p[1536] = (bf16_t)(w.w & 0xffff); p[1792] = (bf16_t)(w.w >> 16); }
                }
            }
    }
};
struct EpiSoftmax {
    static constexpr bool AFTER_DRAIN = false, HAS_RS = false;
    bf16_t* P; LAS float* red;
    __device__ __forceinline__ void operator()(AccRef acc, const Unit& u, int wr, int wc, int fr, int fq) const {
        const int b = u.bz >> 2, h = u.bz & 3;
        float mx[2][4];
#pragma unroll
        for (int ai = 0; ai < 2; ++ai)
#pragma unroll
            for (int m = 0; m < 4; ++m) {
                float v = -INFINITY;
#pragma unroll
                for (int bj = 0; bj < 2; ++bj)
#pragma unroll
                    for (int n = 0; n < 2; ++n)
#pragma unroll
                        for (int j = 0; j < 4; ++j) v = fmaxf(v, acc[ai][bj][m][n][j]);
                v = fq_max(v);
                const int rl = ai * 128 + wr * 64 + m * 16 + fr;
                if (fq == 0) red[rl * 4 + wc] = v;
            }
        asm volatile("s_waitcnt lgkmcnt(0)" ::: "memory"); __builtin_amdgcn_s_barrier(); asm volatile("" ::: "memory");
#pragma unroll
        for (int ai = 0; ai < 2; ++ai)
#pragma unroll
            for (int m = 0; m < 4; ++m) {
                const int rl = ai * 128 + wr * 64 + m * 16 + fr;
                const f32x4 r4 = *(const LAS f32x4*)(red + rl * 4);
                const float M = fmaxf(fmaxf(r4[0], r4[1]), fmaxf(r4[2], r4[3]));
                float s = 0.f;
#pragma unroll
                for (int bj = 0; bj < 2; ++bj)
#pragma unroll
                    for (int n = 0; n < 2; ++n)
#pragma unroll
                        for (int j = 0; j < 4; ++j) { const float p = fast_exp2(acc[ai][bj][m][n][j] - M); acc[ai][bj][m][n][j] = p; s += p; }
                s = fq_sum(s);
                if (fq == 0) red[1024 + rl * 4 + wc] = s;
            }
        asm volatile("s_waitcnt lgkmcnt(0)" ::: "memory"); __builtin_amdgcn_s_barrier(); asm volatile("" ::: "memory");
#pragma unroll
        for (int ai = 0; ai < 2; ++ai)
#pragma unroll
            for (int m = 0; m < 4; ++m) {
                const int rl = ai * 128 + wr * 64 + m * 16 + fr;
                const f32x4 r4 = *(const LAS f32x4*)(red + 1024 + rl * 4);
                const float inv = 1.f / ((r4[0] + r4[1]) + (r4[2] + r4[3]));
                const size_t row = (size_t)b * SEQ + u.pm * 256 + rl;
#pragma unroll
                for (int bj = 0; bj < 2; ++bj)
                    *(u32x4*)(P + row * D + h * 256 + bj * 128 + wc * 32 + 8 * fq) = pack8(acc[ai][bj][m][0] * inv, acc[ai][bj][m][1] * inv);
            }
    }
};
struct EpiNull {
    static constexpr bool AFTER_DRAIN = false, HAS_RS = false;
    float* sink;
    __device__ __forceinline__ void operator()(AccRef acc, const Unit& u, int wr, int wc, int fr, int fq) const {
        float t = 0.f;
#pragma unroll
        for (int ai = 0; ai < 2; ++ai)
#pragma unroll
            for (int bj = 0; bj < 2; ++bj)
#pragma unroll
                for (int m = 0; m < 4; ++m)
#pragma unroll
                    for (int n = 0; n < 2; ++n) t += acc[ai][bj][m][n][0] + acc[ai][bj][m][n][1] + acc[ai][bj][m][n][2] + acc[ai][bj][m][n][3];
        if (t == 12345.678f) sink[u.pm] = t;
    }
};
struct EpiPV {
    static constexpr bool AFTER_DRAIN = false, HAS_RS = false;
    bf16_t* O;
    __device__ __forceinline__ void operator()(AccRef acc, const Unit& u, int wr, int wc, int fr, int fq) const {
        const int b = u.bz >> 2, h = u.bz & 3;
#pragma unroll
        for (int ai = 0; ai < 2; ++ai)
#pragma unroll
            for (int m = 0; m < 4; ++m) {
                const size_t row = (size_t)b * SEQ + u.pm * 256 + ai * 128 + wr * 64 + m * 16 + fr;
#pragma unroll
                for (int bj = 0; bj < 2; ++bj)
                    *(u32x4*)(O + row * D + h * 256 + bj * 128 + wc * 32 + 8 * fq) = pack8(acc[ai][bj][m][0], acc[ai][bj][m][1]);
            }
    }
};
struct EpiSsm1 {
    static constexpr bool AFTER_DRAIN = true, HAS_RS = false;
    bf16_t* up; const float *lam_re, *lam_im, *log_dt;
    __device__ __forceinline__ void operator()(AccRef, const Unit&, int, int, int, int) const {}
    __device__ __forceinline__ void fused(AccRef acc, const Unit& u, int wr, int wc, int fr, int fq, LAS unsigned char* lds, int wid, int lane) const {
        LAS float* L = (LAS float*)lds;
#pragma unroll
        for (int ai = 0; ai < 2; ++ai)
#pragma unroll
            for (int m = 0; m < 4; ++m) {
                const int rl = ai * 128 + wr * 64 + m * 16 + fr;
#pragma unroll
                for (int n = 0; n < 2; ++n) { const int col = wc * 32 + 8 * fq + 4 * n; *(LAS f32x4*)(L + rl * 128 + (col ^ ((rl & 15) << 3))) = acc[ai][0][m][n]; }
            }
        __syncthreads();
        if (wid == 0) {
            const int g = u.bz & 31, p = lane;
            const float dt = expf(log_dt[g]) * (float)CH;
            const float lr = fminf(lam_re[g * NP + p], -1e-4f), li = lam_im[g * NP + p];
            const float mag = expf(lr * dt); float sn, cs; sincosf(li * dt, &sn, &cs);
            const float ar = mag * cs, aim = mag * sn;
            float xr = 0.f, xi = 0.f;
            unsigned* dst = (unsigned*)(up + (size_t)u.bz * NCH * UPW + 512) + p;
            for (int c = 0; c < NCH; ++c) {
                dst[(size_t)c * (UPW / 2)] = cvtpk(xr, xi);
                const f32x2 l2 = *(const LAS f32x2*)(L + c * 128 + ((2 * p) ^ ((c & 15) << 3)));
                const float nr = ar * xr - aim * xi + l2[0], ni = ar * xi + aim * xr + l2[1];
                xr = nr; xi = ni;
            }
        }
        __syncthreads();
    }
};

struct GainSpec { const float* g1; const float* g2; float g2s; };
__device__ __forceinline__ float gain_of(const GainSpec& gs, int k) {
    if (!gs.g1) return 1.f;
    if (gs.g2 && k >= 512) return gs.g2[(k - 512) & 127] * gs.g2s;
    return gs.g1[k];
}
__device__ __forceinline__ void transpose_item(const float* W, int K, int N, bf16_t* WT, bool il, int nh, int hb, const GainSpec gs, LAS float* scr, int item, int lane) {
    const int nblk = N / 32, kb = item / nblk, nb = item % nblk, k0 = 64 * kb, n0 = 32 * nb;
    float tv[32];
#pragma unroll
    for (int i = 0; i < 32; ++i) { const int kk = 2 * i + (lane >> 5); tv[i] = W[(size_t)(k0 + kk) * N + n0 + (lane & 31)]; }
#pragma unroll
    for (int i = 0; i < 32; ++i) { const int kk = 2 * i + (lane >> 5); scr[kk * 33 + (lane & 31)] = tv[i] * gain_of(gs, k0 + kk); }
    asm volatile("s_waitcnt lgkmcnt(0)" ::: "memory");
    const int c = lane & 7;
#pragma unroll
    for (int j = 0; j < 4; ++j) { const int n = (lane >> 3) + 8 * j; const LAS float* s = scr + (8 * c) * 33 + n;
        u32x4 o; o.x = cvtpk(s[0 * 33], s[1 * 33]); o.y = cvtpk(s[2 * 33], s[3 * 33]); o.z = cvtpk(s[4 * 33], s[5 * 33]); o.w = cvtpk(s[6 * 33], s[7 * 33]);
        int row = n0 + n; if (il) { const int jj = row % nh, half = hb + row / nh; row = (jj >> 7) * 256 + half * 128 + (jj & 127); }
        *(u32x4*)(WT + (size_t)row * K + k0 + 8 * c) = o; }
    asm volatile("s_waitcnt lgkmcnt(0)" ::: "memory");
}

__device__ __forceinline__ void ssm_matrices(KArgsP a, int l, int g, LAS unsigned char* lds, bf16_t* Bm, bf16_t* Mt) {
    int tid = threadIdx.x; asm volatile("" : "+v"(tid));
    LAS f32x2* lamtab = (LAS f32x2*)lds;
    LAS f32x2* cc = (LAS f32x2*)(lds + 16896);
    LAS f32x2* bb = (LAS f32x2*)(lds + 16896 + 8192);
    LAS float* Kt = (LAS float*)(lds + 16896 + 16384);
    const float* lam_re = a->in[9] + (size_t)(l * NG + g) * NP; const float* lam_im = a->in[10] + (size_t)(l * NG + g) * NP;
    const float* b_re = a->in[11] + (size_t)(l * NG + g) * NP * 16; const float* b_im = a->in[12] + (size_t)(l * NG + g) * NP * 16;
    const float* c_re = a->in[13] + (size_t)(l * NG + g) * 16 * NP; const float* c_im = a->in[14] + (size_t)(l * NG + g) * 16 * NP;
    const float* dd = a->in[15] + (size_t)(l * NG + g) * 16;
    const float dt = expf(a->in[16][l * NG + g]);
    for (int idx = tid; idx < 33 * 64; idx += 512) { const int tau = idx >> 6, p = idx & 63;
        const float lr = fminf(lam_re[p], -1e-4f), li = lam_im[p]; const float zr = lr * dt * (float)tau, zi = li * dt * (float)tau;
        const float mag = expf(zr); float sn, cs; sincosf(zi, &sn, &cs); lamtab[idx] = (f32x2){mag * cs, mag * sn}; }
    for (int idx = tid; idx < 1024; idx += 512) {
        cc[idx] = (f32x2){c_re[idx], c_im[idx]};
        const int p = idx >> 4;
        const float lr = fminf(lam_re[p], -1e-4f), li = lam_im[p]; const float mag = expf(lr * dt); float sn, cs; sincosf(li * dt, &sn, &cs);
        const float ar = mag * cs - 1.f, ai = mag * sn, den = 1.f / (lr * lr + li * li);
        const float qr = (ar * lr + ai * li) * den, qi = (ai * lr - ar * li) * den;
        const float br = b_re[idx], bi = b_im[idx];
        bb[idx] = (f32x2){qr * br - qi * bi, qr * bi + qi * br};
    }
    __syncthreads();
    for (int idx = tid; idx < 32 * 256; idx += 512) { const int tau = idx >> 8, ho = (idx >> 4) & 15, hi = idx & 15; float s = 0.f;
        for (int p = 0; p < NP; ++p) { const f32x2 c = cc[ho * 64 + p], lm = lamtab[tau * 64 + p], b = bb[p * 16 + hi];
            const float wr_ = c[0] * lm[0] - c[1] * lm[1], wi_ = c[0] * lm[1] + c[1] * lm[0]; s += wr_ * b[0] - wi_ * b[1]; }
        if (tau == 0 && ho == hi) s += dd[ho];
        Kt[idx] = s; }
    __syncthreads();
    for (int ch = tid; ch < 512 * 80; ch += 512) { const int n = ch / 80, kc = ch % 80, t = n >> 4, ho = n & 15, k0 = kc * 8; float v[8];
        if (k0 < 512) { const int s = k0 >> 4, hi0 = k0 & 15;
#pragma unroll
            for (int j = 0; j < 8; ++j) v[j] = (s <= t) ? Kt[(t - s) * 256 + ho * 16 + hi0 + j] : 0.f;
        } else { const int p0 = (k0 - 512) >> 1;
#pragma unroll
            for (int j = 0; j < 4; ++j) { const f32x2 c = cc[ho * 64 + p0 + j], lm = lamtab[(t + 1) * 64 + p0 + j];
                v[2 * j] = c[0] * lm[0] - c[1] * lm[1]; v[2 * j + 1] = -(c[0] * lm[1] + c[1] * lm[0]); } }
        u32x4 o; o.x = cvtpk(v[0], v[1]); o.y = cvtpk(v[2], v[3]); o.z = cvtpk(v[4], v[5]); o.w = cvtpk(v[6], v[7]);
        *(u32x4*)(Mt + (size_t)n * UPW + k0) = o; }
    for (int ch = tid; ch < 256 * 64; ch += 512) { const int n = ch >> 6, k0 = (ch & 63) * 8; float v[8];
        if (n < 128) { const int p = n >> 1, ri = n & 1, s = k0 >> 4, hi0 = k0 & 15; const f32x2 lm = lamtab[(CH - 1 - s) * 64 + p];
#pragma unroll
            for (int j = 0; j < 8; ++j) { const f32x2 b = bb[p * 16 + hi0 + j]; v[j] = ri ? (lm[0] * b[1] + lm[1] * b[0]) : (lm[0] * b[0] - lm[1] * b[1]); }
        } else {
#pragma unroll
            for (int j = 0; j < 8; ++j) v[j] = 0.f; }
        u32x4 o; o.x = cvtpk(v[0], v[1]); o.y = cvtpk(v[2], v[3]); o.z = cvtpk(v[4], v[5]); o.w = cvtpk(v[6], v[7]);
        *(u32x4*)(Bm + (size_t)n * 512 + k0) = o; }
    __syncthreads();
}

__device__ __forceinline__ void prologue(KArgsP a, LAS unsigned char* lds, int G) {
    unsigned char* ws = a->ws;
    int tid = threadIdx.x; asm volatile("" : "+v"(tid));
    const int lane = tid & 63, wave = tid >> 6, bid = blockIdx.x;
    for (int it = bid; it < DEPTH * NG; it += G) { const int l = it >> 5, g = it & 31;
        ssm_matrices(a, l, g, lds, (bf16_t*)(ws + WS_W + l * W_LAYER + W_BM) + (size_t)g * 256 * 512, (bf16_t*)(ws + WS_W + l * W_LAYER + W_MT) + (size_t)g * 512 * UPW); }
    if (bid == 0) {
        float* sm = (float*)(ws + WS_SMALL);
        if (tid < 128) { const int l = tid >> 6, i = tid & 63;
            const float d1 = wave_sum(a->in[20][l * 64 + i] * a->in[21][l * 64 + i]), d2 = wave_sum(a->in[22][l * 64 + i] * a->in[23][l * 64 + i]);
            if (i == 0) sm[l] = expf(d1) - expf(d2) + (0.8f - 0.6f * expf(-0.3f * (float)l)); }
        for (int idx = tid; idx < 4 * 132; idx += 512) { const int h = idx / 132, n = idx % 132; int bk;
            if (n < 16) bk = n; else { const float nf = (float)n; int lg = 16 + (int)(logf(nf / 16.f) / 2.0794415416798357f * 16.f); bk = lg < 31 ? lg : 31; }
            sm[16 + idx] = a->in[2][bk * 4 + h] * LOG2E; }
    }
    { LAS float* scr = (LAS float*)(lds + wave * 16384);
      const int gw = bid * 8 + wave, NGW = G * 8;
      const int nssm = (G > DEPTH * NG) ? DEPTH * NG : 0;
      for (int it = (bid - nssm) * 8 + wave; bid >= nssm && it < DEPTH * 12288; it += (G - nssm) * 8) {
          const int l = it / 12288; int r = it % 12288; unsigned char* wl = ws + WS_W + l * W_LAYER;
          const GainSpec none{nullptr, nullptr, 0.f};
          if (r < 1408) { transpose_item(a->in[4] + (size_t)l * D * FF, D, FF, (bf16_t*)(wl + W_GU1), true, FF, 0, GainSpec{a->in[3] + l * D, nullptr, 0.f}, scr, r, lane); continue; } r -= 1408;
          if (r < 1408) { transpose_item(a->in[5] + (size_t)l * D * FF, D, FF, (bf16_t*)(wl + W_GU1), true, FF, 1, GainSpec{a->in[3] + l * D, nullptr, 0.f}, scr, r, lane); continue; } r -= 1408;
          if (r < 1408) { transpose_item(a->in[6] + (size_t)l * FF * D, FF, D, (bf16_t*)(wl + W_D1), false, 1, 0, none, scr, r, lane); continue; } r -= 1408;
          if (r < 1408) { transpose_item(a->in[32] + (size_t)l * D * FF, D, FF, (bf16_t*)(wl + W_GU2), true, FF, 0, GainSpec{a->in[31] + l * D, nullptr, 0.f}, scr, r, lane); continue; } r -= 1408;
          if (r < 1408) { transpose_item(a->in[33] + (size_t)l * D * FF, D, FF, (bf16_t*)(wl + W_GU2), true, FF, 1, GainSpec{a->in[31] + l * D, nullptr, 0.f}, scr, r, lane); continue; } r -= 1408;
          if (r < 1408) { transpose_item(a->in[34] + (size_t)l * FF * D, FF, D, (bf16_t*)(wl + W_D2), false, 1, 0, none, scr, r, lane); continue; } r -= 1408;
          if (r < 1024) { transpose_item(a->in[8] + (size_t)l * D * 2048, D, 2048, (bf16_t*)(wl + W_IN), false, 1, 0, GainSpec{a->in[7] + l * D, nullptr, 0.f}, scr, r, lane); continue; } r -= 1024;
          if (r < 256) { transpose_item(a->in[17] + (size_t)l * 512 * 1024, 512, 1024, (bf16_t*)(wl + W_GLU), true, 512, 0, none, scr, r, lane); continue; } r -= 256;
          if (r < 512) { transpose_item(a->in[25] + (size_t)l * D * D, D, D, (bf16_t*)(wl + W_OUT), false, 1, 0, GainSpec{a->in[19] + l * 512, a->in[24] + l * 128, 1.f - (0.8f - 0.6f * expf(-0.3f * (float)l))}, scr, r, lane); continue; } r -= 512;
          if (r < 512) { transpose_item(a->in[28] + (size_t)l * D * D, D, D, (bf16_t*)(wl + W_Q), false, 1, 0, GainSpec{a->in[26] + l * D, nullptr, 0.f}, scr, r, lane); continue; } r -= 512;
          if (r < 1024) { transpose_item(a->in[29] + (size_t)l * D * 2048, D, 2048, (bf16_t*)(wl + W_KV), false, 1, 0, none, scr, r, lane); continue; } r -= 1024;
          transpose_item(a->in[30] + (size_t)l * D * D, D, D, (bf16_t*)(wl + W_O), false, 1, 0, none, scr, r, lane);
      }
      for (int row = gw; row < T + DEPTH * BATCH * MEM; row += NGW) {
          const bool ismem = row >= T; const int mr = row - T, l = mr >> 10, mrow = mr & 1023;
          const float* src = ismem ? a->in[1] + (size_t)mrow * D : a->in[0] + (size_t)row * D;
          f32x4 v[4]; float s = 0.f;
#pragma unroll
          for (int j = 0; j < 4; ++j) { v[j] = *((const f32x4*)src + lane + 64 * j); s += (v[j][0] * v[j][0] + v[j][1] * v[j][1]) + (v[j][2] * v[j][2] + v[j][3] * v[j][3]); }
          s = wave_sum(s);
          if (!ismem) { if (lane < 16) ((float*)(ws + WS_SS))[(size_t)row * 16 + lane] = lane == 0 ? s : 0.f;
#pragma unroll
              for (int j = 0; j < 4; ++j) *((u32x2*)(ws + WS_HB + (size_t)row * D * 2) + lane + 64 * j) = (u32x2){cvtpk(v[j][0], v[j][1]), cvtpk(v[j][2], v[j][3])};
          } else { const float rs = rsqrtf(s * (1.f / D) + EPS); const float* gn = a->in[27] + l * D;
#pragma unroll
              for (int j = 0; j < 4; ++j) { const f32x4 gg = *((const f32x4*)gn + lane + 64 * j);
                  *((u32x2*)(ws + WS_MEMN + ((size_t)l * 1024 + mrow) * D * 2) + lane + 64 * j) = (u32x2){cvtpk(v[j][0] * rs * gg[0], v[j][1] * rs * gg[1]), cvtpk(v[j][2] * rs * gg[2], v[j][3] * rs * gg[3])}; }
          }
      }
    }
}

constexpr int AT_KROW = 256, AT_VROW = 128, AT_KBUF = 64 * AT_KROW, AT_VBUF = 128 * AT_VROW;
constexpr int AT_NBUF = 3, AT_K0 = 0, AT_V0 = AT_NBUF * AT_KBUF, AT_BIAS = AT_V0 + AT_NBUF * AT_VBUF;

__device__ __forceinline__ void at_pv(LAS unsigned char* Vb, int r, int g, const bf16x8 (&pfr)[2][2], f32x4 (&o)[2][8], f32x4 (&ol)[2]) {
    bf16x8 vfa[8], vfb[8];
#pragma unroll
    for (int db = 0; db < 4; ++db)
#pragma unroll
        for (int kk = 0; kk < 2; ++kk) vfa[db * 2 + kk] = *(const LAS bf16x8*)(Vb + (db * 16 + r) * AT_VROW + (((kk * 4 + g) ^ (r >> 1)) * 16));
    __builtin_amdgcn_sched_barrier(0);
#pragma unroll
    for (int db = 0; db < 4; ++db)
#pragma unroll
        for (int kk = 0; kk < 2; ++kk) vfb[db * 2 + kk] = *(const LAS bf16x8*)(Vb + ((db + 4) * 16 + r) * AT_VROW + (((kk * 4 + g) ^ (r >> 1)) * 16));
    __builtin_amdgcn_sched_barrier(0);
#pragma unroll
    for (int kk = 0; kk < 2; ++kk) {
#pragma unroll
        for (int db = 0; db < 4; ++db) {
            o[0][db] = __builtin_amdgcn_mfma_f32_16x16x32_bf16(vfa[db * 2 + kk], pfr[0][kk], o[0][db], 0, 0, 0);
            o[1][db] = __builtin_amdgcn_mfma_f32_16x16x32_bf16(vfa[db * 2 + kk], pfr[1][kk], o[1][db], 0, 0, 0); }
        __builtin_amdgcn_sched_barrier(0); }
#pragma unroll
    for (int kk = 0; kk < 2; ++kk) {
#pragma unroll
        for (int db = 0; db < 4; ++db) {
            o[0][db + 4] = __builtin_amdgcn_mfma_f32_16x16x32_bf16(vfb[db * 2 + kk], pfr[0][kk], o[0][db + 4], 0, 0, 0);
            o[1][db + 4] = __builtin_amdgcn_mfma_f32_16x16x32_bf16(vfb[db * 2 + kk], pfr[1][kk], o[1][db + 4], 0, 0, 0); }
        __builtin_amdgcn_sched_barrier(0); }
    { const short one = (short)0x3F80; const bf16x8 ones = {one, one, one, one, one, one, one, one};
#pragma unroll
      for (int kk = 0; kk < 2; ++kk) { ol[0] = __builtin_amdgcn_mfma_f32_16x16x32_bf16(ones, pfr[0][kk], ol[0], 0, 0, 0); ol[1] = __builtin_amdgcn_mfma_f32_16x16x32_bf16(ones, pfr[1][kk], ol[1], 0, 0, 0); } }
    __builtin_amdgcn_sched_barrier(0);
}

__device__ __forceinline__ void at_qk_sm(LAS unsigned char* Kb, const LAS float* biasl, int r, int g, int k0, int qw0, int qrow, float cfar,
                                         const bf16x8 (&qf)[2][2], float (&mrow)[2], f32x4 (&ol)[2], f32x4 (&o)[2][8], bf16x8 (&pfr)[2][2], bool first) {
    f32x4 s[2][4];
    const bool far = (qw0 - (k0 + 63)) >= 128;
    const float cf = far ? cfar : 0.f;
    const float ci0 = first ? cf : cf - mrow[0], ci1 = first ? cf : cf - mrow[1];
    bf16x8 kfa[8], kfb[8];
#pragma unroll
    for (int kb = 0; kb < 4; ++kb)
#pragma unroll
        for (int ks = 0; ks < 2; ++ks) kfa[kb * 2 + ks] = *(const LAS bf16x8*)(Kb + (kb * 16 + r) * AT_KROW + (((ks * 4 + g) ^ r) * 16));
    __builtin_amdgcn_sched_barrier(0);
#pragma unroll
    for (int kb = 0; kb < 4; ++kb)
#pragma unroll
        for (int ks = 0; ks < 2; ++ks) kfb[kb * 2 + ks] = *(const LAS bf16x8*)(Kb + (kb * 16 + r) * AT_KROW + (((8 + ks * 4 + g) ^ r) * 16));
    __builtin_amdgcn_sched_barrier(0);
#pragma unroll
    for (int kb = 0; kb < 4; ++kb) s[0][kb] = __builtin_amdgcn_mfma_f32_16x16x32_bf16(kfa[kb * 2], qf[0][0], (f32x4){ci0, ci0, ci0, ci0}, 0, 0, 0);
    __builtin_amdgcn_sched_barrier(0);
#pragma unroll
    for (int kb = 0; kb < 4; ++kb) s[0][kb] = __builtin_amdgcn_mfma_f32_16x16x32_bf16(kfa[kb * 2 + 1], qf[0][1], s[0][kb], 0, 0, 0);
    __builtin_amdgcn_sched_barrier(0);
#pragma unroll
    for (int kb = 0; kb < 4; ++kb) s[1][kb] = __builtin_amdgcn_mfma_f32_16x16x32_bf16(kfb[kb * 2], qf[1][0], (f32x4){ci1, ci1, ci1, ci1}, 0, 0, 0);
    __builtin_amdgcn_sched_barrier(0);
#pragma unroll
    for (int kb = 0; kb < 4; ++kb) s[1][kb] = __builtin_amdgcn_mfma_f32_16x16x32_bf16(kfb[kb * 2 + 1], qf[1][1], s[1][kb], 0, 0, 0);
    __builtin_amdgcn_sched_barrier(0);
    if (!far) {
        float badd[4][4];
#pragma unroll
        for (int kb = 0; kb < 4; ++kb)
#pragma unroll
            for (int j = 0; j < 4; ++j) { const int key = k0 + (kb >> 1) * 32 + g * 8 + (kb & 1) * 4 + j, dist = qrow - key;
                const int idx = dist < 0 ? 0 : (dist > 128 ? 128 : dist);
                badd[kb][j] = biasl[idx]; }
#pragma unroll
        for (int kb = 0; kb < 4; ++kb)
#pragma unroll
            for (int j = 0; j < 4; ++j) { const int key = k0 + (kb >> 1) * 32 + g * 8 + (kb & 1) * 4 + j;
                const float ad = (qrow >= key) ? badd[kb][j] : -INFINITY;
                s[0][kb][j] += ad; s[1][kb][j] += ad; }
    }
#pragma unroll
    for (int m = 0; m < 2; ++m) {
        float mx = max3f(s[m][0][0], s[m][0][1], s[m][0][2]);
        mx = max3f(mx, s[m][0][3], s[m][1][0]); mx = max3f(mx, s[m][1][1], s[m][1][2]); mx = max3f(mx, s[m][1][3], s[m][2][0]);
        mx = max3f(mx, s[m][2][1], s[m][2][2]); mx = max3f(mx, s[m][2][3], s[m][3][0]); mx = max3f(mx, s[m][3][1], s[m][3][2]); mx = max2f(mx, s[m][3][3]);
        mx = xl_max(mx);
        if (first || __any(mx > 6.0f)) {
            const float delta = first ? mx : fmaxf(mx, 0.f), alpha = first ? 0.f : fast_exp2(-delta);
            mrow[m] = first ? delta : mrow[m] + delta;
            ol[m] = ol[m] * alpha;
#pragma unroll
            for (int db = 0; db < 8; ++db) o[m][db] = o[m][db] * alpha;
#pragma unroll
            for (int kb = 0; kb < 4; ++kb) s[m][kb] = s[m][kb] - delta;
        }
#pragma unroll
        for (int kb = 0; kb < 4; ++kb)
#pragma unroll
            for (int j = 0; j < 4; ++j) s[m][kb][j] = fast_exp2(s[m][kb][j]);
#pragma unroll
        for (int kk = 0; kk < 2; ++kk) { const u32x4 pw = pack8(s[m][2 * kk], s[m][2 * kk + 1]); pfr[m][kk] = __builtin_bit_cast(bf16x8, pw); }
    }
}

__device__ __forceinline__ void attn_qblock(int b, int h, int q0, float lam, LAS unsigned char* lds, const bf16_t* qbuf, const bf16_t* kbuf, const bf16_t* vT, bf16_t* mix, const float* bias_g, bool var) {
    int tid = threadIdx.x; asm volatile("" : "+v"(tid));
    const int lane = tid & 63, w = __builtin_amdgcn_readfirstlane(tid >> 6), r = lane & 15, g = lane >> 4;
    const bool grpB = w >= 4;
    const int qw0 = q0 + w * 16, qrow = qw0 + r;
    LAS float* biasl = (LAS float*)(lds + AT_BIAS);
    __syncthreads();
    if (tid < 129) biasl[tid] = bias_g[h * 132 + tid];
    bf16x8 qf[2][2];
    { const bf16_t* qp = qbuf + ((size_t)(b * SEQ + qrow)) * 512 + h * 128 + g * 8;
#pragma unroll
      for (int m = 0; m < 2; ++m)
#pragma unroll
          for (int ks = 0; ks < 2; ++ks) qf[m][ks] = *(const bf16x8*)(qp + m * 64 + ks * 32); }
    f32x4 o[2][8];
#pragma unroll
    for (int m = 0; m < 2; ++m)
#pragma unroll
        for (int db = 0; db < 8; ++db) o[m][db] = (f32x4){0.f, 0.f, 0.f, 0.f};
    float mrow[2] = {0.f, 0.f};
    f32x4 ol[2] = {(f32x4){0.f, 0.f, 0.f, 0.f}, (f32x4){0.f, 0.f, 0.f, 0.f}};
    bf16x8 pfr[2][2];
#pragma unroll
    for (int m = 0; m < 2; ++m)
#pragma unroll
        for (int kk = 0; kk < 2; ++kk) pfr[m][kk] = (bf16x8){0, 0, 0, 0, 0, 0, 0, 0};
    const int ntiles = (q0 + 128) >> 6;
    unsigned gk[2], lk[2], gv[2], lv[2];
#pragma unroll
    for (int i = 0; i < 2; ++i) { const int c = tid + i * 512;
        { const int key = c >> 4, ch = c & 15, rho = ((key >> 5) * 2 + ((key >> 2) & 1)) * 16 + ((key >> 3) & 3) * 4 + (key & 3); gk[i] = key * 512 + ch * 8; lk[i] = rho * AT_KROW + ((ch ^ (rho & 15)) * 16); }
        { const int dv = c >> 3, ch = c & 7; gv[i] = dv * SEQ + ch * 8; lv[i] = dv * AT_VROW + ((ch ^ ((dv >> 1) & 7)) * 16); } }
    const bf16_t* kbase = kbuf + ((size_t)b * SEQ) * 512 + h * 128;
    const bf16_t* vbase = vT + ((size_t)(b * 4 + h) * 128) * SEQ;
    u32x4 kreg[2], vreg[2];
#pragma unroll
    for (int i = 0; i < 2; ++i) { kreg[i] = *(const u32x4*)(kbase + gk[i]); vreg[i] = *(const u32x4*)(vbase + gv[i]); }
#pragma unroll
    for (int i = 0; i < 2; ++i) { *(LAS u32x4*)(lds + AT_K0 + lk[i]) = kreg[i]; *(LAS u32x4*)(lds + AT_V0 + lv[i]) = vreg[i]; }
    __syncthreads();
    const float cfar = biasl[128];
    int cur = 0; bool pend = false;
    for (int kt = 0; kt < ntiles; ++kt) {
        const int k0 = kt * 64, nxt = (cur == AT_NBUF - 1) ? 0 : cur + 1, prv = (cur == 0) ? AT_NBUF - 1 : cur - 1;
        const bool pf = (kt + 1 < ntiles);
        if (pf) {
#pragma unroll
            for (int i = 0; i < 2; ++i) { kreg[i] = *(const u32x4*)(kbase + (size_t)(k0 + 64) * 512 + gk[i]); vreg[i] = *(const u32x4*)(vbase + (k0 + 64) + gv[i]); } }
        const bool active = (k0 <= qw0 + 15) && !(ATT_VAR == 7 && var && w >= 4);
        if (grpB && pend) at_pv(lds + AT_V0 + prv * AT_VBUF, r, g, pfr, o, ol);
        if (active) at_qk_sm(lds + AT_K0 + cur * AT_KBUF, biasl, r, g, k0, qw0, qrow, cfar, qf, mrow, ol, o, pfr, kt == 0);
        if (!grpB && active) at_pv(lds + AT_V0 + cur * AT_VBUF, r, g, pfr, o, ol);
        pend = active;
        if (pf) {
#pragma unroll
            for (int i = 0; i < 2; ++i) { *(LAS u32x4*)(lds + AT_K0 + nxt * AT_KBUF + lk[i]) = kreg[i]; *(LAS u32x4*)(lds + AT_V0 + nxt * AT_VBUF + lv[i]) = vreg[i]; } }
        __syncthreads();
        cur = nxt;
    }
    if (grpB && pend) { const int prv = (cur == 0) ? AT_NBUF - 1 : cur - 1; at_pv(lds + AT_V0 + prv * AT_VBUF, r, g, pfr, o, ol); }
    const float inv0 = 1.f / ol[0][0], inv1 = lam / ol[1][0];
    float ssq = 0.f;
#pragma unroll
    for (int db = 0; db < 8; ++db)
#pragma unroll
        for (int j = 0; j < 4; ++j) { const float v = o[0][db][j] * inv0 - o[1][db][j] * inv1; o[0][db][j] = v; ssq += v * v; }
    ssq = fq_sum(ssq);
    const float rn = rsqrtf(ssq * (1.f / 128.f) + EPS);
    bf16_t* op = mix + ((size_t)(b * SEQ + qrow)) * D + 512 + h * 128 + g * 4;
#pragma unroll
    for (int db = 0; db < 8; ++db) *(u32x2*)(op + db * 16) = (u32x2){cvtpk(o[0][db][0] * rn, o[0][db][1] * rn), cvtpk(o[0][db][2] * rn, o[0][db][3] * rn)};
}

#if DEBUG_CHECK
__device__ __forceinline__ unsigned hash_u(unsigned x) { x ^= x >> 16; x *= 0x7feb352dU; x ^= x >> 15; x *= 0x846ca68bU; x ^= x >> 16; return x; }
__device__ __forceinline__ void dbg_flag(unsigned* ctl, int id, float got, float ref, float rtol, float atol) {
    const float d = fabsf(got - ref);
    if (!(d <= atol + rtol * fabsf(ref))) atomicAdd(ctl + 64 + id, 1u);
}
#endif

__global__ void __launch_bounds__(512, 2) fwd_kernel(Args a) {
    extern __shared__ __attribute__((aligned(16))) unsigned char lds_raw[];
    LAS unsigned char* lds = (LAS unsigned char*)lds_raw;
    cg::grid_group grid = cg::this_grid();
    const int G = gridDim.x;
#define PH KArgsP ka = KARGS(); int bid = blockIdx.x, G = gridDim.x, tidl = threadIdx.x; asm volatile("" : "+s"(bid), "+s"(G), "+v"(tidl)); const int lane = tidl & 63, wave = tidl >> 6; (void)lane; (void)wave; unsigned char* ws = ka->ws; float* ssb = (float*)(ws + WS_SS); float* ssm_ss = (float*)(ws + WS_SSM_SS); const float* smalls = (const float*)(ws + WS_SMALL); \
    bf16_t* hb = (bf16_t*)(ws + WS_HB); unsigned char* ar = ws + WS_AR; unsigned char* wl = ws + WS_W + l * W_LAYER; float* hbuf = ka->out; \
    (void)ssb; (void)ssm_ss; (void)smalls; (void)hb; (void)ar; (void)wl; (void)hbuf;
    if (threadIdx.x < 2) ((LAS unsigned*)(lds + LDS_XB))[threadIdx.x] = 0u;
    __syncthreads();
    XcdBarrier xbar = xcd_barrier_post((unsigned*)(KARGS()->ws + WS_CTL) + 1024, (volatile LAS unsigned*)(lds + LDS_XB));
    for (int rep = 0; rep < (PROBE == 5 ? 2 : 1); ++rep) prologue(KARGS(), lds, G);
    grid.sync();
#define GSYNC() xcd_barrier(xbar)

    for (int l = 0; l < DEPTH; ++l) {
        if (PROBE == 4) { for (int rep = 0; rep < 10; ++rep) GSYNC(); }
        for (int rep = 0; rep < (PROBE == 2 ? 2 : 1); ++rep)
        { PH StdSched S; S.init(T, 2 * FF, G, bid, D, D); EpiFfnUp E{(bf16_t*)(ar + AR_HID), ssb + (size_t)(4 * l + 0) * T * 16, (const LAS float*)(lds + LDS_RS)};
          gemm_phase<EpiFfnUp, StdSched, true>(lds, hb, (const bf16_t*)(wl + W_GU1), D, D, D, S, E); }
        GSYNC();
        if (PROBE == 6) { PH StdSched S; S.init(T, D, G, bid, FF, FF); EpiNull E{(float*)(ws + WS_CTL + 20000)};
          gemm_phase<EpiNull, StdSched, false>(lds, (const bf16_t*)(ar + AR_HID), (const bf16_t*)(wl + W_D1), FF, FF, FF, S, E); }
        for (int rep = (PROBE == 7 ? 0 : 1); rep < 2; ++rep)
        { PH StdSched S; S.init(T, D, G, bid, FF, FF); EpiResid E{hb, ssb + (size_t)(4 * l + 1) * T * 16, (PROBE == 7 && rep == 0) ? 0.f : 0.5f};
          gemm_phase<EpiResid, StdSched, true>(lds, (const bf16_t*)(ar + AR_HID), (const bf16_t*)(wl + W_D1), FF, FF, FF, S, E); }
        GSYNC();
        for (int rep = 0; rep < (PROBE == 3 ? 2 : 1); ++rep)
        { PH StdSched S; S.init(T, 2048, G, bid, D, D); EpiWin E{ar, ssb + (size_t)(4 * l + 1) * T * 16, (const LAS float*)(lds + LDS_RS)};
          gemm_phase<EpiWin, StdSched, true>(lds, hb, (const bf16_t*)(wl + W_IN), D, D, D, S, E); }
        GSYNC();
        for (int rep = 0; rep < (PROBE == 3 ? 2 : 1); ++rep)
        if ((int)blockIdx.x < 128) { PH Ssm1Sched S{bid}; EpiSsm1 E{(bf16_t*)(ar + AR_UP), ka->in[9] + (size_t)l * NG * NP, ka->in[10] + (size_t)l * NG * NP, ka->in[16] + (size_t)l * NG};
          gemm_phase<EpiSsm1, Ssm1Sched, false>(lds, (const bf16_t*)(ar + AR_UP), (const bf16_t*)(wl + W_BM), UPW, 512, 512, S, E); }
        else if (l == 0) { PH WkvSched S{G, bid}; EpiWkv E{(bf16_t*)(ws + WS_KX), (bf16_t*)(ws + WS_VXT)};
          gemm_phase<EpiWkv, WkvSched, false>(lds, (const bf16_t*)(ws + WS_MEMN), (const bf16_t*)(ws + WS_W + W_KV), D, D, D, S, E); }
        GSYNC();
        for (int rep = 0; rep < (PROBE == 3 ? 2 : 1); ++rep)
        { PH Ssm2Sched S{G, bid}; EpiSsm2 E{(bf16_t*)(ar + AR_Y)};
          gemm_phase<EpiSsm2, Ssm2Sched, false>(lds, (const bf16_t*)(ar + AR_UP), (const bf16_t*)(wl + W_MT), UPW, UPW, UPW, S, E); }
        GSYNC();
        for (int rep = 0; rep < (PROBE == 8 ? 2 : 1); ++rep)
        { PH StdSched S; S.init(T, 1024, G, bid, 512, 512); EpiGlu E{(bf16_t*)(ar + AR_MIX), ka->in[18] + (size_t)l * 1024, ssm_ss + (size_t)l * T * 16};
          gemm_phase<EpiGlu, StdSched, true>(lds, (const bf16_t*)(ar + AR_Y), (const bf16_t*)(wl + W_GLU), 512, 512, 512, S, E); }
        GSYNC();
        { PH const float lam = smalls[l];
          for (int rep = 0; rep < ((PROBE == 1 || ATT_VAR) ? 2 : 1); ++rep)
          for (int uidx = bid; uidx < 512; uidx += G) { const bool var = ATT_VAR && rep == 0;
              int bh = uidx >> 5, j = uidx & 31;
              if (G == 256) { bh = (bid & 7) + 8 * (uidx >> 8); j = bid >> 3; }
              const int b = bh >> 2, h = bh & 3;
              attn_qblock(b, h, j * 128, lam, lds, (const bf16_t*)(ar + AR_Q), (const bf16_t*)(ar + AR_K), (const bf16_t*)(ar + AR_VT), (bf16_t*)(ar + AR_MIX), smalls + 16, var);
              attn_qblock(b, h, (63 - j) * 128, lam, lds, (const bf16_t*)(ar + AR_Q), (const bf16_t*)(ar + AR_K), (const bf16_t*)(ar + AR_VT), (bf16_t*)(ar + AR_MIX), smalls + 16, var); }
          bf16_t* mix = (bf16_t*)(ar + AR_MIX); const float* sq = ssm_ss + (size_t)l * T * 16;
          for (int row = bid * 8 + wave; row < T; row += G * 8) { const float rs = rsqrtf(ss_sum16(sq, row) * (1.f / 512.f) + EPS);
              u32x4* p = (u32x4*)(mix + (size_t)row * D) + lane; u32x4 v = *p;
              v.x = cvtpk(__uint_as_float(v.x << 16) * rs, __uint_as_float(v.x & 0xffff0000u) * rs); v.y = cvtpk(__uint_as_float(v.y << 16) * rs, __uint_as_float(v.y & 0xffff0000u) * rs);
              v.z = cvtpk(__uint_as_float(v.z << 16) * rs, __uint_as_float(v.z & 0xffff0000u) * rs); v.w = cvtpk(__uint_as_float(v.w << 16) * rs, __uint_as_float(v.w & 0xffff0000u) * rs);
              *p = v; } }
        GSYNC();
        for (int rep = (PROBE == 7 ? 0 : 1); rep < 2; ++rep)
        { PH StdSched S; S.init(T, D, G, bid, D, D); EpiResid E{hb, ssb + (size_t)(4 * l + 2) * T * 16, (PROBE == 7 && rep == 0) ? 0.f : 1.f};
          gemm_phase<EpiResid, StdSched, true>(lds, (const bf16_t*)(ar + AR_MIX), (const bf16_t*)(wl + W_OUT), D, D, D, S, E); }
        GSYNC();
        for (int rep = 0; rep < (PROBE == 3 ? 2 : 1); ++rep)
        { PH StdSched S; S.init(T, D, G, bid, D, D); EpiWq E{(bf16_t*)(ar + AR_QX), ssb + (size_t)(4 * l + 2) * T * 16, 0.0625f * LOG2E, (const LAS float*)(lds + LDS_RS)};
          gemm_phase<EpiWq, StdSched, true>(lds, hb, (const bf16_t*)(wl + W_Q), D, D, D, S, E); }
        GSYNC();
        for (int rep = 0; rep < (PROBE == 3 ? 2 : 1); ++rep)
        { PH XaSched S{G, bid, (unsigned)MEM * 1024, 256u}; EpiSoftmax E{(bf16_t*)(ar + AR_P), (LAS float*)(lds + LDS_RED)};
          gemm_phase<EpiSoftmax, XaSched, true>(lds, (const bf16_t*)(ar + AR_QX), (const bf16_t*)(ws + WS_KX) + (size_t)l * 1024 * 1024, D, D, 256, S, E); }
        GSYNC();
        for (int rep = 0; rep < (PROBE == 3 ? 2 : 1); ++rep)
        { PH XaSched S{G, bid, 4u * 65536u, 65536u}; EpiPV E{(bf16_t*)(ar + AR_OX)};
          gemm_phase<EpiPV, XaSched, false>(lds, (const bf16_t*)(ar + AR_P), (const bf16_t*)(ws + WS_VXT) + (size_t)l * 1024 * 1024, D, 256, 256, S, E); }
        GSYNC();
        for (int rep = (PROBE == 7 ? 0 : 1); rep < 2; ++rep)
        { PH StdSched S; S.init(T, D, G, bid, D, D); EpiResid E{hb, ssb + (size_t)(4 * l + 3) * T * 16, (PROBE == 7 && rep == 0) ? 0.f : 1.f};
          gemm_phase<EpiResid, StdSched, true>(lds, (const bf16_t*)(ar + AR_OX), (const bf16_t*)(wl + W_O), D, D, D, S, E); }
        GSYNC();
        for (int rep = 0; rep < (PROBE == 2 ? 2 : 1); ++rep)
        { PH StdSched S; S.init(T, 2 * FF, G, bid, D, D); EpiFfnUp E{(bf16_t*)(ar + AR_HID), ssb + (size_t)(4 * l + 3) * T * 16, (const LAS float*)(lds + LDS_RS)};
          gemm_phase<EpiFfnUp, StdSched, true>(lds, hb, (const bf16_t*)(wl + W_GU2), D, D, D, S, E); }
        GSYNC();
        if (PROBE == 6) { PH StdSched S; S.init(T, D, G, bid, FF, FF); EpiNull E{(float*)(ws + WS_CTL + 20000)};
          gemm_phase<EpiNull, StdSched, false>(lds, (const bf16_t*)(ar + AR_HID), (const bf16_t*)(wl + W_D2), FF, FF, FF, S, E); }
        for (int rep = (PROBE == 7 ? 0 : 1); rep < 2; ++rep)
        { PH StdSched S; S.init(T, D, G, bid, FF, FF); EpiResid E{hb, ssb + (size_t)(4 * l + 4) * T * 16, (PROBE == 7 && rep == 0) ? 0.f : 0.5f};
          gemm_phase<EpiResid, StdSched, true>(lds, (const bf16_t*)(ar + AR_HID), (const bf16_t*)(wl + W_D2), FF, FF, FF, S, E); }
        GSYNC();
    }
    { const int l = 0; PH const float* sq = ssb + (size_t)8 * T * 16; const float* gn = ka->in[35];
      for (int row = bid * 8 + wave; row < T; row += G * 8) { const float rs = rsqrtf(ss_sum16(sq, row) * (1.f / D) + EPS);
#pragma unroll
          for (int j = 0; j < 2; ++j) { const u32x4 w = *((const u32x4*)(hb + (size_t)row * D) + lane + 64 * j);
              const f32x4 g0 = *((const f32x4*)gn + 2 * (lane + 64 * j)), g1 = *((const f32x4*)gn + 2 * (lane + 64 * j) + 1);
              f32x4 v0, v1;
              v0[0] = __uint_as_float(w.x << 16) * rs * g0[0]; v0[1] = __uint_as_float(w.x & 0xffff0000u) * rs * g0[1]; v0[2] = __uint_as_float(w.y << 16) * rs * g0[2]; v0[3] = __uint_as_float(w.y & 0xffff0000u) * rs * g0[3];
              v1[0] = __uint_as_float(w.z << 16) * rs * g1[0]; v1[1] = __uint_as_float(w.z & 0xffff0000u) * rs * g1[1]; v1[2] = __uint_as_float(w.w << 16) * rs * g1[2]; v1[3] = __uint_as_float(w.w & 0xffff0000u) * rs * g1[3];
              f32x4* op = (f32x4*)(hbuf + (size_t)row * D) + 2 * (lane + 64 * j); op[0] = v0; op[1] = v1; } } }
}

extern "C" void kernel_launch(void* const* d_in, const int* in_sizes, int n_in, void* d_out, int out_size, void* d_ws, size_t ws_size, hipStream_t stream) {
    static int grid = 0;
    if (grid == 0) {
        if (n_in != 36 || out_size != T * D || ws_size < WS_END) { fprintf(stderr, "kernel_launch: unexpected problem (n_in %d out %d ws %zu)\n", n_in, out_size, ws_size); grid = -1; return; }
        int dev = 0, cus = 0, per_cu = 0;
        if (hipGetDevice(&dev) != hipSuccess || hipDeviceGetAttribute(&cus, hipDeviceAttributeMultiprocessorCount, dev) != hipSuccess) { grid = -1; return; }
        if (hipFuncSetAttribute((const void*)fwd_kernel, hipFuncAttributeMaxDynamicSharedMemorySize, LDS_BYTES) != hipSuccess) { fprintf(stderr, "hipFuncSetAttribute failed\n"); grid = -1; return; }
        if (hipOccupancyMaxActiveBlocksPerMultiprocessor(&per_cu, (const void*)fwd_kernel, 512, LDS_BYTES) != hipSuccess || per_cu < 1) { fprintf(stderr, "occupancy query: %d\n", per_cu); }
        (void)hipGetLastError();
        grid = cus;
        if (grid != 256) fprintf(stderr, "kernel_launch: %d CUs (expected 256)\n", grid);
    }
    if (grid < 0) return;
    (void)hipMemsetAsync((char*)d_ws + WS_CTL, 0, 32768, stream);
    Args a{};
    for (int i = 0; i < 36; ++i) a.in[i] = (const float*)d_in[i];
    a.out = (float*)d_out; a.ws = (unsigned char*)d_ws;
    void* args[] = {&a};
    hipError_t e = hipLaunchCooperativeKernel((const void*)fwd_kernel, dim3(grid), dim3(512), args, LDS_BYTES, stream);
    if (e != hipSuccess) fprintf(stderr, "cooperative launch failed: %s (grid %d)\n", hipGetErrorString(e), grid);
}
```

```cpp
#include <hip/hip_runtime.h>
#include <hip/hip_cooperative_groups.h>
#include <cstdio>
#include <cstdint>
namespace cg = cooperative_groups;

#define LAS __attribute__((address_space(3)))
typedef unsigned short bf16_t;
typedef short bf16x8 __attribute__((ext_vector_type(8)));
typedef float f32x4 __attribute__((ext_vector_type(4)));
typedef float f32x2 __attribute__((ext_vector_type(2)));
typedef unsigned u32x4 __attribute__((ext_vector_type(4)));
typedef unsigned u32x2 __attribute__((ext_vector_type(2)));
typedef __bf16 bf16x2_t __attribute__((ext_vector_type(2)));

#ifndef PROBE
#define PROBE 0
#endif
#ifndef ATT_VAR
#define ATT_VAR 0
#endif
#ifndef DEBUG_CHECK
#define DEBUG_CHECK 0
#endif

constexpr int D = 1024, BATCH = 4, SEQ = 8192, T = BATCH * SEQ, DEPTH = 2, MEM = 256, FF = 2816;
constexpr int SSMW = 512, NG = 32, NP = 64, CH = 32  , NCH = SEQ / CH  , UPW = 640  ;
constexpr float EPS = 1e-6f, LOG2E = 1.4426950408889634f;

constexpr size_t MiB = 1u << 20;
constexpr size_t WS_CTL = 0;
constexpr size_t WS_SS = 466 * MiB;
constexpr size_t WS_SSM_SS = WS_SS + 9 * (size_t)T * 64;
constexpr size_t WS_SMALL = 3 * MiB;
constexpr size_t WS_MEMN = 4 * MiB;
constexpr size_t WS_KX = 8 * MiB;
constexpr size_t WS_VXT = 12 * MiB;
constexpr size_t WS_W = 16 * MiB, W_LAYER = 76 * MiB;
constexpr size_t W_GU1 = 0, W_D1 = 11 * MiB, W_GU2 = 16 * MiB + MiB / 2, W_D2 = 27 * MiB + MiB / 2, W_IN = 33 * MiB, W_GLU = 37 * MiB, W_OUT = 38 * MiB,
                 W_Q = 40 * MiB, W_KV = 42 * MiB, W_O = 46 * MiB, W_BM = 48 * MiB, W_MT = 56 * MiB;
constexpr size_t WS_HB = WS_W + 2 * W_LAYER;
constexpr size_t WS_AR = WS_HB + 64 * MiB;
constexpr size_t AR_UP = 0, AR_Q = 40 * MiB, AR_K = 72 * MiB, AR_VT = 104 * MiB, AR_Y = 136 * MiB, AR_MIX = 168 * MiB;
constexpr size_t AR_QX = 0, AR_P = 64 * MiB, AR_OX = 128 * MiB, AR_HID = 0;
constexpr size_t WS_END = WS_SSM_SS + 2 * (size_t)T * 64;

constexpr int LDS_BYTES = 155648;
constexpr int LDS_RED = 131072; constexpr int LDS_XB = 131072 + 8192;
constexpr int LDS_RS = 131072 + 8192 + 256, RS_MAX_UNITS = 12;

struct Args { const float* in[36]; float* out; unsigned char* ws; };
typedef const __attribute__((address_space(4))) Args* KArgsP;
#define KARGS() ({ KArgsP _p = (KArgsP)__builtin_amdgcn_kernarg_segment_ptr(); asm volatile("" : "+s"(_p)); _p; })

__device__ __forceinline__ unsigned cvtpk(float lo, float hi) { f32x2 v = {lo, hi}; bf16x2_t b = __builtin_convertvector(v, bf16x2_t); return __builtin_bit_cast(unsigned, b); }
__device__ __forceinline__ float bf2f(bf16_t x) { return __uint_as_float((unsigned)x << 16); }
__device__ __forceinline__ float wave_sum(float v) {
#pragma unroll
    for (int o = 1; o < 64; o <<= 1) v += __shfl_xor(v, o);
    return v;
}
__device__ __forceinline__ float fq_sum(float v) { v += __shfl_xor(v, 16); v += __shfl_xor(v, 32); return v; }
__device__ __forceinline__ float max3f(float a, float b, float c) { float r; asm("v_max3_f32 %0, %1, %2, %3" : "=v"(r) : "v"(a), "v"(b), "v"(c)); return r; }
__device__ __forceinline__ float max2f(float a, float b) { float r; asm("v_max_f32_e32 %0, %1, %2" : "=v"(r) : "v"(a), "v"(b)); return r; }
__device__ __forceinline__ float xl_max(float v) {
    u32x2 r = __builtin_amdgcn_permlane32_swap(__float_as_uint(v), __float_as_uint(v), false, false); v = max2f(__uint_as_float(r[0]), __uint_as_float(r[1]));
    r = __builtin_amdgcn_permlane16_swap(__float_as_uint(v), __float_as_uint(v), false, false); return max2f(__uint_as_float(r[0]), __uint_as_float(r[1]));
}
__device__ __forceinline__ float fq_max(float v) { v = fmaxf(v, __shfl_xor(v, 16)); v = fmaxf(v, __shfl_xor(v, 32)); return v; }
__device__ __forceinline__ u32x4 pack8(f32x4 a, f32x4 b) { u32x4 w; w.x = cvtpk(a[0], a[1]); w.y = cvtpk(a[2], a[3]); w.z = cvtpk(b[0], b[1]); w.w = cvtpk(b[2], b[3]); return w; }
__device__ __forceinline__ float fast_exp2(float x) { return __builtin_amdgcn_exp2f(x); }
__device__ __forceinline__ float fast_rcp(float x) { return __builtin_amdgcn_rcpf(x); }
__device__ __forceinline__ float sigmoidf_(float x) { return fast_rcp(1.f + fast_exp2(-x * LOG2E)); }


__device__ __forceinline__ float ss_sum16(const float* ss16, int row) {
    const f32x4* p = (const f32x4*)(ss16 + (size_t)row * 16); const f32x4 a = p[0], b = p[1], c = p[2], d = p[3];
    return (((a[0] + a[1]) + (a[2] + a[3])) + ((b[0] + b[1]) + (b[2] + b[3]))) + (((c[0] + c[1]) + (c[2] + c[3])) + ((d[0] + d[1]) + (d[2] + d[3])));
}
#define XB_TMO      128
#define XB_XCNT(j)  (256  + 64 * (j))
#define XB_XSUB(j)  (1280 + 64 * (j))
#define XB_XGEN(j)  (2304 + 64 * (j))
#define XB_TOP      3328
#define XB_TOPGEN   3392
#define XCD_BAR_WORDS 3456
#define XB_SPIN_CAP (1u << 22)
__device__ __forceinline__ unsigned xb_ld(unsigned* p)              { return __hip_atomic_load(p, __ATOMIC_RELAXED, __HIP_MEMORY_SCOPE_AGENT); }
__device__ __forceinline__ unsigned xb_add(unsigned* p, unsigned v) { return __hip_atomic_fetch_add(p, v, __ATOMIC_RELAXED, __HIP_MEMORY_SCOPE_AGENT); }
__device__ __forceinline__ unsigned xb_xcc_id() { return (unsigned)__builtin_amdgcn_s_getreg((3 << 11) | 20) & 0xFu; }
#define XB_SPIN(cond, bar) do { unsigned _sp = 0; while (cond) { __builtin_amdgcn_s_sleep(1); \
    if ((++_sp & 255u) == 0u) { if (xb_ld(&(bar)[XB_TMO])) break; if (_sp > XB_SPIN_CAP) { atomicAdd(&(bar)[XB_TMO], 1u); break; } } } } while (0)
struct XcdBarrier { unsigned* bar; unsigned x; volatile LAS unsigned* st; };
__device__ __forceinline__ XcdBarrier xcd_barrier_post(unsigned* bar, volatile LAS unsigned* st) {
    XcdBarrier b; b.bar = bar; b.x = xb_xcc_id(); b.st = st;
    if (threadIdx.x == 0) (void)xb_add(&bar[XB_XCNT(b.x)], 1u);
    return b;
}
__device__ __forceinline__ void xcd_barrier_complete(unsigned* bar, unsigned x, unsigned& nloc, unsigned& nx) {
    const unsigned G = gridDim.x * gridDim.y * gridDim.z;
    unsigned sum, cnt, mine, sp = 0u;
    for (;;) {
        sum = 0u; cnt = 0u; mine = 0u;
#pragma unroll
        for (unsigned j = 0; j < 16; ++j) { const unsigned c = xb_ld(&bar[XB_XCNT(j)]); sum += c; cnt += (c > 0u) ? 1u : 0u; mine = (j == x) ? c : mine; }
        if (sum == G) break;
        __builtin_amdgcn_s_sleep(1);
        if ((++sp & 255u) == 0u) { if (xb_ld(&bar[XB_TMO])) break; if (sp > XB_SPIN_CAP) { atomicAdd(&bar[XB_TMO], 1u); break; } }
    }
    nloc = mine > 0u ? mine : 1u; nx = cnt > 0u ? cnt : 1u;
}
__device__ __forceinline__ void xcd_barrier(const XcdBarrier& b) {
    asm volatile("s_waitcnt vmcnt(0)" ::: "memory");
    __syncthreads();
    if (threadIdx.x == 0) {
        unsigned* bar = b.bar;
        __builtin_amdgcn_s_waitcnt(0);
        unsigned nloc = b.st[0], nx = b.st[1];
        if (nloc == 0u) { xcd_barrier_complete(bar, b.x, nloc, nx); b.st[0] = nloc; b.st[1] = nx; }
        const unsigned old = xb_add(&bar[XB_XSUB(b.x)], 1u);
        const unsigned gen = old / nloc;
        if (old + 1u == (gen + 1u) * nloc) {
            __builtin_amdgcn_fence(__ATOMIC_RELEASE, "agent");
            asm volatile("s_waitcnt vmcnt(0)" ::: "memory");
            const unsigned og = xb_add(&bar[XB_TOP], 1u);
            const unsigned tg = og / nx;
            if (og + 1u == (tg + 1u) * nx) xb_add(&bar[XB_TOPGEN], 1u);
            else XB_SPIN(xb_ld(&bar[XB_TOPGEN]) == tg, bar);
            __builtin_amdgcn_fence(__ATOMIC_ACQUIRE, "agent");
            xb_add(&bar[XB_XGEN(b.x)], 1u);
            asm volatile("s_waitcnt vmcnt(0)" ::: "memory");
        } else {
            XB_SPIN(xb_ld(&bar[XB_XGEN(b.x)]) == gen, bar);
            __builtin_amdgcn_fence(__ATOMIC_ACQUIRE, "agent");
            asm volatile("s_waitcnt vmcnt(0)" ::: "memory");
        }
    }
    __syncthreads();
}

constexpr int BM = 256, BK = 64, HALF = 128, HTB = HALF * BK * 2, NXCD = 8, WGM = 8;
__host__ __device__ __forceinline__ int lds_byte(int r, int c) { const int st = (r >> 4) * 2 + (c >> 5), rr = r & 15, cc = c & 31, ob = rr * 64 + cc * 2; return st * 1024 + (ob ^ (((ob >> 9) & 1) << 5)); }
__host__ __device__ __forceinline__ void stage_rc(int b, int& R, int& C) { const int st = b / 1024, sb = b % 1024, swz = sb ^ (((sb >> 9) & 1) << 5); R = (st >> 1) * 16 + swz / 64; C = (st & 1) * 32 + (swz % 64) / 2; }
__host__ __device__ __forceinline__ int perm32(int rho) { const int n = rho >> 4, i = rho & 15; return 8 * (i >> 2) + 4 * n + (i & 3); }

struct Unit { int pm, pn, bz, ui; unsigned a_off, b_off; };

struct StdSched {
    int nM, nN, nwg, G, c, lda, ldb;
    __device__ void init(int M, int N, int G_, int c_, int lda_, int ldb_) { nM = M / BM; nN = N / BM; nwg = nM * nN; G = G_; c = c_; lda = lda_; ldb = ldb_; }
    __device__ bool next(int i, Unit& u) const {
        const long L = (long)i * G + c; if (L >= nwg) return false;
        int wgid = (int)L; { const int q = nwg / NXCD, r = nwg % NXCD, xcd = wgid % NXCD, off = wgid / NXCD; wgid = (xcd < r ? xcd * (q + 1) : r * (q + 1) + (xcd - r) * q) + off; }
        const int nig = WGM * nN, gid = wgid / nig, fm = gid * WGM, gsz = (nM - fm) < WGM ? (nM - fm) : WGM;
        u.pm = fm + ((wgid % nig) % gsz); u.pn = (wgid % nig) / gsz; u.bz = 0;
        u.a_off = (unsigned)(u.pm * BM) * (unsigned)lda; u.b_off = (unsigned)(u.pn * BM) * (unsigned)ldb; return true;
    }
};
struct Ssm1Sched {
    int c;
    __device__ bool next(int i, Unit& u) const {
        if (i > 0 || c >= BATCH * NG) return false;
        u.pm = 0; u.pn = 0; u.bz = c; u.a_off = (unsigned)c * NCH * UPW; u.b_off = (unsigned)(c & 31) * 256 * 512; return true;
    }
};
struct WkvSched {
    int G, c;
    __device__ bool next(int i, Unit& u) const {
        if (c < 128) return false;
        const int L = (c - 128) + i * (G - 128); if (L >= 64) return false;
        const int layer = L >> 5, rem = L & 31; u.pm = rem >> 3; u.pn = rem & 7; u.bz = layer;
        u.a_off = (unsigned)layer * 1024 * 1024 + (unsigned)u.pm * 256 * 1024; u.b_off = (unsigned)layer * (unsigned)(W_LAYER / 2) + (unsigned)u.pn * 256 * 1024; return true;
    }
};
struct Ssm2Sched {
    int G, c;
    __device__ bool next(int i, Unit& u) const {
        const int L = c + i * G; if (L >= 2 * BATCH * NG) return false;
        u.bz = L >> 1; u.pn = L & 1; u.pm = 0; u.a_off = (unsigned)u.bz * NCH * UPW; u.b_off = ((unsigned)(u.bz & 31) * 512 + (unsigned)u.pn * 256) * UPW; return true;
    }
};
struct XaSched {
    int G, c; unsigned bs_b, bs_h;
    __device__ bool next(int i, Unit& u) const {
        const int L = c + i * G; if (L >= 512) return false;
        const int bh = L >> 5; u.pm = L & 31; u.pn = 0; u.bz = bh; const int b = bh >> 2, h = bh & 3;
        u.a_off = ((unsigned)(b * SEQ + u.pm * 256)) * 1024 + h * 256; u.b_off = (unsigned)b * bs_b + (unsigned)h * bs_h; return true;
    }
};

template <class Epi, class Sched, bool ALIGN_EPI>
__device__ __forceinline__ void gemm_phase(LAS unsigned char* lds, const bf16_t* Ab, const bf16_t* Bb, int lda, int ldb, int K, const Sched& S, Epi& E) {
    int tid = threadIdx.x; asm volatile("" : "+v"(tid));
    const int wid = __builtin_amdgcn_readfirstlane(tid >> 6), lane = tid & 63, wr = wid >> 2, wc = wid & 3, fr = lane & 15, fq = lane >> 4;
    const int nt = K / BK;
    unsigned voffA[2], voffB[2]; int aoff, boff;
#define PG8_LANEOFFS(tt) do { _Pragma("unroll") for (int i = 0; i < 2; ++i) { int R, C; stage_rc((tt) * 16 + i * 8192, R, C); const int Rb = (R & ~31) + perm32(R & 31); \
        voffA[i] = (unsigned)(R * lda + C) * 2u; voffB[i] = (unsigned)(Rb * ldb + C) * 2u; } \
        aoff = lds_byte(wr * 64 + ((tt) & 15), (((tt) >> 4) & 3) * 8); boff = lds_byte(wc * 32 + ((tt) & 15), (((tt) >> 4) & 3) * 8); } while (0)
    PG8_LANEOFFS(tid);
    const unsigned kstep = (unsigned)(BK * 2);
    const unsigned hstepA = (unsigned)HALF * lda * 2, hstepB = (unsigned)HALF * ldb * 2;
    const unsigned ldsw = (unsigned)wid * 1024u;
#define PG8_SA(b, h) (((b) * 2 + (h)) * HTB)
#define PG8_SB(b, h) ((4 + (b) * 2 + (h)) * HTB)
#define PG8_STAGE(bufoff, gbase, voff) do { _Pragma("unroll") for (int _i = 0; _i < 2; ++_i) \
        __builtin_amdgcn_global_load_lds((const unsigned*)((const char*)(gbase) + (voff)[_i]), (LAS unsigned*)(lds + (bufoff) + ldsw + _i * 8192), 16, 0, 0); } while (0)
#define PG8_LDA(dst, b, h) do { _Pragma("unroll") for (int m = 0; m < 4; ++m) _Pragma("unroll") for (int k = 0; k < 2; ++k) dst[m][k] = *(const LAS bf16x8*)(lds + PG8_SA(b, h) + aoff + m * 2048 + k * 1024); } while (0)
#define PG8_LDB(dst, b, h) do { _Pragma("unroll") for (int n = 0; n < 2; ++n) _Pragma("unroll") for (int k = 0; k < 2; ++k) dst[n][k] = *(const LAS bf16x8*)(lds + PG8_SB(b, h) + boff + n * 2048 + k * 1024); } while (0)
#define PG8_MMA(ai, bj, At, Bt) do { __builtin_amdgcn_s_setprio(1); _Pragma("unroll") for (int m = 0; m < 4; ++m) _Pragma("unroll") for (int n = 0; n < 2; ++n) _Pragma("unroll") for (int k = 0; k < 2; ++k) \
        acc[ai][bj][m][n] = __builtin_amdgcn_mfma_f32_16x16x32_bf16(Bt[n][k], At[m][k], acc[ai][bj][m][n], 0, 0, 0); __builtin_amdgcn_s_setprio(0); } while (0)
#define PG8_WAIT_V(n) asm volatile("s_waitcnt vmcnt(" #n ")" ::: "memory")
#define PG8_WAIT_L(n) asm volatile("s_waitcnt lgkmcnt(" #n ")" ::: "memory")
#define PG8_BAR __builtin_amdgcn_s_barrier()
#define PG8_SCHED __builtin_amdgcn_sched_barrier(0)
    Unit cur, nxt; int ui = 0;
    if (!S.next(0, cur)) return;
    cur.ui = 0;
    if constexpr (Epi::HAS_RS) {
        LAS float* rst = (LAS float*)(lds + LDS_RS);
        for (int i = (tid >> 8); i < RS_MAX_UNITS; i += 2) { Unit uu; if (!S.next(i, uu)) break; const int row = uu.pm * 256 + (tid & 255); rst[i * 256 + (tid & 255)] = rsqrtf(ss_sum16(E.ss, row) * Epi::RS_INVN + EPS); }
        __syncthreads();
    }
    f32x4 acc[2][2][4][2];
#pragma unroll
    for (int a = 0; a < 2; ++a)
#pragma unroll
        for (int b = 0; b < 2; ++b)
#pragma unroll
            for (int m = 0; m < 4; ++m)
#pragma unroll
                for (int n = 0; n < 2; ++n) acc[a][b][m][n] = (f32x4){0.f, 0.f, 0.f, 0.f};
    bf16x8 At[4][2], B0[2][2], B1[2][2];
    const char* cA = (const char*)(Ab + cur.a_off); const char* cB = (const char*)(Bb + cur.b_off);
    PG8_STAGE(PG8_SB(0, 0), cB, voffB); PG8_STAGE(PG8_SB(0, 1), cB + hstepB, voffB); PG8_STAGE(PG8_SA(0, 0), cA, voffA); PG8_STAGE(PG8_SA(0, 1), cA + hstepA, voffA);
    if (wr == 1) PG8_BAR;
    PG8_WAIT_V(2); PG8_BAR;
    PG8_STAGE(PG8_SB(1, 0), cB + kstep, voffB); PG8_STAGE(PG8_SA(1, 0), cA + kstep, voffA); PG8_STAGE(PG8_SB(1, 1), cB + hstepB + kstep, voffB);
    PG8_WAIT_V(6); PG8_BAR;
    for (;;) {
        const bool has_next = S.next(ui + 1, nxt); nxt.ui = ui + 1;
        const char* nA = has_next ? (const char*)(Ab + nxt.a_off) : cA; const char* nB = has_next ? (const char*)(Bb + nxt.b_off) : cB;
        for (int t = 0; t < nt; t += 2) {
            const bool last = (t == nt - 2);
            const char* a1 = cA + (unsigned)(t + 1) * kstep;
            const char* a2 = last ? nA : cA + (unsigned)(t + 2) * kstep; const char* b2 = last ? nB : cB + (unsigned)(t + 2) * kstep;
            const char* a3 = a2 + kstep; const char* b3 = b2 + kstep;
            PG8_LDB(B0, 0, 0); PG8_LDB(B1, 0, 1); PG8_SCHED; PG8_LDA(At, 0, 0); PG8_STAGE(PG8_SA(1, 1), a1 + hstepA, voffA);
            PG8_WAIT_V(8); PG8_WAIT_L(0); PG8_BAR; PG8_MMA(0, 0, At, B0); PG8_MMA(0, 1, At, B1); PG8_BAR; PG8_SCHED;
            PG8_LDA(At, 0, 1); PG8_STAGE(PG8_SB(0, 0), b2, voffB); PG8_STAGE(PG8_SB(0, 1), b2 + hstepB, voffB); PG8_STAGE(PG8_SA(0, 0), a2, voffA);
            PG8_WAIT_V(8); PG8_WAIT_L(0); PG8_BAR; PG8_MMA(1, 0, At, B0); PG8_MMA(1, 1, At, B1); PG8_BAR; PG8_SCHED;
            PG8_LDB(B0, 1, 0); PG8_LDB(B1, 1, 1); PG8_SCHED; PG8_LDA(At, 1, 0); PG8_STAGE(PG8_SA(0, 1), a2 + hstepA, voffA);
            PG8_WAIT_V(8); PG8_WAIT_L(0); PG8_BAR; PG8_MMA(0, 0, At, B0); PG8_MMA(0, 1, At, B1); PG8_BAR; PG8_SCHED;
            PG8_LDA(At, 1, 1); PG8_STAGE(PG8_SB(1, 0), b3, voffB); PG8_STAGE(PG8_SB(1, 1), b3 + hstepB, voffB); PG8_STAGE(PG8_SA(1, 0), a3, voffA);
            PG8_WAIT_V(8); PG8_WAIT_L(0); PG8_BAR; PG8_MMA(1, 0, At, B0); PG8_MMA(1, 1, At, B1); PG8_BAR; PG8_SCHED;
        }
        if constexpr (ALIGN_EPI) { if (wr == 0) PG8_BAR; }
        if constexpr (!Epi::AFTER_DRAIN) { int t2 = threadIdx.x; asm volatile("" : "+v"(t2)); E(acc, cur, wr, wc, t2 & 15, (t2 >> 4) & 3); }
        if (!has_next) break;
#pragma unroll
        for (int a = 0; a < 2; ++a)
#pragma unroll
            for (int b = 0; b < 2; ++b)
#pragma unroll
                for (int m = 0; m < 4; ++m)
#pragma unroll
                    for (int n = 0; n < 2; ++n) acc[a][b][m][n] = (f32x4){0.f, 0.f, 0.f, 0.f};
        cur = nxt; cA = nA; cB = nB; ++ui;
        { int t3 = threadIdx.x; asm volatile("" : "+v"(t3)); PG8_LANEOFFS(t3); }
        if constexpr (ALIGN_EPI) { if (wr == 1) PG8_BAR; }
    }
    PG8_WAIT_V(0);
    if constexpr (!ALIGN_EPI) { if (wr == 0) PG8_BAR; }
    PG8_BAR;
    if constexpr (Epi::AFTER_DRAIN) { E.fused(acc, cur, wr, wc, fr, fq, lds, wid, lane); }
#undef PG8_LANEOFFS
#undef PG8_SA
#undef PG8_SB
#undef PG8_STAGE
#undef PG8_LDA
#undef PG8_LDB
#undef PG8_MMA
#undef PG8_WAIT_V
#undef PG8_WAIT_L
#undef PG8_BAR
#undef PG8_SCHED
}

typedef f32x4 (&AccRef)[2][2][4][2];
template <bool RS> struct EpiResidT;
typedef EpiResidT<false> EpiResid;

struct EpiFfnUp {
    static constexpr bool AFTER_DRAIN = false, HAS_RS = true; static constexpr float RS_INVN = 1.f / D;
    bf16_t* H; const float* ss; const LAS float* rst;
    __device__ __forceinline__ void operator()(AccRef acc, const Unit& u, int wr, int wc, int fr, int fq) const {
#pragma unroll
        for (int ai = 0; ai < 2; ++ai)
#pragma unroll
            for (int m = 0; m < 4; ++m) {
                const int row = u.pm * 256 + ai * 128 + wr * 64 + m * 16 + fr;
                const float rs = rst[u.ui * 256 + ai * 128 + wr * 64 + m * 16 + fr];
                f32x4 o[2];
#pragma unroll
                for (int n = 0; n < 2; ++n)
#pragma unroll
                    for (int j = 0; j < 4; ++j) { const float g = acc[ai][0][m][n][j] * rs, up = acc[ai][1][m][n][j] * rs; o[n][j] = g * sigmoidf_(g) * up; }
                *(u32x4*)(H + (size_t)row * FF + u.pn * 128 + wc * 32 + 8 * fq) = pack8(o[0], o[1]);
            }
    }
};
template <bool RS> struct EpiResidT {
    static constexpr bool AFTER_DRAIN = false, HAS_RS = RS; static constexpr float RS_INVN = 1.f / 512.f;
    bf16_t* hb; float* ssn; float scale; const float* ss; const LAS float* rst;
    __device__ __forceinline__ void operator()(AccRef acc, const Unit& u, int wr, int wc, int fr, int fq) const {
#pragma unroll
        for (int ai = 0; ai < 2; ++ai) {
            u32x4 ow[4][2];
#pragma unroll
            for (int m = 0; m < 4; ++m)
#pragma unroll
                for (int bj = 0; bj < 2; ++bj)
                    ow[m][bj] = *(const u32x4*)(hb + (size_t)(u.pm * 256 + ai * 128 + wr * 64 + m * 16 + fr) * D + u.pn * 256 + bj * 128 + wc * 32 + 8 * fq);
            __builtin_amdgcn_sched_barrier(0);
#pragma unroll
            for (int m = 0; m < 4; ++m) {
                const int row = u.pm * 256 + ai * 128 + wr * 64 + m * 16 + fr; float part = 0.f;
                const float sc = RS ? scale * rst[u.ui * 256 + ai * 128 + wr * 64 + m * 16 + fr] : scale;
#pragma unroll
                for (int bj = 0; bj < 2; ++bj) {
                    const size_t idx = (size_t)row * D + u.pn * 256 + bj * 128 + wc * 32 + 8 * fq;
                    const u32x4 o4 = ow[m][bj];
                    f32x4 v0, v1;
                    v0[0] = __uint_as_float(o4.x << 16); v0[1] = __uint_as_float(o4.x & 0xffff0000u); v0[2] = __uint_as_float(o4.y << 16); v0[3] = __uint_as_float(o4.y & 0xffff0000u);
                    v1[0] = __uint_as_float(o4.z << 16); v1[1] = __uint_as_float(o4.z & 0xffff0000u); v1[2] = __uint_as_float(o4.w << 16); v1[3] = __uint_as_float(o4.w & 0xffff0000u);
                    v0 = v0 + acc[ai][bj][m][0] * sc; v1 = v1 + acc[ai][bj][m][1] * sc;
                    *(u32x4*)(hb + idx) = pack8(v0, v1);
                    part += (v0[0] * v0[0] + v0[1] * v0[1]) + (v0[2] * v0[2] + v0[3] * v0[3]) + (v1[0] * v1[0] + v1[1] * v1[1]) + (v1[2] * v1[2] + v1[3] * v1[3]);
                }
                part = fq_sum(part);
                if (fq == 0) ssn[(size_t)row * 16 + u.pn * 4 + wc] = part;
            }
            __builtin_amdgcn_sched_barrier(0);
        }
    }
};
struct EpiWin {
    static constexpr bool AFTER_DRAIN = false, HAS_RS = true; static constexpr float RS_INVN = 1.f / D;
    unsigned char* arp; const float* ss; const LAS float* rst;
    __device__ __forceinline__ void operator()(AccRef acc, const Unit& u, int wr, int wc, int fr, int fq) const {
        bf16_t* up = (bf16_t*)(arp + AR_UP); bf16_t* qb = (bf16_t*)(arp + AR_Q); bf16_t* kb = (bf16_t*)(arp + AR_K); bf16_t* vt = (bf16_t*)(arp + AR_VT);
        const int sel = u.pn >> 1;
#pragma unroll
        for (int ai = 0; ai < 2; ++ai)
#pragma unroll
            for (int m = 0; m < 4; ++m) {
                const int row = u.pm * 256 + ai * 128 + wr * 64 + m * 16 + fr;
                float rs = rst[u.ui * 256 + ai * 128 + wr * 64 + m * 16 + fr];
                if (sel == 1) rs *= 0.125f * LOG2E;
                const int b = row >> 13, t = row & (SEQ - 1);
#pragma unroll
                for (int bj = 0; bj < 2; ++bj) {
                    const int c = (u.pn & 1) * 256 + bj * 128 + wc * 32 + 8 * fq;
                    const f32x4 v0 = acc[ai][bj][m][0] * rs, v1 = acc[ai][bj][m][1] * rs;
                    if (sel == 0) { const int g = c >> 4, hi0 = c & 15;
                        *(u32x4*)(up + ((size_t)((b * NG + g) * NCH + (t >> 5))) * UPW + (t & 31) * 16 + hi0) = pack8(v0, v1);
                    } else if (sel == 1) { *(u32x4*)(qb + (size_t)row * 512 + c) = pack8(v0, v1);
                    } else if (sel == 2) { *(u32x4*)(kb + (size_t)row * 512 + c) = pack8(v0, v1);
                    } else { const int h = c >> 7, dv = c & 127; bf16_t* p = vt + ((size_t)((b * 4 + h) * 128 + dv)) * SEQ + t;
                        const u32x4 w = pack8(v0, v1);
                        p[0] = (bf16_t)(w.x & 0xffff); p[SEQ] = (bf16_t)(w.x >> 16); p[2 * SEQ] = (bf16_t)(w.y & 0xffff); p[3 * SEQ] = (bf16_t)(w.y >> 16);
                        p[4 * SEQ] = (bf16_t)(w.z & 0xffff); p[5 * SEQ] = (bf16_t)(w.z >> 16); p[6 * SEQ] = (bf16_t)(w.w & 0xffff); p[7 * SEQ] = (bf16_t)(w.w >> 16);
                    }
                }
            }
    }
};
__device__ __forceinline__ float gelu_tanh(float x) { const float z = 0.7978845608028654f * (x + 0.044715f * x * x * x); return x * fast_rcp(1.f + fast_exp2(-2.f * LOG2E * z)); }
struct EpiSsm2 {
    static constexpr bool AFTER_DRAIN = false, HAS_RS = false;
    bf16_t* yb;
    __device__ __forceinline__ void operator()(AccRef acc, const Unit& u, int wr, int wc, int fr, int fq) const {
        const int b = u.bz >> 5, g = u.bz & 31;
#pragma unroll
        for (int ai = 0; ai < 2; ++ai)
#pragma unroll
            for (int m = 0; m < 4; ++m) {
                const int ch = ai * 128 + wr * 64 + m * 16 + fr;
#pragma unroll
                for (int bj = 0; bj < 2; ++bj) {
                    const int cc = u.pn * 256 + bj * 128 + wc * 32 + 8 * fq, t = cc >> 4, ho0 = cc & 15;
                    f32x4 v0, v1;
#pragma unroll
                    for (int j = 0; j < 4; ++j) { v0[j] = gelu_tanh(acc[ai][bj][m][0][j]); v1[j] = gelu_tanh(acc[ai][bj][m][1][j]); }
                    *(u32x4*)(yb + ((size_t)(b * SEQ + ch * CH + t)) * 512 + g * 16 + ho0) = pack8(v0, v1);
                }
            }
    }
};
struct EpiGlu {
    static constexpr bool AFTER_DRAIN = false, HAS_RS = false;
    bf16_t* mix; const float* bglu; float* ssq;
    __device__ __forceinline__ void operator()(AccRef acc, const Unit& u, int wr, int wc, int fr, int fq) const {
        const int c0 = u.pn * 128 + wc * 32 + 8 * fq;
        const f32x4 bv0 = *(const f32x4*)(bglu + c0), bv1 = *(const f32x4*)(bglu + c0 + 4), bg0 = *(const f32x4*)(bglu + 512 + c0), bg1 = *(const f32x4*)(bglu + 512 + c0 + 4);
#pragma unroll
        for (int ai = 0; ai < 2; ++ai)
#pragma unroll
            for (int m = 0; m < 4; ++m) {
                const int row = u.pm * 256 + ai * 128 + wr * 64 + m * 16 + fr;
                f32x4 o0, o1; float part = 0.f;
#pragma unroll
                for (int j = 0; j < 4; ++j) {
                    o0[j] = (acc[ai][0][m][0][j] + bv0[j]) * sigmoidf_(acc[ai][1][m][0][j] + bg0[j]);
                    o1[j] = (acc[ai][0][m][1][j] + bv1[j]) * sigmoidf_(acc[ai][1][m][1][j] + bg1[j]);
                    part += o0[j] * o0[j] + o1[j] * o1[j];
                }
                *(u32x4*)(mix + (size_t)row * D + c0) = pack8(o0, o1);
                part = fq_sum(part);
                if (fq == 0) ssq[(size_t)row * 16 + u.pn * 4 + wc] = part;
            }
    }
};
struct EpiWq {
    static constexpr bool AFTER_DRAIN = false, HAS_RS = true; static constexpr float RS_INVN = 1.f / D;
    bf16_t* O; const float* ss; float mul; const LAS float* rst;
    __device__ __forceinline__ void operator()(AccRef acc, const Unit& u, int wr, int wc, int fr, int fq) const {
#pragma unroll
        for (int ai = 0; ai < 2; ++ai)
#pragma unroll
            for (int m = 0; m < 4; ++m) {
                const int row = u.pm * 256 + ai * 128 + wr * 64 + m * 16 + fr;
                const float rs = rst[u.ui * 256 + ai * 128 + wr * 64 + m * 16 + fr] * mul;
#pragma unroll
                for (int bj = 0; bj < 2; ++bj)
                    *(u32x4*)(O + (size_t)row * D + u.pn * 256 + bj * 128 + wc * 32 + 8 * fq) = pack8(acc[ai][bj][m][0] * rs, acc[ai][bj][m][1] * rs);
            }
    }
};
struct EpiWkv {
    static constexpr bool AFTER_DRAIN = false, HAS_RS = false;
    bf16_t *kx, *vxt;
    __device__ __forceinline__ void operator()(AccRef acc, const Unit& u, int wr, int wc, int fr, int fq) const {
        const size_t lo = (size_t)u.bz * 1024 * 1024;
#pragma unroll
        for (int ai = 0; ai < 2; ++ai)
#pragma unroll
            for (int m = 0; m < 4; ++m) {
                const int row = u.pm * 256 + ai * 128 + wr * 64 + m * 16 + fr;
#pragma unroll
                for (int bj = 0; bj < 2; ++bj) {
                    const int col = u.pn * 256 + bj * 128 + wc * 32 + 8 * fq;
                    const u32x4 w = pack8(acc[ai][bj][m][0], acc[ai][bj][m][1]);
                    if (u.pn < 4) *(u32x4*)(kx + lo + (size_t)row * 1024 + col) = w;
                    else { const int c2 = col - 1024, h = c2 >> 8, d = c2 & 255, b = row >> 8, mm = row & 255;
                        bf16_t* p = vxt + lo + ((size_t)((b * 4 + h) * 256 + d)) * 256 + mm;
                        p[0] = (bf16_t)(w.x & 0xffff); p[256] = (bf16_t)(w.x >> 16); p[512] = (bf16_t)(w.y & 0xffff); p[768] = (bf16_t)(w.y >> 16);
                        p[1024] = (bf16_t)(w.z & 0xffff); p[1280] = (bf16_t)(w.z >> 16); p[1536] = (bf16_t)(w.w & 0xffff); p[1792] = (bf16_t)(w.w >> 16); }
                }
            }
    }
};
struct EpiSoftmax {
    static constexpr bool AFTER_DRAIN = false, HAS_RS = false;
    bf16_t* P; LAS float* red;
    __device__ __forceinline__ void operator()(AccRef acc, const Unit& u, int wr, int wc, int fr, int fq) const {
        const int b = u.bz >> 2, h = u.bz & 3;
        float mx[2][4];
#pragma unroll
        for (int ai = 0; ai < 2; ++ai)
#pragma unroll
            for (int m = 0; m < 4; ++m) {
                float v = -INFINITY;
#pragma unroll
                for (int bj = 0; bj < 2; ++bj)
#pragma unroll
                    for (int n = 0; n < 2; ++n)
#pragma unroll
                        for (int j = 0; j < 4; ++j) v = fmaxf(v, acc[ai][bj][m][n][j]);
                v = fq_max(v);
                const int rl = ai * 128 + wr * 64 + m * 16 + fr;
                if (fq == 0) red[rl * 4 + wc] = v;
            }
        asm volatile("s_waitcnt lgkmcnt(0)" ::: "memory"); __builtin_amdgcn_s_barrier(); asm volatile("" ::: "memory");
#pragma unroll
        for (int ai = 0; ai < 2; ++ai)
#pragma unroll
            for (int m = 0; m < 4; ++m) {
                const int rl = ai * 128 + wr * 64 + m * 16 + fr;
                const f32x4 r4 = *(const LAS f32x4*)(red + rl * 4);
                const float M = fmaxf(fmaxf(r4[0], r4[1]), fmaxf(r4[2], r4[3]));
                float s = 0.f;
#pragma unroll
                for (int bj = 0; bj < 2; ++bj)
#pragma unroll
                    for (int n = 0; n < 2; ++n)
#pragma unroll
                        for (int j = 0; j < 4; ++j) { const float p = fast_exp2(acc[ai][bj][m][n][j] - M); acc[ai][bj][m][n][j] = p; s += p; }
                s = fq_sum(s);
                if (fq == 0) red[1024 + rl * 4 + wc] = s;
            }
        asm volatile("s_waitcnt lgkmcnt(0)" ::: "memory"); __builtin_amdgcn_s_barrier(); asm volatile("" ::: "memory");
#pragma unroll
        for (int ai = 0; ai < 2; ++ai)
#pragma unroll
            for (int m = 0; m < 4; ++m) {
                const int rl = ai * 128 + wr * 64 + m * 16 + fr;
                const f32x4 r4 = *(const LAS f32x4*)(red + 1024 + rl * 4);
                const float inv = 1.f / ((r4[0] + r4[1]) + (r4[2] + r4[3]));
                const size_t row = (size_t)b * SEQ + u.pm * 256 + rl;
#pragma unroll
                for (int bj = 0; bj < 2; ++bj)
                    *(u32x4*)(P + row * D + h * 256 + bj * 128 + wc * 32 + 8 * fq) = pack8(acc[ai][bj][m][0] * inv, acc[ai][bj][m][1] * inv);
            }
    }
};
struct EpiNull {
    static constexpr bool AFTER_DRAIN = false, HAS_RS = false;
    float* sink;
    __device__ __forceinline__ void operator()(AccRef acc, const Unit& u, int wr, int wc, int fr, int fq) const {
        float t = 0.f;
#pragma unroll
        for (int ai = 0; ai < 2; ++ai)
#pragma unroll
            for (int bj = 0; bj < 2; ++bj)
#pragma unroll
                for (int m = 0; m < 4; ++m)
#pragma unroll
                    for (int n = 0; n < 2; ++n) t += acc[ai][bj][m][n][0] + acc[ai][bj][m][n][1] + acc[ai][bj][m][n][2] + acc[ai][bj][m][n][3];
        if (t == 12345.678f) sink[u.pm] = t;
    }
};
struct EpiPV {
    static constexpr bool AFTER_DRAIN = false, HAS_RS = false;
    bf16_t* O;
    __device__ __forceinline__ void operator()(AccRef acc, const Unit& u, int wr, int wc, int fr, int fq) const {
        const int b = u.bz >> 2, h = u.bz & 3;
#pragma unroll
        for (int ai = 0; ai < 2; ++ai)
#pragma unroll
            for (int m = 0; m < 4; ++m) {
                const size_t row = (size_t)b * SEQ + u.pm * 256 + ai * 128 + wr * 64 + m * 16 + fr;
#pragma unroll
                for (int bj = 0; bj < 2; ++bj)
                    *(u32x4*)(O + row * D + h * 256 + bj * 128 + wc * 32 + 8 * fq) = pack8(acc[ai][bj][m][0], acc[ai][bj][m][1]);
            }
    }
};
struct EpiSsm1 {
    static constexpr bool AFTER_DRAIN = true, HAS_RS = false;
    bf16_t* up; const float *lam_re, *lam_im, *log_dt;
    __device__ __forceinline__ void operator()(AccRef, const Unit&, int, int, int, int) const {}
    __device__ __forceinline__ void fused(AccRef acc, const Unit& u, int wr, int wc, int fr, int fq, LAS unsigned char* lds, int wid, int lane) const {
        LAS float* L = (LAS float*)lds;
#pragma unroll
        for (int ai = 0; ai < 2; ++ai)
#pragma unroll
            for (int m = 0; m < 4; ++m) {
                const int rl = ai * 128 + wr * 64 + m * 16 + fr;
#pragma unroll
                for (int n = 0; n < 2; ++n) { const int col = wc * 32 + 8 * fq + 4 * n; *(LAS f32x4*)(L + rl * 128 + (col ^ ((rl & 15) << 3))) = acc[ai][0][m][n]; }
            }
        __syncthreads();
        {
            const int g = u.bz & 31, p = lane;
            const float dtc = expf(log_dt[g]) * (float)CH;
            const float lr = fminf(lam_re[g * NP + p], -1e-4f), li = lam_im[g * NP + p];
            float sn, cs; const float mag = expf(lr * dtc); sincosf(li * dtc, &sn, &cs);
            const float ar = mag * cs, aim = mag * sn;
            const float mag32 = expf(lr * dtc * 32.f); float sn32, cs32; sincosf(li * dtc * 32.f, &sn32, &cs32);
            const float br = mag32 * cs32, bim = mag32 * sn32;
            LAS f32x2* Eb = (LAS f32x2*)(lds + LDS_RED);
            const int c0 = wid * 32;
            float xr = 0.f, xi = 0.f;
            for (int c = c0; c < c0 + 32; ++c) {
                const f32x2 l2 = *(const LAS f32x2*)(L + c * 128 + ((2 * p) ^ ((c & 15) << 3)));
                const float nr = ar * xr - aim * xi + l2[0], ni = ar * xi + aim * xr + l2[1]; xr = nr; xi = ni; }
            Eb[wid * 64 + p] = (f32x2){xr, xi};
            __syncthreads();
            xr = 0.f; xi = 0.f;
            for (int v = 0; v < wid; ++v) { const f32x2 e = Eb[v * 64 + p]; const float nr = br * xr - bim * xi + e[0], ni = br * xi + bim * xr + e[1]; xr = nr; xi = ni; }
            unsigned* dst = (unsigned*)(up + (size_t)u.bz * NCH * UPW + 512) + p;
            for (int c = c0; c < c0 + 32; ++c) {
                dst[(size_t)c * (UPW / 2)] = cvtpk(xr, xi);
                const f32x2 l2 = *(const LAS f32x2*)(L + c * 128 + ((2 * p) ^ ((c & 15) << 3)));
                const float nr = ar * xr - aim * xi + l2[0], ni = ar * xi + aim * xr + l2[1]; xr = nr; xi = ni; }
        }
        __syncthreads();
    }
};

struct GainSpec { const float* g1; const float* g2; float g2s; };
__device__ __forceinline__ float gain_of(const GainSpec& gs, int k) {
    if (!gs.g1) return 1.f;
    if (gs.g2 && k >= 512) return gs.g2[(k - 512) & 127] * gs.g2s;
    return gs.g1[k];
}
__device__ __forceinline__ void transpose_item(const float* W, int K, int N, bf16_t* WT, bool il, int nh, int hb, const GainSpec gs, LAS float* scr, int item, int lane) {
    const int nblk = N / 32, kb = item / nblk, nb = item % nblk, k0 = 64 * kb, n0 = 32 * nb;
    float tv[32];
#pragma unroll
    for (int i = 0; i < 32; ++i) { const int kk = 2 * i + (lane >> 5); tv[i] = W[(size_t)(k0 + kk) * N + n0 + (lane & 31)]; }
#pragma unroll
    for (int i = 0; i < 32; ++i) { const int kk = 2 * i + (lane >> 5); scr[kk * 33 + (lane & 31)] = tv[i] * gain_of(gs, k0 + kk); }
    asm volatile("s_waitcnt lgkmcnt(0)" ::: "memory");
    const int c = lane & 7;
#pragma unroll
    for (int j = 0; j < 4; ++j) { const int n = (lane >> 3) + 8 * j; const LAS float* s = scr + (8 * c) * 33 + n;
        u32x4 o; o.x = cvtpk(s[0 * 33], s[1 * 33]); o.y = cvtpk(s[2 * 33], s[3 * 33]); o.z = cvtpk(s[4 * 33], s[5 * 33]); o.w = cvtpk(s[6 * 33], s[7 * 33]);
        int row = n0 + n; if (il) { const int jj = row % nh, half = hb + row / nh; row = (jj >> 7) * 256 + half * 128 + (jj & 127); }
        *(u32x4*)(WT + (size_t)row * K + k0 + 8 * c) = o; }
    asm volatile("s_waitcnt lgkmcnt(0)" ::: "memory");
}

__device__ __forceinline__ void ssm_matrices(KArgsP a, int l, int g, LAS unsigned char* lds, bf16_t* Bm, bf16_t* Mt) {
    int tid = threadIdx.x; asm volatile("" : "+v"(tid));
    LAS f32x2* lamtab = (LAS f32x2*)lds;
    LAS f32x2* cc = (LAS f32x2*)(lds + 16896);
    LAS f32x2* bb = (LAS f32x2*)(lds + 16896 + 8192);
    LAS float* Kt = (LAS float*)(lds + 16896 + 16384);
    const float* lam_re = a->in[9] + (size_t)(l * NG + g) * NP; const float* lam_im = a->in[10] + (size_t)(l * NG + g) * NP;
    const float* b_re = a->in[11] + (size_t)(l * NG + g) * NP * 16; const float* b_im = a->in[12] + (size_t)(l * NG + g) * NP * 16;
    const float* c_re = a->in[13] + (size_t)(l * NG + g) * 16 * NP; const float* c_im = a->in[14] + (size_t)(l * NG + g) * 16 * NP;
    const float* dd = a->in[15] + (size_t)(l * NG + g) * 16;
    const float dt = expf(a->in[16][l * NG + g]);
    for (int idx = tid; idx < 33 * 64; idx += 512) { const int tau = idx >> 6, p = idx & 63;
        const float lr = fminf(lam_re[p], -1e-4f), li = lam_im[p]; const float zr = lr * dt * (float)tau, zi = li * dt * (float)tau;
        const float mag = expf(zr); float sn, cs; sincosf(zi, &sn, &cs); lamtab[idx] = (f32x2){mag * cs, mag * sn}; }
    for (int idx = tid; idx < 1024; idx += 512) {
        cc[idx] = (f32x2){c_re[idx], c_im[idx]};
        const int p = idx >> 4;
        const float lr = fminf(lam_re[p], -1e-4f), li = lam_im[p]; const float mag = expf(lr * dt); float sn, cs; sincosf(li * dt, &sn, &cs);
        const float ar = mag * cs - 1.f, ai = mag * sn, den = 1.f / (lr * lr + li * li);
        const float qr = (ar * lr + ai * li) * den, qi = (ai * lr - ar * li) * den;
        const float br = b_re[idx], bi = b_im[idx];
        bb[idx] = (f32x2){qr * br - qi * bi, qr * bi + qi * br};
    }
    __syncthreads();
    for (int idx = tid; idx < 32 * 256; idx += 512) { const int tau = idx >> 8, ho = (idx >> 4) & 15, hi = idx & 15; float s = 0.f;
        for (int p = 0; p < NP; ++p) { const f32x2 c = cc[ho * 64 + p], lm = lamtab[tau * 64 + p], b = bb[p * 16 + hi];
            const float wr_ = c[0] * lm[0] - c[1] * lm[1], wi_ = c[0] * lm[1] + c[1] * lm[0]; s += wr_ * b[0] - wi_ * b[1]; }
        if (tau == 0 && ho == hi) s += dd[ho];
        Kt[idx] = s; }
    __syncthreads();
    for (int ch = tid; ch < 512 * 80; ch += 512) { const int n = ch / 80, kc = ch % 80, t = n >> 4, ho = n & 15, k0 = kc * 8; float v[8];
        if (k0 < 512) { const int s = k0 >> 4, hi0 = k0 & 15;
#pragma unroll
            for (int j = 0; j < 8; ++j) v[j] = (s <= t) ? Kt[(t - s) * 256 + ho * 16 + hi0 + j] : 0.f;
        } else { const int p0 = (k0 - 512) >> 1;
#pragma unroll
            for (int j = 0; j < 4; ++j) { const f32x2 c = cc[ho * 64 + p0 + j], lm = lamtab[(t + 1) * 64 + p0 + j];
                v[2 * j] = c[0] * lm[0] - c[1] * lm[1]; v[2 * j + 1] = -(c[0] * lm[1] + c[1] * lm[0]); } }
        u32x4 o; o.x = cvtpk(v[0], v[1]); o.y = cvtpk(v[2], v[3]); o.z = cvtpk(v[4], v[5]); o.w = cvtpk(v[6], v[7]);
        *(u32x4*)(Mt + (size_t)n * UPW + k0) = o; }
    for (int ch = tid; ch < 256 * 64; ch += 512) { const int n = ch >> 6, k0 = (ch & 63) * 8; float v[8];
        if (n < 128) { const int p = n >> 1, ri = n & 1, s = k0 >> 4, hi0 = k0 & 15; const f32x2 lm = lamtab[(CH - 1 - s) * 64 + p];
#pragma unroll
            for (int j = 0; j < 8; ++j) { const f32x2 b = bb[p * 16 + hi0 + j]; v[j] = ri ? (lm[0] * b[1] + lm[1] * b[0]) : (lm[0] * b[0] - lm[1] * b[1]); }
        } else {
#pragma unroll
            for (int j = 0; j < 8; ++j) v[j] = 0.f; }
        u32x4 o; o.x = cvtpk(v[0], v[1]); o.y = cvtpk(v[2], v[3]); o.z = cvtpk(v[4], v[5]); o.w = cvtpk(v[6], v[7]);
        *(u32x4*)(Bm + (size_t)n * 512 + k0) = o; }
    __syncthreads();
}

__device__ __forceinline__ void prologue(KArgsP a, LAS unsigned char* lds, int G) {
    unsigned char* ws = a->ws;
    int tid = threadIdx.x; asm volatile("" : "+v"(tid));
    const int lane = tid & 63, wave = tid >> 6, bid = blockIdx.x;
    for (int it = bid; it < DEPTH * NG; it += G) { const int l = it >> 5, g = it & 31;
        ssm_matrices(a, l, g, lds, (bf16_t*)(ws + WS_W + l * W_LAYER + W_BM) + (size_t)g * 256 * 512, (bf16_t*)(ws + WS_W + l * W_LAYER + W_MT) + (size_t)g * 512 * UPW); }
    if (bid == 0) {
        float* sm = (float*)(ws + WS_SMALL);
        if (tid < 128) { const int l = tid >> 6, i = tid & 63;
            const float d1 = wave_sum(a->in[20][l * 64 + i] * a->in[21][l * 64 + i]), d2 = wave_sum(a->in[22][l * 64 + i] * a->in[23][l * 64 + i]);
            if (i == 0) sm[l] = expf(d1) - expf(d2) + (0.8f - 0.6f * expf(-0.3f * (float)l)); }
        for (int idx = tid; idx < 4 * 132; idx += 512) { const int h = idx / 132, n = idx % 132; int bk;
            if (n < 16) bk = n; else { const float nf = (float)n; int lg = 16 + (int)(logf(nf / 16.f) / 2.0794415416798357f * 16.f); bk = lg < 31 ? lg : 31; }
            sm[16 + idx] = a->in[2][bk * 4 + h] * LOG2E; }
    }
    { LAS float* scr = (LAS float*)(lds + wave * 16384);
      const int gw = bid * 8 + wave, NGW = G * 8;
      const int nssm = (G > DEPTH * NG) ? DEPTH * NG : 0;
      for (int it = (bid - nssm) * 8 + wave; bid >= nssm && it < DEPTH * 12288; it += (G - nssm) * 8) {
          const int l = it / 12288; int r = it % 12288; unsigned char* wl = ws + WS_W + l * W_LAYER;
          const GainSpec none{nullptr, nullptr, 0.f};
          if (r < 1408) { transpose_item(a->in[4] + (size_t)l * D * FF, D, FF, (bf16_t*)(wl + W_GU1), true, FF, 0, GainSpec{a->in[3] + l * D, nullptr, 0.f}, scr, r, lane); continue; } r -= 1408;
          if (r < 1408) { transpose_item(a->in[5] + (size_t)l * D * FF, D, FF, (bf16_t*)(wl + W_GU1), true, FF, 1, GainSpec{a->in[3] + l * D, nullptr, 0.f}, scr, r, lane); continue; } r -= 1408;
          if (r < 1408) { transpose_item(a->in[6] + (size_t)l * FF * D, FF, D, (bf16_t*)(wl + W_D1), false, 1, 0, none, scr, r, lane); continue; } r -= 1408;
          if (r < 1408) { transpose_item(a->in[32] + (size_t)l * D * FF, D, FF, (bf16_t*)(wl + W_GU2), true, FF, 0, GainSpec{a->in[31] + l * D, nullptr, 0.f}, scr, r, lane); continue; } r -= 1408;
          if (r < 1408) { transpose_item(a->in[33] + (size_t)l * D * FF, D, FF, (bf16_t*)(wl + W_GU2), true, FF, 1, GainSpec{a->in[31] + l * D, nullptr, 0.f}, scr, r, lane); continue; } r -= 1408;
          if (r < 1408) { transpose_item(a->in[34] + (size_t)l * FF * D, FF, D, (bf16_t*)(wl + W_D2), false, 1, 0, none, scr, r, lane); continue; } r -= 1408;
          if (r < 1024) { transpose_item(a->in[8] + (size_t)l * D * 2048, D, 2048, (bf16_t*)(wl + W_IN), false, 1, 0, GainSpec{a->in[7] + l * D, nullptr, 0.f}, scr, r, lane); continue; } r -= 1024;
          if (r < 256) { transpose_item(a->in[17] + (size_t)l * 512 * 1024, 512, 1024, (bf16_t*)(wl + W_GLU), true, 512, 0, none, scr, r, lane); continue; } r -= 256;
          if (r < 512) { transpose_item(a->in[25] + (size_t)l * D * D, D, D, (bf16_t*)(wl + W_OUT), false, 1, 0, GainSpec{a->in[19] + l * 512, a->in[24] + l * 128, 1.f - (0.8f - 0.6f * expf(-0.3f * (float)l))}, scr, r, lane); continue; } r -= 512;
          if (r < 512) { transpose_item(a->in[28] + (size_t)l * D * D, D, D, (bf16_t*)(wl + W_Q), false, 1, 0, GainSpec{a->in[26] + l * D, nullptr, 0.f}, scr, r, lane); continue; } r -= 512;
          if (r < 1024) { transpose_item(a->in[29] + (size_t)l * D * 2048, D, 2048, (bf16_t*)(wl + W_KV), false, 1, 0, none, scr, r, lane); continue; } r -= 1024;
          transpose_item(a->in[30] + (size_t)l * D * D, D, D, (bf16_t*)(wl + W_O), false, 1, 0, none, scr, r, lane);
      }
      for (int row = gw; row < T + DEPTH * BATCH * MEM; row += NGW) {
          const bool ismem = row >= T; const int mr = row - T, l = mr >> 10, mrow = mr & 1023;
          const float* src = ismem ? a->in[1] + (size_t)mrow * D : a->in[0] + (size_t)row * D;
          f32x4 v[4]; float s = 0.f;
#pragma unroll
          for (int j = 0; j < 4; ++j) { v[j] = *((const f32x4*)src + lane + 64 * j); s += (v[j][0] * v[j][0] + v[j][1] * v[j][1]) + (v[j][2] * v[j][2] + v[j][3] * v[j][3]); }
          s = wave_sum(s);
          if (!ismem) { if (lane < 16) ((float*)(ws + WS_SS))[(size_t)row * 16 + lane] = lane == 0 ? s : 0.f;
#pragma unroll
              for (int j = 0; j < 4; ++j) *((u32x2*)(ws + WS_HB + (size_t)row * D * 2) + lane + 64 * j) = (u32x2){cvtpk(v[j][0], v[j][1]), cvtpk(v[j][2], v[j][3])};
          } else { const float rs = rsqrtf(s * (1.f / D) + EPS); const float* gn = a->in[27] + l * D;
#pragma unroll
              for (int j = 0; j < 4; ++j) { const f32x4 gg = *((const f32x4*)gn + lane + 64 * j);
                  *((u32x2*)(ws + WS_MEMN + ((size_t)l * 1024 + mrow) * D * 2) + lane + 64 * j) = (u32x2){cvtpk(v[j][0] * rs * gg[0], v[j][1] * rs * gg[1]), cvtpk(v[j][2] * rs * gg[2], v[j][3] * rs * gg[3])}; }
          }
      }
    }
}

constexpr int AT_KROW = 256, AT_VROW = 128, AT_KBUF = 64 * AT_KROW, AT_VBUF = 128 * AT_VROW;
constexpr int AT_NBUF = 3, AT_K0 = 0, AT_V0 = AT_NBUF * AT_KBUF, AT_BIAS = AT_V0 + AT_NBUF * AT_VBUF;

__device__ __forceinline__ void at_tile(LAS unsigned char* Kb, LAS unsigned char* Vb, const LAS float* biasl, int r, int g, int k0, int qw0, int qrow, float cfar,
                                        const bf16x8 (&qf)[2][2], float (&mrow)[2], f32x4 (&ol)[2], f32x4 (&o)[2][8], bool first) {
    f32x4 s[2][4];
    const bool far = (qw0 - (k0 + 63)) >= 128;
    const float cf = far ? cfar : 0.f;
    const float ci0 = first ? cf : cf - mrow[0], ci1 = first ? cf : cf - mrow[1];
    bf16x8 kfa[8], kfb[8];
#pragma unroll
    for (int kb = 0; kb < 4; ++kb)
#pragma unroll
        for (int ks = 0; ks < 2; ++ks) kfa[kb * 2 + ks] = *(const LAS bf16x8*)(Kb + (kb * 16 + r) * AT_KROW + (((ks * 4 + g) ^ r) * 16));
    __builtin_amdgcn_sched_barrier(0);
#pragma unroll
    for (int kb = 0; kb < 4; ++kb)
#pragma unroll
        for (int ks = 0; ks < 2; ++ks) kfb[kb * 2 + ks] = *(const LAS bf16x8*)(Kb + (kb * 16 + r) * AT_KROW + (((8 + ks * 4 + g) ^ r) * 16));
    __builtin_amdgcn_sched_barrier(0);
#pragma unroll
    for (int kb = 0; kb < 4; ++kb) s[0][kb] = __builtin_amdgcn_mfma_f32_16x16x32_bf16(kfa[kb * 2], qf[0][0], (f32x4){ci0, ci0, ci0, ci0}, 0, 0, 0);
#pragma unroll
    for (int kb = 0; kb < 4; ++kb) s[0][kb] = __builtin_amdgcn_mfma_f32_16x16x32_bf16(kfa[kb * 2 + 1], qf[0][1], s[0][kb], 0, 0, 0);
    __builtin_amdgcn_sched_barrier(0);
    bf16x8 vf[16];
#pragma unroll
    for (int db = 0; db < 4; ++db)
#pragma unroll
        for (int kk = 0; kk < 2; ++kk) vf[db * 2 + kk] = *(const LAS bf16x8*)(Vb + (db * 16 + r) * AT_VROW + (((kk * 4 + g) ^ (r >> 1)) * 16));
    __builtin_amdgcn_sched_barrier(0);
#pragma unroll
    for (int kb = 0; kb < 4; ++kb) s[1][kb] = __builtin_amdgcn_mfma_f32_16x16x32_bf16(kfb[kb * 2], qf[1][0], (f32x4){ci1, ci1, ci1, ci1}, 0, 0, 0);
#pragma unroll
    for (int kb = 0; kb < 4; ++kb) s[1][kb] = __builtin_amdgcn_mfma_f32_16x16x32_bf16(kfb[kb * 2 + 1], qf[1][1], s[1][kb], 0, 0, 0);
    __builtin_amdgcn_sched_barrier(0);
    if (!far) {
        float badd[4][4];
#pragma unroll
        for (int kb = 0; kb < 4; ++kb)
#pragma unroll
            for (int j = 0; j < 4; ++j) { const int key = k0 + (kb >> 1) * 32 + g * 8 + (kb & 1) * 4 + j, dist = qrow - key;
                const int idx = dist < 0 ? 0 : (dist > 128 ? 128 : dist);
                badd[kb][j] = biasl[idx]; }
#pragma unroll
        for (int kb = 0; kb < 4; ++kb)
#pragma unroll
            for (int j = 0; j < 4; ++j) { const int key = k0 + (kb >> 1) * 32 + g * 8 + (kb & 1) * 4 + j;
                const float ad = (qrow >= key) ? badd[kb][j] : -INFINITY;
                s[0][kb][j] += ad; s[1][kb][j] += ad; }
    }
    float mx[2];
#pragma unroll
    for (int m = 0; m < 2; ++m) {
        float v = max3f(s[m][0][0], s[m][0][1], s[m][0][2]);
        v = max3f(v, s[m][0][3], s[m][1][0]); v = max3f(v, s[m][1][1], s[m][1][2]); v = max3f(v, s[m][1][3], s[m][2][0]);
        v = max3f(v, s[m][2][1], s[m][2][2]); v = max3f(v, s[m][2][3], s[m][3][0]); v = max3f(v, s[m][3][1], s[m][3][2]); v = max2f(v, s[m][3][3]);
        mx[m] = xl_max(v);
    }
    if (first || __any(max2f(mx[0], mx[1]) > 6.0f)) {
#pragma unroll
        for (int m = 0; m < 2; ++m) {
            const float delta = first ? mx[m] : fmaxf(mx[m], 0.f), alpha = first ? 0.f : fast_exp2(-delta);
            mrow[m] = first ? delta : mrow[m] + delta;
            ol[m] = ol[m] * alpha;
#pragma unroll
            for (int db = 0; db < 8; ++db) o[m][db] = o[m][db] * alpha;
#pragma unroll
            for (int kb = 0; kb < 4; ++kb) s[m][kb] = s[m][kb] - delta;
        }
    }
#pragma unroll
    for (int kb = 0; kb < 4; ++kb)
#pragma unroll
        for (int j = 0; j < 4; ++j) s[0][kb][j] = fast_exp2(s[0][kb][j]);
    bf16x8 pf0[2], pf1[2];
#pragma unroll
    for (int kk = 0; kk < 2; ++kk) { const u32x4 pw = pack8(s[0][2 * kk], s[0][2 * kk + 1]); pf0[kk] = __builtin_bit_cast(bf16x8, pw); }
    __builtin_amdgcn_sched_barrier(0);
#pragma unroll
    for (int db = 4; db < 8; ++db)
#pragma unroll
        for (int kk = 0; kk < 2; ++kk) vf[db * 2 + kk] = *(const LAS bf16x8*)(Vb + (db * 16 + r) * AT_VROW + (((kk * 4 + g) ^ (r >> 1)) * 16));
    __builtin_amdgcn_sched_barrier(0);
#pragma unroll
    for (int i = 0; i < 16; ++i) {
        const int db = i >> 1, kk = i & 1;
        o[0][db] = __builtin_amdgcn_mfma_f32_16x16x32_bf16(vf[db * 2 + kk], pf0[kk], o[0][db], 0, 0, 0);
        s[1][i >> 2][i & 3] = fast_exp2(s[1][i >> 2][i & 3]);
        __builtin_amdgcn_sched_barrier(0);
    }
    const short one = (short)0x3F80; const bf16x8 ones = {one, one, one, one, one, one, one, one};
    ol[0] = __builtin_amdgcn_mfma_f32_16x16x32_bf16(ones, pf0[0], ol[0], 0, 0, 0);
    ol[0] = __builtin_amdgcn_mfma_f32_16x16x32_bf16(ones, pf0[1], ol[0], 0, 0, 0);
#pragma unroll
    for (int kk = 0; kk < 2; ++kk) { const u32x4 pw = pack8(s[1][2 * kk], s[1][2 * kk + 1]); pf1[kk] = __builtin_bit_cast(bf16x8, pw); }
    __builtin_amdgcn_sched_barrier(0);
#pragma unroll
    for (int kk = 0; kk < 2; ++kk)
#pragma unroll
        for (int db = 0; db < 8; ++db) o[1][db] = __builtin_amdgcn_mfma_f32_16x16x32_bf16(vf[db * 2 + kk], pf1[kk], o[1][db], 0, 0, 0);
    ol[1] = __builtin_amdgcn_mfma_f32_16x16x32_bf16(ones, pf1[0], ol[1], 0, 0, 0);
    ol[1] = __builtin_amdgcn_mfma_f32_16x16x32_bf16(ones, pf1[1], ol[1], 0, 0, 0);
    __builtin_amdgcn_sched_barrier(0);
}

__device__ __forceinline__ void attn_qblock(int b, int h, int q0, float lam, LAS unsigned char* lds, const bf16_t* qbuf, const bf16_t* kbuf, const bf16_t* vT, bf16_t* mix, const float* bias_g, const float* ssm_sq, bool var) {
    int tid = threadIdx.x; asm volatile("" : "+v"(tid));
    const int lane = tid & 63, w = __builtin_amdgcn_readfirstlane(tid >> 6), r = lane & 15, g = lane >> 4;
    const int qw0 = q0 + w * 16, qrow = qw0 + r;
    LAS float* biasl = (LAS float*)(lds + AT_BIAS);
    __syncthreads();
    if (tid < 129) biasl[tid] = bias_g[h * 132 + tid];
    bf16x8 qf[2][2];
    { const bf16_t* qp = qbuf + ((size_t)(b * SEQ + qrow)) * 512 + h * 128 + g * 8;
#pragma unroll
      for (int m = 0; m < 2; ++m)
#pragma unroll
          for (int ks = 0; ks < 2; ++ks) qf[m][ks] = *(const bf16x8*)(qp + m * 64 + ks * 32); }
    f32x4 o[2][8];
#pragma unroll
    for (int m = 0; m < 2; ++m)
#pragma unroll
        for (int db = 0; db < 8; ++db) o[m][db] = (f32x4){0.f, 0.f, 0.f, 0.f};
    float mrow[2] = {0.f, 0.f};
    f32x4 ol[2] = {(f32x4){0.f, 0.f, 0.f, 0.f}, (f32x4){0.f, 0.f, 0.f, 0.f}};
    const int ntiles = (q0 + 128) >> 6;
    unsigned gk[2], lk[2], gv[2], lv[2];
#pragma unroll
    for (int i = 0; i < 2; ++i) { const int c = tid + i * 512;
        { const int key = c >> 4, ch = c & 15, rho = ((key >> 5) * 2 + ((key >> 2) & 1)) * 16 + ((key >> 3) & 3) * 4 + (key & 3); gk[i] = key * 512 + ch * 8; lk[i] = rho * AT_KROW + ((ch ^ (rho & 15)) * 16); }
        { const int dv = c >> 3, ch = c & 7; gv[i] = dv * SEQ + ch * 8; lv[i] = dv * AT_VROW + ((ch ^ ((dv >> 1) & 7)) * 16); } }
    const bf16_t* kbase = kbuf + ((size_t)b * SEQ) * 512 + h * 128;
    const bf16_t* vbase = vT + ((size_t)(b * 4 + h) * 128) * SEQ;
    u32x4 kreg[2], vreg[2];
#pragma unroll
    for (int i = 0; i < 2; ++i) { kreg[i] = *(const u32x4*)(kbase + gk[i]); vreg[i] = *(const u32x4*)(vbase + gv[i]); }
#pragma unroll
    for (int i = 0; i < 2; ++i) { *(LAS u32x4*)(lds + AT_K0 + lk[i]) = kreg[i]; *(LAS u32x4*)(lds + AT_V0 + lv[i]) = vreg[i]; }
    __syncthreads();
    const float cfar = biasl[128];
    int cur = 0;
    for (int kt = 0; kt < ntiles; ++kt) {
        const int k0 = kt * 64, nxt = (cur == AT_NBUF - 1) ? 0 : cur + 1;
        const bool pf = (kt + 1 < ntiles);
        if (pf) {
#pragma unroll
            for (int i = 0; i < 2; ++i) { kreg[i] = *(const u32x4*)(kbase + (size_t)(k0 + 64) * 512 + gk[i]); vreg[i] = *(const u32x4*)(vbase + (k0 + 64) + gv[i]); } }
        if (k0 <= qw0 + 15) at_tile(lds + AT_K0 + cur * AT_KBUF, lds + AT_V0 + cur * AT_VBUF, biasl, r, g, k0, qw0, qrow, cfar, qf, mrow, ol, o, kt == 0);
        if (pf) {
#pragma unroll
            for (int i = 0; i < 2; ++i) { *(LAS u32x4*)(lds + AT_K0 + nxt * AT_KBUF + lk[i]) = kreg[i]; *(LAS u32x4*)(lds + AT_V0 + nxt * AT_VBUF + lv[i]) = vreg[i]; } }
        __syncthreads();
        cur = nxt;
    }
    const float inv0 = 1.f / ol[0][0], inv1 = lam / ol[1][0];
    float ssq = 0.f;
#pragma unroll
    for (int db = 0; db < 8; ++db)
#pragma unroll
        for (int j = 0; j < 4; ++j) { const float v = o[0][db][j] * inv0 - o[1][db][j] * inv1; o[0][db][j] = v; ssq += v * v; }
    ssq = fq_sum(ssq);
    const float rn = rsqrtf(ssq * (1.f / 128.f) + EPS) * sqrtf(ss_sum16(ssm_sq, b * SEQ + qrow) * (1.f / 512.f) + EPS);
    bf16_t* op = mix + ((size_t)(b * SEQ + qrow)) * D + 512 + h * 128 + g * 4;
#pragma unroll
    for (int db = 0; db < 8; ++db) *(u32x2*)(op + db * 16) = (u32x2){cvtpk(o[0][db][0] * rn, o[0][db][1] * rn), cvtpk(o[0][db][2] * rn, o[0][db][3] * rn)};
}

#if DEBUG_CHECK
__device__ __forceinline__ unsigned hash_u(unsigned x) { x ^= x >> 16; x *= 0x7feb352dU; x ^= x >> 15; x *= 0x846ca68bU; x ^= x >> 16; return x; }
__device__ __forceinline__ void dbg_flag(unsigned* ctl, int id, float got, float ref, float rtol, float atol) {
    const float d = fabsf(got - ref);
    if (!(d <= atol + rtol * fabsf(ref))) atomicAdd(ctl + 64 + id, 1u);
}
#endif

__global__ void __launch_bounds__(512, 2) fwd_kernel(Args a) {
    extern __shared__ __attribute__((aligned(16))) unsigned char lds_raw[];
    LAS unsigned char* lds = (LAS unsigned char*)lds_raw;
    cg::grid_group grid = cg::this_grid();
    const int G = gridDim.x;
#define PH KArgsP ka = KARGS(); int bid = blockIdx.x, G = gridDim.x, tidl = threadIdx.x; asm volatile("" : "+s"(bid), "+s"(G), "+v"(tidl)); const int lane = tidl & 63, wave = tidl >> 6; (void)lane; (void)wave; unsigned char* ws = ka->ws; float* ssb = (float*)(ws + WS_SS); float* ssm_ss = (float*)(ws + WS_SSM_SS); const float* smalls = (const float*)(ws + WS_SMALL); \
    bf16_t* hb = (bf16_t*)(ws + WS_HB); unsigned char* ar = ws + WS_AR; unsigned char* wl = ws + WS_W + l * W_LAYER; float* hbuf = ka->out; \
    (void)ssb; (void)ssm_ss; (void)smalls; (void)hb; (void)ar; (void)wl; (void)hbuf;
    if (threadIdx.x < 2) ((LAS unsigned*)(lds + LDS_XB))[threadIdx.x] = 0u;
    __syncthreads();
    (void)xcd_barrier_post((unsigned*)(KARGS()->ws + WS_CTL) + 1024, (volatile LAS unsigned*)(lds + LDS_XB));
    for (int rep = 0; rep < (PROBE == 5 ? 2 : 1); ++rep) prologue(KARGS(), lds, G);
    grid.sync();
#define GSYNC() do { XcdBarrier xb_; xb_.bar = (unsigned*)(KARGS()->ws + WS_CTL) + 1024; xb_.x = xb_xcc_id(); xb_.st = (volatile LAS unsigned*)(lds + LDS_XB); xcd_barrier(xb_); } while (0)

    for (int l = 0; l < DEPTH; ++l) {
        if (PROBE == 4) { for (int rep = 0; rep < 10; ++rep) GSYNC(); }
        for (int rep = 0; rep < (PROBE == 2 ? 2 : 1); ++rep)
        { PH StdSched S; S.init(T, 2 * FF, G, bid, D, D); EpiFfnUp E{(bf16_t*)(ar + AR_HID), ssb + (size_t)(4 * l + 0) * T * 16, (const LAS float*)(lds + LDS_RS)};
          gemm_phase<EpiFfnUp, StdSched, true>(lds, hb, (const bf16_t*)(wl + W_GU1), D, D, D, S, E); }
        GSYNC();
        if (PROBE == 6) { PH StdSched S; S.init(T, D, G, bid, FF, FF); EpiNull E{(float*)(ws + WS_CTL + 20000)};
          gemm_phase<EpiNull, StdSched, false>(lds, (const bf16_t*)(ar + AR_HID), (const bf16_t*)(wl + W_D1), FF, FF, FF, S, E); }
        for (int rep = (PROBE == 7 ? 0 : 1); rep < 2; ++rep)
        { PH StdSched S; S.init(T, D, G, bid, FF, FF); EpiResid E{hb, ssb + (size_t)(4 * l + 1) * T * 16, (PROBE == 7 && rep == 0) ? 0.f : 0.5f, nullptr, nullptr};
          gemm_phase<EpiResid, StdSched, true>(lds, (const bf16_t*)(ar + AR_HID), (const bf16_t*)(wl + W_D1), FF, FF, FF, S, E); }
        GSYNC();
        for (int rep = 0; rep < (PROBE == 3 ? 2 : 1); ++rep)
        { PH StdSched S; S.init(T, 2048, G, bid, D, D); EpiWin E{ar, ssb + (size_t)(4 * l + 1) * T * 16, (const LAS float*)(lds + LDS_RS)};
          gemm_phase<EpiWin, StdSched, true>(lds, hb, (const bf16_t*)(wl + W_IN), D, D, D, S, E); }
        GSYNC();
        for (int rep = 0; rep < (PROBE == 3 ? 2 : 1); ++rep)
        if ((int)blockIdx.x < 128) { PH Ssm1Sched S{bid}; EpiSsm1 E{(bf16_t*)(ar + AR_UP), ka->in[9] + (size_t)l * NG * NP, ka->in[10] + (size_t)l * NG * NP, ka->in[16] + (size_t)l * NG};
          gemm_phase<EpiSsm1, Ssm1Sched, false>(lds, (const bf16_t*)(ar + AR_UP), (const bf16_t*)(wl + W_BM), UPW, 512, 512, S, E); }
        else if (l == 0) { PH WkvSched S{G, bid}; EpiWkv E{(bf16_t*)(ws + WS_KX), (bf16_t*)(ws + WS_VXT)};
          gemm_phase<EpiWkv, WkvSched, false>(lds, (const bf16_t*)(ws + WS_MEMN), (const bf16_t*)(ws + WS_W + W_KV), D, D, D, S, E); }
        GSYNC();
        for (int rep = 0; rep < (PROBE == 3 ? 2 : 1); ++rep)
        { PH Ssm2Sched S{G, bid}; EpiSsm2 E{(bf16_t*)(ar + AR_Y)};
          gemm_phase<EpiSsm2, Ssm2Sched, false>(lds, (const bf16_t*)(ar + AR_UP), (const bf16_t*)(wl + W_MT), UPW, UPW, UPW, S, E); }
        GSYNC();
        for (int rep = 0; rep < (PROBE == 8 ? 2 : 1); ++rep)
        { PH StdSched S; S.init(T, 1024, G, bid, 512, 512); EpiGlu E{(bf16_t*)(ar + AR_MIX), ka->in[18] + (size_t)l * 1024, ssm_ss + (size_t)l * T * 16};
          gemm_phase<EpiGlu, StdSched, true>(lds, (const bf16_t*)(ar + AR_Y), (const bf16_t*)(wl + W_GLU), 512, 512, 512, S, E); }
        GSYNC();
        { PH const float lam = smalls[l];
          for (int rep = 0; rep < ((PROBE == 1 || ATT_VAR) ? 2 : 1); ++rep)
          for (int uidx = bid; uidx < 512; uidx += G) { const bool var = ATT_VAR && rep == 0;
              int bh = uidx >> 5, j = uidx & 31;
              if (G == 256) { bh = (bid & 7) + 8 * (uidx >> 8); j = bid >> 3; }
              const int b = bh >> 2, h = bh & 3;
              attn_qblock(b, h, j * 128, lam, lds, (const bf16_t*)(ar + AR_Q), (const bf16_t*)(ar + AR_K), (const bf16_t*)(ar + AR_VT), (bf16_t*)(ar + AR_MIX), smalls + 16, ssm_ss + (size_t)l * T * 16, var);
              attn_qblock(b, h, (63 - j) * 128, lam, lds, (const bf16_t*)(ar + AR_Q), (const bf16_t*)(ar + AR_K), (const bf16_t*)(ar + AR_VT), (bf16_t*)(ar + AR_MIX), smalls + 16, ssm_ss + (size_t)l * T * 16, var); }
        }
        GSYNC();
        for (int rep = (PROBE == 7 ? 0 : 1); rep < 2; ++rep)
        { PH StdSched S; S.init(T, D, G, bid, D, D); EpiResidT<true> E{hb, ssb + (size_t)(4 * l + 2) * T * 16, (PROBE == 7 && rep == 0) ? 0.f : 1.f, ssm_ss + (size_t)l * T * 16, (const LAS float*)(lds + LDS_RS)};
          gemm_phase<EpiResidT<true>, StdSched, true>(lds, (const bf16_t*)(ar + AR_MIX), (const bf16_t*)(wl + W_OUT), D, D, D, S, E); }
        GSYNC();
        for (int rep = 0; rep < (PROBE == 3 ? 2 : 1); ++rep)
        { PH StdSched S; S.init(T, D, G, bid, D, D); EpiWq E{(bf16_t*)(ar + AR_QX), ssb + (size_t)(4 * l + 2) * T * 16, 0.0625f * LOG2E, (const LAS float*)(lds + LDS_RS)};
          gemm_phase<EpiWq, StdSched, true>(lds, hb, (const bf16_t*)(wl + W_Q), D, D, D, S, E); }
        GSYNC();
        for (int rep = 0; rep < (PROBE == 3 ? 2 : 1); ++rep)
        { PH XaSched S{G, bid, (unsigned)MEM * 1024, 256u}; EpiSoftmax E{(bf16_t*)(ar + AR_P), (LAS float*)(lds + LDS_RED)};
          gemm_phase<EpiSoftmax, XaSched, true>(lds, (const bf16_t*)(ar + AR_QX), (const bf16_t*)(ws + WS_KX) + (size_t)l * 1024 * 1024, D, D, 256, S, E); }
        GSYNC();
        for (int rep = 0; rep < (PROBE == 3 ? 2 : 1); ++rep)
        { PH XaSched S{G, bid, 4u * 65536u, 65536u}; EpiPV E{(bf16_t*)(ar + AR_OX)};
          gemm_phase<EpiPV, XaSched, false>(lds, (const bf16_t*)(ar + AR_P), (const bf16_t*)(ws + WS_VXT) + (size_t)l * 1024 * 1024, D, 256, 256, S, E); }
        GSYNC();
        for (int rep = (PROBE == 7 ? 0 : 1); rep < 2; ++rep)
        { PH StdSched S; S.init(T, D, G, bid, D, D); EpiResid E{hb, ssb + (size_t)(4 * l + 3) * T * 16, (PROBE == 7 && rep == 0) ? 0.f : 1.f, nullptr, nullptr};
          gemm_phase<EpiResid, StdSched, true>(lds, (const bf16_t*)(ar + AR_OX), (const bf16_t*)(wl + W_O), D, D, D, S, E); }
        GSYNC();
        for (int rep = 0; rep < (PROBE == 2 ? 2 : 1); ++rep)
        { PH StdSched S; S.init(T, 2 * FF, G, bid, D, D); EpiFfnUp E{(bf16_t*)(ar + AR_HID), ssb + (size_t)(4 * l + 3) * T * 16, (const LAS float*)(lds + LDS_RS)};
          gemm_phase<EpiFfnUp, StdSched, true>(lds, hb, (const bf16_t*)(wl + W_GU2), D, D, D, S, E); }
        GSYNC();
        if (PROBE == 6) { PH StdSched S; S.init(T, D, G, bid, FF, FF); EpiNull E{(float*)(ws + WS_CTL + 20000)};
          gemm_phase<EpiNull, StdSched, false>(lds, (const bf16_t*)(ar + AR_HID), (const bf16_t*)(wl + W_D2), FF, FF, FF, S, E); }
        for (int rep = (PROBE == 7 ? 0 : 1); rep < 2; ++rep)
        { PH StdSched S; S.init(T, D, G, bid, FF, FF); EpiResid E{hb, ssb + (size_t)(4 * l + 4) * T * 16, (PROBE == 7 && rep == 0) ? 0.f : 0.5f, nullptr, nullptr};
          gemm_phase<EpiResid, StdSched, true>(lds, (const bf16_t*)(ar + AR_HID), (const bf16_t*)(wl + W_D2), FF, FF, FF, S, E); }
        GSYNC();
    }
    { const int l = 0; PH const float* sq = ssb + (size_t)8 * T * 16; const float* gn = ka->in[35];
      for (int row = bid * 8 + wave; row < T; row += G * 8) { const float rs = rsqrtf(ss_sum16(sq, row) * (1.f / D) + EPS);
#pragma unroll
          for (int j = 0; j < 2; ++j) { const u32x4 w = *((const u32x4*)(hb + (size_t)row * D) + lane + 64 * j);
              const f32x4 g0 = *((const f32x4*)gn + 2 * (lane + 64 * j)), g1 = *((const f32x4*)gn + 2 * (lane + 64 * j) + 1);
              f32x4 v0, v1;
              v0[0] = __uint_as_float(w.x << 16) * rs * g0[0]; v0[1] = __uint_as_float(w.x & 0xffff0000u) * rs * g0[1]; v0[2] = __uint_as_float(w.y << 16) * rs * g0[2]; v0[3] = __uint_as_float(w.y & 0xffff0000u) * rs * g0[3];
              v1[0] = __uint_as_float(w.z << 16) * rs * g1[0]; v1[1] = __uint_as_float(w.z & 0xffff0000u) * rs * g1[1]; v1[2] = __uint_as_float(w.w << 16) * rs * g1[2]; v1[3] = __uint_as_float(w.w & 0xffff0000u) * rs * g1[3];
              f32x4* op = (f32x4*)(hbuf + (size_t)row * D) + 2 * (lane + 64 * j); op[0] = v0; op[1] = v1; } } }
}

extern "C" void kernel_launch(void* const* d_in, const int* in_sizes, int n_in, void* d_out, int out_size, void* d_ws, size_t ws_size, hipStream_t stream) {
    static int grid = 0;
    if (grid == 0) {
        if (n_in != 36 || out_size != T * D || ws_size < WS_END) { fprintf(stderr, "kernel_launch: unexpected problem (n_in %d out %d ws %zu)\n", n_in, out_size, ws_size); grid = -1; return; }
        int dev = 0, cus = 0, per_cu = 0;
        if (hipGetDevice(&dev) != hipSuccess || hipDeviceGetAttribute(&cus, hipDeviceAttributeMultiprocessorCount, dev) != hipSuccess) { grid = -1; return; }
        if (hipFuncSetAttribute((const void*)fwd_kernel, hipFuncAttributeMaxDynamicSharedMemorySize, LDS_BYTES) != hipSuccess) { fprintf(stderr, "hipFuncSetAttribute failed\n"); grid = -1; return; }
        if (hipOccupancyMaxActiveBlocksPerMultiprocessor(&per_cu, (const void*)fwd_kernel, 512, LDS_BYTES) != hipSuccess || per_cu < 1) { fprintf(stderr, "occupancy query: %d\n", per_cu); }
        (void)hipGetLastError();
        grid = cus;
        if (grid != 256) fprintf(stderr, "kernel_launch: %d CUs (expected 256)\n", grid);
    }
    if (grid < 0) return;
    (void)hipMemsetAsync((char*)d_ws + WS_CTL, 0, 32768, stream);
    Args a{};
    for (int i = 0; i < 36; ++i) a.in[i] = (const float*)d_in[i];
    a.out = (float*)d_out; a.ws = (unsigned char*)d_ws;
    void* args[] = {&a};
    hipError_t e = hipLaunchCooperativeKernel((const void*)fwd_kernel, dim3(grid), dim3(512), args, LDS_BYTES, stream);
    if (e != hipSuccess) fprintf(stderr, "cooperative launch failed: %s (grid %d)\n", hipGetErrorString(e), grid);
}
```

```cpp
#include <hip/hip_runtime.h>
#include <hip/hip_cooperative_groups.h>
#include <cstdio>
#include <cstdint>
namespace cg = cooperative_groups;

#define LAS __attribute__((address_space(3)))
typedef unsigned short bf16_t;
typedef short bf16x8 __attribute__((ext_vector_type(8)));
typedef float f32x4 __attribute__((ext_vector_type(4)));
typedef float f32x2 __attribute__((ext_vector_type(2)));
typedef unsigned u32x4 __attribute__((ext_vector_type(4)));
typedef unsigned u32x2 __attribute__((ext_vector_type(2)));
typedef __bf16 bf16x2_t __attribute__((ext_vector_type(2)));

#ifndef PROBE
#define PROBE 0
#endif
#ifndef ATT_VAR
#define ATT_VAR 0
#endif
#ifndef DEBUG_CHECK
#define DEBUG_CHECK 0
#endif

constexpr int D = 1024, BATCH = 4, SEQ = 8192, T = BATCH * SEQ, DEPTH = 2, MEM = 256, FF = 2816;
constexpr int SSMW = 512, NG = 32, NP = 64, CH = 32  , NCH = SEQ / CH  , UPW = 640  ;
constexpr float EPS = 1e-6f, LOG2E = 1.4426950408889634f;

constexpr size_t MiB = 1u << 20;
constexpr size_t WS_CTL = 0;
constexpr size_t WS_SS = 466 * MiB;
constexpr size_t WS_SSM_SS = WS_SS + 9 * (size_t)T * 64;
constexpr size_t WS_SMALL = 3 * MiB;
constexpr size_t WS_MEMN = 4 * MiB;
constexpr size_t WS_KX = 8 * MiB;
constexpr size_t WS_VXT = 12 * MiB;
constexpr size_t WS_W = 16 * MiB, W_LAYER = 76 * MiB;
constexpr size_t W_GU1 = 0, W_D1 = 11 * MiB, W_GU2 = 16 * MiB + MiB / 2, W_D2 = 27 * MiB + MiB / 2, W_IN = 33 * MiB, W_GLU = 37 * MiB, W_OUT = 38 * MiB,
                 W_Q = 40 * MiB, W_KV = 42 * MiB, W_O = 46 * MiB, W_BM = 48 * MiB, W_MT = 56 * MiB;
constexpr size_t WS_HB = WS_W + 2 * W_LAYER;
constexpr size_t WS_AR = WS_HB + 64 * MiB;
constexpr size_t AR_UP = 0, AR_Q = 40 * MiB, AR_K = 72 * MiB, AR_VT = 104 * MiB, AR_Y = 136 * MiB, AR_MIX = 168 * MiB;
constexpr size_t AR_QX = 0, AR_P = 64 * MiB, AR_OX = 128 * MiB, AR_HID = 0;
constexpr size_t WS_END = WS_SSM_SS + 2 * (size_t)T * 64;

constexpr int LDS_BYTES = 155648;
constexpr int LDS_RED = 131072; constexpr int LDS_XB = 131072 + 8192;
constexpr int LDS_RS = 131072 + 8192 + 256, RS_MAX_UNITS = 12;

struct Args { const float* in[36]; float* out; unsigned char* ws; };
typedef const __attribute__((address_space(4))) Args* KArgsP;
#define KARGS() ({ KArgsP _p = (KArgsP)__builtin_amdgcn_kernarg_segment_ptr(); asm volatile("" : "+s"(_p)); _p; })

__device__ __forceinline__ unsigned cvtpk(float lo, float hi) { f32x2 v = {lo, hi}; bf16x2_t b = __builtin_convertvector(v, bf16x2_t); return __builtin_bit_cast(unsigned, b); }
__device__ __forceinline__ float bf2f(bf16_t x) { return __uint_as_float((unsigned)x << 16); }
__device__ __forceinline__ float wave_sum(float v) {
#pragma unroll
    for (int o = 1; o < 64; o <<= 1) v += __shfl_xor(v, o);
    return v;
}
__device__ __forceinline__ float fq_sum(float v) { v += __shfl_xor(v, 16); v += __shfl_xor(v, 32); return v; }
__device__ __forceinline__ float max3f(float a, float b, float c) { float r; asm("v_max3_f32 %0, %1, %2, %3" : "=v"(r) : "v"(a), "v"(b), "v"(c)); return r; }
__device__ __forceinline__ float max2f(float a, float b) { float r; asm("v_max_f32_e32 %0, %1, %2" : "=v"(r) : "v"(a), "v"(b)); return r; }
__device__ __forceinline__ float xl_max(float v) {
    u32x2 r = __builtin_amdgcn_permlane32_swap(__float_as_uint(v), __float_as_uint(v), false, false); v = max2f(__uint_as_float(r[0]), __uint_as_float(r[1]));
    r = __builtin_amdgcn_permlane16_swap(__float_as_uint(v), __float_as_uint(v), false, false); return max2f(__uint_as_float(r[0]), __uint_as_float(r[1]));
}
__device__ __forceinline__ float fq_max(float v) { v = fmaxf(v, __shfl_xor(v, 16)); v = fmaxf(v, __shfl_xor(v, 32)); return v; }
__device__ __forceinline__ u32x4 pack8(f32x4 a, f32x4 b) { u32x4 w; w.x = cvtpk(a[0], a[1]); w.y = cvtpk(a[2], a[3]); w.z = cvtpk(b[0], b[1]); w.w = cvtpk(b[2], b[3]); return w; }
__device__ __forceinline__ float fast_exp2(float x) { return __builtin_amdgcn_exp2f(x); }
__device__ __forceinline__ float fast_rcp(float x) { return __builtin_amdgcn_rcpf(x); }
__device__ __forceinline__ float sigmoidf_(float x) { return fast_rcp(1.f + fast_exp2(-x * LOG2E)); }


__device__ __forceinline__ float ss_sum16(const float* ss16, int row) {
    const f32x4* p = (const f32x4*)(ss16 + (size_t)row * 16); const f32x4 a = p[0], b = p[1], c = p[2], d = p[3];
    return (((a[0] + a[1]) + (a[2] + a[3])) + ((b[0] + b[1]) + (b[2] + b[3]))) + (((c[0] + c[1]) + (c[2] + c[3])) + ((d[0] + d[1]) + (d[2] + d[3])));
}
#define XB_TMO      128
#define XB_XCNT(j)  (256  + 64 * (j))
#define XB_XSUB(j)  (1280 + 64 * (j))
#define XB_XGEN(j)  (2304 + 64 * (j))
#define XB_TOP      3328
#define XB_TOPGEN   3392
#define XCD_BAR_WORDS 3456
#define XB_SPIN_CAP (1u << 22)
__device__ __forceinline__ unsigned xb_ld(unsigned* p)              { return __hip_atomic_load(p, __ATOMIC_RELAXED, __HIP_MEMORY_SCOPE_AGENT); }
__device__ __forceinline__ unsigned xb_add(unsigned* p, unsigned v) { return __hip_atomic_fetch_add(p, v, __ATOMIC_RELAXED, __HIP_MEMORY_SCOPE_AGENT); }
__device__ __forceinline__ unsigned xb_xcc_id() { return (unsigned)__builtin_amdgcn_s_getreg((3 << 11) | 20) & 0xFu; }
#define XB_SPIN(cond, bar) do { unsigned _sp = 0; while (cond) { __builtin_amdgcn_s_sleep(1); \
    if ((++_sp & 255u) == 0u) { if (xb_ld(&(bar)[XB_TMO])) break; if (_sp > XB_SPIN_CAP) { atomicAdd(&(bar)[XB_TMO], 1u); break; } } } } while (0)
struct XcdBarrier { unsigned* bar; unsigned x; volatile LAS unsigned* st; };
__device__ __forceinline__ XcdBarrier xcd_barrier_post(unsigned* bar, volatile LAS unsigned* st) {
    XcdBarrier b; b.bar = bar; b.x = xb_xcc_id(); b.st = st;
    if (threadIdx.x == 0) (void)xb_add(&bar[XB_XCNT(b.x)], 1u);
    return b;
}
__device__ __forceinline__ void xcd_barrier_complete(unsigned* bar, unsigned x, unsigned& nloc, unsigned& nx) {
    const unsigned G = gridDim.x * gridDim.y * gridDim.z;
    unsigned sum, cnt, mine, sp = 0u;
    for (;;) {
        sum = 0u; cnt = 0u; mine = 0u;
#pragma unroll
        for (unsigned j = 0; j < 16; ++j) { const unsigned c = xb_ld(&bar[XB_XCNT(j)]); sum += c; cnt += (c > 0u) ? 1u : 0u; mine = (j == x) ? c : mine; }
        if (sum == G) break;
        __builtin_amdgcn_s_sleep(1);
        if ((++sp & 255u) == 0u) { if (xb_ld(&bar[XB_TMO])) break; if (sp > XB_SPIN_CAP) { atomicAdd(&bar[XB_TMO], 1u); break; } }
    }
    nloc = mine > 0u ? mine : 1u; nx = cnt > 0u ? cnt : 1u;
}
__device__ __forceinline__ void xcd_barrier(const XcdBarrier& b) {
    asm volatile("s_waitcnt vmcnt(0)" ::: "memory");
    __syncthreads();
    if (threadIdx.x == 0) {
        unsigned* bar = b.bar;
        __builtin_amdgcn_s_waitcnt(0);
        unsigned nloc = b.st[0], nx = b.st[1];
        if (nloc == 0u) { xcd_barrier_complete(bar, b.x, nloc, nx); b.st[0] = nloc; b.st[1] = nx; }
        const unsigned old = xb_add(&bar[XB_XSUB(b.x)], 1u);
        const unsigned gen = old / nloc;
        if (old + 1u == (gen + 1u) * nloc) {
            __builtin_amdgcn_fence(__ATOMIC_RELEASE, "agent");
            asm volatile("s_waitcnt vmcnt(0)" ::: "memory");
            const unsigned og = xb_add(&bar[XB_TOP], 1u);
            const unsigned tg = og / nx;
            if (og + 1u == (tg + 1u) * nx) xb_add(&bar[XB_TOPGEN], 1u);
            else XB_SPIN(xb_ld(&bar[XB_TOPGEN]) == tg, bar);
            __builtin_amdgcn_fence(__ATOMIC_ACQUIRE, "agent");
            xb_add(&bar[XB_XGEN(b.x)], 1u);
            asm volatile("s_waitcnt vmcnt(0)" ::: "memory");
        } else {
            XB_SPIN(xb_ld(&bar[XB_XGEN(b.x)]) == gen, bar);
            __builtin_amdgcn_fence(__ATOMIC_ACQUIRE, "agent");
            asm volatile("s_waitcnt vmcnt(0)" ::: "memory");
        }
    }
    __syncthreads();
}

constexpr int BM = 256, BK = 64, HALF = 128, HTB = HALF * BK * 2, NXCD = 8, WGM = 8;
__host__ __device__ __forceinline__ int lds_byte(int r, int c) { const int st = (r >> 4) * 2 + (c >> 5), rr = r & 15, cc = c & 31, ob = rr * 64 + cc * 2; return st * 1024 + (ob ^ (((ob >> 9) & 1) << 5)); }
__host__ __device__ __forceinline__ void stage_rc(int b, int& R, int& C) { const int st = b / 1024, sb = b % 1024, swz = sb ^ (((sb >> 9) & 1) << 5); R = (st >> 1) * 16 + swz / 64; C = (st & 1) * 32 + (swz % 64) / 2; }
__host__ __device__ __forceinline__ int perm32(int rho) { const int n = rho >> 4, i = rho & 15; return 8 * (i >> 2) + 4 * n + (i & 3); }

struct Unit { int pm, pn, bz, ui; unsigned a_off, b_off; };

struct StdSched {
    int nM, nN, nwg, G, c, lda, ldb;
    __device__ void init(int M, int N, int G_, int c_, int lda_, int ldb_) { nM = M / BM; nN = N / BM; nwg = nM * nN; G = G_; c = c_; lda = lda_; ldb = ldb_; }
    __device__ bool next(int i, Unit& u) const {
        const long L = (long)i * G + c; if (L >= nwg) return false;
        int wgid = (int)L; { const int q = nwg / NXCD, r = nwg % NXCD, xcd = wgid % NXCD, off = wgid / NXCD; wgid = (xcd < r ? xcd * (q + 1) : r * (q + 1) + (xcd - r) * q) + off; }
        const int nig = WGM * nN, gid = wgid / nig, fm = gid * WGM, gsz = (nM - fm) < WGM ? (nM - fm) : WGM;
        u.pm = fm + ((wgid % nig) % gsz); u.pn = (wgid % nig) / gsz; u.bz = 0;
        u.a_off = (unsigned)(u.pm * BM) * (unsigned)lda; u.b_off = (unsigned)(u.pn * BM) * (unsigned)ldb; return true;
    }
};
struct Ssm1Sched {
    int c;
    __device__ bool next(int i, Unit& u) const {
        if (i > 0 || c >= BATCH * NG) return false;
        u.pm = 0; u.pn = 0; u.bz = c; u.a_off = (unsigned)c * NCH * UPW; u.b_off = (unsigned)(c & 31) * 256 * 512; return true;
    }
};
struct WkvSched {
    int G, c;
    __device__ bool next(int i, Unit& u) const {
        if (c < 128) return false;
        const int L = (c - 128) + i * (G - 128); if (L >= 64) return false;
        const int layer = L >> 5, rem = L & 31; u.pm = rem >> 3; u.pn = rem & 7; u.bz = layer;
        u.a_off = (unsigned)layer * 1024 * 1024 + (unsigned)u.pm * 256 * 1024; u.b_off = (unsigned)layer * (unsigned)(W_LAYER / 2) + (unsigned)u.pn * 256 * 1024; return true;
    }
};
struct Ssm2Sched {
    int G, c;
    __device__ bool next(int i, Unit& u) const {
        const int L = c + i * G; if (L >= 2 * BATCH * NG) return false;
        u.bz = L >> 1; u.pn = L & 1; u.pm = 0; u.a_off = (unsigned)u.bz * NCH * UPW; u.b_off = ((unsigned)(u.bz & 31) * 512 + (unsigned)u.pn * 256) * UPW; return true;
    }
};
struct XaSched {
    int G, c; unsigned bs_b, bs_h;
    __device__ bool next(int i, Unit& u) const {
        const int L = c + i * G; if (L >= 512) return false;
        const int bh = L >> 5; u.pm = L & 31; u.pn = 0; u.bz = bh; const int b = bh >> 2, h = bh & 3;
        u.a_off = ((unsigned)(b * SEQ + u.pm * 256)) * 1024 + h * 256; u.b_off = (unsigned)b * bs_b + (unsigned)h * bs_h; return true;
    }
};

template <class Epi, class Sched, bool ALIGN_EPI>
__device__ __forceinline__ void gemm_phase(LAS unsigned char* lds, const bf16_t* Ab, const bf16_t* Bb, int lda, int ldb, int K, const Sched& S, Epi& E) {
    int tid = threadIdx.x; asm volatile("" : "+v"(tid));
    const int wid = __builtin_amdgcn_readfirstlane(tid >> 6), lane = tid & 63, wr = wid >> 2, wc = wid & 3, fr = lane & 15, fq = lane >> 4;
    const int nt = K / BK;
    unsigned voffA[2], voffB[2]; int aoff, boff;
#define PG8_LANEOFFS(tt) do { _Pragma("unroll") for (int i = 0; i < 2; ++i) { int R, C; stage_rc((tt) * 16 + i * 8192, R, C); const int Rb = (R & ~31) + perm32(R & 31); \
        voffA[i] = (unsigned)(R * lda + C) * 2u; voffB[i] = (unsigned)(Rb * ldb + C) * 2u; } \
        aoff = lds_byte(wr * 64 + ((tt) & 15), (((tt) >> 4) & 3) * 8); boff = lds_byte(wc * 32 + ((tt) & 15), (((tt) >> 4) & 3) * 8); } while (0)
    PG8_LANEOFFS(tid);
    const unsigned kstep = (unsigned)(BK * 2);
    const unsigned hstepA = (unsigned)HALF * lda * 2, hstepB = (unsigned)HALF * ldb * 2;
    const unsigned ldsw = (unsigned)wid * 1024u;
#define PG8_SA(b, h) (((b) * 2 + (h)) * HTB)
#define PG8_SB(b, h) ((4 + (b) * 2 + (h)) * HTB)
#define PG8_STAGE(bufoff, gbase, voff) do { _Pragma("unroll") for (int _i = 0; _i < 2; ++_i) \
        __builtin_amdgcn_global_load_lds((const unsigned*)((const char*)(gbase) + (voff)[_i]), (LAS unsigned*)(lds + (bufoff) + ldsw + _i * 8192), 16, 0, 0); } while (0)
#define PG8_LDA(dst, b, h) do { _Pragma("unroll") for (int m = 0; m < 4; ++m) _Pragma("unroll") for (int k = 0; k < 2; ++k) dst[m][k] = *(const LAS bf16x8*)(lds + PG8_SA(b, h) + aoff + m * 2048 + k * 1024); } while (0)
#define PG8_LDB(dst, b, h) do { _Pragma("unroll") for (int n = 0; n < 2; ++n) _Pragma("unroll") for (int k = 0; k < 2; ++k) dst[n][k] = *(const LAS bf16x8*)(lds + PG8_SB(b, h) + boff + n * 2048 + k * 1024); } while (0)
#define PG8_MMA(ai, bj, At, Bt) do { __builtin_amdgcn_s_setprio(1); _Pragma("unroll") for (int m = 0; m < 4; ++m) _Pragma("unroll") for (int n = 0; n < 2; ++n) _Pragma("unroll") for (int k = 0; k < 2; ++k) \
        acc[ai][bj][m][n] = __builtin_amdgcn_mfma_f32_16x16x32_bf16(Bt[n][k], At[m][k], acc[ai][bj][m][n], 0, 0, 0); __builtin_amdgcn_s_setprio(0); } while (0)
#define PG8_WAIT_V(n) asm volatile("s_waitcnt vmcnt(" #n ")" ::: "memory")
#define PG8_WAIT_L(n) asm volatile("s_waitcnt lgkmcnt(" #n ")" ::: "memory")
#define PG8_BAR __builtin_amdgcn_s_barrier()
#define PG8_SCHED __builtin_amdgcn_sched_barrier(0)
    Unit cur, nxt; int ui = 0;
    if (!S.next(0, cur)) return;
    cur.ui = 0;
    if constexpr (Epi::HAS_RS) {
        LAS float* rst = (LAS float*)(lds + LDS_RS);
        for (int i = (tid >> 8); i < RS_MAX_UNITS; i += 2) { Unit uu; if (!S.next(i, uu)) break; const int row = uu.pm * 256 + (tid & 255); rst[i * 256 + (tid & 255)] = rsqrtf(ss_sum16(E.ss, row) * Epi::RS_INVN + EPS); }
        __syncthreads();
    }
    f32x4 acc[2][2][4][2];
#pragma unroll
    for (int a = 0; a < 2; ++a)
#pragma unroll
        for (int b = 0; b < 2; ++b)
#pragma unroll
            for (int m = 0; m < 4; ++m)
#pragma unroll
                for (int n = 0; n < 2; ++n) acc[a][b][m][n] = (f32x4){0.f, 0.f, 0.f, 0.f};
    bf16x8 At[4][2], B0[2][2], B1[2][2];
    const char* cA = (const char*)(Ab + cur.a_off); const char* cB = (const char*)(Bb + cur.b_off);
    PG8_STAGE(PG8_SB(0, 0), cB, voffB); PG8_STAGE(PG8_SB(0, 1), cB + hstepB, voffB); PG8_STAGE(PG8_SA(0, 0), cA, voffA); PG8_STAGE(PG8_SA(0, 1), cA + hstepA, voffA);
    if (wr == 1) PG8_BAR;
    PG8_WAIT_V(2); PG8_BAR;
    PG8_STAGE(PG8_SB(1, 0), cB + kstep, voffB); PG8_STAGE(PG8_SA(1, 0), cA + kstep, voffA); PG8_STAGE(PG8_SB(1, 1), cB + hstepB + kstep, voffB);
    PG8_WAIT_V(6); PG8_BAR;
    for (;;) {
        const bool has_next = S.next(ui + 1, nxt); nxt.ui = ui + 1;
        const char* nA = has_next ? (const char*)(Ab + nxt.a_off) : cA; const char* nB = has_next ? (const char*)(Bb + nxt.b_off) : cB;
        for (int t = 0; t < nt; t += 2) {
            const bool last = (t == nt - 2);
            const char* a1 = cA + (unsigned)(t + 1) * kstep;
            const char* a2 = last ? nA : cA + (unsigned)(t + 2) * kstep; const char* b2 = last ? nB : cB + (unsigned)(t + 2) * kstep;
            const char* a3 = a2 + kstep; const char* b3 = b2 + kstep;
            PG8_LDB(B0, 0, 0); PG8_LDB(B1, 0, 1); PG8_SCHED; PG8_LDA(At, 0, 0); PG8_STAGE(PG8_SA(1, 1), a1 + hstepA, voffA);
            PG8_WAIT_V(8); PG8_WAIT_L(0); PG8_BAR; PG8_MMA(0, 0, At, B0); PG8_MMA(0, 1, At, B1); PG8_BAR; PG8_SCHED;
            PG8_LDA(At, 0, 1); PG8_STAGE(PG8_SB(0, 0), b2, voffB); PG8_STAGE(PG8_SB(0, 1), b2 + hstepB, voffB); PG8_STAGE(PG8_SA(0, 0), a2, voffA);
            PG8_WAIT_V(8); PG8_WAIT_L(0); PG8_BAR; PG8_MMA(1, 0, At, B0); PG8_MMA(1, 1, At, B1); PG8_BAR; PG8_SCHED;
            PG8_LDB(B0, 1, 0); PG8_LDB(B1, 1, 1); PG8_SCHED; PG8_LDA(At, 1, 0); PG8_STAGE(PG8_SA(0, 1), a2 + hstepA, voffA);
            PG8_WAIT_V(8); PG8_WAIT_L(0); PG8_BAR; PG8_MMA(0, 0, At, B0); PG8_MMA(0, 1, At, B1); PG8_BAR; PG8_SCHED;
            PG8_LDA(At, 1, 1); PG8_STAGE(PG8_SB(1, 0), b3, voffB); PG8_STAGE(PG8_SB(1, 1), b3 + hstepB, voffB); PG8_STAGE(PG8_SA(1, 0), a3, voffA);
            PG8_WAIT_V(8); PG8_WAIT_L(0); PG8_BAR; PG8_MMA(1, 0, At, B0); PG8_MMA(1, 1, At, B1); PG8_BAR; PG8_SCHED;
        }
        if constexpr (ALIGN_EPI) { if (wr == 0) PG8_BAR; }
        if constexpr (!Epi::AFTER_DRAIN) { int t2 = threadIdx.x; asm volatile("" : "+v"(t2)); E(acc, cur, wr, wc, t2 & 15, (t2 >> 4) & 3); }
        if (!has_next) break;
#pragma unroll
        for (int a = 0; a < 2; ++a)
#pragma unroll
            for (int b = 0; b < 2; ++b)
#pragma unroll
                for (int m = 0; m < 4; ++m)
#pragma unroll
                    for (int n = 0; n < 2; ++n) acc[a][b][m][n] = (f32x4){0.f, 0.f, 0.f, 0.f};
        cur = nxt; cA = nA; cB = nB; ++ui;
        { int t3 = threadIdx.x; asm volatile("" : "+v"(t3)); PG8_LANEOFFS(t3); }
        if constexpr (ALIGN_EPI) { if (wr == 1) PG8_BAR; }
    }
    PG8_WAIT_V(0);
    if constexpr (!ALIGN_EPI) { if (wr == 0) PG8_BAR; }
    PG8_BAR;
    if constexpr (Epi::AFTER_DRAIN) { E.fused(acc, cur, wr, wc, fr, fq, lds, wid, lane); }
#undef PG8_LANEOFFS
#undef PG8_SA
#undef PG8_SB
#undef PG8_STAGE
#undef PG8_LDA
#undef PG8_LDB
#undef PG8_MMA
#undef PG8_WAIT_V
#undef PG8_WAIT_L
#undef PG8_BAR
#undef PG8_SCHED
}

typedef f32x4 (&AccRef)[2][2][4][2];
template <bool RS> struct EpiResidT;
typedef EpiResidT<false> EpiResid;

struct EpiFfnUp {
    static constexpr bool AFTER_DRAIN = false, HAS_RS = true; static constexpr float RS_INVN = 1.f / D;
    bf16_t* H; const float* ss; const LAS float* rst;
    __device__ __forceinline__ void operator()(AccRef acc, const Unit& u, int wr, int wc, int fr, int fq) const {
#pragma unroll
        for (int ai = 0; ai < 2; ++ai)
#pragma unroll
            for (int m = 0; m < 4; ++m) {
                const int row = u.pm * 256 + ai * 128 + wr * 64 + m * 16 + fr;
                const float rs = rst[u.ui * 256 + ai * 128 + wr * 64 + m * 16 + fr];
                f32x4 o[2];
#pragma unroll
                for (int n = 0; n < 2; ++n)
#pragma unroll
                    for (int j = 0; j < 4; ++j) { const float g = acc[ai][0][m][n][j] * rs, up = acc[ai][1][m][n][j] * rs; o[n][j] = g * sigmoidf_(g) * up; }
                *(u32x4*)(H + (size_t)row * FF + u.pn * 128 + wc * 32 + 8 * fq) = pack8(o[0], o[1]);
            }
    }
};
template <bool RS> struct EpiResidT {
    static constexpr bool AFTER_DRAIN = false, HAS_RS = RS; static constexpr float RS_INVN = 1.f / 512.f;
    bf16_t* hb; float* ssn; float scale; const float* ss; const LAS float* rst;
    __device__ __forceinline__ void operator()(AccRef acc, const Unit& u, int wr, int wc, int fr, int fq) const {
#pragma unroll
        for (int ai = 0; ai < 2; ++ai) {
            u32x4 ow[4][2];
#pragma unroll
            for (int m = 0; m < 4; ++m)
#pragma unroll
                for (int bj = 0; bj < 2; ++bj)
                    ow[m][bj] = *(const u32x4*)(hb + (size_t)(u.pm * 256 + ai * 128 + wr * 64 + m * 16 + fr) * D + u.pn * 256 + bj * 128 + wc * 32 + 8 * fq);
            __builtin_amdgcn_sched_barrier(0);
#pragma unroll
            for (int m = 0; m < 4; ++m) {
                const int row = u.pm * 256 + ai * 128 + wr * 64 + m * 16 + fr; float part = 0.f;
                const float sc = RS ? scale * rst[u.ui * 256 + ai * 128 + wr * 64 + m * 16 + fr] : scale;
#pragma unroll
                for (int bj = 0; bj < 2; ++bj) {
                    const size_t idx = (size_t)row * D + u.pn * 256 + bj * 128 + wc * 32 + 8 * fq;
                    const u32x4 o4 = ow[m][bj];
                    f32x4 v0, v1;
                    v0[0] = __uint_as_float(o4.x << 16); v0[1] = __uint_as_float(o4.x & 0xffff0000u); v0[2] = __uint_as_float(o4.y << 16); v0[3] = __uint_as_float(o4.y & 0xffff0000u);
                    v1[0] = __uint_as_float(o4.z << 16); v1[1] = __uint_as_float(o4.z & 0xffff0000u); v1[2] = __uint_as_float(o4.w << 16); v1[3] = __uint_as_float(o4.w & 0xffff0000u);
                    v0 = v0 + acc[ai][bj][m][0] * sc; v1 = v1 + acc[ai][bj][m][1] * sc;
                    *(u32x4*)(hb + idx) = pack8(v0, v1);
                    part += (v0[0] * v0[0] + v0[1] * v0[1]) + (v0[2] * v0[2] + v0[3] * v0[3]) + (v1[0] * v1[0] + v1[1] * v1[1]) + (v1[2] * v1[2] + v1[3] * v1[3]);
                }
                part = fq_sum(part);
                if (fq == 0) ssn[(size_t)row * 16 + u.pn * 4 + wc] = part;
            }
            __builtin_amdgcn_sched_barrier(0);
        }
    }
};
struct EpiWin {
    static constexpr bool AFTER_DRAIN = false, HAS_RS = true; static constexpr float RS_INVN = 1.f / D;
    unsigned char* arp; const float* ss; const LAS float* rst;
    __device__ __forceinline__ void operator()(AccRef acc, const Unit& u, int wr, int wc, int fr, int fq) const {
        bf16_t* up = (bf16_t*)(arp + AR_UP); bf16_t* qb = (bf16_t*)(arp + AR_Q); bf16_t* kb = (bf16_t*)(arp + AR_K); bf16_t* vt = (bf16_t*)(arp + AR_VT);
        const int sel = u.pn >> 1;
#pragma unroll
        for (int ai = 0; ai < 2; ++ai)
#pragma unroll
            for (int m = 0; m < 4; ++m) {
                const int row = u.pm * 256 + ai * 128 + wr * 64 + m * 16 + fr;
                float rs = rst[u.ui * 256 + ai * 128 + wr * 64 + m * 16 + fr];
                if (sel == 1) rs *= 0.125f * LOG2E;
                const int b = row >> 13, t = row & (SEQ - 1);
#pragma unroll
                for (int bj = 0; bj < 2; ++bj) {
                    const int c = (u.pn & 1) * 256 + bj * 128 + wc * 32 + 8 * fq;
                    const f32x4 v0 = acc[ai][bj][m][0] * rs, v1 = acc[ai][bj][m][1] * rs;
                    if (sel == 0) { const int g = c >> 4, hi0 = c & 15;
                        *(u32x4*)(up + ((size_t)((b * NG + g) * NCH + (t >> 5))) * UPW + (t & 31) * 16 + hi0) = pack8(v0, v1);
                    } else if (sel == 1) { *(u32x4*)(qb + (size_t)row * 512 + c) = pack8(v0, v1);
                    } else if (sel == 2) { *(u32x4*)(kb + (size_t)row * 512 + c) = pack8(v0, v1);
                    } else { const int h = c >> 7, dv = c & 127; bf16_t* p = vt + ((size_t)((b * 4 + h) * 128 + dv)) * SEQ + t;
                        const u32x4 w = pack8(v0, v1);
                        p[0] = (bf16_t)(w.x & 0xffff); p[SEQ] = (bf16_t)(w.x >> 16); p[2 * SEQ] = (bf16_t)(w.y & 0xffff); p[3 * SEQ] = (bf16_t)(w.y >> 16);
                        p[4 * SEQ] = (bf16_t)(w.z & 0xffff); p[5 * SEQ] = (bf16_t)(w.z >> 16); p[6 * SEQ] = (bf16_t)(w.w & 0xffff); p[7 * SEQ] = (bf16_t)(w.w >> 16);
                    }
                }
            }
    }
};
__device__ __forceinline__ float gelu_tanh(float x) { const float z = 0.7978845608028654f * (x + 0.044715f * x * x * x); return x * fast_rcp(1.f + fast_exp2(-2.f * LOG2E * z)); }
struct EpiSsm2 {
    static constexpr bool AFTER_DRAIN = false, HAS_RS = false;
    bf16_t* yb;
    __device__ __forceinline__ void operator()(AccRef acc, const Unit& u, int wr, int wc, int fr, int fq) const {
        const int b = u.bz >> 5, g = u.bz & 31;
#pragma unroll
        for (int ai = 0; ai < 2; ++ai)
#pragma unroll
            for (int m = 0; m < 4; ++m) {
                const int ch = ai * 128 + wr * 64 + m * 16 + fr;
#pragma unroll
                for (int bj = 0; bj < 2; ++bj) {
                    const int cc = u.pn * 256 + bj * 128 + wc * 32 + 8 * fq, t = cc >> 4, ho0 = cc & 15;
                    f32x4 v0, v1;
#pragma unroll
                    for (int j = 0; j < 4; ++j) { v0[j] = gelu_tanh(acc[ai][bj][m][0][j]); v1[j] = gelu_tanh(acc[ai][bj][m][1][j]); }
                    *(u32x4*)(yb + ((size_t)(b * SEQ + ch * CH + t)) * 512 + g * 16 + ho0) = pack8(v0, v1);
                }
            }
    }
};
struct EpiGlu {
    static constexpr bool AFTER_DRAIN = false, HAS_RS = false;
    bf16_t* mix; const float* bglu; float* ssq;
    __device__ __forceinline__ void operator()(AccRef acc, const Unit& u, int wr, int wc, int fr, int fq) const {
        const int c0 = u.pn * 128 + wc * 32 + 8 * fq;
        const f32x4 bv0 = *(const f32x4*)(bglu + c0), bv1 = *(const f32x4*)(bglu + c0 + 4), bg0 = *(const f32x4*)(bglu + 512 + c0), bg1 = *(const f32x4*)(bglu + 512 + c0 + 4);
#pragma unroll
        for (int ai = 0; ai < 2; ++ai)
#pragma unroll
            for (int m = 0; m < 4; ++m) {
                const int row = u.pm * 256 + ai * 128 + wr * 64 + m * 16 + fr;
                f32x4 o0, o1; float part = 0.f;
#pragma unroll
                for (int j = 0; j < 4; ++j) {
                    o0[j] = (acc[ai][0][m][0][j] + bv0[j]) * sigmoidf_(acc[ai][1][m][0][j] + bg0[j]);
                    o1[j] = (acc[ai][0][m][1][j] + bv1[j]) * sigmoidf_(acc[ai][1][m][1][j] + bg1[j]);
                    part += o0[j] * o0[j] + o1[j] * o1[j];
                }
                *(u32x4*)(mix + (size_t)row * D + c0) = pack8(o0, o1);
                part = fq_sum(part);
                if (fq == 0) ssq[(size_t)row * 16 + u.pn * 4 + wc] = part;
            }
    }
};
struct EpiWq {
    static constexpr bool AFTER_DRAIN = false, HAS_RS = true; static constexpr float RS_INVN = 1.f / D;
    bf16_t* O; const float* ss; float mul; const LAS float* rst;
    __device__ __forceinline__ void operator()(AccRef acc, const Unit& u, int wr, int wc, int fr, int fq) const {
#pragma unroll
        for (int ai = 0; ai < 2; ++ai)
#pragma unroll
            for (int m = 0; m < 4; ++m) {
                const int row = u.pm * 256 + ai * 128 + wr * 64 + m * 16 + fr;
                const float rs = rst[u.ui * 256 + ai * 128 + wr * 64 + m * 16 + fr] * mul;
#pragma unroll
                for (int bj = 0; bj < 2; ++bj)
                    *(u32x4*)(O + (size_t)row * D + u.pn * 256 + bj * 128 + wc * 32 + 8 * fq) = pack8(acc[ai][bj][m][0] * rs, acc[ai][bj][m][1] * rs);
            }
    }
};
struct EpiWkv {
    static constexpr bool AFTER_DRAIN = false, HAS_RS = false;
    bf16_t *kx, *vxt;
    __device__ __forceinline__ void operator()(AccRef acc, const Unit& u, int wr, int wc, int fr, int fq) const {
        const size_t lo = (size_t)u.bz * 1024 * 1024;
#pragma unroll
        for (int ai = 0; ai < 2; ++ai)
#pragma unroll
            for (int m = 0; m < 4; ++m) {
                const int row = u.pm * 256 + ai * 128 + wr * 64 + m * 16 + fr;
#pragma unroll
                for (int bj = 0; bj < 2; ++bj) {
                    const int col = u.pn * 256 + bj * 128 + wc * 32 + 8 * fq;
                    const u32x4 w = pack8(acc[ai][bj][m][0], acc[ai][bj][m][1]);
                    if (u.pn < 4) *(u32x4*)(kx + lo + (size_t)row * 1024 + col) = w;
                    else { const int c2 = col - 1024, h = c2 >> 8, d = c2 & 255, b = row >> 8, mm = row & 255;
                        bf16_t* p = vxt + lo + ((size_t)((b * 4 + h) * 256 + d)) * 256 + mm;
                        p[0] = (bf16_t)(w.x & 0xffff); p[256] = (bf16_t)(w.x >> 16); p[512] = (bf16_t)(w.y & 0xffff); p[768] = (bf16_t)(w.y >> 16);
                        p[1024] = (bf16_t)(w.z & 0xffff); p[1280] = (bf16_t)(w.z >> 16); p[1536] = (bf16_t)(w.w & 0xffff); p[1792] = (bf16_t)(w.w >> 16); }
                }
            }
    }
};
struct EpiSoftmax {
    static constexpr bool AFTER_DRAIN = false, HAS_RS = false;
    bf16_t* P; LAS float* red;
    __device__ __forceinline__ void operator()(AccRef acc, const Unit& u, int wr, int wc, int fr, int fq) const {
        const int b = u.bz >> 2, h = u.bz & 3;
        float mx[2][4];
#pragma unroll
        for (int ai = 0; ai < 2; ++ai)
#pragma unroll
            for (int m = 0; m < 4; ++m) {
                float v = -INFINITY;
#pragma unroll
                for (int bj = 0; bj < 2; ++bj)
#pragma unroll
                    for (int n = 0; n < 2; ++n)
#pragma unroll
                        for (int j = 0; j < 4; ++j) v = fmaxf(v, acc[ai][bj][m][n][j]);
                v = fq_max(v);
                const int rl = ai * 128 + wr * 64 + m * 16 + fr;
                if (fq == 0) red[rl * 4 + wc] = v;
            }
        asm volatile("s_waitcnt lgkmcnt(0)" ::: "memory"); __builtin_amdgcn_s_barrier(); asm volatile("" ::: "memory");
#pragma unroll
        for (int ai = 0; ai < 2; ++ai)
#pragma unroll
            for (int m = 0; m < 4; ++m) {
                const int rl = ai * 128 + wr * 64 + m * 16 + fr;
                const f32x4 r4 = *(const LAS f32x4*)(red + rl * 4);
                const float M = fmaxf(fmaxf(r4[0], r4[1]), fmaxf(r4[2], r4[3]));
                float s = 0.f;
#pragma unroll
                for (int bj = 0; bj < 2; ++bj)
#pragma unroll
                    for (int n = 0; n < 2; ++n)
#pragma unroll
                        for (int j = 0; j < 4; ++j) { const float p = fast_exp2(acc[ai][bj][m][n][j] - M); acc[ai][bj][m][n][j] = p; s += p; }
                s = fq_sum(s);
                if (fq == 0) red[1024 + rl * 4 + wc] = s;
            }
        asm volatile("s_waitcnt lgkmcnt(0)" ::: "memory"); __builtin_amdgcn_s_barrier(); asm volatile("" ::: "memory");
#pragma unroll
        for (int ai = 0; ai < 2; ++ai)
#pragma unroll
            for (int m = 0; m < 4; ++m) {
                const int rl = ai * 128 + wr * 64 + m * 16 + fr;
                const f32x4 r4 = *(const LAS f32x4*)(red + 1024 + rl * 4);
                const float inv = 1.f / ((r4[0] + r4[1]) + (r4[2] + r4[3]));
                const size_t row = (size_t)b * SEQ + u.pm * 256 + rl;
#pragma unroll
                for (int bj = 0; bj < 2; ++bj)
                    *(u32x4*)(P + row * D + h * 256 + bj * 128 + wc * 32 + 8 * fq) = pack8(acc[ai][bj][m][0] * inv, acc[ai][bj][m][1] * inv);
            }
    }
};
struct EpiNull {
    static constexpr bool AFTER_DRAIN = false, HAS_RS = false;
    float* sink;
    __device__ __forceinline__ void operator()(AccRef acc, const Unit& u, int wr, int wc, int fr, int fq) const {
        float t = 0.f;
#pragma unroll
        for (int ai = 0; ai < 2; ++ai)
#pragma unroll
            for (int bj = 0; bj < 2; ++bj)
#pragma unroll
                for (int m = 0; m < 4; ++m)
#pragma unroll
                    for (int n = 0; n < 2; ++n) t += acc[ai][bj][m][n][0] + acc[ai][bj][m][n][1] + acc[ai][bj][m][n][2] + acc[ai][bj][m][n][3];
        if (t == 12345.678f) sink[u.pm] = t;
    }
};
struct EpiPV {
    static constexpr bool AFTER_DRAIN = false, HAS_RS = false;
    bf16_t* O;
    __device__ __forceinline__ void operator()(AccRef acc, const Unit& u, int wr, int wc, int fr, int fq) const {
        const int b = u.bz >> 2, h = u.bz & 3;
#pragma unroll
        for (int ai = 0; ai < 2; ++ai)
#pragma unroll
            for (int m = 0; m < 4; ++m) {
                const size_t row = (size_t)b * SEQ + u.pm * 256 + ai * 128 + wr * 64 + m * 16 + fr;
#pragma unroll
                for (int bj = 0; bj < 2; ++bj)
                    *(u32x4*)(O + row * D + h * 256 + bj * 128 + wc * 32 + 8 * fq) = pack8(acc[ai][bj][m][0], acc[ai][bj][m][1]);
            }
    }
};
struct EpiSsm1 {
    static constexpr bool AFTER_DRAIN = true, HAS_RS = false;
    bf16_t* up; const float *lam_re, *lam_im, *log_dt;
    __device__ __forceinline__ void operator()(AccRef, const Unit&, int, int, int, int) const {}
    __device__ __forceinline__ void fused(AccRef acc, const Unit& u, int wr, int wc, int fr, int fq, LAS unsigned char* lds, int wid, int lane) const {
        LAS float* L = (LAS float*)lds;
#pragma unroll
        for (int ai = 0; ai < 2; ++ai)
#pragma unroll
            for (int m = 0; m < 4; ++m) {
                const int rl = ai * 128 + wr * 64 + m * 16 + fr;
#pragma unroll
                for (int n = 0; n < 2; ++n) { const int col = wc * 32 + 8 * fq + 4 * n; *(LAS f32x4*)(L + rl * 128 + (col ^ ((rl & 15) << 3))) = acc[ai][0][m][n]; }
            }
        __syncthreads();
        {
            const int g = u.bz & 31, p = lane;
            const float dtc = expf(log_dt[g]) * (float)CH;
            const float lr = fminf(lam_re[g * NP + p], -1e-4f), li = lam_im[g * NP + p];
            float sn, cs; const float mag = expf(lr * dtc); sincosf(li * dtc, &sn, &cs);
            const float ar = mag * cs, aim = mag * sn;
            const float mag32 = expf(lr * dtc * 32.f); float sn32, cs32; sincosf(li * dtc * 32.f, &sn32, &cs32);
            const float br = mag32 * cs32, bim = mag32 * sn32;
            LAS f32x2* Eb = (LAS f32x2*)(lds + LDS_RED);
            const int c0 = wid * 32;
            float xr = 0.f, xi = 0.f;
            for (int c = c0; c < c0 + 32; ++c) {
                const f32x2 l2 = *(const LAS f32x2*)(L + c * 128 + ((2 * p) ^ ((c & 15) << 3)));
                const float nr = ar * xr - aim * xi + l2[0], ni = ar * xi + aim * xr + l2[1]; xr = nr; xi = ni; }
            Eb[wid * 64 + p] = (f32x2){xr, xi};
            __syncthreads();
            xr = 0.f; xi = 0.f;
            for (int v = 0; v < wid; ++v) { const f32x2 e = Eb[v * 64 + p]; const float nr = br * xr - bim * xi + e[0], ni = br * xi + bim * xr + e[1]; xr = nr; xi = ni; }
            unsigned* dst = (unsigned*)(up + (size_t)u.bz * NCH * UPW + 512) + p;
            for (int c = c0; c < c0 + 32; ++c) {
                dst[(size_t)c * (UPW / 2)] = cvtpk(xr, xi);
                const f32x2 l2 = *(const LAS f32x2*)(L + c * 128 + ((2 * p) ^ ((c & 15) << 3)));
                const float nr = ar * xr - aim * xi + l2[0], ni = ar * xi + aim * xr + l2[1]; xr = nr; xi = ni; }
        }
        __syncthreads();
    }
};

struct GainSpec { const float* g1; const float* g2; float g2s; };
__device__ __forceinline__ float gain_of(const GainSpec& gs, int k) {
    if (!gs.g1) return 1.f;
    if (gs.g2 && k >= 512) return gs.g2[(k - 512) & 127] * gs.g2s;
    return gs.g1[k];
}
__device__ __forceinline__ void transpose_item(const float* W, int K, int N, bf16_t* WT, bool il, int nh, int hb, const GainSpec gs, LAS float* scr, int item, int lane) {
    const int nblk = N / 32, kb = item / nblk, nb = item % nblk, k0 = 64 * kb, n0 = 32 * nb;
    float tv[32];
#pragma unroll
    for (int i = 0; i < 32; ++i) { const int kk = 2 * i + (lane >> 5); tv[i] = W[(size_t)(k0 + kk) * N + n0 + (lane & 31)]; }
#pragma unroll
    for (int i = 0; i < 32; ++i) { const int kk = 2 * i + (lane >> 5); scr[kk * 33 + (lane & 31)] = tv[i] * gain_of(gs, k0 + kk); }
    asm volatile("s_waitcnt lgkmcnt(0)" ::: "memory");
    const int c = lane & 7;
#pragma unroll
    for (int j = 0; j < 4; ++j) { const int n = (lane >> 3) + 8 * j; const LAS float* s = scr + (8 * c) * 33 + n;
        u32x4 o; o.x = cvtpk(s[0 * 33], s[1 * 33]); o.y = cvtpk(s[2 * 33], s[3 * 33]); o.z = cvtpk(s[4 * 33], s[5 * 33]); o.w = cvtpk(s[6 * 33], s[7 * 33]);
        int row = n0 + n; if (il) { const int jj = row % nh, half = hb + row / nh; row = (jj >> 7) * 256 + half * 128 + (jj & 127); }
        *(u32x4*)(WT + (size_t)row * K + k0 + 8 * c) = o; }
    asm volatile("s_waitcnt lgkmcnt(0)" ::: "memory");
}

__device__ __forceinline__ void ssm_matrices(KArgsP a, int l, int g, LAS unsigned char* lds, bf16_t* Bm, bf16_t* Mt) {
    int tid = threadIdx.x; asm volatile("" : "+v"(tid));
    LAS f32x2* lamtab = (LAS f32x2*)lds;
    LAS f32x2* cc = (LAS f32x2*)(lds + 16896);
    LAS f32x2* bb = (LAS f32x2*)(lds + 16896 + 8192);
    LAS float* Kt = (LAS float*)(lds + 16896 + 16384);
    const float* lam_re = a->in[9] + (size_t)(l * NG + g) * NP; const float* lam_im = a->in[10] + (size_t)(l * NG + g) * NP;
    const float* b_re = a->in[11] + (size_t)(l * NG + g) * NP * 16; const float* b_im = a->in[12] + (size_t)(l * NG + g) * NP * 16;
    const float* c_re = a->in[13] + (size_t)(l * NG + g) * 16 * NP; const float* c_im = a->in[14] + (size_t)(l * NG + g) * 16 * NP;
    const float* dd = a->in[15] + (size_t)(l * NG + g) * 16;
    const float dt = expf(a->in[16][l * NG + g]);
    for (int idx = tid; idx < 33 * 64; idx += 512) { const int tau = idx >> 6, p = idx & 63;
        const float lr = fminf(lam_re[p], -1e-4f), li = lam_im[p]; const float zr = lr * dt * (float)tau, zi = li * dt * (float)tau;
        const float mag = expf(zr); float sn, cs; sincosf(zi, &sn, &cs); lamtab[idx] = (f32x2){mag * cs, mag * sn}; }
    for (int idx = tid; idx < 1024; idx += 512) {
        cc[idx] = (f32x2){c_re[idx], c_im[idx]};
        const int p = idx >> 4;
        const float lr = fminf(lam_re[p], -1e-4f), li = lam_im[p]; const float mag = expf(lr * dt); float sn, cs; sincosf(li * dt, &sn, &cs);
        const float ar = mag * cs - 1.f, ai = mag * sn, den = 1.f / (lr * lr + li * li);
        const float qr = (ar * lr + ai * li) * den, qi = (ai * lr - ar * li) * den;
        const float br = b_re[idx], bi = b_im[idx];
        bb[idx] = (f32x2){qr * br - qi * bi, qr * bi + qi * br};
    }
    __syncthreads();
    for (int idx = tid; idx < 32 * 256; idx += 512) { const int tau = idx >> 8, ho = (idx >> 4) & 15, hi = idx & 15; float s = 0.f;
        for (int p = 0; p < NP; ++p) { const f32x2 c = cc[ho * 64 + p], lm = lamtab[tau * 64 + p], b = bb[p * 16 + hi];
            const float wr_ = c[0] * lm[0] - c[1] * lm[1], wi_ = c[0] * lm[1] + c[1] * lm[0]; s += wr_ * b[0] - wi_ * b[1]; }
        if (tau == 0 && ho == hi) s += dd[ho];
        Kt[idx] = s; }
    __syncthreads();
    for (int ch = tid; ch < 512 * 80; ch += 512) { const int n = ch / 80, kc = ch % 80, t = n >> 4, ho = n & 15, k0 = kc * 8; float v[8];
        if (k0 < 512) { const int s = k0 >> 4, hi0 = k0 & 15;
#pragma unroll
            for (int j = 0; j < 8; ++j) v[j] = (s <= t) ? Kt[(t - s) * 256 + ho * 16 + hi0 + j] : 0.f;
        } else { const int p0 = (k0 - 512) >> 1;
#pragma unroll
            for (int j = 0; j < 4; ++j) { const f32x2 c = cc[ho * 64 + p0 + j], lm = lamtab[(t + 1) * 64 + p0 + j];
                v[2 * j] = c[0] * lm[0] - c[1] * lm[1]; v[2 * j + 1] = -(c[0] * lm[1] + c[1] * lm[0]); } }
        u32x4 o; o.x = cvtpk(v[0], v[1]); o.y = cvtpk(v[2], v[3]); o.z = cvtpk(v[4], v[5]); o.w = cvtpk(v[6], v[7]);
        *(u32x4*)(Mt + (size_t)n * UPW + k0) = o; }
    for (int ch = tid; ch < 256 * 64; ch += 512) { const int n = ch >> 6, k0 = (ch & 63) * 8; float v[8];
        if (n < 128) { const int p = n >> 1, ri = n & 1, s = k0 >> 4, hi0 = k0 & 15; const f32x2 lm = lamtab[(CH - 1 - s) * 64 + p];
#pragma unroll
            for (int j = 0; j < 8; ++j) { const f32x2 b = bb[p * 16 + hi0 + j]; v[j] = ri ? (lm[0] * b[1] + lm[1] * b[0]) : (lm[0] * b[0] - lm[1] * b[1]); }
        } else {
#pragma unroll
            for (int j = 0; j < 8; ++j) v[j] = 0.f; }
        u32x4 o; o.x = cvtpk(v[0], v[1]); o.y = cvtpk(v[2], v[3]); o.z = cvtpk(v[4], v[5]); o.w = cvtpk(v[6], v[7]);
        *(u32x4*)(Bm + (size_t)n * 512 + k0) = o; }
    __syncthreads();
}

__device__ __forceinline__ void prologue(KArgsP a, LAS unsigned char* lds, int G) {
    unsigned char* ws = a->ws;
    int tid = threadIdx.x; asm volatile("" : "+v"(tid));
    const int lane = tid & 63, wave = tid >> 6, bid = blockIdx.x;
    for (int it = bid; it < DEPTH * NG; it += G) { const int l = it >> 5, g = it & 31;
        ssm_matrices(a, l, g, lds, (bf16_t*)(ws + WS_W + l * W_LAYER + W_BM) + (size_t)g * 256 * 512, (bf16_t*)(ws + WS_W + l * W_LAYER + W_MT) + (size_t)g * 512 * UPW); }
    if (bid == 0) {
        float* sm = (float*)(ws + WS_SMALL);
        if (tid < 128) { const int l = tid >> 6, i = tid & 63;
            const float d1 = wave_sum(a->in[20][l * 64 + i] * a->in[21][l * 64 + i]), d2 = wave_sum(a->in[22][l * 64 + i] * a->in[23][l * 64 + i]);
            if (i == 0) sm[l] = expf(d1) - expf(d2) + (0.8f - 0.6f * expf(-0.3f * (float)l)); }
        for (int idx = tid; idx < 4 * 132; idx += 512) { const int h = idx / 132, n = idx % 132; int bk;
            if (n < 16) bk = n; else { const float nf = (float)n; int lg = 16 + (int)(logf(nf / 16.f) / 2.0794415416798357f * 16.f); bk = lg < 31 ? lg : 31; }
            sm[16 + idx] = a->in[2][bk * 4 + h] * LOG2E; }
    }
    { LAS float* scr = (LAS float*)(lds + wave * 16384);
      const int gw = bid * 8 + wave, NGW = G * 8;
      const int nssm = (G > DEPTH * NG) ? DEPTH * NG : 0;
      for (int it = (bid - nssm) * 8 + wave; bid >= nssm && it < DEPTH * 12288; it += (G - nssm) * 8) {
          const int l = it / 12288; int r = it % 12288; unsigned char* wl = ws + WS_W + l * W_LAYER;
          const GainSpec none{nullptr, nullptr, 0.f};
          if (r < 1408) { transpose_item(a->in[4] + (size_t)l * D * FF, D, FF, (bf16_t*)(wl + W_GU1), true, FF, 0, GainSpec{a->in[3] + l * D, nullptr, 0.f}, scr, r, lane); continue; } r -= 1408;
          if (r < 1408) { transpose_item(a->in[5] + (size_t)l * D * FF, D, FF, (bf16_t*)(wl + W_GU1), true, FF, 1, GainSpec{a->in[3] + l * D, nullptr, 0.f}, scr, r, lane); continue; } r -= 1408;
          if (r < 1408) { transpose_item(a->in[6] + (size_t)l * FF * D, FF, D, (bf16_t*)(wl + W_D1), false, 1, 0, none, scr, r, lane); continue; } r -= 1408;
          if (r < 1408) { transpose_item(a->in[32] + (size_t)l * D * FF, D, FF, (bf16_t*)(wl + W_GU2), true, FF, 0, GainSpec{a->in[31] + l * D, nullptr, 0.f}, scr, r, lane); continue; } r -= 1408;
          if (r < 1408) { transpose_item(a->in[33] + (size_t)l * D * FF, D, FF, (bf16_t*)(wl + W_GU2), true, FF, 1, GainSpec{a->in[31] + l * D, nullptr, 0.f}, scr, r, lane); continue; } r -= 1408;
          if (r < 1408) { transpose_item(a->in[34] + (size_t)l * FF * D, FF, D, (bf16_t*)(wl + W_D2), false, 1, 0, none, scr, r, lane); continue; } r -= 1408;
          if (r < 1024) { transpose_item(a->in[8] + (size_t)l * D * 2048, D, 2048, (bf16_t*)(wl + W_IN), false, 1, 0, GainSpec{a->in[7] + l * D, nullptr, 0.f}, scr, r, lane); continue; } r -= 1024;
          if (r < 256) { transpose_item(a->in[17] + (size_t)l * 512 * 1024, 512, 1024, (bf16_t*)(wl + W_GLU), true, 512, 0, none, scr, r, lane); continue; } r -= 256;
          if (r < 512) { transpose_item(a->in[25] + (size_t)l * D * D, D, D, (bf16_t*)(wl + W_OUT), false, 1, 0, GainSpec{a->in[19] + l * 512, a->in[24] + l * 128, 1.f - (0.8f - 0.6f * expf(-0.3f * (float)l))}, scr, r, lane); continue; } r -= 512;
          if (r < 512) { transpose_item(a->in[28] + (size_t)l * D * D, D, D, (bf16_t*)(wl + W_Q), false, 1, 0, GainSpec{a->in[26] + l * D, nullptr, 0.f}, scr, r, lane); continue; } r -= 512;
          if (r < 1024) { transpose_item(a->in[29] + (size_t)l * D * 2048, D, 2048, (bf16_t*)(wl + W_KV), false, 1, 0, none, scr, r, lane); continue; } r -= 1024;
          transpose_item(a->in[30] + (size_t)l * D * D, D, D, (bf16_t*)(wl + W_O), false, 1, 0, none, scr, r, lane);
      }
      for (int row = gw; row < T + DEPTH * BATCH * MEM; row += NGW) {
          const bool ismem = row >= T; const int mr = row - T, l = mr >> 10, mrow = mr & 1023;
          const float* src = ismem ? a->in[1] + (size_t)mrow * D : a->in[0] + (size_t)row * D;
          f32x4 v[4]; float s = 0.f;
#pragma unroll
          for (int j = 0; j < 4; ++j) { v[j] = *((const f32x4*)src + lane + 64 * j); s += (v[j][0] * v[j][0] + v[j][1] * v[j][1]) + (v[j][2] * v[j][2] + v[j][3] * v[j][3]); }
          s = wave_sum(s);
          if (!ismem) { if (lane < 16) ((float*)(ws + WS_SS))[(size_t)row * 16 + lane] = lane == 0 ? s : 0.f;
#pragma unroll
              for (int j = 0; j < 4; ++j) *((u32x2*)(ws + WS_HB + (size_t)row * D * 2) + lane + 64 * j) = (u32x2){cvtpk(v[j][0], v[j][1]), cvtpk(v[j][2], v[j][3])};
          } else { const float rs = rsqrtf(s * (1.f / D) + EPS); const float* gn = a->in[27] + l * D;
#pragma unroll
              for (int j = 0; j < 4; ++j) { const f32x4 gg = *((const f32x4*)gn + lane + 64 * j);
                  *((u32x2*)(ws + WS_MEMN + ((size_t)l * 1024 + mrow) * D * 2) + lane + 64 * j) = (u32x2){cvtpk(v[j][0] * rs * gg[0], v[j][1] * rs * gg[1]), cvtpk(v[j][2] * rs * gg[2], v[j][3] * rs * gg[3])}; }
          }
      }
    }
}

constexpr int AT_KROW = 256, AT_VROW = 128, AT_KBUF = 64 * AT_KROW, AT_VBUF = 128 * AT_VROW;
constexpr int AT_NBUF = 3, AT_K0 = 0, AT_V0 = AT_NBUF * AT_KBUF, AT_BIAS = AT_V0 + AT_NBUF * AT_VBUF;

__device__ __forceinline__ void at_tile(LAS unsigned char* Kb, LAS unsigned char* Vb, const LAS float* biasl, int r, int g, int k0, int qw0, int qrow, float cfar,
                                        const bf16x8 (&qf)[2][2], float (&mrow)[2], f32x4 (&ol)[2], f32x4 (&o)[2][8], bool first) {
    f32x4 s[2][4];
    const bool far = (qw0 - (k0 + 63)) >= 128;
    const float cf = far ? cfar : 0.f;
    const float ci0 = first ? cf : cf - mrow[0], ci1 = first ? cf : cf - mrow[1];
    bf16x8 kfa[8], kfb[8];
#pragma unroll
    for (int kb = 0; kb < 4; ++kb)
#pragma unroll
        for (int ks = 0; ks < 2; ++ks) kfa[kb * 2 + ks] = *(const LAS bf16x8*)(Kb + (kb * 16 + r) * AT_KROW + (((ks * 4 + g) ^ r) * 16));
    __builtin_amdgcn_sched_barrier(0);
#pragma unroll
    for (int kb = 0; kb < 4; ++kb)
#pragma unroll
        for (int ks = 0; ks < 2; ++ks) kfb[kb * 2 + ks] = *(const LAS bf16x8*)(Kb + (kb * 16 + r) * AT_KROW + (((8 + ks * 4 + g) ^ r) * 16));
    __builtin_amdgcn_sched_barrier(0);
#pragma unroll
    for (int kb = 0; kb < 4; ++kb) s[0][kb] = __builtin_amdgcn_mfma_f32_16x16x32_bf16(kfa[kb * 2], qf[0][0], (f32x4){ci0, ci0, ci0, ci0}, 0, 0, 0);
#pragma unroll
    for (int kb = 0; kb < 4; ++kb) s[0][kb] = __builtin_amdgcn_mfma_f32_16x16x32_bf16(kfa[kb * 2 + 1], qf[0][1], s[0][kb], 0, 0, 0);
    __builtin_amdgcn_sched_barrier(0);
    bf16x8 vf[16];
#pragma unroll
    for (int db = 0; db < 4; ++db)
#pragma unroll
        for (int kk = 0; kk < 2; ++kk) vf[db * 2 + kk] = *(const LAS bf16x8*)(Vb + (db * 16 + r) * AT_VROW + (((kk * 4 + g) ^ (r >> 1)) * 16));
    __builtin_amdgcn_sched_barrier(0);
#pragma unroll
    for (int kb = 0; kb < 4; ++kb) s[1][kb] = __builtin_amdgcn_mfma_f32_16x16x32_bf16(kfb[kb * 2], qf[1][0], (f32x4){ci1, ci1, ci1, ci1}, 0, 0, 0);
#pragma unroll
    for (int kb = 0; kb < 4; ++kb) s[1][kb] = __builtin_amdgcn_mfma_f32_16x16x32_bf16(kfb[kb * 2 + 1], qf[1][1], s[1][kb], 0, 0, 0);
    __builtin_amdgcn_sched_barrier(0);
    if (!far) {
        float badd[4][4];
#pragma unroll
        for (int kb = 0; kb < 4; ++kb)
#pragma unroll
            for (int j = 0; j < 4; ++j) { const int key = k0 + (kb >> 1) * 32 + g * 8 + (kb & 1) * 4 + j, dist = qrow - key;
                const int idx = dist < 0 ? 0 : (dist > 128 ? 128 : dist);
                badd[kb][j] = biasl[idx]; }
#pragma unroll
        for (int kb = 0; kb < 4; ++kb)
#pragma unroll
            for (int j = 0; j < 4; ++j) { const int key = k0 + (kb >> 1) * 32 + g * 8 + (kb & 1) * 4 + j;
                const float ad = (qrow >= key) ? badd[kb][j] : -INFINITY;
                s[0][kb][j] += ad; s[1][kb][j] += ad; }
    }
    float mx[2];
#pragma unroll
    for (int m = 0; m < 2; ++m) {
        float v = max3f(s[m][0][0], s[m][0][1], s[m][0][2]);
        v = max3f(v, s[m][0][3], s[m][1][0]); v = max3f(v, s[m][1][1], s[m][1][2]); v = max3f(v, s[m][1][3], s[m][2][0]);
        v = max3f(v, s[m][2][1], s[m][2][2]); v = max3f(v, s[m][2][3], s[m][3][0]); v = max3f(v, s[m][3][1], s[m][3][2]); v = max2f(v, s[m][3][3]);
        mx[m] = xl_max(v);
    }
#pragma unroll
    for (int db = 4; db < 8; ++db)
#pragma unroll
        for (int kk = 0; kk < 2; ++kk) vf[db * 2 + kk] = *(const LAS bf16x8*)(Vb + (db * 16 + r) * AT_VROW + (((kk * 4 + g) ^ (r >> 1)) * 16));
    __builtin_amdgcn_sched_barrier(0);
    if (first || __any(max2f(mx[0], mx[1]) > 6.0f)) {
#pragma unroll
        for (int m = 0; m < 2; ++m) {
            const float delta = first ? mx[m] : fmaxf(mx[m], 0.f), alpha = first ? 0.f : fast_exp2(-delta);
            mrow[m] = first ? delta : mrow[m] + delta;
            ol[m] = ol[m] * alpha;
#pragma unroll
            for (int db = 0; db < 8; ++db) o[m][db] = o[m][db] * alpha;
#pragma unroll
            for (int kb = 0; kb < 4; ++kb) s[m][kb] = s[m][kb] - delta;
        }
    }
#pragma unroll
    for (int kb = 0; kb < 4; ++kb)
#pragma unroll
        for (int j = 0; j < 4; ++j) s[0][kb][j] = fast_exp2(s[0][kb][j]);
    bf16x8 pf0[2], pf1[2];
#pragma unroll
    for (int kk = 0; kk < 2; ++kk) { const u32x4 pw = pack8(s[0][2 * kk], s[0][2 * kk + 1]); pf0[kk] = __builtin_bit_cast(bf16x8, pw); }
    __builtin_amdgcn_sched_barrier(0);
#pragma unroll
    for (int i = 0; i < 16; ++i) {
        const int db = i >> 1, kk = i & 1;
        o[0][db] = __builtin_amdgcn_mfma_f32_16x16x32_bf16(vf[db * 2 + kk], pf0[kk], o[0][db], 0, 0, 0);
        s[1][i >> 2][i & 3] = fast_exp2(s[1][i >> 2][i & 3]);
        __builtin_amdgcn_sched_barrier(0);
    }
    const short one = (short)0x3F80; const bf16x8 ones = {one, one, one, one, one, one, one, one};
    ol[0] = __builtin_amdgcn_mfma_f32_16x16x32_bf16(ones, pf0[0], ol[0], 0, 0, 0);
    ol[0] = __builtin_amdgcn_mfma_f32_16x16x32_bf16(ones, pf0[1], ol[0], 0, 0, 0);
#pragma unroll
    for (int kk = 0; kk < 2; ++kk) { const u32x4 pw = pack8(s[1][2 * kk], s[1][2 * kk + 1]); pf1[kk] = __builtin_bit_cast(bf16x8, pw); }
    __builtin_amdgcn_sched_barrier(0);
#pragma unroll
    for (int kk = 0; kk < 2; ++kk)
#pragma unroll
        for (int db = 0; db < 8; ++db) o[1][db] = __builtin_amdgcn_mfma_f32_16x16x32_bf16(vf[db * 2 + kk], pf1[kk], o[1][db], 0, 0, 0);
    ol[1] = __builtin_amdgcn_mfma_f32_16x16x32_bf16(ones, pf1[0], ol[1], 0, 0, 0);
    ol[1] = __builtin_amdgcn_mfma_f32_16x16x32_bf16(ones, pf1[1], ol[1], 0, 0, 0);
    __builtin_amdgcn_sched_barrier(0);
}

__device__ __forceinline__ void attn_qblock(int b, int h, int q0, float lam, LAS unsigned char* lds, const bf16_t* qbuf, const bf16_t* kbuf, const bf16_t* vT, bf16_t* mix, const float* bias_g, const float* ssm_sq, bool var) {
    int tid = threadIdx.x; asm volatile("" : "+v"(tid));
    const int lane = tid & 63, w = __builtin_amdgcn_readfirstlane(tid >> 6), r = lane & 15, g = lane >> 4;
    const int qw0 = q0 + w * 16, qrow = qw0 + r;
    LAS float* biasl = (LAS float*)(lds + AT_BIAS);
    __syncthreads();
    if (tid < 129) biasl[tid] = bias_g[h * 132 + tid];
    bf16x8 qf[2][2];
    { const bf16_t* qp = qbuf + ((size_t)(b * SEQ + qrow)) * 512 + h * 128 + g * 8;
#pragma unroll
      for (int m = 0; m < 2; ++m)
#pragma unroll
          for (int ks = 0; ks < 2; ++ks) qf[m][ks] = *(const bf16x8*)(qp + m * 64 + ks * 32); }
    f32x4 o[2][8];
#pragma unroll
    for (int m = 0; m < 2; ++m)
#pragma unroll
        for (int db = 0; db < 8; ++db) o[m][db] = (f32x4){0.f, 0.f, 0.f, 0.f};
    float mrow[2] = {0.f, 0.f};
    f32x4 ol[2] = {(f32x4){0.f, 0.f, 0.f, 0.f}, (f32x4){0.f, 0.f, 0.f, 0.f}};
    const int ntiles = (q0 + 128) >> 6;
    unsigned gk[2], gv[2];
#pragma unroll
    for (int i = 0; i < 2; ++i) { const int c = w + 8 * i;
        { const int rho = 4 * c + (lane >> 4), ph = lane & 15, ch = ph ^ (rho & 15), kb = rho >> 4, key = (kb >> 1) * 32 + ((rho >> 2) & 3) * 8 + (kb & 1) * 4 + (rho & 3); gk[i] = (unsigned)(key * 512 + ch * 8) * 2u; }
        { const int dv = 8 * c + (lane >> 3), ph = lane & 7, ch = ph ^ ((dv >> 1) & 7); gv[i] = (unsigned)(dv * SEQ + ch * 8) * 2u; } }
    const char* kbase = (const char*)(kbuf + ((size_t)b * SEQ) * 512 + h * 128);
    const char* vbase = (const char*)(vT + ((size_t)(b * 4 + h) * 128) * SEQ);
#define AT_STAGE(buf, k0_) do { _Pragma("unroll") for (int _i = 0; _i < 2; ++_i) { \
        __builtin_amdgcn_global_load_lds((const unsigned*)(kbase + (size_t)(k0_) * 1024 + gk[_i]), (LAS unsigned*)(lds + AT_K0 + (buf) * AT_KBUF + (w + 8 * _i) * 1024), 16, 0, 0); \
        __builtin_amdgcn_global_load_lds((const unsigned*)(vbase + (size_t)(k0_) * 2 + gv[_i]), (LAS unsigned*)(lds + AT_V0 + (buf) * AT_VBUF + (w + 8 * _i) * 1024), 16, 0, 0); } } while (0)
    AT_STAGE(0, 0);
    asm volatile("s_waitcnt vmcnt(0)" ::: "memory");
    __syncthreads();
    const float cfar = biasl[128];
    int cur = 0;
    for (int kt = 0; kt < ntiles; ++kt) {
        const int k0 = kt * 64, nxt = (cur == AT_NBUF - 1) ? 0 : cur + 1;
        if (kt + 1 < ntiles) AT_STAGE(nxt, k0 + 64);
        if (k0 <= qw0 + 15) at_tile(lds + AT_K0 + cur * AT_KBUF, lds + AT_V0 + cur * AT_VBUF, biasl, r, g, k0, qw0, qrow, cfar, qf, mrow, ol, o, kt == 0);
        asm volatile("s_waitcnt vmcnt(0)" ::: "memory");
        __syncthreads();
        cur = nxt;
    }
#undef AT_STAGE
    const float inv0 = 1.f / ol[0][0], inv1 = lam / ol[1][0];
    float ssq = 0.f;
#pragma unroll
    for (int db = 0; db < 8; ++db)
#pragma unroll
        for (int j = 0; j < 4; ++j) { const float v = o[0][db][j] * inv0 - o[1][db][j] * inv1; o[0][db][j] = v; ssq += v * v; }
    ssq = fq_sum(ssq);
    const float rn = rsqrtf(ssq * (1.f / 128.f) + EPS) * sqrtf(ss_sum16(ssm_sq, b * SEQ + qrow) * (1.f / 512.f) + EPS);
    bf16_t* op = mix + ((size_t)(b * SEQ + qrow)) * D + 512 + h * 128 + g * 4;
#pragma unroll
    for (int db = 0; db < 8; ++db) *(u32x2*)(op + db * 16) = (u32x2){cvtpk(o[0][db][0] * rn, o[0][db][1] * rn), cvtpk(o[0][db][2] * rn, o[0][db][3] * rn)};
}

#if DEBUG_CHECK
__device__ __forceinline__ unsigned hash_u(unsigned x) { x ^= x >> 16; x *= 0x7feb352dU; x ^= x >> 15; x *= 0x846ca68bU; x ^= x >> 16; return x; }
__device__ __forceinline__ void dbg_flag(unsigned* ctl, int id, float got, float ref, float rtol, float atol) {
    const float d = fabsf(got - ref);
    if (!(d <= atol + rtol * fabsf(ref))) atomicAdd(ctl + 64 + id, 1u);
}
#endif

__global__ void __launch_bounds__(512, 2) fwd_kernel(Args a) {
    extern __shared__ __attribute__((aligned(16))) unsigned char lds_raw[];
    LAS unsigned char* lds = (LAS unsigned char*)lds_raw;
    cg::grid_group grid = cg::this_grid();
    const int G = gridDim.x;
#define PH KArgsP ka = KARGS(); int bid = blockIdx.x, G = gridDim.x, tidl = threadIdx.x; asm volatile("" : "+s"(bid), "+s"(G), "+v"(tidl)); const int lane = tidl & 63, wave = tidl >> 6; (void)lane; (void)wave; unsigned char* ws = ka->ws; float* ssb = (float*)(ws + WS_SS); float* ssm_ss = (float*)(ws + WS_SSM_SS); const float* smalls = (const float*)(ws + WS_SMALL); \
    bf16_t* hb = (bf16_t*)(ws + WS_HB); unsigned char* ar = ws + WS_AR; unsigned char* wl = ws + WS_W + l * W_LAYER; float* hbuf = ka->out; \
    (void)ssb; (void)ssm_ss; (void)smalls; (void)hb; (void)ar; (void)wl; (void)hbuf;
    if (threadIdx.x < 2) ((LAS unsigned*)(lds + LDS_XB))[threadIdx.x] = 0u;
    __syncthreads();
    (void)xcd_barrier_post((unsigned*)(KARGS()->ws + WS_CTL) + 1024, (volatile LAS unsigned*)(lds + LDS_XB));
    for (int rep = 0; rep < (PROBE == 5 ? 2 : 1); ++rep) prologue(KARGS(), lds, G);
    grid.sync();
#define GSYNC() do { XcdBarrier xb_; xb_.bar = (unsigned*)(KARGS()->ws + WS_CTL) + 1024; xb_.x = xb_xcc_id(); xb_.st = (volatile LAS unsigned*)(lds + LDS_XB); xcd_barrier(xb_); } while (0)

    for (int l = 0; l < DEPTH; ++l) {
        if (PROBE == 4) { for (int rep = 0; rep < 10; ++rep) GSYNC(); }
        for (int rep = 0; rep < (PROBE == 2 ? 2 : 1); ++rep)
        { PH StdSched S; S.init(T, 2 * FF, G, bid, D, D); EpiFfnUp E{(bf16_t*)(ar + AR_HID), ssb + (size_t)(4 * l + 0) * T * 16, (const LAS float*)(lds + LDS_RS)};
          gemm_phase<EpiFfnUp, StdSched, true>(lds, hb, (const bf16_t*)(wl + W_GU1), D, D, D, S, E); }
        GSYNC();
        if (PROBE == 6) { PH StdSched S; S.init(T, D, G, bid, FF, FF); EpiNull E{(float*)(ws + WS_CTL + 20000)};
          gemm_phase<EpiNull, StdSched, false>(lds, (const bf16_t*)(ar + AR_HID), (const bf16_t*)(wl + W_D1), FF, FF, FF, S, E); }
        for (int rep = (PROBE == 7 ? 0 : 1); rep < 2; ++rep)
        { PH StdSched S; S.init(T, D, G, bid, FF, FF); EpiResid E{hb, ssb + (size_t)(4 * l + 1) * T * 16, (PROBE == 7 && rep == 0) ? 0.f : 0.5f, nullptr, nullptr};
          gemm_phase<EpiResid, StdSched, true>(lds, (const bf16_t*)(ar + AR_HID), (const bf16_t*)(wl + W_D1), FF, FF, FF, S, E); }
        GSYNC();
        for (int rep = 0; rep < (PROBE == 3 ? 2 : 1); ++rep)
        { PH StdSched S; S.init(T, 2048, G, bid, D, D); EpiWin E{ar, ssb + (size_t)(4 * l + 1) * T * 16, (const LAS float*)(lds + LDS_RS)};
          gemm_phase<EpiWin, StdSched, true>(lds, hb, (const bf16_t*)(wl + W_IN), D, D, D, S, E); }
        GSYNC();
        for (int rep = 0; rep < (PROBE == 3 ? 2 : 1); ++rep)
        if ((int)blockIdx.x < 128) { PH Ssm1Sched S{bid}; EpiSsm1 E{(bf16_t*)(ar + AR_UP), ka->in[9] + (size_t)l * NG * NP, ka->in[10] + (size_t)l * NG * NP, ka->in[16] + (size_t)l * NG};
          gemm_phase<EpiSsm1, Ssm1Sched, false>(lds, (const bf16_t*)(ar + AR_UP), (const bf16_t*)(wl + W_BM), UPW, 512, 512, S, E); }
        else if (l == 0) { PH WkvSched S{G, bid}; EpiWkv E{(bf16_t*)(ws + WS_KX), (bf16_t*)(ws + WS_VXT)};
          gemm_phase<EpiWkv, WkvSched, false>(lds, (const bf16_t*)(ws + WS_MEMN), (const bf16_t*)(ws + WS_W + W_KV), D, D, D, S, E); }
        GSYNC();
        for (int rep = 0; rep < (PROBE == 3 ? 2 : 1); ++rep)
        { PH Ssm2Sched S{G, bid}; EpiSsm2 E{(bf16_t*)(ar + AR_Y)};
          gemm_phase<EpiSsm2, Ssm2Sched, false>(lds, (const bf16_t*)(ar + AR_UP), (const bf16_t*)(wl + W_MT), UPW, UPW, UPW, S, E); }
        GSYNC();
        for (int rep = 0; rep < (PROBE == 8 ? 2 : 1); ++rep)
        { PH StdSched S; S.init(T, 1024, G, bid, 512, 512); EpiGlu E{(bf16_t*)(ar + AR_MIX), ka->in[18] + (size_t)l * 1024, ssm_ss + (size_t)l * T * 16};
          gemm_phase<EpiGlu, StdSched, true>(lds, (const bf16_t*)(ar + AR_Y), (const bf16_t*)(wl + W_GLU), 512, 512, 512, S, E); }
        GSYNC();
        { PH const float lam = smalls[l];
          for (int rep = 0; rep < ((PROBE == 1 || ATT_VAR) ? 2 : 1); ++rep)
          for (int uidx = bid; uidx < 512; uidx += G) { const bool var = ATT_VAR && rep == 0;
              int bh = uidx >> 5, j = uidx & 31;
              if (G == 256) { bh = (bid & 7) + 8 * (uidx >> 8); j = bid >> 3; }
              const int b = bh >> 2, h = bh & 3;
              attn_qblock(b, h, j * 128, lam, lds, (const bf16_t*)(ar + AR_Q), (const bf16_t*)(ar + AR_K), (const bf16_t*)(ar + AR_VT), (bf16_t*)(ar + AR_MIX), smalls + 16, ssm_ss + (size_t)l * T * 16, var);
              attn_qblock(b, h, (63 - j) * 128, lam, lds, (const bf16_t*)(ar + AR_Q), (const bf16_t*)(ar + AR_K), (const bf16_t*)(ar + AR_VT), (bf16_t*)(ar + AR_MIX), smalls + 16, ssm_ss + (size_t)l * T * 16, var); }
        }
        GSYNC();
        for (int rep = (PROBE == 7 ? 0 : 1); rep < 2; ++rep)
        { PH StdSched S; S.init(T, D, G, bid, D, D); EpiResidT<true> E{hb, ssb + (size_t)(4 * l + 2) * T * 16, (PROBE == 7 && rep == 0) ? 0.f : 1.f, ssm_ss + (size_t)l * T * 16, (const LAS float*)(lds + LDS_RS)};
          gemm_phase<EpiResidT<true>, StdSched, true>(lds, (const bf16_t*)(ar + AR_MIX), (const bf16_t*)(wl + W_OUT), D, D, D, S, E); }
        GSYNC();
        for (int rep = 0; rep < (PROBE == 3 ? 2 : 1); ++rep)
        { PH StdSched S; S.init(T, D, G, bid, D, D); EpiWq E{(bf16_t*)(ar + AR_QX), ssb + (size_t)(4 * l + 2) * T * 16, 0.0625f * LOG2E, (const LAS float*)(lds + LDS_RS)};
          gemm_phase<EpiWq, StdSched, true>(lds, hb, (const bf16_t*)(wl + W_Q), D, D, D, S, E); }
        GSYNC();
        for (int rep = 0; rep < (PROBE == 3 ? 2 : 1); ++rep)
        { PH XaSched S{G, bid, (unsigned)MEM * 1024, 256u}; EpiSoftmax E{(bf16_t*)(ar + AR_P), (LAS float*)(lds + LDS_RED)};
          gemm_phase<EpiSoftmax, XaSched, true>(lds, (const bf16_t*)(ar + AR_QX), (const bf16_t*)(ws + WS_KX) + (size_t)l * 1024 * 1024, D, D, 256, S, E); }
        GSYNC();
        for (int rep = 0; rep < (PROBE == 3 ? 2 : 1); ++rep)
        { PH XaSched S{G, bid, 4u * 65536u, 65536u}; EpiPV E{(bf16_t*)(ar + AR_OX)};
          gemm_phase<EpiPV, XaSched, false>(lds, (const bf16_t*)(ar + AR_P), (const bf16_t*)(ws + WS_VXT) + (size_t)l * 1024 * 1024, D, 256, 256, S, E); }
        GSYNC();
        for (int rep = (PROBE == 7 ? 0 : 1); rep < 2; ++rep)
        { PH StdSched S; S.init(T, D, G, bid, D, D); EpiResid E{hb, ssb + (size_t)(4 * l + 3) * T * 16, (PROBE == 7 && rep == 0) ? 0.f : 1.f, nullptr, nullptr};
          gemm_phase<EpiResid, StdSched, true>(lds, (const bf16_t*)(ar + AR_OX), (const bf16_t*)(wl + W_O), D, D, D, S, E); }
        GSYNC();
        for (int rep = 0; rep < (PROBE == 2 ? 2 : 1); ++rep)
        { PH StdSched S; S.init(T, 2 * FF, G, bid, D, D); EpiFfnUp E{(bf16_t*)(ar + AR_HID), ssb + (size_t)(4 * l + 3) * T * 16, (const LAS float*)(lds + LDS_RS)};
          gemm_phase<EpiFfnUp, StdSched, true>(lds, hb, (const bf16_t*)(wl + W_GU2), D, D, D, S, E); }
        GSYNC();
        if (PROBE == 6) { PH StdSched S; S.init(T, D, G, bid, FF, FF); EpiNull E{(float*)(ws + WS_CTL + 20000)};
          gemm_phase<EpiNull, StdSched, false>(lds, (const bf16_t*)(ar + AR_HID), (const bf16_t*)(wl + W_D2), FF, FF, FF, S, E); }
        for (int rep = (PROBE == 7 ? 0 : 1); rep < 2; ++rep)
        { PH StdSched S; S.init(T, D, G, bid, FF, FF); EpiResid E{hb, ssb + (size_t)(4 * l + 4) * T * 16, (PROBE == 7 && rep == 0) ? 0.f : 0.5f, nullptr, nullptr};
          gemm_phase<EpiResid, StdSched, true>(lds, (const bf16_t*)(ar + AR_HID), (const bf16_t*)(wl + W_D2), FF, FF, FF, S, E); }
        GSYNC();
    }
    { const int l = 0; PH const float* sq = ssb + (size_t)8 * T * 16; const float* gn = ka->in[35];
      for (int row = bid * 8 + wave; row < T; row += G * 8) { const float rs = rsqrtf(ss_sum16(sq, row) * (1.f / D) + EPS);
#pragma unroll
          for (int j = 0; j < 2; ++j) { const u32x4 w = *((const u32x4*)(hb + (size_t)row * D) + lane + 64 * j);
              const f32x4 g0 = *((const f32x4*)gn + 2 * (lane + 64 * j)), g1 = *((const f32x4*)gn + 2 * (lane + 64 * j) + 1);
              f32x4 v0, v1;
              v0[0] = __uint_as_float(w.x << 16) * rs * g0[0]; v0[1] = __uint_as_float(w.x & 0xffff0000u) * rs * g0[1]; v0[2] = __uint_as_float(w.y << 16) * rs * g0[2]; v0[3] = __uint_as_float(w.y & 0xffff0000u) * rs * g0[3];
              v1[0] = __uint_as_float(w.z << 16) * rs * g1[0]; v1[1] = __uint_as_float(w.z & 0xffff0000u) * rs * g1[1]; v1[2] = __uint_as_float(w.w << 16) * rs * g1[2]; v1[3] = __uint_as_float(w.w & 0xffff0000u) * rs * g1[3];
              f32x4* op = (f32x4*)(hbuf + (size_t)row * D) + 2 * (lane + 64 * j); op[0] = v0; op[1] = v1; } } }
}

extern "C" void kernel_launch(void* const* d_in, const int* in_sizes, int n_in, void* d_out, int out_size, void* d_ws, size_t ws_size, hipStream_t stream) {
    static int grid = 0;
    if (grid == 0) {
        if (n_in != 36 || out_size != T * D || ws_size < WS_END) { fprintf(stderr, "kernel_launch: unexpected problem (n_in %d out %d ws %zu)\n", n_in, out_size, ws_size); grid = -1; return; }
        int dev = 0, cus = 0, per_cu = 0;
        if (hipGetDevice(&dev) != hipSuccess || hipDeviceGetAttribute(&cus, hipDeviceAttributeMultiprocessorCount, dev) != hipSuccess) { grid = -1; return; }
        if (hipFuncSetAttribute((const void*)fwd_kernel, hipFuncAttributeMaxDynamicSharedMemorySize, LDS_BYTES) != hipSuccess) { fprintf(stderr, "hipFuncSetAttribute failed\n"); grid = -1; return; }
        if (hipOccupancyMaxActiveBlocksPerMultiprocessor(&per_cu, (const void*)fwd_kernel, 512, LDS_BYTES) != hipSuccess || per_cu < 1) { fprintf(stderr, "occupancy query: %d\n", per_cu); }
        (void)hipGetLastError();
        grid = cus;
        if (grid != 256) fprintf(stderr, "kernel_launch: %d CUs (expected 256)\n", grid);
    }
    if (grid < 0) return;
    (void)hipMemsetAsync((char*)d_ws + WS_CTL, 0, 32768, stream);
    Args a{};
    for (int i = 0; i < 36; ++i) a.in[i] = (const float*)d_in[i];
    a.out = (float*)d_out; a.ws = (unsigned char*)d_ws;
    void* args[] = {&a};
    hipError_t e = hipLaunchCooperativeKernel((const void*)fwd_kernel, dim3(grid), dim3(512), args, LDS_BYTES, stream);
    if (e != hipSuccess) fprintf(stderr, "cooperative launch failed: %s (grid %d)\n", hipGetErrorString(e), grid);
}
```

```cpp
#include <hip/hip_runtime.h>
#include <hip/hip_cooperative_groups.h>
#include <cstdio>
#include <cstdint>
namespace cg = cooperative_groups;

#define LAS __attribute__((address_space(3)))
typedef unsigned short bf16_t;
typedef short bf16x8 __attribute__((ext_vector_type(8)));
typedef float f32x4 __attribute__((ext_vector_type(4)));
typedef float f32x2 __attribute__((ext_vector_type(2)));
typedef unsigned u32x4 __attribute__((ext_vector_type(4)));
typedef unsigned u32x2 __attribute__((ext_vector_type(2)));
typedef __bf16 bf16x2_t __attribute__((ext_vector_type(2)));

#ifndef PROBE
#define PROBE 0
#endif
#ifndef ATT_VAR
#define ATT_VAR 0
#endif
#ifndef DEBUG_CHECK
#define DEBUG_CHECK 0
#endif

constexpr int D = 1024, BATCH = 4, SEQ = 8192, T = BATCH * SEQ, DEPTH = 2, MEM = 256, FF = 2816;
constexpr int SSMW = 512, NG = 32, NP = 64, CH = 32  , NCH = SEQ / CH  , UPW = 640  ;
constexpr float EPS = 1e-6f, LOG2E = 1.4426950408889634f;

constexpr size_t MiB = 1u << 20;
constexpr size_t WS_CTL = 0;
constexpr size_t WS_SS = 466 * MiB;
constexpr size_t WS_SSM_SS = WS_SS + 9 * (size_t)T * 64;
constexpr size_t WS_SMALL = 3 * MiB;
constexpr size_t WS_MEMN = 4 * MiB;
constexpr size_t WS_KX = 8 * MiB;
constexpr size_t WS_VXT = 12 * MiB;
constexpr size_t WS_W = 16 * MiB, W_LAYER = 76 * MiB;
constexpr size_t W_GU1 = 0, W_D1 = 11 * MiB, W_GU2 = 16 * MiB + MiB / 2, W_D2 = 27 * MiB + MiB / 2, W_IN = 33 * MiB, W_GLU = 37 * MiB, W_OUT = 38 * MiB,
                 W_Q = 40 * MiB, W_KV = 42 * MiB, W_O = 46 * MiB, W_BM = 48 * MiB, W_MT = 56 * MiB;
constexpr size_t WS_HB = WS_W + 2 * W_LAYER;
constexpr size_t WS_AR = WS_HB + 64 * MiB;
constexpr size_t AR_UP = 0, AR_Q = 40 * MiB, AR_K = 72 * MiB, AR_VT = 104 * MiB, AR_Y = 136 * MiB, AR_MIX = 168 * MiB;
constexpr size_t AR_QX = 0, AR_P = 64 * MiB, AR_OX = 128 * MiB, AR_HID = 0;
constexpr size_t WS_END = WS_SSM_SS + 2 * (size_t)T * 64;

constexpr int LDS_BYTES = 155648;
constexpr int LDS_RED = 131072; constexpr int LDS_XB = 131072 + 8192;
constexpr int LDS_RS = 131072 + 8192 + 256, RS_MAX_UNITS = 12;

struct Args { const float* in[36]; float* out; unsigned char* ws; };
typedef const __attribute__((address_space(4))) Args* KArgsP;
#define KARGS() ({ KArgsP _p = (KArgsP)__builtin_amdgcn_kernarg_segment_ptr(); asm volatile("" : "+s"(_p)); _p; })

__device__ __forceinline__ unsigned cvtpk(float lo, float hi) { f32x2 v = {lo, hi}; bf16x2_t b = __builtin_convertvector(v, bf16x2_t); return __builtin_bit_cast(unsigned, b); }
__device__ __forceinline__ float bf2f(bf16_t x) { return __uint_as_float((unsigned)x << 16); }
__device__ __forceinline__ float wave_sum(float v) {
#pragma unroll
    for (int o = 1; o < 64; o <<= 1) v += __shfl_xor(v, o);
    return v;
}
__device__ __forceinline__ float fq_sum(float v) { v += __shfl_xor(v, 16); v += __shfl_xor(v, 32); return v; }
__device__ __forceinline__ float max3f(float a, float b, float c) { float r; asm("v_max3_f32 %0, %1, %2, %3" : "=v"(r) : "v"(a), "v"(b), "v"(c)); return r; }
__device__ __forceinline__ float max2f(float a, float b) { float r; asm("v_max_f32_e32 %0, %1, %2" : "=v"(r) : "v"(a), "v"(b)); return r; }
__device__ __forceinline__ float xl_max(float v) {
    u32x2 r = __builtin_amdgcn_permlane32_swap(__float_as_uint(v), __float_as_uint(v), false, false); v = max2f(__uint_as_float(r[0]), __uint_as_float(r[1]));
    r = __builtin_amdgcn_permlane16_swap(__float_as_uint(v), __float_as_uint(v), false, false); return max2f(__uint_as_float(r[0]), __uint_as_float(r[1]));
}
__device__ __forceinline__ float fq_max(float v) { v = fmaxf(v, __shfl_xor(v, 16)); v = fmaxf(v, __shfl_xor(v, 32)); return v; }
__device__ __forceinline__ u32x4 pack8(f32x4 a, f32x4 b) { u32x4 w; w.x = cvtpk(a[0], a[1]); w.y = cvtpk(a[2], a[3]); w.z = cvtpk(b[0], b[1]); w.w = cvtpk(b[2], b[3]); return w; }
__device__ __forceinline__ float fast_exp2(float x) { return __builtin_amdgcn_exp2f(x); }
__device__ __forceinline__ float fast_rcp(float x) { return __builtin_amdgcn_rcpf(x); }
__device__ __forceinline__ float sigmoidf_(float x) { return fast_rcp(1.f + fast_exp2(-x * LOG2E)); }


__device__ __forceinline__ float ss_sum16(const float* ss16, int row) {
    const f32x4* p = (const f32x4*)(ss16 + (size_t)row * 16); const f32x4 a = p[0], b = p[1], c = p[2], d = p[3];
    return (((a[0] + a[1]) + (a[2] + a[3])) + ((b[0] + b[1]) + (b[2] + b[3]))) + (((c[0] + c[1]) + (c[2] + c[3])) + ((d[0] + d[1]) + (d[2] + d[3])));
}
#define XB_TMO      128
#define XB_XCNT(j)  (256  + 64 * (j))
#define XB_XSUB(j)  (1280 + 64 * (j))
#define XB_XGEN(j)  (2304 + 64 * (j))
#define XB_TOP      3328
#define XB_TOPGEN   3392
#define XCD_BAR_WORDS 3456
#define XB_SPIN_CAP (1u << 22)
__device__ __forceinline__ unsigned xb_ld(unsigned* p)              { return __hip_atomic_load(p, __ATOMIC_RELAXED, __HIP_MEMORY_SCOPE_AGENT); }
__device__ __forceinline__ unsigned xb_add(unsigned* p, unsigned v) { return __hip_atomic_fetch_add(p, v, __ATOMIC_RELAXED, __HIP_MEMORY_SCOPE_AGENT); }
__device__ __forceinline__ unsigned xb_xcc_id() { return (unsigned)__builtin_amdgcn_s_getreg((3 << 11) | 20) & 0xFu; }
#define XB_SPIN(cond, bar) do { unsigned _sp = 0; while (cond) { __builtin_amdgcn_s_sleep(1); \
    if ((++_sp & 255u) == 0u) { if (xb_ld(&(bar)[XB_TMO])) break; if (_sp > XB_SPIN_CAP) { atomicAdd(&(bar)[XB_TMO], 1u); break; } } } } while (0)
struct XcdBarrier { unsigned* bar; unsigned x; volatile LAS unsigned* st; };
__device__ __forceinline__ XcdBarrier xcd_barrier_post(unsigned* bar, volatile LAS unsigned* st) {
    XcdBarrier b; b.bar = bar; b.x = xb_xcc_id(); b.st = st;
    if (threadIdx.x == 0) (void)xb_add(&bar[XB_XCNT(b.x)], 1u);
    return b;
}
__device__ __forceinline__ void xcd_barrier_complete(unsigned* bar, unsigned x, unsigned& nloc, unsigned& nx) {
    const unsigned G = gridDim.x * gridDim.y * gridDim.z;
    unsigned sum, cnt, mine, sp = 0u;
    for (;;) {
        sum = 0u; cnt = 0u; mine = 0u;
#pragma unroll
        for (unsigned j = 0; j < 16; ++j) { const unsigned c = xb_ld(&bar[XB_XCNT(j)]); sum += c; cnt += (c > 0u) ? 1u : 0u; mine = (j == x) ? c : mine; }
        if (sum == G) break;
        __builtin_amdgcn_s_sleep(1);
        if ((++sp & 255u) == 0u) { if (xb_ld(&bar[XB_TMO])) break; if (sp > XB_SPIN_CAP) { atomicAdd(&bar[XB_TMO], 1u); break; } }
    }
    nloc = mine > 0u ? mine : 1u; nx = cnt > 0u ? cnt : 1u;
}
__device__ __forceinline__ void xcd_barrier(const XcdBarrier& b) {
    asm volatile("s_waitcnt vmcnt(0)" ::: "memory");
    __syncthreads();
    if (threadIdx.x == 0) {
        unsigned* bar = b.bar;
        __builtin_amdgcn_s_waitcnt(0);
        unsigned nloc = b.st[0], nx = b.st[1];
        if (nloc == 0u) { xcd_barrier_complete(bar, b.x, nloc, nx); b.st[0] = nloc; b.st[1] = nx; }
        const unsigned old = xb_add(&bar[XB_XSUB(b.x)], 1u);
        const unsigned gen = old / nloc;
        if (old + 1u == (gen + 1u) * nloc) {
            __builtin_amdgcn_fence(__ATOMIC_RELEASE, "agent");
            asm volatile("s_waitcnt vmcnt(0)" ::: "memory");
            const unsigned og = xb_add(&bar[XB_TOP], 1u);
            const unsigned tg = og / nx;
            if (og + 1u == (tg + 1u) * nx) xb_add(&bar[XB_TOPGEN], 1u);
            else XB_SPIN(xb_ld(&bar[XB_TOPGEN]) == tg, bar);
            __builtin_amdgcn_fence(__ATOMIC_ACQUIRE, "agent");
            xb_add(&bar[XB_XGEN(b.x)], 1u);
            asm volatile("s_waitcnt vmcnt(0)" ::: "memory");
        } else {
            XB_SPIN(xb_ld(&bar[XB_XGEN(b.x)]) == gen, bar);
            __builtin_amdgcn_fence(__ATOMIC_ACQUIRE, "agent");
            asm volatile("s_waitcnt vmcnt(0)" ::: "memory");
        }
    }
    __syncthreads();
}

constexpr int BM = 256, BK = 64, HALF = 128, HTB = HALF * BK * 2, NXCD = 8, WGM = 8;
__host__ __device__ __forceinline__ int lds_byte(int r, int c) { const int st = (r >> 4) * 2 + (c >> 5), rr = r & 15, cc = c & 31, ob = rr * 64 + cc * 2; return st * 1024 + (ob ^ (((ob >> 9) & 1) << 5)); }
__host__ __device__ __forceinline__ void stage_rc(int b, int& R, int& C) { const int st = b / 1024, sb = b % 1024, swz = sb ^ (((sb >> 9) & 1) << 5); R = (st >> 1) * 16 + swz / 64; C = (st & 1) * 32 + (swz % 64) / 2; }
__host__ __device__ __forceinline__ int perm32(int rho) { const int n = rho >> 4, i = rho & 15; return 8 * (i >> 2) + 4 * n + (i & 3); }

struct Unit { int pm, pn, bz, ui; unsigned a_off, b_off; };

struct StdSched {
    int nM, nN, nwg, G, c, lda, ldb;
    __device__ void init(int M, int N, int G_, int c_, int lda_, int ldb_) { nM = M / BM; nN = N / BM; nwg = nM * nN; G = G_; c = c_; lda = lda_; ldb = ldb_; }
    __device__ bool next(int i, Unit& u) const {
        const long L = (long)i * G + c; if (L >= nwg) return false;
        int wgid = (int)L; { const int q = nwg / NXCD, r = nwg % NXCD, xcd = wgid % NXCD, off = wgid / NXCD; wgid = (xcd < r ? xcd * (q + 1) : r * (q + 1) + (xcd - r) * q) + off; }
        const int nig = WGM * nN, gid = wgid / nig, fm = gid * WGM, gsz = (nM - fm) < WGM ? (nM - fm) : WGM;
        u.pm = fm + ((wgid % nig) % gsz); u.pn = (wgid % nig) / gsz; u.bz = 0;
        u.a_off = (unsigned)(u.pm * BM) * (unsigned)lda; u.b_off = (unsigned)(u.pn * BM) * (unsigned)ldb; return true;
    }
};
struct Ssm1Sched {
    int c;
    __device__ bool next(int i, Unit& u) const {
        if (i > 0 || c >= BATCH * NG) return false;
        u.pm = 0; u.pn = 0; u.bz = c; u.a_off = (unsigned)c * NCH * UPW; u.b_off = (unsigned)(c & 31) * 256 * 512; return true;
    }
};
struct WkvSched {
    int G, c;
    __device__ bool next(int i, Unit& u) const {
        if (c < 128) return false;
        const int L = (c - 128) + i * (G - 128); if (L >= 64) return false;
        const int layer = L >> 5, rem = L & 31; u.pm = rem >> 3; u.pn = rem & 7; u.bz = layer;
        u.a_off = (unsigned)layer * 1024 * 1024 + (unsigned)u.pm * 256 * 1024; u.b_off = (unsigned)layer * (unsigned)(W_LAYER / 2) + (unsigned)u.pn * 256 * 1024; return true;
    }
};
struct Ssm2Sched {
    int G, c;
    __device__ bool next(int i, Unit& u) const {
        const int L = c + i * G; if (L >= 2 * BATCH * NG) return false;
        u.bz = L >> 1; u.pn = L & 1; u.pm = 0; u.a_off = (unsigned)u.bz * NCH * UPW; u.b_off = ((unsigned)(u.bz & 31) * 512 + (unsigned)u.pn * 256) * UPW; return true;
    }
};
struct XaSched {
    int G, c; unsigned bs_b, bs_h;
    __device__ bool next(int i, Unit& u) const {
        const int L = c + i * G; if (L >= 512) return false;
        const int bh = L >> 5; u.pm = L & 31; u.pn = 0; u.bz = bh; const int b = bh >> 2, h = bh & 3;
        u.a_off = ((unsigned)(b * SEQ + u.pm * 256)) * 1024 + h * 256; u.b_off = (unsigned)b * bs_b + (unsigned)h * bs_h; return true;
    }
};

template <class Epi, class Sched, bool ALIGN_EPI>
__device__ __forceinline__ void gemm_phase(LAS unsigned char* lds, const bf16_t* Ab, const bf16_t* Bb, int lda, int ldb, int K, const Sched& S, Epi& E) {
    int tid = threadIdx.x; asm volatile("" : "+v"(tid));
    const int wid = __builtin_amdgcn_readfirstlane(tid >> 6), lane = tid & 63, wr = wid >> 2, wc = wid & 3, fr = lane & 15, fq = lane >> 4;
    const int nt = K / BK;
    unsigned voffA[2], voffB[2]; int aoff, boff;
#define PG8_LANEOFFS(tt) do { _Pragma("unroll") for (int i = 0; i < 2; ++i) { int R, C; stage_rc((tt) * 16 + i * 8192, R, C); const int Rb = (R & ~31) + perm32(R & 31); \
        voffA[i] = (unsigned)(R * lda + C) * 2u; voffB[i] = (unsigned)(Rb * ldb + C) * 2u; } \
        aoff = lds_byte(wr * 64 + ((tt) & 15), (((tt) >> 4) & 3) * 8); boff = lds_byte(wc * 32 + ((tt) & 15), (((tt) >> 4) & 3) * 8); } while (0)
    PG8_LANEOFFS(tid);
    const unsigned kstep = (unsigned)(BK * 2);
    const unsigned hstepA = (unsigned)HALF * lda * 2, hstepB = (unsigned)HALF * ldb * 2;
    const unsigned ldsw = (unsigned)wid * 1024u;
#define PG8_SA(b, h) (((b) * 2 + (h)) * HTB)
#define PG8_SB(b, h) ((4 + (b) * 2 + (h)) * HTB)
#define PG8_STAGE(bufoff, gbase, voff) do { _Pragma("unroll") for (int _i = 0; _i < 2; ++_i) \
        __builtin_amdgcn_global_load_lds((const unsigned*)((const char*)(gbase) + (voff)[_i]), (LAS unsigned*)(lds + (bufoff) + ldsw + _i * 8192), 16, 0, 0); } while (0)
#define PG8_LDA(dst, b, h) do { _Pragma("unroll") for (int m = 0; m < 4; ++m) _Pragma("unroll") for (int k = 0; k < 2; ++k) dst[m][k] = *(const LAS bf16x8*)(lds + PG8_SA(b, h) + aoff + m * 2048 + k * 1024); } while (0)
#define PG8_LDB(dst, b, h) do { _Pragma("unroll") for (int n = 0; n < 2; ++n) _Pragma("unroll") for (int k = 0; k < 2; ++k) dst[n][k] = *(const LAS bf16x8*)(lds + PG8_SB(b, h) + boff + n * 2048 + k * 1024); } while (0)
#define PG8_MMA(ai, bj, At, Bt) do { __builtin_amdgcn_s_setprio(1); _Pragma("unroll") for (int m = 0; m < 4; ++m) _Pragma("unroll") for (int n = 0; n < 2; ++n) _Pragma("unroll") for (int k = 0; k < 2; ++k) \
        acc[ai][bj][m][n] = __builtin_amdgcn_mfma_f32_16x16x32_bf16(Bt[n][k], At[m][k], acc[ai][bj][m][n], 0, 0, 0); __builtin_amdgcn_s_setprio(0); } while (0)
#define PG8_WAIT_V(n) asm volatile("s_waitcnt vmcnt(" #n ")" ::: "memory")
#define PG8_WAIT_L(n) asm volatile("s_waitcnt lgkmcnt(" #n ")" ::: "memory")
#define PG8_BAR __builtin_amdgcn_s_barrier()
#define PG8_SCHED __builtin_amdgcn_sched_barrier(0)
    Unit cur, nxt; int ui = 0;
    if (!S.next(0, cur)) return;
    cur.ui = 0;
    if constexpr (Epi::HAS_RS) {
        LAS float* rst = (LAS float*)(lds + LDS_RS);
        for (int i = (tid >> 8); i < RS_MAX_UNITS; i += 2) { Unit uu; if (!S.next(i, uu)) break; const int row = uu.pm * 256 + (tid & 255); rst[i * 256 + (tid & 255)] = rsqrtf(ss_sum16(E.ss, row) * Epi::RS_INVN + EPS); }
        __syncthreads();
    }
    f32x4 acc[2][2][4][2];
#pragma unroll
    for (int a = 0; a < 2; ++a)
#pragma unroll
        for (int b = 0; b < 2; ++b)
#pragma unroll
            for (int m = 0; m < 4; ++m)
#pragma unroll
                for (int n = 0; n < 2; ++n) acc[a][b][m][n] = (f32x4){0.f, 0.f, 0.f, 0.f};
    bf16x8 At[4][2], B0[2][2], B1[2][2];
    const char* cA = (const char*)(Ab + cur.a_off); const char* cB = (const char*)(Bb + cur.b_off);
    PG8_STAGE(PG8_SB(0, 0), cB, voffB); PG8_STAGE(PG8_SB(0, 1), cB + hstepB, voffB); PG8_STAGE(PG8_SA(0, 0), cA, voffA); PG8_STAGE(PG8_SA(0, 1), cA + hstepA, voffA);
    if (wr == 1) PG8_BAR;
    PG8_WAIT_V(2); PG8_BAR;
    PG8_STAGE(PG8_SB(1, 0), cB + kstep, voffB); PG8_STAGE(PG8_SA(1, 0), cA + kstep, voffA); PG8_STAGE(PG8_SB(1, 1), cB + hstepB + kstep, voffB);
    PG8_WAIT_V(6); PG8_BAR;
    for (;;) {
        const bool has_next = S.next(ui + 1, nxt); nxt.ui = ui + 1;
        const char* nA = has_next ? (const char*)(Ab + nxt.a_off) : cA; const char* nB = has_next ? (const char*)(Bb + nxt.b_off) : cB;
        for (int t = 0; t < nt; t += 2) {
            const bool last = (t == nt - 2);
            const char* a1 = cA + (unsigned)(t + 1) * kstep;
            const char* a2 = last ? nA : cA + (unsigned)(t + 2) * kstep; const char* b2 = last ? nB : cB + (unsigned)(t + 2) * kstep;
            const char* a3 = a2 + kstep; const char* b3 = b2 + kstep;
            PG8_LDB(B0, 0, 0); PG8_LDB(B1, 0, 1); PG8_SCHED; PG8_LDA(At, 0, 0); PG8_STAGE(PG8_SA(1, 1), a1 + hstepA, voffA);
            PG8_WAIT_V(8); PG8_WAIT_L(0); PG8_BAR; PG8_MMA(0, 0, At, B0); PG8_MMA(0, 1, At, B1); PG8_BAR; PG8_SCHED;
            PG8_LDA(At, 0, 1); PG8_STAGE(PG8_SB(0, 0), b2, voffB); PG8_STAGE(PG8_SB(0, 1), b2 + hstepB, voffB); PG8_STAGE(PG8_SA(0, 0), a2, voffA);
            PG8_WAIT_V(8); PG8_WAIT_L(0); PG8_BAR; PG8_MMA(1, 0, At, B0); PG8_MMA(1, 1, At, B1); PG8_BAR; PG8_SCHED;
            PG8_LDB(B0, 1, 0); PG8_LDB(B1, 1, 1); PG8_SCHED; PG8_LDA(At, 1, 0); PG8_STAGE(PG8_SA(0, 1), a2 + hstepA, voffA);
            PG8_WAIT_V(8); PG8_WAIT_L(0); PG8_BAR; PG8_MMA(0, 0, At, B0); PG8_MMA(0, 1, At, B1); PG8_BAR; PG8_SCHED;
            PG8_LDA(At, 1, 1); PG8_STAGE(PG8_SB(1, 0), b3, voffB); PG8_STAGE(PG8_SB(1, 1), b3 + hstepB, voffB); PG8_STAGE(PG8_SA(1, 0), a3, voffA);
            PG8_WAIT_V(8); PG8_WAIT_L(0); PG8_BAR; PG8_MMA(1, 0, At, B0); PG8_MMA(1, 1, At, B1); PG8_BAR; PG8_SCHED;
        }
        if constexpr (ALIGN_EPI) { if (wr == 0) PG8_BAR; }
        if constexpr (!Epi::AFTER_DRAIN) { int t2 = threadIdx.x; asm volatile("" : "+v"(t2)); E(acc, cur, wr, wc, t2 & 15, (t2 >> 4) & 3); }
        if (!has_next) break;
#pragma unroll
        for (int a = 0; a < 2; ++a)
#pragma unroll
            for (int b = 0; b < 2; ++b)
#pragma unroll
                for (int m = 0; m < 4; ++m)
#pragma unroll
                    for (int n = 0; n < 2; ++n) acc[a][b][m][n] = (f32x4){0.f, 0.f, 0.f, 0.f};
        cur = nxt; cA = nA; cB = nB; ++ui;
        { int t3 = threadIdx.x; asm volatile("" : "+v"(t3)); PG8_LANEOFFS(t3); }
        if constexpr (ALIGN_EPI) { if (wr == 1) PG8_BAR; }
    }
    PG8_WAIT_V(0);
    if constexpr (!ALIGN_EPI) { if (wr == 0) PG8_BAR; }
    PG8_BAR;
    if constexpr (Epi::AFTER_DRAIN) { E.fused(acc, cur, wr, wc, fr, fq, lds, wid, lane); }
#undef PG8_LANEOFFS
#undef PG8_SA
#undef PG8_SB
#undef PG8_STAGE
#undef PG8_LDA
#undef PG8_LDB
#undef PG8_MMA
#undef PG8_WAIT_V
#undef PG8_WAIT_L
#undef PG8_BAR
#undef PG8_SCHED
}

typedef f32x4 (&AccRef)[2][2][4][2];
template <bool RS> struct EpiResidT;
typedef EpiResidT<false> EpiResid;

struct EpiFfnUp {
    static constexpr bool AFTER_DRAIN = false, HAS_RS = true; static constexpr float RS_INVN = 1.f / D;
    bf16_t* H; const float* ss; const LAS float* rst;
    __device__ __forceinline__ void operator()(AccRef acc, const Unit& u, int wr, int wc, int fr, int fq) const {
#pragma unroll
        for (int ai = 0; ai < 2; ++ai)
#pragma unroll
            for (int m = 0; m < 4; ++m) {
                const int row = u.pm * 256 + ai * 128 + wr * 64 + m * 16 + fr;
                const float rs = rst[u.ui * 256 + ai * 128 + wr * 64 + m * 16 + fr];
                f32x4 o[2];
#pragma unroll
                for (int n = 0; n < 2; ++n)
#pragma unroll
                    for (int j = 0; j < 4; ++j) { const float g = acc[ai][0][m][n][j] * rs, up = acc[ai][1][m][n][j] * rs; o[n][j] = g * sigmoidf_(g) * up; }
                *(u32x4*)(H + (size_t)row * FF + u.pn * 128 + wc * 32 + 8 * fq) = pack8(o[0], o[1]);
            }
    }
};
template <bool RS> struct EpiResidT {
    static constexpr bool AFTER_DRAIN = false, HAS_RS = RS; static constexpr float RS_INVN = 1.f / 512.f;
    bf16_t* hb; float* ssn; float scale; const float* ss; const LAS float* rst;
    __device__ __forceinline__ void operator()(AccRef acc, const Unit& u, int wr, int wc, int fr, int fq) const {
#pragma unroll
        for (int ai = 0; ai < 2; ++ai) {
            u32x4 ow[4][2];
#pragma unroll
            for (int m = 0; m < 4; ++m)
#pragma unroll
                for (int bj = 0; bj < 2; ++bj)
                    ow[m][bj] = *(const u32x4*)(hb + (size_t)(u.pm * 256 + ai * 128 + wr * 64 + m * 16 + fr) * D + u.pn * 256 + bj * 128 + wc * 32 + 8 * fq);
            __builtin_amdgcn_sched_barrier(0);
#pragma unroll
            for (int m = 0; m < 4; ++m) {
                const int row = u.pm * 256 + ai * 128 + wr * 64 + m * 16 + fr; float part = 0.f;
                const float sc = RS ? scale * rst[u.ui * 256 + ai * 128 + wr * 64 + m * 16 + fr] : scale;
#pragma unroll
                for (int bj = 0; bj < 2; ++bj) {
                    const size_t idx = (size_t)row * D + u.pn * 256 + bj * 128 + wc * 32 + 8 * fq;
                    const u32x4 o4 = ow[m][bj];
                    f32x4 v0, v1;
                    v0[0] = __uint_as_float(o4.x << 16); v0[1] = __uint_as_float(o4.x & 0xffff0000u); v0[2] = __uint_as_float(o4.y << 16); v0[3] = __uint_as_float(o4.y & 0xffff0000u);
                    v1[0] = __uint_as_float(o4.z << 16); v1[1] = __uint_as_float(o4.z & 0xffff0000u); v1[2] = __uint_as_float(o4.w << 16); v1[3] = __uint_as_float(o4.w & 0xffff0000u);
                    v0 = v0 + acc[ai][bj][m][0] * sc; v1 = v1 + acc[ai][bj][m][1] * sc;
                    *(u32x4*)(hb + idx) = pack8(v0, v1);
                    part += (v0[0] * v0[0] + v0[1] * v0[1]) + (v0[2] * v0[2] + v0[3] * v0[3]) + (v1[0] * v1[0] + v1[1] * v1[1]) + (v1[2] * v1[2] + v1[3] * v1[3]);
                }
                part = fq_sum(part);
                if (fq == 0) ssn[(size_t)row * 16 + u.pn * 4 + wc] = part;
            }
            __builtin_amdgcn_sched_barrier(0);
        }
    }
};
struct EpiWin {
    static constexpr bool AFTER_DRAIN = false, HAS_RS = true; static constexpr float RS_INVN = 1.f / D;
    unsigned char* arp; const float* ss; const LAS float* rst;
    __device__ __forceinline__ void operator()(AccRef acc, const Unit& u, int wr, int wc, int fr, int fq) const {
        bf16_t* up = (bf16_t*)(arp + AR_UP); bf16_t* qb = (bf16_t*)(arp + AR_Q); bf16_t* kb = (bf16_t*)(arp + AR_K); bf16_t* vt = (bf16_t*)(arp + AR_VT);
        const int sel = u.pn >> 1;
#pragma unroll
        for (int ai = 0; ai < 2; ++ai)
#pragma unroll
            for (int m = 0; m < 4; ++m) {
                const int row = u.pm * 256 + ai * 128 + wr * 64 + m * 16 + fr;
                float rs = rst[u.ui * 256 + ai * 128 + wr * 64 + m * 16 + fr];
                if (sel == 1) rs *= 0.125f * LOG2E;
                const int b = row >> 13, t = row & (SEQ - 1);
#pragma unroll
                for (int bj = 0; bj < 2; ++bj) {
                    const int c = (u.pn & 1) * 256 + bj * 128 + wc * 32 + 8 * fq;
                    const f32x4 v0 = acc[ai][bj][m][0] * rs, v1 = acc[ai][bj][m][1] * rs;
                    if (sel == 0) { const int g = c >> 4, hi0 = c & 15;
                        *(u32x4*)(up + ((size_t)((b * NG + g) * NCH + (t >> 5))) * UPW + (t & 31) * 16 + hi0) = pack8(v0, v1);
                    } else if (sel == 1) { *(u32x4*)(qb + (size_t)row * 512 + c) = pack8(v0, v1);
                    } else if (sel == 2) { *(u32x4*)(kb + (size_t)row * 512 + c) = pack8(v0, v1);
                    } else { const int h = c >> 7, dv = c & 127; bf16_t* p = vt + ((size_t)((b * 4 + h) * 128 + dv)) * SEQ + t;
                        const u32x4 w = pack8(v0, v1);
                        p[0] = (bf16_t)(w.x & 0xffff); p[SEQ] = (bf16_t)(w.x >> 16); p[2 * SEQ] = (bf16_t)(w.y & 0xffff); p[3 * SEQ] = (bf16_t)(w.y >> 16);
                        p[4 * SEQ] = (bf16_t)(w.z & 0xffff); p[5 * SEQ] = (bf16_t)(w.z >> 16); p[6 * SEQ] = (bf16_t)(w.w & 0xffff); p[7 * SEQ] = (bf16_t)(w.w >> 16);
                    }
                }
            }
    }
};
__device__ __forceinline__ float gelu_tanh(float x) { const float z = 0.7978845608028654f * (x + 0.044715f * x * x * x); return x * fast_rcp(1.f + fast_exp2(-2.f * LOG2E * z)); }
struct EpiSsm2 {
    static constexpr bool AFTER_DRAIN = false, HAS_RS = false;
    bf16_t* yb;
    __device__ __forceinline__ void operator()(AccRef acc, const Unit& u, int wr, int wc, int fr, int fq) const {
        const int b = u.bz >> 5, g = u.bz & 31;
#pragma unroll
        for (int ai = 0; ai < 2; ++ai)
#pragma unroll
            for (int m = 0; m < 4; ++m) {
                const int ch = ai * 128 + wr * 64 + m * 16 + fr;
#pragma unroll
                for (int bj = 0; bj < 2; ++bj) {
                    const int cc = u.pn * 256 + bj * 128 + wc * 32 + 8 * fq, t = cc >> 4, ho0 = cc & 15;
                    f32x4 v0, v1;
#pragma unroll
                    for (int j = 0; j < 4; ++j) { v0[j] = gelu_tanh(acc[ai][bj][m][0][j]); v1[j] = gelu_tanh(acc[ai][bj][m][1][j]); }
                    *(u32x4*)(yb + ((size_t)(b * SEQ + ch * CH + t)) * 512 + g * 16 + ho0) = pack8(v0, v1);
                }
            }
    }
};
struct EpiGlu {
    static constexpr bool AFTER_DRAIN = false, HAS_RS = false;
    bf16_t* mix; const float* bglu; float* ssq;
    __device__ __forceinline__ void operator()(AccRef acc, const Unit& u, int wr, int wc, int fr, int fq) const {
        const int c0 = u.pn * 128 + wc * 32 + 8 * fq;
        const f32x4 bv0 = *(const f32x4*)(bglu + c0), bv1 = *(const f32x4*)(bglu + c0 + 4), bg0 = *(const f32x4*)(bglu + 512 + c0), bg1 = *(const f32x4*)(bglu + 512 + c0 + 4);
#pragma unroll
        for (int ai = 0; ai < 2; ++ai)
#pragma unroll
            for (int m = 0; m < 4; ++m) {
                const int row = u.pm * 256 + ai * 128 + wr * 64 + m * 16 + fr;
                f32x4 o0, o1; float part = 0.f;
#pragma unroll
                for (int j = 0; j < 4; ++j) {
                    o0[j] = (acc[ai][0][m][0][j] + bv0[j]) * sigmoidf_(acc[ai][1][m][0][j] + bg0[j]);
                    o1[j] = (acc[ai][0][m][1][j] + bv1[j]) * sigmoidf_(acc[ai][1][m][1][j] + bg1[j]);
                    part += o0[j] * o0[j] + o1[j] * o1[j];
                }
                *(u32x4*)(mix + (size_t)row * D + c0) = pack8(o0, o1);
                part = fq_sum(part);
                if (fq == 0) ssq[(size_t)row * 16 + u.pn * 4 + wc] = part;
            }
    }
};
struct EpiWq {
    static constexpr bool AFTER_DRAIN = false, HAS_RS = true; static constexpr float RS_INVN = 1.f / D;
    bf16_t* O; const float* ss; float mul; const LAS float* rst;
    __device__ __forceinline__ void operator()(AccRef acc, const Unit& u, int wr, int wc, int fr, int fq) const {
#pragma unroll
        for (int ai = 0; ai < 2; ++ai)
#pragma unroll
            for (int m = 0; m < 4; ++m) {
                const int row = u.pm * 256 + ai * 128 + wr * 64 + m * 16 + fr;
                const float rs = rst[u.ui * 256 + ai * 128 + wr * 64 + m * 16 + fr] * mul;
#pragma unroll
                for (int bj = 0; bj < 2; ++bj)
                    *(u32x4*)(O + (size_t)row * D + u.pn * 256 + bj * 128 + wc * 32 + 8 * fq) = pack8(acc[ai][bj][m][0] * rs, acc[ai][bj][m][1] * rs);
            }
    }
};
struct EpiWkv {
    static constexpr bool AFTER_DRAIN = false, HAS_RS = false;
    bf16_t *kx, *vxt;
    __device__ __forceinline__ void operator()(AccRef acc, const Unit& u, int wr, int wc, int fr, int fq) const {
        const size_t lo = (size_t)u.bz * 1024 * 1024;
#pragma unroll
        for (int ai = 0; ai < 2; ++ai)
#pragma unroll
            for (int m = 0; m < 4; ++m) {
                const int row = u.pm * 256 + ai * 128 + wr * 64 + m * 16 + fr;
#pragma unroll
                for (int bj = 0; bj < 2; ++bj) {
                    const int col = u.pn * 256 + bj * 128 + wc * 32 + 8 * fq;
                    const u32x4 w = pack8(acc[ai][bj][m][0], acc[ai][bj][m][1]);
                    if (u.pn < 4) *(u32x4*)(kx + lo + (size_t)row * 1024 + col) = w;
                    else { const int c2 = col - 1024, h = c2 >> 8, d = c2 & 255, b = row >> 8, mm = row & 255;
                        bf16_t* p = vxt + lo + ((size_t)((b * 4 + h) * 256 + d)) * 256 + mm;
                        p[0] = (bf16_t)(w.x & 0xffff); p[256] = (bf16_t)(w.x >> 16); p[512] = (bf16_t)(w.y & 0xffff); p[768] = (bf16_t)(w.y >> 16);
                        p[1024] = (bf16_t)(w.z & 0xffff); p[1280] = (bf16_t)(w.z >> 16); p[1536] = (bf16_t)(w.w & 0xffff); p[1792] = (bf16_t)(w.w >> 16); }
                }
            }
    }
};
struct EpiSoftmax {
    static constexpr bool AFTER_DRAIN = false, HAS_RS = false;
    bf16_t* P; LAS float* red;
    __device__ __forceinline__ void operator()(AccRef acc, const Unit& u, int wr, int wc, int fr, int fq) const {
        const int b = u.bz >> 2, h = u.bz & 3;
        float mx[2][4];
#pragma unroll
        for (int ai = 0; ai < 2; ++ai)
#pragma unroll
            for (int m = 0; m < 4; ++m) {
                float v = -INFINITY;
#pragma unroll
                for (int bj = 0; bj < 2; ++bj)
#pragma unroll
                    for (int n = 0; n < 2; ++n)
#pragma unroll
                        for (int j = 0; j < 4; ++j) v = fmaxf(v, acc[ai][bj][m][n][j]);
                v = fq_max(v);
                const int rl = ai * 128 + wr * 64 + m * 16 + fr;
                if (fq == 0) red[rl * 4 + wc] = v;
            }
        asm volatile("s_waitcnt lgkmcnt(0)" ::: "memory"); __builtin_amdgcn_s_barrier(); asm volatile("" ::: "memory");
#pragma unroll
        for (int ai = 0; ai < 2; ++ai)
#pragma unroll
            for (int m = 0; m < 4; ++m) {
                const int rl = ai * 128 + wr * 64 + m * 16 + fr;
                const f32x4 r4 = *(const LAS f32x4*)(red + rl * 4);
                const float M = fmaxf(fmaxf(r4[0], r4[1]), fmaxf(r4[2], r4[3]));
                float s = 0.f;
#pragma unroll
                for (int bj = 0; bj < 2; ++bj)
#pragma unroll
                    for (int n = 0; n < 2; ++n)
#pragma unroll
                        for (int j = 0; j < 4; ++j) { const float p = fast_exp2(acc[ai][bj][m][n][j] - M); acc[ai][bj][m][n][j] = p; s += p; }
                s = fq_sum(s);
                if (fq == 0) red[1024 + rl * 4 + wc] = s;
            }
        asm volatile("s_waitcnt lgkmcnt(0)" ::: "memory"); __builtin_amdgcn_s_barrier(); asm volatile("" ::: "memory");
#pragma unroll
        for (int ai = 0; ai < 2; ++ai)
#pragma unroll
            for (int m = 0; m < 4; ++m) {
                const int rl = ai * 128 + wr * 64 + m * 16 + fr;
                const f32x4 r4 = *(const LAS f32x4*)(red + 1024 + rl * 4);
                const float inv = 1.f / ((r4[0] + r4[1]) + (r4[2] + r4[3]));
                const size_t row = (size_t)b * SEQ + u.pm * 256 + rl;
#pragma unroll
                for (int bj = 0; bj < 2; ++bj)
                    *(u32x4*)(P + row * D + h * 256 + bj * 128 + wc * 32 + 8 * fq) = pack8(acc[ai][bj][m][0] * inv, acc[ai][bj][m][1] * inv);
            }
    }
};
struct EpiNull {
    static constexpr bool AFTER_DRAIN = false, HAS_RS = false;
    float* sink;
    __device__ __forceinline__ void operator()(AccRef acc, const Unit& u, int wr, int wc, int fr, int fq) const {
        float t = 0.f;
#pragma unroll
        for (int ai = 0; ai < 2; ++ai)
#pragma unroll
            for (int bj = 0; bj < 2; ++bj)
#pragma unroll
                for (int m = 0; m < 4; ++m)
#pragma unroll
                    for (int n = 0; n < 2; ++n) t += acc[ai][bj][m][n][0] + acc[ai][bj][m][n][1] + acc[ai][bj][m][n][2] + acc[ai][bj][m][n][3];
        if (t == 12345.678f) sink[u.pm] = t;
    }
};
struct EpiPV {
    static constexpr bool AFTER_DRAIN = false, HAS_RS = false;
    bf16_t* O;
    __device__ __forceinline__ void operator()(AccRef acc, const Unit& u, int wr, int wc, int fr, int fq) const {
        const int b = u.bz >> 2, h = u.bz & 3;
#pragma unroll
        for (int ai = 0; ai < 2; ++ai)
#pragma unroll
            for (int m = 0; m < 4; ++m) {
                const size_t row = (size_t)b * SEQ + u.pm * 256 + ai * 128 + wr * 64 + m * 16 + fr;
#pragma unroll
                for (int bj = 0; bj < 2; ++bj)
                    *(u32x4*)(O + row * D + h * 256 + bj * 128 + wc * 32 + 8 * fq) = pack8(acc[ai][bj][m][0], acc[ai][bj][m][1]);
            }
    }
};
struct EpiSsm1 {
    static constexpr bool AFTER_DRAIN = true, HAS_RS = false;
    bf16_t* up; const float *lam_re, *lam_im, *log_dt;
    __device__ __forceinline__ void operator()(AccRef, const Unit&, int, int, int, int) const {}
    __device__ __forceinline__ void fused(AccRef acc, const Unit& u, int wr, int wc, int fr, int fq, LAS unsigned char* lds, int wid, int lane) const {
        LAS float* L = (LAS float*)lds;
#pragma unroll
        for (int ai = 0; ai < 2; ++ai)
#pragma unroll
            for (int m = 0; m < 4; ++m) {
                const int rl = ai * 128 + wr * 64 + m * 16 + fr;
#pragma unroll
                for (int n = 0; n < 2; ++n) { const int col = wc * 32 + 8 * fq + 4 * n; *(LAS f32x4*)(L + rl * 128 + (col ^ ((rl & 15) << 3))) = acc[ai][0][m][n]; }
            }
        __syncthreads();
        {
            const int g = u.bz & 31, p = lane;
            const float dtc = expf(log_dt[g]) * (float)CH;
            const float lr = fminf(lam_re[g * NP + p], -1e-4f), li = lam_im[g * NP + p];
            float sn, cs; const float mag = expf(lr * dtc); sincosf(li * dtc, &sn, &cs);
            const float ar = mag * cs, aim = mag * sn;
            const float mag32 = expf(lr * dtc * 32.f); float sn32, cs32; sincosf(li * dtc * 32.f, &sn32, &cs32);
            const float br = mag32 * cs32, bim = mag32 * sn32;
            LAS f32x2* Eb = (LAS f32x2*)(lds + LDS_RED);
            const int c0 = wid * 32;
            float xr = 0.f, xi = 0.f;
            for (int c = c0; c < c0 + 32; ++c) {
                const f32x2 l2 = *(const LAS f32x2*)(L + c * 128 + ((2 * p) ^ ((c & 15) << 3)));
                const float nr = ar * xr - aim * xi + l2[0], ni = ar * xi + aim * xr + l2[1]; xr = nr; xi = ni; }
            Eb[wid * 64 + p] = (f32x2){xr, xi};
            __syncthreads();
            xr = 0.f; xi = 0.f;
            for (int v = 0; v < wid; ++v) { const f32x2 e = Eb[v * 64 + p]; const float nr = br * xr - bim * xi + e[0], ni = br * xi + bim * xr + e[1]; xr = nr; xi = ni; }
            unsigned* dst = (unsigned*)(up + (size_t)u.bz * NCH * UPW + 512) + p;
            for (int c = c0; c < c0 + 32; ++c) {
                dst[(size_t)c * (UPW / 2)] = cvtpk(xr, xi);
                const f32x2 l2 = *(const LAS f32x2*)(L + c * 128 + ((2 * p) ^ ((c & 15) << 3)));
                const float nr = ar * xr - aim * xi + l2[0], ni = ar * xi + aim * xr + l2[1]; xr = nr; xi = ni; }
        }
        __syncthreads();
    }
};

struct GainSpec { const float* g1; const float* g2; float g2s; };
__device__ __forceinline__ float gain_of(const GainSpec& gs, int k) {
    if (!gs.g1) return 1.f;
    if (gs.g2 && k >= 512) return gs.g2[(k - 512) & 127] * gs.g2s;
    return gs.g1[k];
}
__device__ __forceinline__ void transpose_item(const float* W, int K, int N, bf16_t* WT, bool il, int nh, int hb, const GainSpec gs, LAS float* scr, int item, int lane) {
    const int nblk = N / 32, kb = item / nblk, nb = item % nblk, k0 = 64 * kb, n0 = 32 * nb;
    float tv[32];
#pragma unroll
    for (int i = 0; i < 32; ++i) { const int kk = 2 * i + (lane >> 5); tv[i] = W[(size_t)(k0 + kk) * N + n0 + (lane & 31)]; }
#pragma unroll
    for (int i = 0; i < 32; ++i) { const int kk = 2 * i + (lane >> 5); scr[kk * 33 + (lane & 31)] = tv[i] * gain_of(gs, k0 + kk); }
    asm volatile("s_waitcnt lgkmcnt(0)" ::: "memory");
    const int c = lane & 7;
#pragma unroll
    for (int j = 0; j < 4; ++j) { const int n = (lane >> 3) + 8 * j; const LAS float* s = scr + (8 * c) * 33 + n;
        u32x4 o; o.x = cvtpk(s[0 * 33], s[1 * 33]); o.y = cvtpk(s[2 * 33], s[3 * 33]); o.z = cvtpk(s[4 * 33], s[5 * 33]); o.w = cvtpk(s[6 * 33], s[7 * 33]);
        int row = n0 + n; if (il) { const int jj = row % nh, half = hb + row / nh; row = (jj >> 7) * 256 + half * 128 + (jj & 127); }
        *(u32x4*)(WT + (size_t)row * K + k0 + 8 * c) = o; }
    asm volatile("s_waitcnt lgkmcnt(0)" ::: "memory");
}

__device__ __forceinline__ void ssm_matrices(KArgsP a, int l, int g, LAS unsigned char* lds, bf16_t* Bm, bf16_t* Mt) {
    int tid = threadIdx.x; asm volatile("" : "+v"(tid));
    LAS f32x2* lamtab = (LAS f32x2*)lds;
    LAS f32x2* cc = (LAS f32x2*)(lds + 16896);
    LAS f32x2* bb = (LAS f32x2*)(lds + 16896 + 8192);
    LAS float* Kt = (LAS float*)(lds + 16896 + 16384);
    const float* lam_re = a->in[9] + (size_t)(l * NG + g) * NP; const float* lam_im = a->in[10] + (size_t)(l * NG + g) * NP;
    const float* b_re = a->in[11] + (size_t)(l * NG + g) * NP * 16; const float* b_im = a->in[12] + (size_t)(l * NG + g) * NP * 16;
    const float* c_re = a->in[13] + (size_t)(l * NG + g) * 16 * NP; const float* c_im = a->in[14] + (size_t)(l * NG + g) * 16 * NP;
    const float* dd = a->in[15] + (size_t)(l * NG + g) * 16;
    const float dt = expf(a->in[16][l * NG + g]);
    for (int idx = tid; idx < 33 * 64; idx += 512) { const int tau = idx >> 6, p = idx & 63;
        const float lr = fminf(lam_re[p], -1e-4f), li = lam_im[p]; const float zr = lr * dt * (float)tau, zi = li * dt * (float)tau;
        const float mag = expf(zr); float sn, cs; sincosf(zi, &sn, &cs); lamtab[idx] = (f32x2){mag * cs, mag * sn}; }
    for (int idx = tid; idx < 1024; idx += 512) {
        cc[idx] = (f32x2){c_re[idx], c_im[idx]};
        const int p = idx >> 4;
        const float lr = fminf(lam_re[p], -1e-4f), li = lam_im[p]; const float mag = expf(lr * dt); float sn, cs; sincosf(li * dt, &sn, &cs);
        const float ar = mag * cs - 1.f, ai = mag * sn, den = 1.f / (lr * lr + li * li);
        const float qr = (ar * lr + ai * li) * den, qi = (ai * lr - ar * li) * den;
        const float br = b_re[idx], bi = b_im[idx];
        bb[idx] = (f32x2){qr * br - qi * bi, qr * bi + qi * br};
    }
    __syncthreads();
    for (int idx = tid; idx < 32 * 256; idx += 512) { const int tau = idx >> 8, ho = (idx >> 4) & 15, hi = idx & 15; float s = 0.f;
        for (int p = 0; p < NP; ++p) { const f32x2 c = cc[ho * 64 + p], lm = lamtab[tau * 64 + p], b = bb[p * 16 + hi];
            const float wr_ = c[0] * lm[0] - c[1] * lm[1], wi_ = c[0] * lm[1] + c[1] * lm[0]; s += wr_ * b[0] - wi_ * b[1]; }
        if (tau == 0 && ho == hi) s += dd[ho];
        Kt[idx] = s; }
    __syncthreads();
    for (int ch = tid; ch < 512 * 80; ch += 512) { const int n = ch / 80, kc = ch % 80, t = n >> 4, ho = n & 15, k0 = kc * 8; float v[8];
        if (k0 < 512) { const int s = k0 >> 4, hi0 = k0 & 15;
#pragma unroll
            for (int j = 0; j < 8; ++j) v[j] = (s <= t) ? Kt[(t - s) * 256 + ho * 16 + hi0 + j] : 0.f;
        } else { const int p0 = (k0 - 512) >> 1;
#pragma unroll
            for (int j = 0; j < 4; ++j) { const f32x2 c = cc[ho * 64 + p0 + j], lm = lamtab[(t + 1) * 64 + p0 + j];
                v[2 * j] = c[0] * lm[0] - c[1] * lm[1]; v[2 * j + 1] = -(c[0] * lm[1] + c[1] * lm[0]); } }
        u32x4 o; o.x = cvtpk(v[0], v[1]); o.y = cvtpk(v[2], v[3]); o.z = cvtpk(v[4], v[5]); o.w = cvtpk(v[6], v[7]);
        *(u32x4*)(Mt + (size_t)n * UPW + k0) = o; }
    for (int ch = tid; ch < 256 * 64; ch += 512) { const int n = ch >> 6, k0 = (ch & 63) * 8; float v[8];
        if (n < 128) { const int p = n >> 1, ri = n & 1, s = k0 >> 4, hi0 = k0 & 15; const f32x2 lm = lamtab[(CH - 1 - s) * 64 + p];
#pragma unroll
            for (int j = 0; j < 8; ++j) { const f32x2 b = bb[p * 16 + hi0 + j]; v[j] = ri ? (lm[0] * b[1] + lm[1] * b[0]) : (lm[0] * b[0] - lm[1] * b[1]); }
        } else {
#pragma unroll
            for (int j = 0; j < 8; ++j) v[j] = 0.f; }
        u32x4 o; o.x = cvtpk(v[0], v[1]); o.y = cvtpk(v[2], v[3]); o.z = cvtpk(v[4], v[5]); o.w = cvtpk(v[6], v[7]);
        *(u32x4*)(Bm + (size_t)n * 512 + k0) = o; }
    __syncthreads();
}

__device__ __forceinline__ void prologue(KArgsP a, LAS unsigned char* lds, int G) {
    unsigned char* ws = a->ws;
    int tid = threadIdx.x; asm volatile("" : "+v"(tid));
    const int lane = tid & 63, wave = tid >> 6, bid = blockIdx.x;
    for (int it = bid; it < DEPTH * NG; it += G) { const int l = it >> 5, g = it & 31;
        ssm_matrices(a, l, g, lds, (bf16_t*)(ws + WS_W + l * W_LAYER + W_BM) + (size_t)g * 256 * 512, (bf16_t*)(ws + WS_W + l * W_LAYER + W_MT) + (size_t)g * 512 * UPW); }
    if (bid == 0) {
        float* sm = (float*)(ws + WS_SMALL);
        if (tid < 128) { const int l = tid >> 6, i = tid & 63;
            const float d1 = wave_sum(a->in[20][l * 64 + i] * a->in[21][l * 64 + i]), d2 = wave_sum(a->in[22][l * 64 + i] * a->in[23][l * 64 + i]);
            if (i == 0) sm[l] = expf(d1) - expf(d2) + (0.8f - 0.6f * expf(-0.3f * (float)l)); }
        for (int idx = tid; idx < 4 * 132; idx += 512) { const int h = idx / 132, n = idx % 132; int bk;
            if (n < 16) bk = n; else { const float nf = (float)n; int lg = 16 + (int)(logf(nf / 16.f) / 2.0794415416798357f * 16.f); bk = lg < 31 ? lg : 31; }
            sm[16 + idx] = a->in[2][bk * 4 + h] * LOG2E; }
    }
    { LAS float* scr = (LAS float*)(lds + wave * 16384);
      const int gw = bid * 8 + wave, NGW = G * 8;
      const int nssm = (G > DEPTH * NG) ? DEPTH * NG : 0;
      for (int it = (bid - nssm) * 8 + wave; bid >= nssm && it < DEPTH * 12288; it += (G - nssm) * 8) {
          const int l = it / 12288; int r = it % 12288; unsigned char* wl = ws + WS_W + l * W_LAYER;
          const GainSpec none{nullptr, nullptr, 0.f};
          if (r < 1408) { transpose_item(a->in[4] + (size_t)l * D * FF, D, FF, (bf16_t*)(wl + W_GU1), true, FF, 0, GainSpec{a->in[3] + l * D, nullptr, 0.f}, scr, r, lane); continue; } r -= 1408;
          if (r < 1408) { transpose_item(a->in[5] + (size_t)l * D * FF, D, FF, (bf16_t*)(wl + W_GU1), true, FF, 1, GainSpec{a->in[3] + l * D, nullptr, 0.f}, scr, r, lane); continue; } r -= 1408;
          if (r < 1408) { transpose_item(a->in[6] + (size_t)l * FF * D, FF, D, (bf16_t*)(wl + W_D1), false, 1, 0, none, scr, r, lane); continue; } r -= 1408;
          if (r < 1408) { transpose_item(a->in[32] + (size_t)l * D * FF, D, FF, (bf16_t*)(wl + W_GU2), true, FF, 0, GainSpec{a->in[31] + l * D, nullptr, 0.f}, scr, r, lane); continue; } r -= 1408;
          if (r < 1408) { transpose_item(a->in[33] + (size_t)l * D * FF, D, FF, (bf16_t*)(wl + W_GU2), true, FF, 1, GainSpec{a->in[31] + l * D, nullptr, 0.f}, scr, r, lane); continue; } r -= 1408;
          if (r < 1408) { transpose_item(a->in[34] + (size_t)l * FF * D, FF, D, (bf16_t*)(wl + W_D2), false, 1, 0, none, scr, r, lane); continue; } r -= 1408;
          if (r < 1024) { transpose_item(a->in[8] + (size_t)l * D * 2048, D, 2048, (bf16_t*)(wl + W_IN), false, 1, 0, GainSpec{a->in[7] + l * D, nullptr, 0.f}, scr, r, lane); continue; } r -= 1024;
          if (r < 256) { transpose_item(a->in[17] + (size_t)l * 512 * 1024, 512, 1024, (bf16_t*)(wl + W_GLU), true, 512, 0, none, scr, r, lane); continue; } r -= 256;
          if (r < 512) { transpose_item(a->in[25] + (size_t)l * D * D, D, D, (bf16_t*)(wl + W_OUT), false, 1, 0, GainSpec{a->in[19] + l * 512, a->in[24] + l * 128, 1.f - (0.8f - 0.6f * expf(-0.3f * (float)l))}, scr, r, lane); continue; } r -= 512;
          if (r < 512) { transpose_item(a->in[28] + (size_t)l * D * D, D, D, (bf16_t*)(wl + W_Q), false, 1, 0, GainSpec{a->in[26] + l * D, nullptr, 0.f}, scr, r, lane); continue; } r -= 512;
          if (r < 1024) { transpose_item(a->in[29] + (size_t)l * D * 2048, D, 2048, (bf16_t*)(wl + W_KV), false, 1, 0, none, scr, r, lane); continue; } r -= 1024;
          transpose_item(a->in[30] + (size_t)l * D * D, D, D, (bf16_t*)(wl + W_O), false, 1, 0, none, scr, r, lane);
      }
      for (int row0 = gw; row0 < T + DEPTH * BATCH * MEM; row0 += 2 * NGW) {
          f32x4 v[2][4]; bool ok[2];
#pragma unroll
          for (int k = 0; k < 2; ++k) { const int row = row0 + k * NGW; ok[k] = row < T + DEPTH * BATCH * MEM;
              const bool ismem = row >= T; const int mrow = (row - T) & 1023;
              const float* src = ismem ? a->in[1] + (size_t)mrow * D : a->in[0] + (size_t)row * D;
              if (ok[k]) {
#pragma unroll
                  for (int j = 0; j < 4; ++j) v[k][j] = *((const f32x4*)src + lane + 64 * j); } }
#pragma unroll
          for (int k = 0; k < 2; ++k) { if (!ok[k]) continue;
              const int row = row0 + k * NGW; const bool ismem = row >= T; const int mr = row - T, l = mr >> 10, mrow = mr & 1023;
              float s = 0.f;
#pragma unroll
              for (int j = 0; j < 4; ++j) s += (v[k][j][0] * v[k][j][0] + v[k][j][1] * v[k][j][1]) + (v[k][j][2] * v[k][j][2] + v[k][j][3] * v[k][j][3]);
              s = wave_sum(s);
              if (!ismem) { if (lane < 16) ((float*)(ws + WS_SS))[(size_t)row * 16 + lane] = lane == 0 ? s : 0.f;
#pragma unroll
                  for (int j = 0; j < 4; ++j) *((u32x2*)(ws + WS_HB + (size_t)row * D * 2) + lane + 64 * j) = (u32x2){cvtpk(v[k][j][0], v[k][j][1]), cvtpk(v[k][j][2], v[k][j][3])};
              } else { const float rs = rsqrtf(s * (1.f / D) + EPS); const float* gn = a->in[27] + l * D;
#pragma unroll
                  for (int j = 0; j < 4; ++j) { const f32x4 gg = *((const f32x4*)gn + lane + 64 * j);
                      *((u32x2*)(ws + WS_MEMN + ((size_t)l * 1024 + mrow) * D * 2) + lane + 64 * j) = (u32x2){cvtpk(v[k][j][0] * rs * gg[0], v[k][j][1] * rs * gg[1]), cvtpk(v[k][j][2] * rs * gg[2], v[k][j][3] * rs * gg[3])}; }
              }
          }
      }
    }
}

constexpr int AT_KROW = 256, AT_VROW = 128, AT_KBUF = 64 * AT_KROW, AT_VBUF = 128 * AT_VROW;
constexpr int AT_NBUF = 3, AT_K0 = 0, AT_V0 = AT_NBUF * AT_KBUF, AT_BIAS = AT_V0 + AT_NBUF * AT_VBUF;

__device__ __forceinline__ void at_tile(LAS unsigned char* Kb, LAS unsigned char* Vb, const LAS float* biasl, int r, int g, int k0, int qw0, int qrow, float cfar,
                                        const bf16x8 (&qf)[2][2], float (&mrow)[2], f32x4 (&ol)[2], f32x4 (&o)[2][8], bool first) {
    f32x4 s[2][4];
    const bool far = (qw0 - (k0 + 63)) >= 128;
    const float cf = far ? cfar : 0.f;
    const float ci0 = first ? cf : cf - mrow[0], ci1 = first ? cf : cf - mrow[1];
    bf16x8 kfa[8], kfb[8];
#pragma unroll
    for (int kb = 0; kb < 4; ++kb)
#pragma unroll
        for (int ks = 0; ks < 2; ++ks) kfa[kb * 2 + ks] = *(const LAS bf16x8*)(Kb + (kb * 16 + r) * AT_KROW + (((ks * 4 + g) ^ r) * 16));
    __builtin_amdgcn_sched_barrier(0);
#pragma unroll
    for (int kb = 0; kb < 4; ++kb)
#pragma unroll
        for (int ks = 0; ks < 2; ++ks) kfb[kb * 2 + ks] = *(const LAS bf16x8*)(Kb + (kb * 16 + r) * AT_KROW + (((8 + ks * 4 + g) ^ r) * 16));
    __builtin_amdgcn_sched_barrier(0);
#pragma unroll
    for (int kb = 0; kb < 4; ++kb) s[0][kb] = __builtin_amdgcn_mfma_f32_16x16x32_bf16(kfa[kb * 2], qf[0][0], (f32x4){ci0, ci0, ci0, ci0}, 0, 0, 0);
#pragma unroll
    for (int kb = 0; kb < 4; ++kb) s[0][kb] = __builtin_amdgcn_mfma_f32_16x16x32_bf16(kfa[kb * 2 + 1], qf[0][1], s[0][kb], 0, 0, 0);
    __builtin_amdgcn_sched_barrier(0);
    bf16x8 vf[16];
#pragma unroll
    for (int db = 0; db < 4; ++db)
#pragma unroll
        for (int kk = 0; kk < 2; ++kk) vf[db * 2 + kk] = *(const LAS bf16x8*)(Vb + (db * 16 + r) * AT_VROW + (((kk * 4 + g) ^ (r >> 1)) * 16));
    __builtin_amdgcn_sched_barrier(0);
#pragma unroll
    for (int kb = 0; kb < 4; ++kb) s[1][kb] = __builtin_amdgcn_mfma_f32_16x16x32_bf16(kfb[kb * 2], qf[1][0], (f32x4){ci1, ci1, ci1, ci1}, 0, 0, 0);
#pragma unroll
    for (int kb = 0; kb < 4; ++kb) s[1][kb] = __builtin_amdgcn_mfma_f32_16x16x32_bf16(kfb[kb * 2 + 1], qf[1][1], s[1][kb], 0, 0, 0);
    __builtin_amdgcn_sched_barrier(0);
    if (!far) {
        float badd[4][4];
#pragma unroll
        for (int kb = 0; kb < 4; ++kb)
#pragma unroll
            for (int j = 0; j < 4; ++j) { const int key = k0 + (kb >> 1) * 32 + g * 8 + (kb & 1) * 4 + j, dist = qrow - key;
                const int idx = dist < 0 ? 0 : (dist > 128 ? 128 : dist);
                badd[kb][j] = biasl[idx]; }
#pragma unroll
        for (int kb = 0; kb < 4; ++kb)
#pragma unroll
            for (int j = 0; j < 4; ++j) { const int key = k0 + (kb >> 1) * 32 + g * 8 + (kb & 1) * 4 + j;
                const float ad = (qrow >= key) ? badd[kb][j] : -INFINITY;
                s[0][kb][j] += ad; s[1][kb][j] += ad; }
    }
    float mx[2];
#pragma unroll
    for (int m = 0; m < 2; ++m) {
        float v = max3f(s[m][0][0], s[m][0][1], s[m][0][2]);
        v = max3f(v, s[m][0][3], s[m][1][0]); v = max3f(v, s[m][1][1], s[m][1][2]); v = max3f(v, s[m][1][3], s[m][2][0]);
        v = max3f(v, s[m][2][1], s[m][2][2]); v = max3f(v, s[m][2][3], s[m][3][0]); v = max3f(v, s[m][3][1], s[m][3][2]); v = max2f(v, s[m][3][3]);
        mx[m] = xl_max(v);
    }
#pragma unroll
    for (int db = 4; db < 8; ++db)
#pragma unroll
        for (int kk = 0; kk < 2; ++kk) vf[db * 2 + kk] = *(const LAS bf16x8*)(Vb + (db * 16 + r) * AT_VROW + (((kk * 4 + g) ^ (r >> 1)) * 16));
    __builtin_amdgcn_sched_barrier(0);
    if (first || __any(max2f(mx[0], mx[1]) > 6.0f)) {
#pragma unroll
        for (int m = 0; m < 2; ++m) {
            const float delta = first ? mx[m] : fmaxf(mx[m], 0.f), alpha = first ? 0.f : fast_exp2(-delta);
            mrow[m] = first ? delta : mrow[m] + delta;
            ol[m] = ol[m] * alpha;
#pragma unroll
            for (int db = 0; db < 8; ++db) o[m][db] = o[m][db] * alpha;
#pragma unroll
            for (int kb = 0; kb < 4; ++kb) s[m][kb] = s[m][kb] - delta;
        }
    }
#pragma unroll
    for (int kb = 0; kb < 4; ++kb)
#pragma unroll
        for (int j = 0; j < 4; ++j) s[0][kb][j] = fast_exp2(s[0][kb][j]);
    bf16x8 pf0[2], pf1[2];
#pragma unroll
    for (int kk = 0; kk < 2; ++kk) { const u32x4 pw = pack8(s[0][2 * kk], s[0][2 * kk + 1]); pf0[kk] = __builtin_bit_cast(bf16x8, pw); }
    __builtin_amdgcn_sched_barrier(0);
#pragma unroll
    for (int i = 0; i < 16; ++i) {
        const int db = i >> 1, kk = i & 1;
        o[0][db] = __builtin_amdgcn_mfma_f32_16x16x32_bf16(vf[db * 2 + kk], pf0[kk], o[0][db], 0, 0, 0);
        s[1][i >> 2][i & 3] = fast_exp2(s[1][i >> 2][i & 3]);
        __builtin_amdgcn_sched_barrier(0);
    }
    const short one = (short)0x3F80; const bf16x8 ones = {one, one, one, one, one, one, one, one};
    ol[0] = __builtin_amdgcn_mfma_f32_16x16x32_bf16(ones, pf0[0], ol[0], 0, 0, 0);
    ol[0] = __builtin_amdgcn_mfma_f32_16x16x32_bf16(ones, pf0[1], ol[0], 0, 0, 0);
#pragma unroll
    for (int kk = 0; kk < 2; ++kk) { const u32x4 pw = pack8(s[1][2 * kk], s[1][2 * kk + 1]); pf1[kk] = __builtin_bit_cast(bf16x8, pw); }
    __builtin_amdgcn_sched_barrier(0);
#pragma unroll
    for (int kk = 0; kk < 2; ++kk)
#pragma unroll
        for (int db = 0; db < 8; ++db) o[1][db] = __builtin_amdgcn_mfma_f32_16x16x32_bf16(vf[db * 2 + kk], pf1[kk], o[1][db], 0, 0, 0);
    ol[1] = __builtin_amdgcn_mfma_f32_16x16x32_bf16(ones, pf1[0], ol[1], 0, 0, 0);
    ol[1] = __builtin_amdgcn_mfma_f32_16x16x32_bf16(ones, pf1[1], ol[1], 0, 0, 0);
    __builtin_amdgcn_sched_barrier(0);
}

__device__ __forceinline__ void attn_qblock(int b, int h, int q0, float lam, LAS unsigned char* lds, const bf16_t* qbuf, const bf16_t* kbuf, const bf16_t* vT, bf16_t* mix, const float* bias_g, const float* ssm_sq, bool var) {
    int tid = threadIdx.x; asm volatile("" : "+v"(tid));
    const int lane = tid & 63, w = __builtin_amdgcn_readfirstlane(tid >> 6), r = lane & 15, g = lane >> 4;
    const int qw0 = q0 + w * 16, qrow = qw0 + r;
    LAS float* biasl = (LAS float*)(lds + AT_BIAS);
    __syncthreads();
    if (tid < 129) biasl[tid] = bias_g[h * 132 + tid];
    bf16x8 qf[2][2];
    { const bf16_t* qp = qbuf + ((size_t)(b * SEQ + qrow)) * 512 + h * 128 + g * 8;
#pragma unroll
      for (int m = 0; m < 2; ++m)
#pragma unroll
          for (int ks = 0; ks < 2; ++ks) qf[m][ks] = *(const bf16x8*)(qp + m * 64 + ks * 32); }
    f32x4 o[2][8];
#pragma unroll
    for (int m = 0; m < 2; ++m)
#pragma unroll
        for (int db = 0; db < 8; ++db) o[m][db] = (f32x4){0.f, 0.f, 0.f, 0.f};
    float mrow[2] = {0.f, 0.f};
    f32x4 ol[2] = {(f32x4){0.f, 0.f, 0.f, 0.f}, (f32x4){0.f, 0.f, 0.f, 0.f}};
    const int ntiles = (q0 + 128) >> 6;
    unsigned gk[2], gv[2];
#pragma unroll
    for (int i = 0; i < 2; ++i) { const int c = w + 8 * i;
        { const int rho = 4 * c + (lane >> 4), ph = lane & 15, ch = ph ^ (rho & 15), kb = rho >> 4, key = (kb >> 1) * 32 + ((rho >> 2) & 3) * 8 + (kb & 1) * 4 + (rho & 3); gk[i] = (unsigned)(key * 512 + ch * 8) * 2u; }
        { const int dv = 8 * c + (lane >> 3), ph = lane & 7, ch = ph ^ ((dv >> 1) & 7); gv[i] = (unsigned)(dv * SEQ + ch * 8) * 2u; } }
    const char* kbase = (const char*)(kbuf + ((size_t)b * SEQ) * 512 + h * 128);
    const char* vbase = (const char*)(vT + ((size_t)(b * 4 + h) * 128) * SEQ);
#define AT_STAGE(buf, k0_) do { _Pragma("unroll") for (int _i = 0; _i < 2; ++_i) { \
        __builtin_amdgcn_global_load_lds((const unsigned*)(kbase + (size_t)(k0_) * 1024 + gk[_i]), (LAS unsigned*)(lds + AT_K0 + (buf) * AT_KBUF + (w + 8 * _i) * 1024), 16, 0, 0); \
        __builtin_amdgcn_global_load_lds((const unsigned*)(vbase + (size_t)(k0_) * 2 + gv[_i]), (LAS unsigned*)(lds + AT_V0 + (buf) * AT_VBUF + (w + 8 * _i) * 1024), 16, 0, 0); } } while (0)
    AT_STAGE(0, 0);
    asm volatile("s_waitcnt vmcnt(0)" ::: "memory");
    __syncthreads();
    const float cfar = biasl[128];
    int cur = 0;
    for (int kt = 0; kt < ntiles; ++kt) {
        const int k0 = kt * 64, nxt = (cur == AT_NBUF - 1) ? 0 : cur + 1;
        if (kt + 1 < ntiles) AT_STAGE(nxt, k0 + 64);
        if (k0 <= qw0 + 15) at_tile(lds + AT_K0 + cur * AT_KBUF, lds + AT_V0 + cur * AT_VBUF, biasl, r, g, k0, qw0, qrow, cfar, qf, mrow, ol, o, kt == 0);
        asm volatile("s_waitcnt vmcnt(0)" ::: "memory");
        __syncthreads();
        cur = nxt;
    }
#undef AT_STAGE
    const float inv0 = 1.f / ol[0][0], inv1 = lam / ol[1][0];
    float ssq = 0.f;
#pragma unroll
    for (int db = 0; db < 8; ++db)
#pragma unroll
        for (int j = 0; j < 4; ++j) { const float v = o[0][db][j] * inv0 - o[1][db][j] * inv1; o[0][db][j] = v; ssq += v * v; }
    ssq = fq_sum(ssq);
    const float rn = rsqrtf(ssq * (1.f / 128.f) + EPS) * sqrtf(ss_sum16(ssm_sq, b * SEQ + qrow) * (1.f / 512.f) + EPS);
    bf16_t* op = mix + ((size_t)(b * SEQ + qrow)) * D + 512 + h * 128 + g * 4;
#pragma unroll
    for (int db = 0; db < 8; ++db) *(u32x2*)(op + db * 16) = (u32x2){cvtpk(o[0][db][0] * rn, o[0][db][1] * rn), cvtpk(o[0][db][2] * rn, o[0][db][3] * rn)};
}

#if DEBUG_CHECK
__device__ __forceinline__ unsigned hash_u(unsigned x) { x ^= x >> 16; x *= 0x7feb352dU; x ^= x >> 15; x *= 0x846ca68bU; x ^= x >> 16; return x; }
__device__ __forceinline__ void dbg_flag(unsigned* ctl, int id, float got, float ref, float rtol, float atol) {
    const float d = fabsf(got - ref);
    if (!(d <= atol + rtol * fabsf(ref))) atomicAdd(ctl + 64 + id, 1u);
}
#endif

__global__ void __launch_bounds__(512, 2) fwd_kernel(Args a) {
    extern __shared__ __attribute__((aligned(16))) unsigned char lds_raw[];
    LAS unsigned char* lds = (LAS unsigned char*)lds_raw;
    cg::grid_group grid = cg::this_grid();
    const int G = gridDim.x;
#define PH KArgsP ka = KARGS(); int bid = blockIdx.x, G = gridDim.x, tidl = threadIdx.x; asm volatile("" : "+s"(bid), "+s"(G), "+v"(tidl)); const int lane = tidl & 63, wave = tidl >> 6; (void)lane; (void)wave; unsigned char* ws = ka->ws; float* ssb = (float*)(ws + WS_SS); float* ssm_ss = (float*)(ws + WS_SSM_SS); const float* smalls = (const float*)(ws + WS_SMALL); \
    bf16_t* hb = (bf16_t*)(ws + WS_HB); unsigned char* ar = ws + WS_AR; unsigned char* wl = ws + WS_W + l * W_LAYER; float* hbuf = ka->out; \
    (void)ssb; (void)ssm_ss; (void)smalls; (void)hb; (void)ar; (void)wl; (void)hbuf;
    if (threadIdx.x < 2) ((LAS unsigned*)(lds + LDS_XB))[threadIdx.x] = 0u;
    __syncthreads();
    (void)xcd_barrier_post((unsigned*)(KARGS()->ws + WS_CTL) + 1024, (volatile LAS unsigned*)(lds + LDS_XB));
    for (int rep = 0; rep < (PROBE == 5 ? 2 : 1); ++rep) prologue(KARGS(), lds, G);
    grid.sync();
#define GSYNC() do { XcdBarrier xb_; xb_.bar = (unsigned*)(KARGS()->ws + WS_CTL) + 1024; xb_.x = xb_xcc_id(); xb_.st = (volatile LAS unsigned*)(lds + LDS_XB); xcd_barrier(xb_); } while (0)

    for (int l = 0; l < DEPTH; ++l) {
        if (PROBE == 4) { for (int rep = 0; rep < 10; ++rep) GSYNC(); }
        for (int rep = 0; rep < (PROBE == 2 ? 2 : 1); ++rep)
        { PH StdSched S; S.init(T, 2 * FF, G, bid, D, D); EpiFfnUp E{(bf16_t*)(ar + AR_HID), ssb + (size_t)(4 * l + 0) * T * 16, (const LAS float*)(lds + LDS_RS)};
          gemm_phase<EpiFfnUp, StdSched, true>(lds, hb, (const bf16_t*)(wl + W_GU1), D, D, D, S, E); }
        GSYNC();
        if (PROBE == 6) { PH StdSched S; S.init(T, D, G, bid, FF, FF); EpiNull E{(float*)(ws + WS_CTL + 20000)};
          gemm_phase<EpiNull, StdSched, false>(lds, (const bf16_t*)(ar + AR_HID), (const bf16_t*)(wl + W_D1), FF, FF, FF, S, E); }
        for (int rep = (PROBE == 7 ? 0 : 1); rep < 2; ++rep)
        { PH StdSched S; S.init(T, D, G, bid, FF, FF); EpiResid E{hb, ssb + (size_t)(4 * l + 1) * T * 16, (PROBE == 7 && rep == 0) ? 0.f : 0.5f, nullptr, nullptr};
          gemm_phase<EpiResid, StdSched, true>(lds, (const bf16_t*)(ar + AR_HID), (const bf16_t*)(wl + W_D1), FF, FF, FF, S, E); }
        GSYNC();
        for (int rep = 0; rep < (PROBE == 3 ? 2 : 1); ++rep)
        { PH StdSched S; S.init(T, 2048, G, bid, D, D); EpiWin E{ar, ssb + (size_t)(4 * l + 1) * T * 16, (const LAS float*)(lds + LDS_RS)};
          gemm_phase<EpiWin, StdSched, true>(lds, hb, (const bf16_t*)(wl + W_IN), D, D, D, S, E); }
        GSYNC();
        for (int rep = 0; rep < (PROBE == 3 ? 2 : 1); ++rep)
        if ((int)blockIdx.x < 128) { PH Ssm1Sched S{bid}; EpiSsm1 E{(bf16_t*)(ar + AR_UP), ka->in[9] + (size_t)l * NG * NP, ka->in[10] + (size_t)l * NG * NP, ka->in[16] + (size_t)l * NG};
          gemm_phase<EpiSsm1, Ssm1Sched, false>(lds, (const bf16_t*)(ar + AR_UP), (const bf16_t*)(wl + W_BM), UPW, 512, 512, S, E); }
        else if (l == 0) { PH WkvSched S{G, bid}; EpiWkv E{(bf16_t*)(ws + WS_KX), (bf16_t*)(ws + WS_VXT)};
          gemm_phase<EpiWkv, WkvSched, false>(lds, (const bf16_t*)(ws + WS_MEMN), (const bf16_t*)(ws + WS_W + W_KV), D, D, D, S, E); }
        GSYNC();
        for (int rep = 0; rep < (PROBE == 3 ? 2 : 1); ++rep)
        { PH Ssm2Sched S{G, bid}; EpiSsm2 E{(bf16_t*)(ar + AR_Y)};
          gemm_phase<EpiSsm2, Ssm2Sched, false>(lds, (const bf16_t*)(ar + AR_UP), (const bf16_t*)(wl + W_MT), UPW, UPW, UPW, S, E); }
        GSYNC();
        for (int rep = 0; rep < (PROBE == 8 ? 2 : 1); ++rep)
        { PH StdSched S; S.init(T, 1024, G, bid, 512, 512); EpiGlu E{(bf16_t*)(ar + AR_MIX), ka->in[18] + (size_t)l * 1024, ssm_ss + (size_t)l * T * 16};
          gemm_phase<EpiGlu, StdSched, true>(lds, (const bf16_t*)(ar + AR_Y), (const bf16_t*)(wl + W_GLU), 512, 512, 512, S, E); }
        GSYNC();
        { PH const float lam = smalls[l];
          for (int rep = 0; rep < ((PROBE == 1 || ATT_VAR) ? 2 : 1); ++rep)
          for (int uidx = bid; uidx < 512; uidx += G) { const bool var = ATT_VAR && rep == 0;
              int bh = uidx >> 5, j = uidx & 31;
              if (G == 256) { bh = (bid & 7) + 8 * (uidx >> 8); j = bid >> 3; }
              const int b = bh >> 2, h = bh & 3;
              attn_qblock(b, h, j * 128, lam, lds, (const bf16_t*)(ar + AR_Q), (const bf16_t*)(ar + AR_K), (const bf16_t*)(ar + AR_VT), (bf16_t*)(ar + AR_MIX), smalls + 16, ssm_ss + (size_t)l * T * 16, var);
              attn_qblock(b, h, (63 - j) * 128, lam, lds, (const bf16_t*)(ar + AR_Q), (const bf16_t*)(ar + AR_K), (const bf16_t*)(ar + AR_VT), (bf16_t*)(ar + AR_MIX), smalls + 16, ssm_ss + (size_t)l * T * 16, var); }
        }
        GSYNC();
        for (int rep = (PROBE == 7 ? 0 : 1); rep < 2; ++rep)
        { PH StdSched S; S.init(T, D, G, bid, D, D); EpiResidT<true> E{hb, ssb + (size_t)(4 * l + 2) * T * 16, (PROBE == 7 && rep == 0) ? 0.f : 1.f, ssm_ss + (size_t)l * T * 16, (const LAS float*)(lds + LDS_RS)};
          gemm_phase<EpiResidT<true>, StdSched, true>(lds, (const bf16_t*)(ar + AR_MIX), (const bf16_t*)(wl + W_OUT), D, D, D, S, E); }
        GSYNC();
        for (int rep = 0; rep < (PROBE == 3 ? 2 : 1); ++rep)
        { PH StdSched S; S.init(T, D, G, bid, D, D); EpiWq E{(bf16_t*)(ar + AR_QX), ssb + (size_t)(4 * l + 2) * T * 16, 0.0625f * LOG2E, (const LAS float*)(lds + LDS_RS)};
          gemm_phase<EpiWq, StdSched, true>(lds, hb, (const bf16_t*)(wl + W_Q), D, D, D, S, E); }
        GSYNC();
        for (int rep = 0; rep < (PROBE == 3 ? 2 : 1); ++rep)
        { PH XaSched S{G, bid, (unsigned)MEM * 1024, 256u}; EpiSoftmax E{(bf16_t*)(ar + AR_P), (LAS float*)(lds + LDS_RED)};
          gemm_phase<EpiSoftmax, XaSched, true>(lds, (const bf16_t*)(ar + AR_QX), (const bf16_t*)(ws + WS_KX) + (size_t)l * 1024 * 1024, D, D, 256, S, E); }
        GSYNC();
        for (int rep = 0; rep < (PROBE == 3 ? 2 : 1); ++rep)
        { PH XaSched S{G, bid, 4u * 65536u, 65536u}; EpiPV E{(bf16_t*)(ar + AR_OX)};
          gemm_phase<EpiPV, XaSched, false>(lds, (const bf16_t*)(ar + AR_P), (const bf16_t*)(ws + WS_VXT) + (size_t)l * 1024 * 1024, D, 256, 256, S, E); }
        GSYNC();
        for (int rep = (PROBE == 7 ? 0 : 1); rep < 2; ++rep)
        { PH StdSched S; S.init(T, D, G, bid, D, D); EpiResid E{hb, ssb + (size_t)(4 * l + 3) * T * 16, (PROBE == 7 && rep == 0) ? 0.f : 1.f, nullptr, nullptr};
          gemm_phase<EpiResid, StdSched, true>(lds, (const bf16_t*)(ar + AR_OX), (const bf16_t*)(wl + W_O), D, D, D, S, E); }
        GSYNC();
        for (int rep = 0; rep < (PROBE == 2 ? 2 : 1); ++rep)
        { PH StdSched S; S.init(T, 2 * FF, G, bid, D, D); EpiFfnUp E{(bf16_t*)(ar + AR_HID), ssb + (size_t)(4 * l + 3) * T * 16, (const LAS float*)(lds + LDS_RS)};
          gemm_phase<EpiFfnUp, StdSched, true>(lds, hb, (const bf16_t*)(wl + W_GU2), D, D, D, S, E); }
        GSYNC();
        if (PROBE == 6) { PH StdSched S; S.init(T, D, G, bid, FF, FF); EpiNull E{(float*)(ws + WS_CTL + 20000)};
          gemm_phase<EpiNull, StdSched, false>(lds, (const bf16_t*)(ar + AR_HID), (const bf16_t*)(wl + W_D2), FF, FF, FF, S, E); }
        for (int rep = (PROBE == 7 ? 0 : 1); rep < 2; ++rep)
        { PH StdSched S; S.init(T, D, G, bid, FF, FF); EpiResid E{hb, ssb + (size_t)(4 * l + 4) * T * 16, (PROBE == 7 && rep == 0) ? 0.f : 0.5f, nullptr, nullptr};
          gemm_phase<EpiResid, StdSched, true>(lds, (const bf16_t*)(ar + AR_HID), (const bf16_t*)(wl + W_D2), FF, FF, FF, S, E); }
        GSYNC();
    }
    { const int l = 0; PH const float* sq = ssb + (size_t)8 * T * 16; const float* gn = ka->in[35];
      const f32x4 ga0 = *((const f32x4*)gn + 2 * lane), ga1 = *((const f32x4*)gn + 2 * lane + 1), gb0 = *((const f32x4*)gn + 2 * (lane + 64)), gb1 = *((const f32x4*)gn + 2 * (lane + 64) + 1);
      for (int row0 = bid * 8 + wave; row0 < T; row0 += 2 * G * 8) {
          u32x4 w[2][2]; float rs[2];
#pragma unroll
          for (int k = 0; k < 2; ++k) { const int row = row0 + k * G * 8;
              if (row < T) { w[k][0] = *((const u32x4*)(hb + (size_t)row * D) + lane); w[k][1] = *((const u32x4*)(hb + (size_t)row * D) + lane + 64); rs[k] = rsqrtf(ss_sum16(sq, row) * (1.f / D) + EPS); } }
#pragma unroll
          for (int k = 0; k < 2; ++k) { const int row = row0 + k * G * 8; if (row >= T) continue;
#pragma unroll
              for (int j = 0; j < 2; ++j) { const u32x4 x = w[k][j]; const f32x4 g0 = j ? gb0 : ga0, g1 = j ? gb1 : ga1; const float r_ = rs[k];
                  f32x4 v0, v1;
                  v0[0] = __uint_as_float(x.x << 16) * r_ * g0[0]; v0[1] = __uint_as_float(x.x & 0xffff0000u) * r_ * g0[1]; v0[2] = __uint_as_float(x.y << 16) * r_ * g0[2]; v0[3] = __uint_as_float(x.y & 0xffff0000u) * r_ * g0[3];
                  v1[0] = __uint_as_float(x.z << 16) * r_ * g1[0]; v1[1] = __uint_as_float(x.z & 0xffff0000u) * r_ * g1[1]; v1[2] = __uint_as_float(x.w << 16) * r_ * g1[2]; v1[3] = __uint_as_float(x.w & 0xffff0000u) * r_ * g1[3];
                  f32x4* op = (f32x4*)(hbuf + (size_t)row * D) + 2 * (lane + 64 * j); op[0] = v0; op[1] = v1; } } } }
}

extern "C" void kernel_launch(void* const* d_in, const int* in_sizes, int n_in, void* d_out, int out_size, void* d_ws, size_t ws_size, hipStream_t stream) {
    static int grid = 0;
    if (grid == 0) {
        if (n_in != 36 || out_size != T * D || ws_size < WS_END) { fprintf(stderr, "kernel_launch: unexpected problem (n_in %d out %d ws %zu)\n", n_in, out_size, ws_size); grid = -1; return; }
        int dev = 0, cus = 0, per_cu = 0;
        if (hipGetDevice(&dev) != hipSuccess || hipDeviceGetAttribute(&cus, hipDeviceAttributeMultiprocessorCount, dev) != hipSuccess) { grid = -1; return; }
        if (hipFuncSetAttribute((const void*)fwd_kernel, hipFuncAttributeMaxDynamicSharedMemorySize, LDS_BYTES) != hipSuccess) { fprintf(stderr, "hipFuncSetAttribute failed\n"); grid = -1; return; }
        if (hipOccupancyMaxActiveBlocksPerMultiprocessor(&per_cu, (const void*)fwd_kernel, 512, LDS_BYTES) != hipSuccess || per_cu < 1) { fprintf(stderr, "occupancy query: %d\n", per_cu); }
        (void)hipGetLastError();
        grid = cus;
        if (grid != 256) fprintf(stderr, "kernel_launch: %d CUs (expected 256)\n", grid);
    }
    if (grid < 0) return;
    (void)hipMemsetAsync((char*)d_ws + WS_CTL, 0, 32768, stream);
    Args a{};
    for (int i = 0; i < 36; ++i) a.in[i] = (const float*)d_in[i];
    a.out = (float*)d_out; a.ws = (unsigned char*)d_ws;
    void* args[] = {&a};
    hipError_t e = hipLaunchCooperativeKernel((const void*)fwd_kernel, dim3(grid), dim3(512), args, LDS_BYTES, stream);
    if (e != hipSuccess) fprintf(stderr, "cooperative launch failed: %s (grid %d)\n", hipGetErrorString(e), grid);
}
```
